# Optimizing an MI355X kernel written in HIP

```python
import jax, jax.numpy as jnp
from jax import lax
import numpy as np

D_MODEL = 1024
BATCH = 4
SEQ = 4096
DEPTH = 1

CHUNK = 64
Q_BLOCK = 128
HEAD_DIM = 64
N_HEADS_A = 8
N_HEADS_B = 8
IDX_HEADS = 8
IDX_DIM = 64
TOPK_MAX = 256
ROPE_DIM = HEAD_DIM // 4
ROPE_THETA = 500000.0
N_GROUPS = 4
EXPERTS_PER_GROUP = 8
N_EXPERTS = N_GROUPS * EXPERTS_PER_GROUP
TOPK_IN_GROUP = 2
D_EXPERT = 512
EXPERT_BLOCK = 128
RMS_EPS = 1e-6
NEG_INF = -1e30
ATTN_SCALE = HEAD_DIM ** -0.5
IDX_SCALE = IDX_DIM ** -0.5

W_IN_SPLITS = (N_HEADS_A * HEAD_DIM, HEAD_DIM, HEAD_DIM, IDX_HEADS * IDX_DIM, IDX_DIM, IDX_HEADS,
               N_HEADS_B * HEAD_DIM, N_HEADS_B * HEAD_DIM, N_HEADS_B * HEAD_DIM, N_HEADS_B,
               D_MODEL, D_MODEL)
W_IN_COLS = sum(W_IN_SPLITS)

kernel_name = 'hybrid_dsa_fox_hiermoe_adaln_block'


def _split_cols(proj):
    offs = []
    acc = 0
    for w in W_IN_SPLITS[:-1]:
        acc += w
        offs.append(acc)
    return jnp.split(proj, offs, axis=-1)


def rmsnorm(t, g):
    tf = t.astype(jnp.float32)
    tf = tf * lax.rsqrt(jnp.mean(tf * tf, axis=-1, keepdims=True) + RMS_EPS)
    return (tf * g.astype(jnp.float32)).astype(t.dtype)


def modulate(h, shift, scale):
    return h * (1.0 + scale[:, None, :]) + shift[:, None, :]


def rope_tables(positions):
    inv_freq = ROPE_THETA ** (-jnp.arange(0, ROPE_DIM, 2, dtype=jnp.float32) / ROPE_DIM)
    ang = positions.astype(jnp.float32)[..., None] * inv_freq
    return jnp.cos(ang), jnp.sin(ang)


def partial_rope(t, cos, sin):
    extra = t.ndim - 3
    cos = cos.reshape(cos.shape[:2] + (1,) * extra + cos.shape[2:])
    sin = sin.reshape(sin.shape[:2] + (1,) * extra + sin.shape[2:])
    half = ROPE_DIM // 2
    r = t[..., :ROPE_DIM].astype(jnp.float32)
    r1, r2 = r[..., :half], r[..., half:]
    rot = jnp.concatenate([r1 * cos - r2 * sin, r2 * cos + r1 * sin], axis=-1)
    return jnp.concatenate([rot.astype(t.dtype), t[..., ROPE_DIM:]], axis=-1)


def token_mixers(h, cos, sin, w_in, b_forget, w_out_a, w_out_b, w_out):
    B, S, _ = h.shape
    nb = S // Q_BLOCK
    topk = min(TOPK_MAX, S // 4)
    qa, ka, va, qi, ki, wi, qb, kb, vb, fb, ga, gb = _split_cols(h @ w_in)

    qa = partial_rope(qa.reshape(B, S, N_HEADS_A, HEAD_DIM), cos, sin)
    ka = partial_rope(ka, cos, sin)
    qi = partial_rope(qi.reshape(B, S, IDX_HEADS, IDX_DIM), cos, sin)
    ki = partial_rope(ki, cos, sin)
    wi = wi * IDX_HEADS ** -0.5
    chunk_id = jnp.arange(S) // CHUNK

    def blocks(t):
        return jnp.swapaxes(t.reshape((B, nb, Q_BLOCK) + t.shape[2:]), 0, 1)

    def unblock(t):
        return jnp.swapaxes(t, 0, 1).reshape((B, S) + t.shape[3:])

    def dsa_block(args):
        bi, q_blk, qi_blk, wi_blk = args
        q_chunk = (bi * Q_BLOCK + jnp.arange(Q_BLOCK)) // CHUNK
        rel = jnp.einsum('bqhd,bsd->bqhs', qi_blk, ki,
                         preferred_element_type=jnp.float32) * IDX_SCALE
        score = jnp.einsum('bqh,bqhs->bqs', wi_blk.astype(jnp.float32), jax.nn.relu(rel))
        admissible = chunk_id[None, :] <= q_chunk[:, None]
        score = jnp.where(admissible[None], score, NEG_INF)
        _, sel = lax.top_k(score, topk)
        valid = chunk_id[sel] <= q_chunk[None, :, None]
        k_sel = jax.vmap(lambda t, i: t[i])(ka, sel)
        v_sel = jax.vmap(lambda t, i: t[i])(va, sel)
        logit = jnp.einsum('bqhd,bqkd->bqhk', q_blk, k_sel,
                           preferred_element_type=jnp.float32) * ATTN_SCALE
        logit = jnp.where(valid[:, :, None, :], logit, NEG_INF)
        p = jax.nn.softmax(logit, axis=-1).astype(v_sel.dtype)
        return jnp.einsum('bqhk,bqkd->bqhd', p, v_sel)

    oa = unblock(lax.map(dsa_block, (jnp.arange(nb), blocks(qa), blocks(qi), blocks(wi))))

    qb = qb.reshape(B, S, N_HEADS_B, HEAD_DIM)
    kb = kb.reshape(B, S, N_HEADS_B, HEAD_DIM)
    vb = vb.reshape(B, S, N_HEADS_B, HEAD_DIM)
    logf = jax.nn.log_sigmoid(fb.astype(jnp.float32) + b_forget.astype(jnp.float32))
    cum = jnp.cumsum(logf, axis=1)
    cum_t = jnp.swapaxes(cum, 1, 2)
    key_pos = jnp.arange(S)

    def fox_block(args):
        bi, q_blk, cq_blk = args
        q_pos = bi * Q_BLOCK + jnp.arange(Q_BLOCK)
        logit = jnp.einsum('bqhd,bshd->bhqs', q_blk, kb,
                           preferred_element_type=jnp.float32) * ATTN_SCALE
        logit = logit + jnp.swapaxes(cq_blk, 1, 2)[..., None] - cum_t[:, :, None, :]
        causal = key_pos[None, :] <= q_pos[:, None]
        logit = jnp.where(causal[None, None], logit, NEG_INF)
        p = jax.nn.softmax(logit, axis=-1).astype(vb.dtype)
        return jnp.einsum('bhqs,bshd->bqhd', p, vb)

    ob = unblock(lax.map(fox_block, (jnp.arange(nb), blocks(qb), blocks(cum))))

    ya = oa.reshape(B, S, N_HEADS_A * HEAD_DIM) @ w_out_a
    yb = ob.reshape(B, S, N_HEADS_B * HEAD_DIM) @ w_out_b
    merged = jax.nn.sigmoid(ga) * ya + jax.nn.sigmoid(gb) * yb
    return merged @ w_out


def hier_moe(h, w_group, b_group, w_router, b_router, w_e_gate, w_e_up, w_e_down):
    B, S, D = h.shape
    xt = h.reshape(B * S, D)
    N = xt.shape[0]
    g_logits = (xt @ w_group).astype(jnp.float32) + b_group.astype(jnp.float32)
    g_prob = jax.nn.softmax(g_logits, axis=-1)
    grp = jnp.argmax(g_logits, axis=-1)
    p_grp = jnp.take_along_axis(g_prob, grp[:, None], axis=1)[:, 0]
    e_logits = ((xt @ w_router).astype(jnp.float32) + b_router.astype(jnp.float32))
    e_logits = e_logits.reshape(N, N_GROUPS, EXPERTS_PER_GROUP)
    e_in = jnp.take_along_axis(e_logits, grp[:, None, None], axis=1)[:, 0]
    top_v, top_i = lax.top_k(e_in, TOPK_IN_GROUP)
    gate_w = jax.nn.softmax(top_v, axis=-1) * p_grp[:, None]
    eid = grp[:, None] * EXPERTS_PER_GROUP + top_i

    A = N * TOPK_IN_GROUP
    flat_e = eid.reshape(-1)
    flat_tok = jnp.repeat(jnp.arange(N, dtype=jnp.int32), TOPK_IN_GROUP)
    flat_w = gate_w.reshape(-1)
    order = jnp.argsort(flat_e)
    se, stok, sw = flat_e[order], flat_tok[order], flat_w[order]
    counts = jnp.bincount(flat_e, length=N_EXPERTS)
    start = jnp.cumsum(counts) - counts
    padded = (counts + EXPERT_BLOCK - 1) // EXPERT_BLOCK * EXPERT_BLOCK
    pend = jnp.cumsum(padded)
    pstart = pend - padded
    dest = pstart[se] + (jnp.arange(A) - start[se])
    P = (A + EXPERT_BLOCK - 1) // EXPERT_BLOCK * EXPERT_BLOCK + N_EXPERTS * EXPERT_BLOCK
    n_blocks = P // EXPERT_BLOCK
    tok_buf = jnp.zeros((P,), jnp.int32).at[dest].set(stok)
    w_buf = jnp.zeros((P,), jnp.float32).at[dest].set(sw)
    block_e = jnp.minimum(jnp.searchsorted(pend, jnp.arange(n_blocks) * EXPERT_BLOCK, side='right'),
                          N_EXPERTS - 1)

    def expert_block(args):
        e, toks = args
        xb = xt[toks]
        hid = jax.nn.silu(xb @ w_e_gate[e]) * (xb @ w_e_up[e])
        return hid @ w_e_down[e]

    y_buf = lax.map(expert_block, (block_e, tok_buf.reshape(n_blocks, EXPERT_BLOCK)))
    contrib = (y_buf.reshape(P, D) * w_buf[:, None]).astype(xt.dtype)
    y = jnp.zeros_like(xt).at[tok_buf].add(contrib)
    return y.reshape(B, S, D)


def setup_inputs(seed: int = 0) -> dict:
    key = jax.random.key(seed)
    ks = jax.random.split(key, 24)
    L, D = DEPTH, D_MODEL

    def nrm(k, shape, scale):
        return jax.random.normal(k, shape, jnp.float32) * scale

    x = nrm(ks[0], (BATCH, SEQ, D), 1.0)
    c = nrm(ks[1], (BATCH, D), 1.0)
    start = jax.random.randint(ks[2], (BATCH, 1), 0, 64, dtype=jnp.int32) * CHUNK
    positions = (start + jnp.arange(SEQ, dtype=jnp.int32)[None, :]).astype(jnp.int32)
    return {
        'x': x,
        'c': c,
        'positions': positions,
        'w_mod': nrm(ks[3], (L, D, 6 * D), D ** -0.5),
        'b_mod': nrm(ks[4], (L, 6 * D), 0.02),
        'g_mix': 1.0 + nrm(ks[5], (L, D), 0.02),
        'w_in': nrm(ks[6], (L, D, W_IN_COLS), D ** -0.5),
        'b_forget': 2.0 + nrm(ks[7], (L, N_HEADS_B), 0.5),
        'w_out_a': nrm(ks[8], (L, N_HEADS_A * HEAD_DIM, D), (N_HEADS_A * HEAD_DIM) ** -0.5),
        'w_out_b': nrm(ks[9], (L, N_HEADS_B * HEAD_DIM, D), (N_HEADS_B * HEAD_DIM) ** -0.5),
        'w_out': nrm(ks[10], (L, D, D), D ** -0.5),
        'g_ffn': 1.0 + nrm(ks[11], (L, D), 0.02),
        'w_group': nrm(ks[12], (L, D, N_GROUPS), D ** -0.5),
        'b_group': nrm(ks[13], (L, N_GROUPS), 0.01),
        'w_router': nrm(ks[14], (L, D, N_EXPERTS), D ** -0.5),
        'b_router': nrm(ks[15], (L, N_EXPERTS), 0.01),
        'w_e_gate': nrm(ks[16], (L, N_EXPERTS, D, D_EXPERT), D ** -0.5),
        'w_e_up': nrm(ks[17], (L, N_EXPERTS, D, D_EXPERT), D ** -0.5),
        'w_e_down': nrm(ks[18], (L, N_EXPERTS, D_EXPERT, D), D_EXPERT ** -0.5),
        'g_final': 1.0 + nrm(ks[19], (D,), 0.02),
    }


def reference(x, c, positions, w_mod, b_mod, g_mix, w_in, b_forget, w_out_a, w_out_b, w_out,
              g_ffn, w_group, b_group, w_router, b_router, w_e_gate, w_e_up, w_e_down, g_final):
    cos, sin = rope_tables(positions)
    c_act = jax.nn.silu(c)
    for l in range(DEPTH):
        mod = c_act @ w_mod[l] + b_mod[l]
        sh1, sc1, gt1, sh2, sc2, gt2 = jnp.split(mod, 6, axis=-1)
        h = modulate(rmsnorm(x, g_mix[l]), sh1, sc1)
        x = x + gt1[:, None, :] * token_mixers(h, cos, sin, w_in[l], b_forget[l],
                                               w_out_a[l], w_out_b[l], w_out[l])
        h = modulate(rmsnorm(x, g_ffn[l]), sh2, sc2)
        x = x + gt2[:, None, :] * hier_moe(h, w_group[l], b_group[l], w_router[l], b_router[l],
                                           w_e_gate[l], w_e_up[l], w_e_down[l])
    return rmsnorm(x, g_final)
```

```cpp
#define MK_N_LAUNCHES 1
#include <hip/hip_runtime.h>
#include <hip/hip_bf16.h>
#include <cstdio>
#include <cstdint>
#include <cmath>
namespace pg8 {
#define PG8_LAS __attribute__((address_space(3)))
typedef unsigned short bf16_t;
typedef short bf16x8 __attribute__((ext_vector_type(8)));
typedef float f32x4 __attribute__((ext_vector_type(4)));
typedef unsigned u32x4 __attribute__((ext_vector_type(4)));
constexpr int BM = 256, BK = 64, HALF = 128, HTB = HALF * BK * 2  , STAGE_BYTES = 8 * HTB, NXCD = 8, WGM = 8;

__host__ __device__ __forceinline__ int lds_byte(int r, int c) { const int st = (r >> 4) * 2 + (c >> 5), rr = r & 15, cc = c & 31, ob = rr * 64 + cc * 2; return st * 1024 + (ob ^ (((ob >> 9) & 1) << 5)); }
__host__ __device__ __forceinline__ void stage_rc(int b, int& R, int& C) { const int st = b / 1024, sb = b % 1024, swz = sb ^ (((sb >> 9) & 1) << 5); R = (st >> 1) * 16 + swz / 64; C = (st & 1) * 32 + (swz % 64) / 2; }
__host__ __device__ __forceinline__ int perm32(int rho) { const int n = rho >> 4, i = rho & 15; return 8 * (i >> 2) + 4 * n + (i & 3); }

struct Unit { int pm, pn; };
struct Gemm { const bf16_t* A; const bf16_t* Bt; int M, N, K; };

struct StaticOrder {
    int nM, nN, nwg, G, c;
    __host__ __device__ void init(int M, int N, int G_, int c_) { nM = M / BM; nN = N / BM; nwg = nM * nN; G = G_; c = c_; }
    __host__ __device__ bool next(int i, Unit& u) const {
        const long L = (long)i * G + c; if (L >= nwg) return false;
        int wgid = (int)L; { const int q = nwg / NXCD, r = nwg % NXCD, xcd = wgid % NXCD, off = wgid / NXCD; wgid = (xcd < r ? xcd * (q + 1) : r * (q + 1) + (xcd - r) * q) + off; }
        const int nig = WGM * nN, gid = wgid / nig, fm = gid * WGM, gsz = (nM - fm) < WGM ? (nM - fm) : WGM;
        u.pm = fm + ((wgid % nig) % gsz); u.pn = (wgid % nig) / gsz; return true;
    }
    __device__ __forceinline__ void a_ready(const Unit&) const {}
    __device__ __forceinline__ void done(const Unit&) const {}
};

__device__ __forceinline__ unsigned cvt_pk_bf16(float lo, float hi) { unsigned r; asm volatile("v_cvt_pk_bf16_f32 %0, %1, %2" : "=v"(r) : "v"(lo), "v"(hi)); return r; }
typedef float f32x2 __attribute__((ext_vector_type(2)));
template <class Epi, class Sched, bool ALIGN_EPI = false, bool SP2 = false>
__device__ __forceinline__ void gemm_phase(PG8_LAS unsigned char* lds, const Gemm g, const Sched& S, const Epi& E) {
    const int tid = threadIdx.x, wid = __builtin_amdgcn_readfirstlane(tid >> 6), lane = tid & 63, wr = wid >> 2, wc = wid & 3, fr = lane & 15, fq = lane >> 4;
    const int K = g.K, nt = K / BK;
    unsigned voffA[2], voffB[2];
#pragma unroll
    for (int i = 0; i < 2; ++i) { int R, C; stage_rc(tid * 16 + i * 8192, R, C); const int Rb = Epi::PERM ? ((R & ~31) + perm32(R & 31)) : R;
        voffA[i] = (unsigned)(R * K + C) * 2u; voffB[i] = (unsigned)(Rb * K + C) * 2u; }
    const size_t kstep = (size_t)(BK * 2);
    const size_t hstep = (size_t)HALF * K * 2;
    const size_t tstep = 2 * hstep;
    const unsigned ldsw = (unsigned)wid * 1024u;
    const int aoff = lds_byte(wr * 64 + fr, fq * 8), boff = lds_byte(wc * 32 + fr, fq * 8);
#define PG8_SA(b, h) (((b) * 2 + (h)) * HTB)
#define PG8_SB(b, h) ((4 + (b) * 2 + (h)) * HTB)
#define PG8_STAGE(bufoff, gbase, voff) do { _Pragma("unroll") for (int _i = 0; _i < 2; ++_i) \
        __builtin_amdgcn_global_load_lds((const unsigned*)((const char*)(gbase) + (voff)[_i]), (PG8_LAS unsigned*)(lds + (bufoff) + ldsw + _i * 8192), 16, 0, 0); } while (0)
#define PG8_LDA(dst, b, h) do { _Pragma("unroll") for (int m = 0; m < 4; ++m) _Pragma("unroll") for (int k = 0; k < 2; ++k) dst[m][k] = *(const PG8_LAS bf16x8*)(lds + PG8_SA(b, h) + aoff + m * 2048 + k * 1024); } while (0)
#define PG8_LDB(dst, b, h) do { _Pragma("unroll") for (int n = 0; n < 2; ++n) _Pragma("unroll") for (int k = 0; k < 2; ++k) dst[n][k] = *(const PG8_LAS bf16x8*)(lds + PG8_SB(b, h) + boff + n * 2048 + k * 1024); } while (0)
#define PG8_MMA(ai, bj, At, Bt) do { __builtin_amdgcn_s_setprio(1); _Pragma("unroll") for (int m = 0; m < 4; ++m) _Pragma("unroll") for (int n = 0; n < 2; ++n) _Pragma("unroll") for (int k = 0; k < 2; ++k) \
        acc[ai][bj][m][n] = __builtin_amdgcn_mfma_f32_16x16x32_bf16(Bt[n][k], At[m][k], acc[ai][bj][m][n], 0, 0, 0); __builtin_amdgcn_s_setprio(0); } while (0)
#define PG8_WAIT_V(n) asm volatile("s_waitcnt vmcnt(" #n ")" ::: "memory")
#define PG8_WAIT_L(n) asm volatile("s_waitcnt lgkmcnt(" #n ")" ::: "memory")
#define PG8_BAR __builtin_amdgcn_s_barrier()
#define PG8_SCHED __builtin_amdgcn_sched_barrier(0)
    Unit cur, nxt; int ui = 0;
    if (!S.next(0, cur)) return;
    f32x4 acc[2][2][4][2];
#pragma unroll
    for (int a = 0; a < 2; ++a)
#pragma unroll
        for (int b = 0; b < 2; ++b)
#pragma unroll
            for (int m = 0; m < 4; ++m)
#pragma unroll
                for (int n = 0; n < 2; ++n) acc[a][b][m][n] = (f32x4){0.f, 0.f, 0.f, 0.f};
    bf16x8 At[4][2], B0[2][2], B1[2][2];
    const char* cA = (const char*)g.A + (size_t)cur.pm * tstep; const char* cB = (const char*)g.Bt + (size_t)cur.pn * tstep;
    S.a_ready(cur);
    if constexpr (SP2) {
        PG8_STAGE(PG8_SB(0, 0), cB, voffB); PG8_STAGE(PG8_SB(0, 1), cB + hstep, voffB); PG8_STAGE(PG8_SA(0, 0), cA, voffA); PG8_STAGE(PG8_SA(0, 1), cA + hstep, voffA);
        if (wr == 1) PG8_BAR;
        PG8_WAIT_V(2); PG8_BAR;
        PG8_STAGE(PG8_SB(1, 0), cB + kstep, voffB); PG8_STAGE(PG8_SA(1, 0), cA + kstep, voffA); PG8_STAGE(PG8_SB(1, 1), cB + hstep + kstep, voffB);
        PG8_WAIT_V(6); PG8_BAR;
    } else {
        PG8_STAGE(PG8_SB(0, 0), cB, voffB); PG8_STAGE(PG8_SA(0, 0), cA, voffA); PG8_STAGE(PG8_SB(0, 1), cB + hstep, voffB); PG8_STAGE(PG8_SA(0, 1), cA + hstep, voffA);
        if (wr == 1) PG8_BAR;
        PG8_WAIT_V(4); PG8_BAR;
        PG8_STAGE(PG8_SB(1, 0), cB + kstep, voffB); PG8_STAGE(PG8_SA(1, 0), cA + kstep, voffA); PG8_STAGE(PG8_SB(1, 1), cB + hstep + kstep, voffB);
        PG8_WAIT_V(6); PG8_BAR;
    }
    for (;;) {
        const bool has_next = S.next(ui + 1, nxt);
        const char* nA = has_next ? (const char*)g.A + (size_t)nxt.pm * tstep : cA; const char* nB = has_next ? (const char*)g.Bt + (size_t)nxt.pn * tstep : cB;
        for (int t = 0; t < nt; t += 2) {
            const bool last = (t == nt - 2);
            const char* a1 = cA + (size_t)(t + 1) * kstep;
            const char* a2 = last ? nA : cA + (size_t)(t + 2) * kstep; const char* b2 = last ? nB : cB + (size_t)(t + 2) * kstep;
            const char* a3 = a2 + kstep; const char* b3 = b2 + kstep;
            if (last && has_next) S.a_ready(nxt);
            if constexpr (SP2) {
            PG8_LDB(B0, 0, 0); PG8_LDB(B1, 0, 1); PG8_SCHED; PG8_LDA(At, 0, 0); PG8_STAGE(PG8_SA(1, 1), a1 + hstep, voffA);
            PG8_WAIT_V(8); PG8_WAIT_L(0); PG8_BAR; PG8_MMA(0, 0, At, B0); PG8_MMA(0, 1, At, B1); PG8_BAR; PG8_SCHED;
            PG8_LDA(At, 0, 1); PG8_STAGE(PG8_SB(0, 0), b2, voffB); PG8_STAGE(PG8_SB(0, 1), b2 + hstep, voffB); PG8_STAGE(PG8_SA(0, 0), a2, voffA);
            PG8_WAIT_V(8); PG8_WAIT_L(0); PG8_BAR; PG8_MMA(1, 0, At, B0); PG8_MMA(1, 1, At, B1); PG8_BAR; PG8_SCHED;
            PG8_LDB(B0, 1, 0); PG8_LDB(B1, 1, 1); PG8_SCHED; PG8_LDA(At, 1, 0); PG8_STAGE(PG8_SA(0, 1), a2 + hstep, voffA);
            PG8_WAIT_V(8); PG8_WAIT_L(0); PG8_BAR; PG8_MMA(0, 0, At, B0); PG8_MMA(0, 1, At, B1); PG8_BAR; PG8_SCHED;
            PG8_LDA(At, 1, 1); PG8_STAGE(PG8_SB(1, 0), b3, voffB); PG8_STAGE(PG8_SB(1, 1), b3 + hstep, voffB); PG8_STAGE(PG8_SA(1, 0), a3, voffA);
            PG8_WAIT_V(8); PG8_WAIT_L(0); PG8_BAR; PG8_MMA(1, 0, At, B0); PG8_MMA(1, 1, At, B1); PG8_BAR; PG8_SCHED;
            } else {
            PG8_LDB(B0, 0, 0); PG8_SCHED; PG8_LDA(At, 0, 0); PG8_STAGE(PG8_SA(1, 1), a1 + hstep, voffA);
            PG8_WAIT_L(8); PG8_BAR; PG8_WAIT_L(0); PG8_MMA(0, 0, At, B0); PG8_BAR; PG8_SCHED;
            PG8_LDB(B1, 0, 1); PG8_STAGE(PG8_SB(0, 0), b2, voffB);
            PG8_BAR; PG8_WAIT_L(0); PG8_MMA(0, 1, At, B1); PG8_BAR;
            PG8_LDA(At, 0, 1); PG8_STAGE(PG8_SA(0, 0), a2, voffA);
            PG8_BAR; PG8_WAIT_L(0); PG8_MMA(1, 0, At, B0); PG8_BAR; PG8_SCHED;
            PG8_STAGE(PG8_SB(0, 1), b2 + hstep, voffB);
            PG8_WAIT_V(6); PG8_BAR; PG8_MMA(1, 1, At, B1); PG8_BAR;
            PG8_LDB(B0, 1, 0); PG8_SCHED; PG8_LDA(At, 1, 0); PG8_STAGE(PG8_SA(0, 1), a2 + hstep, voffA);
            PG8_WAIT_L(8); PG8_BAR; PG8_WAIT_L(0); PG8_MMA(0, 0, At, B0); PG8_BAR; PG8_SCHED;
            PG8_LDB(B1, 1, 1); PG8_STAGE(PG8_SB(1, 0), b3, voffB);
            PG8_BAR; PG8_WAIT_L(0); PG8_MMA(0, 1, At, B1); PG8_BAR;
            PG8_LDA(At, 1, 1); PG8_STAGE(PG8_SA(1, 0), a3, voffA);
            PG8_BAR; PG8_WAIT_L(0); PG8_MMA(1, 0, At, B0); PG8_BAR; PG8_SCHED;
            PG8_STAGE(PG8_SB(1, 1), b3 + hstep, voffB);
            PG8_WAIT_V(6); PG8_BAR; PG8_MMA(1, 1, At, B1); PG8_BAR;
            }
        }
        if constexpr (ALIGN_EPI) { if (wr == 0) PG8_BAR; }
        if constexpr (!Epi::AFTER_DRAIN) { E(acc, cur, wr, wc, fr, fq); S.done(cur); }
        if (!has_next) break;
#pragma unroll
        for (int a = 0; a < 2; ++a)
#pragma unroll
            for (int b = 0; b < 2; ++b)
#pragma unroll
                for (int m = 0; m < 4; ++m)
#pragma unroll
                    for (int n = 0; n < 2; ++n) acc[a][b][m][n] = (f32x4){0.f, 0.f, 0.f, 0.f};
        cur = nxt; cA = nA; cB = nB; ++ui;
        if constexpr (ALIGN_EPI) { if (wr == 1) PG8_BAR; }
    }
    PG8_WAIT_V(0);
    if constexpr (!ALIGN_EPI) { if (wr == 0) PG8_BAR; }
    PG8_BAR;
    if constexpr (Epi::AFTER_DRAIN) { E.fused(acc, cur, wr, wc, fr, fq, lds, wid, lane); S.done(cur); }
#undef PG8_SA
#undef PG8_SB
#undef PG8_STAGE
#undef PG8_LDA
#undef PG8_LDB
#undef PG8_MMA
#undef PG8_WAIT_V
#undef PG8_WAIT_L
#undef PG8_BAR
#undef PG8_SCHED
}
}
constexpr int NWAVES = 8;
constexpr int BATCH = 4, SEQ = 4096, D = 1024, M = BATCH * SEQ;
constexpr int NPROJ = 4864;
constexpr float RMS_EPS = 1e-6f;
constexpr float LOG2E = 1.4426950408889634f;
constexpr float QSCALE = 0.125f * LOG2E;
constexpr int PMAX = 40960, NTMAX = 160;
constexpr int NPHASE = 11;
#ifndef MK_N_LAUNCHES
#define MK_N_LAUNCHES 1
#endif
constexpr int N_LAUNCHES = MK_N_LAUNCHES;

constexpr size_t MiB = 1u << 20;
constexpr size_t WS_CTL = 0, CTL_ZERO_BYTES = 1 * MiB;
constexpr size_t WS_MOD = 1 * MiB;
constexpr size_t WS_WRT = 1 * MiB + 256 * 1024;
constexpr size_t WS_TOKSLOT = 1 * MiB + 512 * 1024;
constexpr size_t WS_WROW = 1 * MiB + 768 * 1024;
constexpr size_t WS_COS = 2 * MiB, WS_SIN = 2 * MiB + 512 * 1024;
constexpr size_t WS_WI = 3 * MiB, WS_LOGF = 3 * MiB + 512 * 1024;
constexpr size_t WS_ROUTE = 4 * MiB;
constexpr size_t WS_WIN = 5 * MiB;
constexpr size_t WS_WOA = 15 * MiB, WS_WOB = 16 * MiB, WS_WO = 17 * MiB;
constexpr size_t WS_WGU = 19 * MiB, WS_WDN = 83 * MiB;
constexpr size_t WS_H = 115 * MiB;
constexpr size_t WS_OA = 115 * MiB, WS_OB = 131 * MiB, WS_H2 = 115 * MiB;
constexpr size_t WS_QA = 147 * MiB, WS_QI = 163 * MiB, WS_QB = 179 * MiB, WS_KB = 195 * MiB, WS_VB = 211 * MiB;
constexpr size_t WS_KA = 227 * MiB, WS_VA = 229 * MiB, WS_KI = 231 * MiB;
constexpr size_t WS_XS = 147 * MiB;
constexpr size_t WS_YC = 147 * MiB;
constexpr size_t WS_GA = 233 * MiB, WS_GB = 265 * MiB;
constexpr size_t WS_HID = 233 * MiB;
constexpr size_t WS_END = 297 * MiB;
constexpr int CW_BAR = 4096, CW_CNT = 8192, CW_SSQ = 16384;
constexpr int RING_OFF = 0, RING_BYTES = 131072;
constexpr int SEL_OFF = 131072;
constexpr int LX_OFF = 139264;
constexpr int LDS_BYTES = 143360;

#define GAS __attribute__((address_space(1)))
#define LAS __attribute__((address_space(3)))
typedef unsigned short bf16;
typedef unsigned v4u __attribute__((ext_vector_type(4)));
typedef float f32x4 __attribute__((ext_vector_type(4)));
typedef short bf16x8 __attribute__((ext_vector_type(8)));
typedef GAS unsigned gu32;
typedef GAS unsigned long long gu64;
#define RLX_AGENT __ATOMIC_RELAXED, __HIP_MEMORY_SCOPE_AGENT
#define LDS_WAIT() asm volatile("s_waitcnt lgkmcnt(0)" ::: "memory")
#define VM_WAIT() asm volatile("s_waitcnt vmcnt(0)" ::: "memory")
__device__ __forceinline__ unsigned long long rt() { return __builtin_amdgcn_s_memrealtime(); }
__device__ __forceinline__ unsigned f2bf(float f) { unsigned u = __builtin_bit_cast(unsigned, f); return (u + 0x7fffu + ((u >> 16) & 1u)) >> 16; }
__device__ __forceinline__ unsigned pk2(float lo, float hi) { return f2bf(lo) | (f2bf(hi) << 16); }

#define XB_TMO      128
#define XB_XCNT(j)  (256  + 64 * (j))
#define XB_XSUB(j)  (1280 + 64 * (j))
#define XB_XGEN(j)  (2304 + 64 * (j))
#define XB_TOP      3328
#define XB_TOPGEN   3392
#define XCD_BAR_WORDS 3456
#define XB_SPIN_CAP (1u << 18)

__device__ __forceinline__ unsigned xb_ld(unsigned* p)              { return __hip_atomic_load(p, __ATOMIC_RELAXED, __HIP_MEMORY_SCOPE_AGENT); }
__device__ __forceinline__ unsigned xb_add(unsigned* p, unsigned v) { return __hip_atomic_fetch_add(p, v, __ATOMIC_RELAXED, __HIP_MEMORY_SCOPE_AGENT); }
__device__ __forceinline__ unsigned xb_xcc_id() { return (unsigned)__builtin_amdgcn_s_getreg((3 << 11) | 20) & 0xFu; }
#define XB_SPIN(cond, bar) do { unsigned _sp = 0; while (cond) { __builtin_amdgcn_s_sleep(1); \
    if ((++_sp & 255u) == 0u) { if (xb_ld(&(bar)[XB_TMO])) break; if (_sp > XB_SPIN_CAP) { atomicAdd(&(bar)[XB_TMO], 1u); break; } } } } while (0)

struct XcdBarrier {
    unsigned* bar; unsigned x;
    volatile LAS unsigned* st;
};

__device__ __forceinline__ XcdBarrier xcd_barrier_post(unsigned* bar, volatile LAS unsigned* st) {
    XcdBarrier b; b.bar = bar; b.x = xb_xcc_id(); b.st = st;
    if (threadIdx.x == 0) (void)xb_add(&bar[XB_XCNT(b.x)], 1u);
    return b;
}
__device__ __forceinline__ void xcd_barrier_complete(unsigned* bar, unsigned x, unsigned& nloc, unsigned& nx) {
    const unsigned G = gridDim.x * gridDim.y * gridDim.z;
    unsigned sum, cnt, mine, sp = 0u;
    for (;;) {
        sum = 0u; cnt = 0u; mine = 0u;
#pragma unroll
        for (unsigned j = 0; j < 16; ++j) { const unsigned c = xb_ld(&bar[XB_XCNT(j)]); sum += c; cnt += (c > 0u) ? 1u : 0u; mine = (j == x) ? c : mine; }
        if (sum == G) break;
        __builtin_amdgcn_s_sleep(1);
        if ((++sp & 255u) == 0u) { if (xb_ld(&bar[XB_TMO])) break; if (sp > XB_SPIN_CAP) { atomicAdd(&bar[XB_TMO], 1u); break; } }
    }
    nloc = mine > 0u ? mine : 1u; nx = cnt > 0u ? cnt : 1u;
}

__device__ __forceinline__ void xcd_barrier(const XcdBarrier& b) {
    asm volatile("s_waitcnt vmcnt(0)" ::: "memory");
    __syncthreads();
    if (threadIdx.x == 0) {
        unsigned* bar = b.bar;
        __builtin_amdgcn_s_waitcnt(0);
        unsigned nloc = b.st[0], nx = b.st[1];
        if (nloc == 0u) { xcd_barrier_complete(bar, b.x, nloc, nx); b.st[0] = nloc; b.st[1] = nx; }
        const unsigned old = xb_add(&bar[XB_XSUB(b.x)], 1u);
        const unsigned gen = old / nloc;
        if (old + 1u == (gen + 1u) * nloc) {
            __builtin_amdgcn_fence(__ATOMIC_RELEASE, "agent");
            asm volatile("s_waitcnt vmcnt(0)" ::: "memory");
            const unsigned og = xb_add(&bar[XB_TOP], 1u);
            const unsigned tg = og / nx;
            if (og + 1u == (tg + 1u) * nx) xb_add(&bar[XB_TOPGEN], 1u);
            else XB_SPIN(xb_ld(&bar[XB_TOPGEN]) == tg, bar);
            __builtin_amdgcn_fence(__ATOMIC_ACQUIRE, "agent");
            xb_add(&bar[XB_XGEN(b.x)], 1u);
            asm volatile("s_waitcnt vmcnt(0)" ::: "memory");
        } else {
            XB_SPIN(xb_ld(&bar[XB_XGEN(b.x)]) == gen, bar);
            __builtin_amdgcn_fence(__ATOMIC_ACQUIRE, "agent");
            asm volatile("s_waitcnt vmcnt(0)" ::: "memory");
        }
    }
    __syncthreads();
}
typedef float f32x2_t __attribute__((ext_vector_type(2))); typedef __bf16 bf16x2_t __attribute__((ext_vector_type(2)));
typedef float f32x16 __attribute__((ext_vector_type(16)));
typedef short s16x4 __attribute__((ext_vector_type(4)));
__device__ __forceinline__ unsigned cvtpk(float lo, float hi) { f32x2_t v = {lo, hi}; bf16x2_t b = __builtin_convertvector(v, bf16x2_t); return __builtin_bit_cast(unsigned, b); }
__device__ __forceinline__ float bflo(unsigned w) { return __uint_as_float(w << 16); }
__device__ __forceinline__ float bfhi(unsigned w) { return __uint_as_float(w & 0xffff0000u); }
__device__ __forceinline__ float sigmoidf_(float v) { return 1.f / (1.f + __expf(-v)); }
#define MFMA32(a, b, c) __builtin_amdgcn_mfma_f32_32x32x16_bf16((a), (b), (c), 0, 0, 0)
#define MFMA16(a, b, c) __builtin_amdgcn_mfma_f32_16x16x32_bf16((a), (b), (c), 0, 0, 0)

struct Frame {
    unsigned char* lds;
    LAS unsigned char* ldsl;
    volatile LAS unsigned* LX;
    gu32* ctl;
    unsigned char* ws;
    int tid, lane, wave, vcu, G;
    const float *x, *c, *w_mod, *b_mod, *g_mix, *w_in, *b_forget, *w_out_a, *w_out_b, *w_out, *g_ffn, *w_group, *b_group, *w_router, *b_router, *w_e_gate, *w_e_up, *w_e_down, *g_final;
    const int* positions;
    float* out;
};
__device__ __forceinline__ float wave_sum(float v) {
#pragma unroll
    for (int o = 1; o < 64; o <<= 1) v += __shfl_xor(v, o);
    return v;
}

struct CmIn { __device__ __forceinline__ int operator()(int n) const { if (n < 1216) return n; if (n < 2752) return n + 8; if (n < 4800) return n + 16; if (n < 4808) return n - 4800 + 1216; if (n < 4816) return n - 4808 + 2760; return -1; } };
struct CmId { int base; __device__ __forceinline__ int operator()(int n) const { return n - base; } };
template <class CM>
__device__ __forceinline__ void transpose_item(const float* W, int ldw, bf16* WT, int K, int k0, int n0, const CM& cm, LAS float* scr, int lane) {
    const int sc = cm(n0 + (lane & 31));
#pragma unroll 8
    for (int i = 0; i < 32; ++i) { const int kk = 2 * i + (lane >> 5); scr[kk * 33 + (lane & 31)] = sc >= 0 ? W[(size_t)(k0 + kk) * ldw + sc] : 0.f; }
    LDS_WAIT(); asm volatile("" ::: "memory");
    const int c = lane & 7;
#pragma unroll
    for (int j = 0; j < 4; ++j) { const int n = (lane >> 3) + 8 * j; const LAS float* s = scr + (8 * c) * 33 + n;
        v4u o; o.x = pk2(s[0 * 33], s[1 * 33]); o.y = pk2(s[2 * 33], s[3 * 33]); o.z = pk2(s[4 * 33], s[5 * 33]); o.w = pk2(s[6 * 33], s[7 * 33]);
        *(GAS v4u*)(WT + (size_t)(n0 + n) * K + k0 + 8 * c) = o; }
    LDS_WAIT(); asm volatile("" ::: "memory");
}
__device__ __forceinline__ void p0_prologue(Frame& F) {
    {
        LAS float* ca = (LAS float*)(F.ldsl + RING_OFF);
        LAS float* red = (LAS float*)(F.ldsl + RING_OFF + 16384);
        for (int i = F.tid; i < 4096; i += NWAVES * 64) { const float v = F.c[i]; ca[i] = v / (1.f + expf(-v)); }
        __syncthreads();
        float* MOD = (float*)(F.ws + WS_MOD);
        for (int cb = F.vcu; cb < 256; cb += F.G) {
            const int col0 = cb * 24;
            if (F.tid < 384) { const int j = F.tid % 24, ks = F.tid / 24; float a0 = 0.f, a1 = 0.f, a2 = 0.f, a3 = 0.f;
#pragma unroll 8
                for (int i = 0; i < 64; ++i) { const int k = ks + 16 * i; const float w = F.w_mod[(size_t)k * 6144 + col0 + j];
                    a0 += ca[k] * w; a1 += ca[1024 + k] * w; a2 += ca[2048 + k] * w; a3 += ca[3072 + k] * w; }
                LAS float* r = red + (ks * 24 + j) * 4; r[0] = a0; r[1] = a1; r[2] = a2; r[3] = a3; }
            __syncthreads();
            if (F.tid < 96) { const int j = F.tid % 24, bb = F.tid / 24; float s = 0.f;
#pragma unroll
                for (int ks = 0; ks < 16; ++ks) s += red[(ks * 24 + j) * 4 + bb];
                MOD[bb * 6144 + col0 + j] = s + F.b_mod[col0 + j]; }
            __syncthreads();
        }
    }
    LAS float* scr = (LAS float*)(F.ldsl + RING_OFF + F.wave * 16384);
    const int gw = F.vcu * NWAVES + F.wave, NGW = F.G * NWAVES;
    constexpr int I_IN = 16 * 152, I_OA = 8 * 32, I_O = 16 * 32, I_GU = 32 * 16 * 32, I_DN = 32 * 8 * 32;
    constexpr int NITEMS = I_IN + 2 * I_OA + I_O + I_GU + I_DN;
    bf16* WinT = (bf16*)(F.ws + WS_WIN); bf16* WoaT = (bf16*)(F.ws + WS_WOA); bf16* WobT = (bf16*)(F.ws + WS_WOB); bf16* WoT = (bf16*)(F.ws + WS_WO);
    bf16* WguT = (bf16*)(F.ws + WS_WGU); bf16* WdnT = (bf16*)(F.ws + WS_WDN);
    for (int it = gw; it < NITEMS; it += NGW) {
        int r = it;
        if (r < I_IN) { const int kb = r / 152, nb = r % 152; transpose_item(F.w_in, 4816, WinT, 1024, 64 * kb, 32 * nb, CmIn{}, scr, F.lane); continue; } r -= I_IN;
        if (r < I_OA) { const int kb = r / 32, nb = r % 32; transpose_item(F.w_out_a + 32 * nb, 1024, WoaT, 512, 64 * kb, 32 * nb, CmId{32 * nb}, scr, F.lane); continue; } r -= I_OA;
        if (r < I_OA) { const int kb = r / 32, nb = r % 32; transpose_item(F.w_out_b + 32 * nb, 1024, WobT, 512, 64 * kb, 32 * nb, CmId{32 * nb}, scr, F.lane); continue; } r -= I_OA;
        if (r < I_O) { const int kb = r / 32, nb = r % 32; transpose_item(F.w_out + 32 * nb, 1024, WoT, 1024, 64 * kb, 32 * nb, CmId{32 * nb}, scr, F.lane); continue; } r -= I_O;
        if (r < I_GU) { const int e = r / 512, q = r % 512, kb = q / 32, nb = q % 32;
            const int np = 32 * nb, ct = np >> 8, bj = (np >> 7) & 1, j0 = np & 127;
            const float* src = (bj ? F.w_e_up : F.w_e_gate) + (size_t)e * 1024 * 512 + ct * 128 + j0;
            transpose_item(src, 512, WguT, 1024, 64 * kb, e * 1024 + np, CmId{e * 1024 + np}, scr, F.lane); continue; } r -= I_GU;
        { const int e = r / 256, q = r % 256, kb = q / 32, nb = q % 32;
            const float* src = F.w_e_down + (size_t)e * 512 * 1024 + 32 * nb;
            transpose_item(src, 1024, WdnT, 512, 64 * kb, e * 1024 + 32 * nb, CmId{e * 1024 + 32 * nb}, scr, F.lane); }
    }
    { bf16* WrT = (bf16*)(F.ws + WS_WRT);
      for (int i = (F.vcu * NWAVES * 64 + F.tid); i < 64 * 1024; i += F.G * NWAVES * 64) { const int n = i >> 10, k = i & 1023;
          float v = 0.f; if (n < 32) v = F.w_router[k * 32 + n]; else if (n < 36) v = F.w_group[k * 4 + (n - 32)];
          WrT[i] = (bf16)f2bf(v); } }
}

__device__ __forceinline__ void p1_hnorm(Frame& F) {
    const int gw = F.vcu * NWAVES + F.wave, NGW = F.G * NWAVES;
    const float* MOD = (const float*)(F.ws + WS_MOD); bf16* H = (bf16*)(F.ws + WS_H);
    float* COS = (float*)(F.ws + WS_COS); float* SIN = (float*)(F.ws + WS_SIN);
    for (int m = gw; m < M; m += NGW) {
        const int b = m >> 12;
        const GAS f32x4* xr = (const GAS f32x4*)(F.x + (size_t)m * D) + F.lane;
        f32x4 v[4]; float s = 0.f;
#pragma unroll
        for (int j = 0; j < 4; ++j) { v[j] = xr[64 * j]; s += (v[j].x * v[j].x + v[j].y * v[j].y) + (v[j].z * v[j].z + v[j].w * v[j].w); }
        const float rstd = 1.f / sqrtf(wave_sum(s) * (1.f / D) + RMS_EPS);
        GAS unsigned long long* o8 = (GAS unsigned long long*)(H + (size_t)m * D) + F.lane;
#pragma unroll
        for (int j = 0; j < 4; ++j) { const int col = 4 * F.lane + 256 * j;
            const f32x4 g = *(const f32x4*)(F.g_mix + col), sc = *(const f32x4*)(MOD + b * 6144 + 1024 + col), sh = *(const f32x4*)(MOD + b * 6144 + col);
            const f32x4 h = v[j] * rstd * g * (sc + 1.0f) + sh;
            o8[64 * j] = (unsigned long long)cvtpk(h.x, h.y) | ((unsigned long long)cvtpk(h.z, h.w) << 32); }
        if (F.lane < 8) { const float invf = exp2f(-(float)F.lane * 2.3664460711655218f); const float ang = (float)F.positions[m] * invf;
            COS[m * 8 + F.lane] = cosf(ang); SIN[m * 8 + F.lane] = sinf(ang); }
    }
}

struct EpiProj {
    static constexpr bool PERM = true, AFTER_DRAIN = false;
    unsigned char* ws; const float* bfg;
    template <int BJ>
    __device__ __forceinline__ void part(const pg8::f32x4 (&acc)[2][2][4][2], const pg8::Unit& u, int wr, int wc, int fr, int fq) const {
        const float* COS = (const float*)(ws + WS_COS); const float* SIN = (const float*)(ws + WS_SIN);
        const int cg = __builtin_amdgcn_readfirstlane(u.pn * 256 + BJ * 128 + wc * 32);
        size_t boff = 0; int ld = 0, cofs = 0, kind = 4; float scale = 1.f;
        if (cg < 512)       { boff = WS_QA; ld = 512; cofs = 0;    kind = 1; scale = QSCALE; }
        else if (cg < 576)  { boff = WS_KA; ld = 64;  cofs = 512;  kind = 1; }
        else if (cg < 640)  { boff = WS_VA; ld = 64;  cofs = 576;  kind = 0; }
        else if (cg < 1152) { boff = WS_QI; ld = 512; cofs = 640;  kind = 1; scale = 0.125f; }
        else if (cg < 1216) { boff = WS_KI; ld = 64;  cofs = 1152; kind = 1; }
        else if (cg < 1728) { boff = WS_QB; ld = 512; cofs = 1216; kind = 0; scale = QSCALE; }
        else if (cg < 2240) { boff = WS_KB; ld = 512; cofs = 1728; kind = 0; }
        else if (cg < 2752) { boff = WS_VB; ld = 512; cofs = 2240; kind = 0; }
        else if (cg < 3776) { boff = WS_GA; ld = 1024; cofs = 2752; kind = 2; }
        else if (cg < 4800) { boff = WS_GB; ld = 1024; cofs = 3776; kind = 2; }
        else if (cg == 4800) { kind = 3; }
        if (kind == 4) return;
        if (kind == 3) {
#pragma unroll
            for (int ai = 0; ai < 2; ++ai)
#pragma unroll
                for (int m = 0; m < 4; ++m) {
                    const int row = u.pm * 256 + ai * 128 + wr * 64 + m * 16 + fr;
                    const pg8::f32x4 v0 = acc[ai][BJ][m][0], v1 = acc[ai][BJ][m][1];
                    if (fq == 0) { float* wi = (float*)(ws + WS_WI) + (size_t)row * 8; const float s = 0.35355339059327373f; *(pg8::f32x4*)wi = v0 * s; *(pg8::f32x4*)(wi + 4) = v1 * s; }
                    else if (fq == 1) { float* lf = (float*)(ws + WS_LOGF) + (size_t)(row >> 12) * 8 * SEQ + (row & (SEQ - 1));
#pragma unroll
                        for (int i = 0; i < 8; ++i) { const float z = (i < 4 ? v0[i & 3] : v1[i & 3]) + bfg[i];
                            const float ls = z >= 0.f ? -log1pf(expf(-z)) : z - log1pf(expf(z)); lf[(size_t)i * SEQ] = ls; } }
                }
            return;
        }
        const bool rope = (kind == 1) && ((cg & 63) == 0);
        bf16* base = (bf16*)(ws + boff);
        const int c0 = cg + 8 * fq - cofs;
#pragma unroll
        for (int ai = 0; ai < 2; ++ai)
#pragma unroll
            for (int m = 0; m < 4; ++m) {
                const int row = u.pm * 256 + ai * 128 + wr * 64 + m * 16 + fr;
                pg8::f32x4 v0 = acc[ai][BJ][m][0], v1 = acc[ai][BJ][m][1];
                if (rope) {
                    pg8::f32x4 o0, o1;
#pragma unroll
                    for (int i = 0; i < 4; ++i) { o0[i] = __shfl_xor(v0[i], 16); o1[i] = __shfl_xor(v1[i], 16); }
                    const pg8::f32x4 c0v = *(const pg8::f32x4*)(COS + (size_t)row * 8), c1v = *(const pg8::f32x4*)(COS + (size_t)row * 8 + 4);
                    const pg8::f32x4 s0v = *(const pg8::f32x4*)(SIN + (size_t)row * 8), s1v = *(const pg8::f32x4*)(SIN + (size_t)row * 8 + 4);
                    if (fq < 2) { const float sg = fq == 0 ? -1.f : 1.f; v0 = v0 * c0v + o0 * s0v * sg; v1 = v1 * c1v + o1 * s1v * sg; }
                }
                if (kind == 2) {
#pragma unroll
                    for (int i = 0; i < 4; ++i) { v0[i] = sigmoidf_(v0[i]); v1[i] = sigmoidf_(v1[i]); }
                }
                v0 = v0 * scale; v1 = v1 * scale;
                pg8::u32x4 w; w.x = cvtpk(v0[0], v0[1]); w.y = cvtpk(v0[2], v0[3]); w.z = cvtpk(v1[0], v1[1]); w.w = cvtpk(v1[2], v1[3]);
                *(pg8::u32x4*)(base + (size_t)row * ld + c0) = w;
            }
    }
    __device__ __forceinline__ void operator()(const pg8::f32x4 (&acc)[2][2][4][2], const pg8::Unit& u, int wr, int wc, int fr, int fq) const {
        part<0>(acc, u, wr, wc, fr, fq); part<1>(acc, u, wr, wc, fr, fq);
    }
};
template <int STEP> struct EpiMerge {
    static constexpr bool PERM = true, AFTER_DRAIN = false;
    unsigned char* ws;
    __device__ __forceinline__ void operator()(const pg8::f32x4 (&acc)[2][2][4][2], const pg8::Unit& u, int wr, int wc, int fr, int fq) const {
        bf16* GA = (bf16*)(ws + WS_GA); const bf16* GB = (const bf16*)(ws + WS_GB);
#pragma unroll
        for (int ai = 0; ai < 2; ++ai)
#pragma unroll
            for (int m = 0; m < 4; ++m) {
                const int row = u.pm * 256 + ai * 128 + wr * 64 + m * 16 + fr;
#pragma unroll
                for (int bj = 0; bj < 2; ++bj) {
                    const size_t off = (size_t)row * 1024 + u.pn * 256 + bj * 128 + wc * 32 + 8 * fq;
                    const pg8::f32x4 v0 = acc[ai][bj][m][0], v1 = acc[ai][bj][m][1];
                    const pg8::u32x4 a = *(const pg8::u32x4*)(GA + off);
                    float r[8];
                    if (STEP == 0) {
                        r[0] = bflo(a.x) * v0[0]; r[1] = bfhi(a.x) * v0[1]; r[2] = bflo(a.y) * v0[2]; r[3] = bfhi(a.y) * v0[3];
                        r[4] = bflo(a.z) * v1[0]; r[5] = bfhi(a.z) * v1[1]; r[6] = bflo(a.w) * v1[2]; r[7] = bfhi(a.w) * v1[3];
                    } else {
                        const pg8::u32x4 g = *(const pg8::u32x4*)(GB + off);
                        r[0] = bflo(a.x) + bflo(g.x) * v0[0]; r[1] = bfhi(a.x) + bfhi(g.x) * v0[1]; r[2] = bflo(a.y) + bflo(g.y) * v0[2]; r[3] = bfhi(a.y) + bfhi(g.y) * v0[3];
                        r[4] = bflo(a.z) + bflo(g.z) * v1[0]; r[5] = bfhi(a.z) + bfhi(g.z) * v1[1]; r[6] = bflo(a.w) + bflo(g.w) * v1[2]; r[7] = bfhi(a.w) + bfhi(g.w) * v1[3];
                    }
                    pg8::u32x4 w; w.x = cvtpk(r[0], r[1]); w.y = cvtpk(r[2], r[3]); w.z = cvtpk(r[4], r[5]); w.w = cvtpk(r[6], r[7]);
                    *(pg8::u32x4*)(GA + off) = w;
                }
            }
    }
};
struct EpiOut {
    static constexpr bool PERM = true, AFTER_DRAIN = false;
    unsigned char* ws; const float* x; float* out;
    __device__ __forceinline__ void operator()(const pg8::f32x4 (&acc)[2][2][4][2], const pg8::Unit& u, int wr, int wc, int fr, int fq) const {
        const float* MOD = (const float*)(ws + WS_MOD); float* SSQ = (float*)(ws + WS_CTL) + CW_SSQ;
        const int b = u.pm >> 4;
        const int colb = u.pn * 256 + wc * 32 + 8 * fq;
        pg8::f32x4 gt[2][2];
#pragma unroll
        for (int bj = 0; bj < 2; ++bj) { gt[bj][0] = *(const pg8::f32x4*)(MOD + b * 6144 + 2048 + colb + bj * 128); gt[bj][1] = *(const pg8::f32x4*)(MOD + b * 6144 + 2048 + colb + bj * 128 + 4); }
#pragma unroll
        for (int ai = 0; ai < 2; ++ai)
#pragma unroll
            for (int m = 0; m < 4; ++m) {
                const int row = u.pm * 256 + ai * 128 + wr * 64 + m * 16 + fr; float ss = 0.f;
#pragma unroll
                for (int bj = 0; bj < 2; ++bj) {
                    const size_t off = (size_t)row * 1024 + colb + bj * 128;
                    const pg8::f32x4 x0 = *(const pg8::f32x4*)(x + off), x1 = *(const pg8::f32x4*)(x + off + 4);
                    const pg8::f32x4 y0 = x0 + gt[bj][0] * acc[ai][bj][m][0], y1 = x1 + gt[bj][1] * acc[ai][bj][m][1];
                    *(pg8::f32x4*)(out + off) = y0; *(pg8::f32x4*)(out + off + 4) = y1;
                    ss += (y0[0] * y0[0] + y0[1] * y0[1]) + (y0[2] * y0[2] + y0[3] * y0[3]) + (y1[0] * y1[0] + y1[1] * y1[1]) + (y1[2] * y1[2] + y1[3] * y1[3]);
                }
                ss += __shfl_xor(ss, 16); ss += __shfl_xor(ss, 32);
                if (fq == 0) atomicAdd(SSQ + row, ss);
            }
    }
};
struct EpiGU {
    static constexpr bool PERM = true, AFTER_DRAIN = false;
    unsigned char* ws;
    __device__ __forceinline__ void operator()(const pg8::f32x4 (&acc)[2][2][4][2], const pg8::Unit& u, int wr, int wc, int fr, int fq) const {
        bf16* HID = (bf16*)(ws + WS_HID);
        const int col = (u.pn & 3) * 128 + wc * 32 + 8 * fq;
#pragma unroll
        for (int ai = 0; ai < 2; ++ai)
#pragma unroll
            for (int m = 0; m < 4; ++m) {
                const int row = u.pm * 256 + ai * 128 + wr * 64 + m * 16 + fr;
                float r[8];
#pragma unroll
                for (int i = 0; i < 8; ++i) { const float g = i < 4 ? acc[ai][0][m][0][i] : acc[ai][0][m][1][i - 4]; const float up = i < 4 ? acc[ai][1][m][0][i] : acc[ai][1][m][1][i - 4];
                    r[i] = g * sigmoidf_(g) * up; }
                pg8::u32x4 w; w.x = cvtpk(r[0], r[1]); w.y = cvtpk(r[2], r[3]); w.z = cvtpk(r[4], r[5]); w.w = cvtpk(r[6], r[7]);
                *(pg8::u32x4*)(HID + (size_t)row * 512 + col) = w;
            }
    }
};
struct EpiDown {
    static constexpr bool PERM = true, AFTER_DRAIN = false;
    unsigned char* ws;
    __device__ __forceinline__ void operator()(const pg8::f32x4 (&acc)[2][2][4][2], const pg8::Unit& u, int wr, int wc, int fr, int fq) const {
        bf16* YC = (bf16*)(ws + WS_YC); const int* TOKSLOT = (const int*)(ws + WS_TOKSLOT); const float* WROW = (const float*)(ws + WS_WROW);
        const int colb = (u.pn & 3) * 256 + wc * 32 + 8 * fq;
#pragma unroll
        for (int ai = 0; ai < 2; ++ai)
#pragma unroll
            for (int m = 0; m < 4; ++m) {
                const int row = u.pm * 256 + ai * 128 + wr * 64 + m * 16 + fr;
                const int ts = TOKSLOT[row]; const float gw = WROW[row];
                if (ts >= 0) {
#pragma unroll
                    for (int bj = 0; bj < 2; ++bj) { const pg8::f32x4 v0 = acc[ai][bj][m][0] * gw, v1 = acc[ai][bj][m][1] * gw;
                        pg8::u32x4 w; w.x = cvtpk(v0[0], v0[1]); w.y = cvtpk(v0[2], v0[3]); w.z = cvtpk(v1[0], v1[1]); w.w = cvtpk(v1[2], v1[3]);
                        *(pg8::u32x4*)(YC + (size_t)ts * 1024 + colb + bj * 128) = w; }
                }
            }
    }
};
struct MoeOrder {
    int G, c, nunits; const volatile LAS unsigned* tile_e;
    __device__ __forceinline__ bool next(int i, pg8::Unit& u) const { const int L = i * G + c; if (L >= nunits) return false; const int rt = L >> 2; u.pm = rt; u.pn = (int)tile_e[rt] * 4 + (L & 3); return true; }
    __device__ __forceinline__ void a_ready(const pg8::Unit&) const {}
    __device__ __forceinline__ void done(const pg8::Unit&) const {}
};
__device__ __forceinline__ void moe_table(Frame& F) {
    const gu32* CNT = F.ctl + CW_CNT;
    if (F.tid == 0) { unsigned p = 0;
        for (int e = 0; e < 32; ++e) { F.LX[96 + e] = p; const unsigned c = __hip_atomic_load(CNT + e, RLX_AGENT); const unsigned nt = (c + 255u) >> 8;
            for (unsigned t = 0; t < nt; ++t) if ((p >> 8) + t < (unsigned)NTMAX) F.LX[160 + (p >> 8) + t] = (unsigned)e;
            p += nt << 8; }
        F.LX[128] = p; F.LX[132] = (p >> 8) < (unsigned)NTMAX ? (p >> 8) : (unsigned)NTMAX; }
    __syncthreads();
}
typedef short v4i16_t __attribute__((ext_vector_type(4)));
__device__ __forceinline__ s16x4 trread(LAS const unsigned char* p) { return __builtin_bit_cast(s16x4, __builtin_amdgcn_ds_read_tr16_b64_v4i16((LAS v4i16_t*)p)); }
constexpr int FX_CK = 0, FX_K = 16384, FX_V = 32768, FX_VROW = 144, FX_VBUF = 64 * FX_VROW;
__device__ __forceinline__ void fox_unit(Frame& F, int b, int h, int qb) {
    const int tid = F.tid, lane = F.lane, wave = F.wave, r32 = lane & 31, hi = lane >> 5;
    LAS unsigned char* L = F.ldsl + RING_OFF;
    LAS float* CK = (LAS float*)(L + FX_CK);
    const int nkeys = (qb + 1) * 256, NT = nkeys / 64;
    const bf16* QBp = (const bf16*)(F.ws + WS_QB); const bf16* KBp = (const bf16*)(F.ws + WS_KB); const bf16* VBp = (const bf16*)(F.ws + WS_VB);
    __syncthreads();
    {
        const float* lf = (const float*)(F.ws + WS_LOGF) + (size_t)(b * 8 + h) * SEQ;
        float v[8]; const int k0 = tid * 8;
        if (k0 < nkeys) { const f32x4 a = *(const f32x4*)(lf + k0), c = *(const f32x4*)(lf + k0 + 4); v[0] = a.x; v[1] = a.y; v[2] = a.z; v[3] = a.w; v[4] = c.x; v[5] = c.y; v[6] = c.z; v[7] = c.w; }
        else {
#pragma unroll
            for (int i = 0; i < 8; ++i) v[i] = 0.f; }
#pragma unroll
        for (int i = 1; i < 8; ++i) v[i] += v[i - 1];
        const float tot = v[7]; float sc = tot;
#pragma unroll
        for (int o = 1; o < 64; o <<= 1) { const float t = __shfl_up(sc, o); if (lane >= o) sc += t; }
        if (lane == 63) F.LX[8 + wave] = __float_as_uint(sc);
        __syncthreads();
        float woff = 0.f, cref = 0.f;
#pragma unroll
        for (int w = 0; w < 8; ++w) { const float t = __uint_as_float(F.LX[8 + w]); cref += t; if (w < wave) woff += t; }
        const float base = woff + sc - tot;
        if (k0 < nkeys) {
#pragma unroll
            for (int i = 0; i < 8; ++i) CK[k0 + i] = (base + v[i] - cref) * LOG2E; }
    }
    const size_t qrow = (size_t)b * SEQ + qb * 256 + wave * 32 + r32;
    pg8::bf16x8 qf[4];
#pragma unroll
    for (int d0 = 0; d0 < 4; ++d0) qf[d0] = *(const pg8::bf16x8*)(QBp + qrow * 512 + h * 64 + d0 * 16 + hi * 8);
    float m_run = -1e30f, l_run = 0.f; f32x16 o0 = {}, o1 = {};
    const int kr = tid >> 3, ch = tid & 7;
    const bf16* Kg = KBp + ((size_t)b * SEQ + kr) * 512 + h * 64 + ch * 8;
    const bf16* Vg = VBp + ((size_t)b * SEQ + kr) * 512 + h * 64 + ch * 8;
    const int kwo = FX_K + kr * 128 + ((ch ^ (kr & 7)) * 16), vwo = FX_V + kr * FX_VROW + ch * 16;
    v4u kreg = *(const v4u*)Kg, vreg = *(const v4u*)Vg;
    *(LAS v4u*)(L + kwo) = kreg; *(LAS v4u*)(L + vwo) = vreg;
    __syncthreads();
    const int qminw = qb * 256 + wave * 32, qmaxw = qminw + 31, q = qminw + r32;
    for (int t = 0; t < NT; ++t) {
        const int cur = t & 1;
        if (t + 1 < NT) { kreg = *(const v4u*)(Kg + (size_t)(t + 1) * 64 * 512); vreg = *(const v4u*)(Vg + (size_t)(t + 1) * 64 * 512); }
        if (64 * t <= qmaxw) {
            LAS const unsigned char* Kb = L + FX_K + cur * 8192; LAS const unsigned char* Vb = L + FX_V + cur * FX_VBUF;
            f32x16 p0 = {}, p1 = {};
#pragma unroll
            for (int d0 = 0; d0 < 4; ++d0) {
                const int co = ((2 * d0 + hi) ^ (r32 & 7)) * 16;
                const pg8::bf16x8 a0 = *(LAS const pg8::bf16x8*)(Kb + r32 * 128 + co);
                const pg8::bf16x8 a1 = *(LAS const pg8::bf16x8*)(Kb + (r32 + 32) * 128 + co);
                p0 = MFMA32(a0, qf[d0], p0); p1 = MFMA32(a1, qf[d0], p1);
            }
#pragma unroll
            for (int rq = 0; rq < 4; ++rq) { const f32x4 c0 = *(LAS const f32x4*)(CK + 64 * t + 8 * rq + 4 * hi), c1 = *(LAS const f32x4*)(CK + 64 * t + 32 + 8 * rq + 4 * hi);
#pragma unroll
                for (int i = 0; i < 4; ++i) { p0[4 * rq + i] -= c0[i]; p1[4 * rq + i] -= c1[i]; } }
            if (64 * t + 63 > qminw) {
#pragma unroll
                for (int r = 0; r < 16; ++r) { const int key = 64 * t + (r & 3) + 8 * (r >> 2) + 4 * hi; if (key > q) p0[r] = -1e30f; if (key + 32 > q) p1[r] = -1e30f; } }
            float mx = p0[0];
#pragma unroll
            for (int r = 1; r < 16; ++r) mx = fmaxf(mx, p0[r]);
#pragma unroll
            for (int r = 0; r < 16; ++r) mx = fmaxf(mx, p1[r]);
            mx = fmaxf(mx, __shfl_xor(mx, 32));
            const float mnew = fmaxf(m_run, mx), alpha = exp2f(m_run - mnew); m_run = mnew;
            float rs = 0.f;
#pragma unroll
            for (int r = 0; r < 16; ++r) { p0[r] = exp2f(p0[r] - mnew); p1[r] = exp2f(p1[r] - mnew); rs += p0[r] + p1[r]; }
            rs += __shfl_xor(rs, 32);
            l_run = l_run * alpha + rs;
#pragma unroll
            for (int r = 0; r < 16; ++r) { o0[r] *= alpha; o1[r] *= alpha; }
            pg8::bf16x8 pb[4];
#pragma unroll
            for (int s = 0; s < 2; ++s) { v4u w;
                w.x = cvtpk(p0[8 * s], p0[8 * s + 1]); w.y = cvtpk(p0[8 * s + 2], p0[8 * s + 3]); w.z = cvtpk(p0[8 * s + 4], p0[8 * s + 5]); w.w = cvtpk(p0[8 * s + 6], p0[8 * s + 7]); pb[s] = __builtin_bit_cast(pg8::bf16x8, w);
                w.x = cvtpk(p1[8 * s], p1[8 * s + 1]); w.y = cvtpk(p1[8 * s + 2], p1[8 * s + 3]); w.z = cvtpk(p1[8 * s + 4], p1[8 * s + 5]); w.w = cvtpk(p1[8 * s + 6], p1[8 * s + 7]); pb[2 + s] = __builtin_bit_cast(pg8::bf16x8, w); }
            LAS const unsigned char* vb = Vb + (4 * hi + ((lane & 15) >> 2)) * FX_VROW + (16 * ((lane >> 4) & 1) + 4 * (lane & 3)) * 2;
#pragma unroll
            for (int s = 0; s < 4; ++s) {
                const s16x4 l0 = trread(vb + (16 * s) * FX_VROW), h0 = trread(vb + (16 * s + 8) * FX_VROW);
                const s16x4 l1 = trread(vb + (16 * s) * FX_VROW + 64), h1 = trread(vb + (16 * s + 8) * FX_VROW + 64);
                const pg8::bf16x8 a0 = {l0[0], l0[1], l0[2], l0[3], h0[0], h0[1], h0[2], h0[3]};
                const pg8::bf16x8 a1 = {l1[0], l1[1], l1[2], l1[3], h1[0], h1[1], h1[2], h1[3]};
                o0 = MFMA32(a0, pb[s], o0); o1 = MFMA32(a1, pb[s], o1);
            }
        }
        if (t + 1 < NT) { const int nb = cur ^ 1; *(LAS v4u*)(L + kwo + nb * 8192) = kreg; *(LAS v4u*)(L + vwo + nb * FX_VBUF) = vreg; }
        __syncthreads();
    }
    const float inv = 1.f / l_run;
    bf16* Op = (bf16*)(F.ws + WS_OB) + qrow * 512 + h * 64;
#pragma unroll
    for (int rq = 0; rq < 4; ++rq) {
        const unsigned long long w0 = (unsigned long long)cvtpk(o0[4 * rq] * inv, o0[4 * rq + 1] * inv) | ((unsigned long long)cvtpk(o0[4 * rq + 2] * inv, o0[4 * rq + 3] * inv) << 32);
        const unsigned long long w1 = (unsigned long long)cvtpk(o1[4 * rq] * inv, o1[4 * rq + 1] * inv) | ((unsigned long long)cvtpk(o1[4 * rq + 2] * inv, o1[4 * rq + 3] * inv) << 32);
        *(unsigned long long*)(Op + 8 * rq + 4 * hi) = w0; *(unsigned long long*)(Op + 32 + 8 * rq + 4 * hi) = w1;
    }
}

constexpr int DS_VROW = 144, DS_VBUF = 64 * DS_VROW;
__device__ __forceinline__ void dsa_unit(Frame& F, int b, int c, int g) {
    const int lane = F.lane, wave = F.wave;
    LAS unsigned char* L = F.ldsl + RING_OFF;
    LAS float* SC = (LAS float*)L;
    LAS int* SEL = (LAS int*)(F.ldsl + SEL_OFF) + wave * 256;
    const int q0 = c * 64 + g * 8, Kn = (c + 1) * 64;
    const bf16* QI = (const bf16*)(F.ws + WS_QI); const bf16* KI = (const bf16*)(F.ws + WS_KI); const float* WI = (const float*)(F.ws + WS_WI);
    const bf16* QA = (const bf16*)(F.ws + WS_QA); const bf16* KA = (const bf16*)(F.ws + WS_KA); const bf16* VA = (const bf16*)(F.ws + WS_VA);
    __syncthreads();
    {
        const int mt = wave & 1, m = lane & 31, hi = lane >> 5;
        const int q4 = 2 * ((m >> 2) & 1) + (m >> 4), head = (m & 3) + 4 * ((m >> 3) & 1);
        const size_t arow = (size_t)b * SEQ + q0 + 4 * mt + q4;
        pg8::bf16x8 af[4];
#pragma unroll
        for (int s = 0; s < 4; ++s) af[s] = *(const pg8::bf16x8*)(QI + arow * 512 + head * 64 + 16 * s + 8 * hi);
        float wq[16];
        { const size_t wrow = (size_t)b * SEQ + q0 + 4 * mt + 2 * hi;
#pragma unroll
          for (int j = 0; j < 4; ++j) { const f32x4 t = *(const f32x4*)(WI + wrow * 8 + 4 * j); wq[4 * j] = t.x; wq[4 * j + 1] = t.y; wq[4 * j + 2] = t.z; wq[4 * j + 3] = t.w; } }
        LAS float* s0p = SC + (4 * mt + 2 * hi) * 4096 + m; LAS float* s1p = s0p + 4096;
        for (int kt = (wave >> 1); kt < Kn / 32; kt += 4) {
            const bf16* kp = KI + ((size_t)b * SEQ + 32 * kt + m) * 64 + 8 * hi;
            f32x16 acc = {};
#pragma unroll
            for (int s = 0; s < 4; ++s) { const pg8::bf16x8 bfr = *(const pg8::bf16x8*)(kp + 16 * s); acc = MFMA32(af[s], bfr, acc); }
            float s0 = 0.f, s1 = 0.f;
#pragma unroll
            for (int r = 0; r < 8; ++r) { s0 += wq[r] * fmaxf(acc[r], 0.f); s1 += wq[8 + r] * fmaxf(acc[8 + r], 0.f); }
            s0p[32 * kt] = s0; s1p[32 * kt] = s1;
        }
    }
    __syncthreads();
    int nsel;
    if (Kn <= 256) { nsel = Kn; for (int i = lane; i < Kn; i += 64) SEL[i] = i; }
    else {
        nsel = 256;
        unsigned key[64];
        LAS const float* sr = SC + wave * 4096;
#pragma unroll
        for (int j = 0; j < 64; ++j) { const int idx = 64 * j + lane; unsigned u = 0u;
            if (idx < Kn) { u = __float_as_uint(sr[idx]); u = (u >> 31) ? ~u : (u | 0x80000000u); }
            key[j] = u; }
        unsigned T = 0u;
        for (int bit = 31; bit >= 0; --bit) {
            const unsigned cand = T | (1u << bit); int cnt = 0;
#pragma unroll
            for (int j = 0; j < 64; ++j) cnt += __popcll(__ballot(key[j] >= cand));
            if (cnt >= 256) T = cand;
            if (cnt == 256) break;
        }
        int ngt = 0;
#pragma unroll
        for (int j = 0; j < 64; ++j) ngt += __popcll(__ballot(key[j] > T));
        const int need_eq = 256 - ngt; int pos = 0, eq_seen = 0;
#pragma unroll
        for (int j = 0; j < 64; ++j) {
            const bool gt = key[j] > T, eq = key[j] == T;
            const unsigned long long meq = __ballot(eq);
            const int eq_rank = eq_seen + (int)__builtin_amdgcn_mbcnt_hi((unsigned)(meq >> 32), __builtin_amdgcn_mbcnt_lo((unsigned)meq, 0u));
            const bool take = gt || (eq && eq_rank < need_eq);
            const unsigned long long mt = __ballot(take);
            const int pr = (int)__builtin_amdgcn_mbcnt_hi((unsigned)(mt >> 32), __builtin_amdgcn_mbcnt_lo((unsigned)mt, 0u));
            if (take && pos + pr < 256) SEL[pos + pr] = 64 * j + lane;
            pos += __popcll(mt); eq_seen += __popcll(meq);
        }
    }
    __syncthreads();
    {
        const int n = lane & 15, kg = lane >> 4;
        const size_t qrow = (size_t)b * SEQ + q0 + wave;
        pg8::bf16x8 qf[2];
#pragma unroll
        for (int s = 0; s < 2; ++s) { qf[s] = (pg8::bf16x8){0, 0, 0, 0, 0, 0, 0, 0}; if (n < 8) qf[s] = *(const pg8::bf16x8*)(QA + qrow * 512 + n * 64 + 32 * s + 8 * kg); }
        const int ntile = nsel >> 4;
        f32x4 x[16];
#pragma unroll
        for (int t = 0; t < 16; ++t) {
            x[t] = (f32x4){-1e30f, -1e30f, -1e30f, -1e30f};
            if (t < ntile) { const int idx = SEL[16 * t + n]; const bf16* kp = KA + ((size_t)b * SEQ + idx) * 64 + 8 * kg;
                const pg8::bf16x8 a0 = *(const pg8::bf16x8*)kp, a1 = *(const pg8::bf16x8*)(kp + 32);
                f32x4 z = {0.f, 0.f, 0.f, 0.f}; z = MFMA16(a0, qf[0], z); z = MFMA16(a1, qf[1], z); x[t] = z; }
        }
        float mx = -1e30f;
#pragma unroll
        for (int t = 0; t < 16; ++t) mx = fmaxf(fmaxf(mx, fmaxf(x[t][0], x[t][1])), fmaxf(x[t][2], x[t][3]));
        mx = fmaxf(mx, __shfl_xor(mx, 16)); mx = fmaxf(mx, __shfl_xor(mx, 32));
        float ls = 0.f;
#pragma unroll
        for (int t = 0; t < 16; ++t) {
#pragma unroll
            for (int i = 0; i < 4; ++i) { x[t][i] = exp2f(x[t][i] - mx); ls += x[t][i]; } }
        ls += __shfl_xor(ls, 16); ls += __shfl_xor(ls, 32);
        pg8::bf16x8 pb[8];
#pragma unroll
        for (int s = 0; s < 8; ++s) { v4u w; w.x = cvtpk(x[2 * s][0], x[2 * s][1]); w.y = cvtpk(x[2 * s][2], x[2 * s][3]); w.z = cvtpk(x[2 * s + 1][0], x[2 * s + 1][1]); w.w = cvtpk(x[2 * s + 1][2], x[2 * s + 1][3]); pb[s] = __builtin_bit_cast(pg8::bf16x8, w); }
        LAS unsigned char* VS = L + wave * DS_VBUF;
        f32x4 o[4];
#pragma unroll
        for (int dt = 0; dt < 4; ++dt) o[dt] = (f32x4){0.f, 0.f, 0.f, 0.f};
        LAS const unsigned char* vb = VS + (4 * kg + (n >> 2)) * DS_VROW + (4 * (n & 3)) * 2;
#pragma unroll
        for (int cc = 0; cc < 4; ++cc) {
            if (cc * 64 < nsel) {
                v4u vr[8];
#pragma unroll
                for (int i = 0; i < 8; ++i) { const int kl = (lane >> 3) + 8 * i; const int idx = SEL[64 * cc + kl]; vr[i] = *(const v4u*)(VA + ((size_t)b * SEQ + idx) * 64 + 8 * (lane & 7)); }
#pragma unroll
                for (int i = 0; i < 8; ++i) { const int kl = (lane >> 3) + 8 * i; *(LAS v4u*)(VS + kl * DS_VROW + 16 * (lane & 7)) = vr[i]; }
                asm volatile("s_waitcnt lgkmcnt(0)" ::: "memory");
#pragma unroll
                for (int ks = 0; ks < 2; ++ks)
#pragma unroll
                    for (int dt = 0; dt < 4; ++dt) {
                        const s16x4 lo = trread(vb + (32 * ks) * DS_VROW + dt * 32), hh = trread(vb + (32 * ks + 16) * DS_VROW + dt * 32);
                        const pg8::bf16x8 a = {lo[0], lo[1], lo[2], lo[3], hh[0], hh[1], hh[2], hh[3]};
                        o[dt] = MFMA16(a, pb[2 * cc + ks], o[dt]);
                    }
                asm volatile("s_waitcnt lgkmcnt(0)" ::: "memory");
            }
        }
        if (n < 8) { const float inv = 1.f / ls; bf16* Op = (bf16*)(F.ws + WS_OA) + qrow * 512 + n * 64 + 4 * kg;
#pragma unroll
            for (int dt = 0; dt < 4; ++dt) *(unsigned long long*)(Op + 16 * dt) = (unsigned long long)cvtpk(o[dt][0] * inv, o[dt][1] * inv) | ((unsigned long long)cvtpk(o[dt][2] * inv, o[dt][3] * inv) << 32); }
    }
}
__device__ __forceinline__ void p3_attention(Frame& F) {
    for (int v = F.vcu; v < 256; v += F.G) {
        const int bh = v >> 3, s = v & 7;
        fox_unit(F, bh >> 3, bh & 7, 15 - s);
        fox_unit(F, bh >> 3, bh & 7, s);
    }
    for (int v = F.vcu; v < 256; v += F.G) {
        const int b = v >> 6, t = v & 63, g0 = (t < 32) ? 0 : 4;
        for (int i = 0; i < 4; ++i) dsa_unit(F, b, 63 - t, g0 + i);
        for (int i = 0; i < 4; ++i) dsa_unit(F, b, t, g0 + i);
    }
}

__device__ __forceinline__ void p6_router(Frame& F) {
    const float* MOD = (const float*)(F.ws + WS_MOD); const float* X1 = F.out; const float* SSQ = (const float*)(F.ws + WS_CTL) + CW_SSQ;
    bf16* H2 = (bf16*)(F.ws + WS_H2); const bf16* WrT = (const bf16*)(F.ws + WS_WRT); unsigned* ROUTE = (unsigned*)(F.ws + WS_ROUTE);
    int* TOKSLOT = (int*)(F.ws + WS_TOKSLOT);
    for (int i = F.vcu * NWAVES * 64 + F.tid; i < PMAX; i += F.G * NWAVES * 64) TOKSLOT[i] = -1;
    const int lane = F.lane, r = lane & 15, kg = lane >> 4;
    LAS float* LG = (LAS float*)(F.ldsl + RING_OFF) + F.wave * (16 * 52);
    for (int base = F.vcu * 4; base < M / 16; base += F.G * 4) {
        if (F.tid < 32) F.LX[32 + F.tid] = 0u;
        __syncthreads();
        const int item = base + F.wave; const bool act = (F.wave < 4) && (item < M / 16);
        int e1 = 0, e2 = 0, lr1 = 0, lr2 = 0; float w1 = 0.f, w2 = 0.f;
        if (act) {
            const int row = item * 16 + r, b = row >> 12;
            const float rstd = 1.f / sqrtf(SSQ[row] * (1.f / D) + RMS_EPS);
            f32x4 acc[3];
#pragma unroll
            for (int nt = 0; nt < 3; ++nt) acc[nt] = (f32x4){0.f, 0.f, 0.f, 0.f};
#pragma unroll 4
            for (int s = 0; s < 32; ++s) {
                const int k = 32 * s + 8 * kg;
                const f32x4 xa = *(const f32x4*)(X1 + (size_t)row * D + k), xb = *(const f32x4*)(X1 + (size_t)row * D + k + 4);
                const f32x4 ga = *(const f32x4*)(F.g_ffn + k), gb = *(const f32x4*)(F.g_ffn + k + 4);
                const f32x4 sa = *(const f32x4*)(MOD + b * 6144 + 4096 + k), sb = *(const f32x4*)(MOD + b * 6144 + 4096 + k + 4);
                const f32x4 ha = *(const f32x4*)(MOD + b * 6144 + 3072 + k), hb = *(const f32x4*)(MOD + b * 6144 + 3072 + k + 4);
                const f32x4 ya = xa * rstd * ga * (sa + 1.0f) + ha, yb = xb * rstd * gb * (sb + 1.0f) + hb;
                v4u w; w.x = cvtpk(ya.x, ya.y); w.y = cvtpk(ya.z, ya.w); w.z = cvtpk(yb.x, yb.y); w.w = cvtpk(yb.z, yb.w);
                *(v4u*)(H2 + (size_t)row * D + k) = w;
                const pg8::bf16x8 a = __builtin_bit_cast(pg8::bf16x8, w);
#pragma unroll
                for (int nt = 0; nt < 3; ++nt) { const pg8::bf16x8 bw = *(const pg8::bf16x8*)(WrT + (size_t)(16 * nt + r) * D + k); acc[nt] = MFMA16(a, bw, acc[nt]); }
            }
#pragma unroll
            for (int nt = 0; nt < 3; ++nt)
#pragma unroll
                for (int i = 0; i < 4; ++i) LG[(4 * kg + i) * 52 + 16 * nt + r] = acc[nt][i];
            asm volatile("s_waitcnt lgkmcnt(0)" ::: "memory");
            if (lane < 16) {
                LAS const float* lg = LG + lane * 52;
                float gl[4]; int grp = 0;
#pragma unroll
                for (int i = 0; i < 4; ++i) gl[i] = lg[32 + i] + F.b_group[i];
#pragma unroll
                for (int i = 1; i < 4; ++i) if (gl[i] > gl[grp]) grp = i;
                const float gmax = (grp == 0) ? gl[0] : (grp == 1) ? gl[1] : (grp == 2) ? gl[2] : gl[3];
                float den = 0.f;
#pragma unroll
                for (int i = 0; i < 4; ++i) den += expf(gl[i] - gmax);
                const float pg = 1.f / den;
                float ev[8];
#pragma unroll
                for (int i = 0; i < 8; ++i) ev[i] = lg[grp * 8 + i] + F.b_router[grp * 8 + i];
                int i1 = 0; float v1 = ev[0];
#pragma unroll
                for (int i = 1; i < 8; ++i) if (ev[i] > v1) { v1 = ev[i]; i1 = i; }
                int i2 = -1; float v2 = -3.0e38f;
#pragma unroll
                for (int i = 0; i < 8; ++i) if (i != i1 && ev[i] > v2) { v2 = ev[i]; i2 = i; }
                const float t = expf(v2 - v1);
                w1 = pg / (1.f + t); w2 = pg * t / (1.f + t);
                e1 = grp * 8 + i1; e2 = grp * 8 + i2;
                lr1 = (int)atomicAdd((unsigned*)&F.LX[32 + e1], 1u); lr2 = (int)atomicAdd((unsigned*)&F.LX[32 + e2], 1u);
            }
        }
        __syncthreads();
        if (F.tid < 32) { const unsigned c = F.LX[32 + F.tid]; F.LX[64 + F.tid] = c ? atomicAdd((unsigned*)(F.ctl + CW_CNT + F.tid), c) : 0u; }
        __syncthreads();
        if (act && lane < 16) { const int row = item * 16 + lane; unsigned* rp = ROUTE + (size_t)row * 8;
            rp[0] = (unsigned)e1; rp[1] = F.LX[64 + e1] + (unsigned)lr1; rp[2] = __float_as_uint(w1); rp[3] = 0u;
            rp[4] = (unsigned)e2; rp[5] = F.LX[64 + e2] + (unsigned)lr2; rp[6] = __float_as_uint(w2); rp[7] = 0u; }
        __syncthreads();
    }
}
__device__ __forceinline__ void p7_scatter(Frame& F) {
    moe_table(F);
    const int gw = F.vcu * NWAVES + F.wave, NGW = F.G * NWAVES;
    const bf16* H2 = (const bf16*)(F.ws + WS_H2); bf16* XS = (bf16*)(F.ws + WS_XS); const unsigned* ROUTE = (const unsigned*)(F.ws + WS_ROUTE);
    int* TOKSLOT = (int*)(F.ws + WS_TOKSLOT); float* WROW = (float*)(F.ws + WS_WROW);
    for (int m = gw; m < M; m += NGW) {
        const v4u ra = *(const v4u*)(ROUTE + (size_t)m * 8), rb = *(const v4u*)(ROUTE + (size_t)m * 8 + 4);
        const unsigned d0 = F.LX[96 + (ra.x & 31u)] + ra.y, d1 = F.LX[96 + (rb.x & 31u)] + rb.y;
        const v4u a = *((const v4u*)(H2 + (size_t)m * D) + F.lane), c = *((const v4u*)(H2 + (size_t)m * D) + 64 + F.lane);
        if (d0 < (unsigned)PMAX) { *((v4u*)(XS + (size_t)d0 * D) + F.lane) = a; *((v4u*)(XS + (size_t)d0 * D) + 64 + F.lane) = c; if (F.lane == 0) { TOKSLOT[d0] = 2 * m; WROW[d0] = __uint_as_float(ra.z); } }
        if (d1 < (unsigned)PMAX) { *((v4u*)(XS + (size_t)d1 * D) + F.lane) = a; *((v4u*)(XS + (size_t)d1 * D) + 64 + F.lane) = c; if (F.lane == 0) { TOKSLOT[d1] = 2 * m + 1; WROW[d1] = __uint_as_float(rb.z); } }
    }
}
__device__ __forceinline__ void p10_final(Frame& F) {
    const int gw = F.vcu * NWAVES + F.wave, NGW = F.G * NWAVES;
    const float* MOD = (const float*)(F.ws + WS_MOD); const bf16* YC = (const bf16*)(F.ws + WS_YC);
    for (int m = gw; m < M; m += NGW) {
        const int b = m >> 12;
        GAS f32x4* xr = (GAS f32x4*)(F.out + (size_t)m * D) + F.lane;
        const GAS unsigned long long* y0 = (const GAS unsigned long long*)(YC + (size_t)(2 * m) * D) + F.lane;
        const GAS unsigned long long* y1 = (const GAS unsigned long long*)(YC + (size_t)(2 * m + 1) * D) + F.lane;
        f32x4 v[4]; float s = 0.f;
#pragma unroll
        for (int j = 0; j < 4; ++j) { const int col = 4 * F.lane + 256 * j;
            const f32x4 x1 = xr[64 * j]; const unsigned long long a = y0[64 * j], c = y1[64 * j];
            const f32x4 gt = *(const f32x4*)(MOD + b * 6144 + 5120 + col);
            f32x4 y; y.x = bflo((unsigned)a) + bflo((unsigned)c); y.y = bfhi((unsigned)a) + bfhi((unsigned)c); y.z = bflo((unsigned)(a >> 32)) + bflo((unsigned)(c >> 32)); y.w = bfhi((unsigned)(a >> 32)) + bfhi((unsigned)(c >> 32));
            v[j] = x1 + gt * y; s += (v[j].x * v[j].x + v[j].y * v[j].y) + (v[j].z * v[j].z + v[j].w * v[j].w); }
        const float rstd = 1.f / sqrtf(wave_sum(s) * (1.f / D) + RMS_EPS);
#pragma unroll
        for (int j = 0; j < 4; ++j) { const int col = 4 * F.lane + 256 * j; const f32x4 g = *(const f32x4*)(F.g_final + col); xr[64 * j] = v[j] * rstd * g; }
    }
}

struct Args { const void* in[20]; float* out; unsigned char* ws; int ph_lo, ph_hi; };
__global__ void __launch_bounds__(NWAVES * 64, 2) hybrid_fwd(Args args) {
    extern __shared__ __attribute__((aligned(16))) unsigned char lds[];
    Frame F;
    F.lds = lds; F.ldsl = (LAS unsigned char*)lds; F.LX = (volatile LAS unsigned*)(F.ldsl + LX_OFF);
    F.tid = threadIdx.x; F.lane = F.tid & 63; F.wave = __builtin_amdgcn_readfirstlane(F.tid >> 6);
    F.G = gridDim.x; { const int bx = blockIdx.x; F.vcu = (F.G % 8 == 0) ? (bx % 8) * (F.G / 8) + bx / 8 : bx; }
    F.ws = args.ws; F.ctl = (gu32*)(args.ws + WS_CTL); F.out = args.out;
    F.x = (const float*)args.in[0]; F.c = (const float*)args.in[1]; F.positions = (const int*)args.in[2]; F.w_mod = (const float*)args.in[3]; F.b_mod = (const float*)args.in[4];
    F.g_mix = (const float*)args.in[5]; F.w_in = (const float*)args.in[6]; F.b_forget = (const float*)args.in[7]; F.w_out_a = (const float*)args.in[8]; F.w_out_b = (const float*)args.in[9];
    F.w_out = (const float*)args.in[10]; F.g_ffn = (const float*)args.in[11]; F.w_group = (const float*)args.in[12]; F.b_group = (const float*)args.in[13]; F.w_router = (const float*)args.in[14];
    F.b_router = (const float*)args.in[15]; F.w_e_gate = (const float*)args.in[16]; F.w_e_up = (const float*)args.in[17]; F.w_e_down = (const float*)args.in[18]; F.g_final = (const float*)args.in[19];
    for (int u = F.tid; u < (LDS_BYTES - LX_OFF) / 4; u += NWAVES * 64) F.LX[u] = 0u;
    __syncthreads();
    XcdBarrier bar; bar.bar = (unsigned*)(F.ctl + CW_BAR); bar.x = 0; bar.st = nullptr;
    if (N_LAUNCHES == 1) bar = xcd_barrier_post((unsigned*)(F.ctl + CW_BAR), F.LX);
    const int lo = args.ph_lo, hi = args.ph_hi;
#ifndef PH_MASK
#define PH_MASK 0xFFFF
#endif
#define IN(k) (((PH_MASK >> (k)) & 1) && lo <= (k) && (k) < hi)
#define SEAM(k) do { if (IN(k) && IN((k) + 1)) xcd_barrier(bar); } while (0)
    LAS unsigned char* ring = F.ldsl + RING_OFF;
    if (IN(0)) { p0_prologue(F); } SEAM(0);
    if (IN(1)) { p1_hnorm(F); } SEAM(1);
    if (IN(2)) {
        pg8::Gemm g{(const pg8::bf16_t*)(F.ws + WS_H), (const pg8::bf16_t*)(F.ws + WS_WIN), M, NPROJ, D}; pg8::StaticOrder S; S.init(M, NPROJ, F.G, (int)blockIdx.x);
        EpiProj E{F.ws, F.b_forget};
        pg8::gemm_phase<EpiProj, pg8::StaticOrder, true, true>(ring, g, S, E);
    } SEAM(2);
    if (IN(3)) { p3_attention(F); } SEAM(3);
    if (IN(4)) {
        { pg8::Gemm g{(const pg8::bf16_t*)(F.ws + WS_OA), (const pg8::bf16_t*)(F.ws + WS_WOA), M, D, 512}; pg8::StaticOrder S; S.init(M, D, F.G, (int)blockIdx.x);
          EpiMerge<0> E{F.ws}; pg8::gemm_phase<EpiMerge<0>, pg8::StaticOrder, true, true>(ring, g, S, E); }
        asm volatile("s_waitcnt vmcnt(0)" ::: "memory"); __syncthreads();
        { pg8::Gemm g{(const pg8::bf16_t*)(F.ws + WS_OB), (const pg8::bf16_t*)(F.ws + WS_WOB), M, D, 512}; pg8::StaticOrder S; S.init(M, D, F.G, (int)blockIdx.x);
          EpiMerge<1> E{F.ws}; pg8::gemm_phase<EpiMerge<1>, pg8::StaticOrder, true, true>(ring, g, S, E); }
    } SEAM(4);
    if (IN(5)) {
        pg8::Gemm g{(const pg8::bf16_t*)(F.ws + WS_GA), (const pg8::bf16_t*)(F.ws + WS_WO), M, D, D}; pg8::StaticOrder S; S.init(M, D, F.G, (int)blockIdx.x);
        EpiOut E{F.ws, F.x, F.out}; pg8::gemm_phase<EpiOut, pg8::StaticOrder, true, true>(ring, g, S, E);
    } SEAM(5);
    if (IN(6)) { p6_router(F); } SEAM(6);
    if (IN(7)) { p7_scatter(F); } SEAM(7);
    if (IN(8)) {
        moe_table(F);
        pg8::Gemm g{(const pg8::bf16_t*)(F.ws + WS_XS), (const pg8::bf16_t*)(F.ws + WS_WGU), PMAX, 32 * 1024, D};
        MoeOrder S{F.G, F.vcu, (int)F.LX[132] * 4, F.LX + 160};
        EpiGU E{F.ws}; pg8::gemm_phase<EpiGU, MoeOrder, true, true>(ring, g, S, E);
    } SEAM(8);
    if (IN(9)) {
        moe_table(F);
        pg8::Gemm g{(const pg8::bf16_t*)(F.ws + WS_HID), (const pg8::bf16_t*)(F.ws + WS_WDN), PMAX, 32 * 1024, 512};
        MoeOrder S{F.G, F.vcu, (int)F.LX[132] * 4, F.LX + 160};
        EpiDown E{F.ws}; pg8::gemm_phase<EpiDown, MoeOrder, true, true>(ring, g, S, E);
    } SEAM(9);
    if (IN(10)) { p10_final(F); }
#undef IN
#undef SEAM
}

extern "C" void kernel_launch(void* const* d_in, const int* in_sizes, int n_in, void* d_out, int out_size, void* d_ws, size_t ws_size, hipStream_t stream) {
    static int grid = 0;
    if (grid == 0) {
        if (n_in != 20 || in_sizes[0] != M * D || out_size != M * D || ws_size < WS_END) { fprintf(stderr, "kernel_launch: unexpected shapes (n_in %d, in0 %d, out %d, ws %zu); nothing launched\n", n_in, n_in > 0 ? in_sizes[0] : -1, out_size, ws_size); grid = -1; return; }
        int dev = 0, cus = 0, per_cu = 0;
        if (hipGetDevice(&dev) != hipSuccess || hipDeviceGetAttribute(&cus, hipDeviceAttributeMultiprocessorCount, dev) != hipSuccess) { grid = -1; return; }
        if (hipFuncSetAttribute((const void*)hybrid_fwd, hipFuncAttributeMaxDynamicSharedMemorySize, LDS_BYTES) != hipSuccess) { fprintf(stderr, "kernel_launch: hipFuncSetAttribute failed\n"); grid = -1; return; }
        if (hipOccupancyMaxActiveBlocksPerMultiprocessor(&per_cu, (const void*)hybrid_fwd, NWAVES * 64, LDS_BYTES) != hipSuccess || per_cu < 1)
            fprintf(stderr, "kernel_launch: note: occupancy query reports %d workgroups per CU\n", per_cu);
        (void)hipGetLastError();
        grid = cus;
    }
    if (grid < 0) return;
    if (hipMemsetAsync((char*)d_ws + WS_CTL, 0, CTL_ZERO_BYTES, stream) != hipSuccess) { fprintf(stderr, "kernel_launch: hipMemsetAsync failed\n"); return; }
    Args a{};
    for (int i = 0; i < 20; ++i) a.in[i] = d_in[i];
    a.out = (float*)d_out; a.ws = (unsigned char*)d_ws;
    for (int li = 0; li < N_LAUNCHES; ++li) {
        a.ph_lo = (N_LAUNCHES == 1) ? 0 : li; a.ph_hi = (N_LAUNCHES == 1) ? NPHASE : li + 1;
        hipLaunchKernelGGL(hybrid_fwd, dim3(grid), dim3(NWAVES * 64), LDS_BYTES, stream, a);
        const hipError_t le = hipPeekAtLastError();
        if (le != hipSuccess) { fprintf(stderr, "kernel_launch: launch %d failed: %s\n", li, hipGetErrorName(le)); break; }
    }
}
```

```cpp
#define MK_N_LAUNCHES 1
#include <hip/hip_runtime.h>
#include <hip/hip_bf16.h>
#include <cstdio>
#include <cstdint>
#include <cmath>
namespace pg8 {
#define PG8_LAS __attribute__((address_space(3)))
typedef unsigned short bf16_t;
typedef short bf16x8 __attribute__((ext_vector_type(8)));
typedef float f32x4 __attribute__((ext_vector_type(4)));
typedef unsigned u32x4 __attribute__((ext_vector_type(4)));
constexpr int BM = 256, BK = 64, HALF = 128, HTB = HALF * BK * 2  , STAGE_BYTES = 8 * HTB, NXCD = 8, WGM = 8;

__host__ __device__ __forceinline__ int lds_byte(int r, int c) { const int st = (r >> 4) * 2 + (c >> 5), rr = r & 15, cc = c & 31, ob = rr * 64 + cc * 2; return st * 1024 + (ob ^ (((ob >> 9) & 1) << 5)); }
__host__ __device__ __forceinline__ void stage_rc(int b, int& R, int& C) { const int st = b / 1024, sb = b % 1024, swz = sb ^ (((sb >> 9) & 1) << 5); R = (st >> 1) * 16 + swz / 64; C = (st & 1) * 32 + (swz % 64) / 2; }
__host__ __device__ __forceinline__ int perm32(int rho) { const int n = rho >> 4, i = rho & 15; return 8 * (i >> 2) + 4 * n + (i & 3); }

struct Unit { int pm, pn; };
struct Gemm { const bf16_t* A; const bf16_t* Bt; int M, N, K; };

struct StaticOrder {
    int nM, nN, nwg, G, c;
    __host__ __device__ void init(int M, int N, int G_, int c_) { nM = M / BM; nN = N / BM; nwg = nM * nN; G = G_; c = c_; }
    __host__ __device__ bool next(int i, Unit& u) const {
        const long L = (long)i * G + c; if (L >= nwg) return false;
        int wgid = (int)L; { const int q = nwg / NXCD, r = nwg % NXCD, xcd = wgid % NXCD, off = wgid / NXCD; wgid = (xcd < r ? xcd * (q + 1) : r * (q + 1) + (xcd - r) * q) + off; }
        const int nig = WGM * nN, gid = wgid / nig, fm = gid * WGM, gsz = (nM - fm) < WGM ? (nM - fm) : WGM;
        u.pm = fm + ((wgid % nig) % gsz); u.pn = (wgid % nig) / gsz; return true;
    }
    __device__ __forceinline__ void a_ready(const Unit&) const {}
    __device__ __forceinline__ void done(const Unit&) const {}
};

__device__ __forceinline__ unsigned cvt_pk_bf16(float lo, float hi) { unsigned r; asm volatile("v_cvt_pk_bf16_f32 %0, %1, %2" : "=v"(r) : "v"(lo), "v"(hi)); return r; }
typedef float f32x2 __attribute__((ext_vector_type(2)));
template <class Epi, class Sched, bool ALIGN_EPI = false, bool SP2 = false>
__device__ __forceinline__ void gemm_phase(PG8_LAS unsigned char* lds, const Gemm g, const Sched& S, const Epi& E) {
    const int tid = threadIdx.x, wid = __builtin_amdgcn_readfirstlane(tid >> 6), lane = tid & 63, wr = wid >> 2, wc = wid & 3, fr = lane & 15, fq = lane >> 4;
    const int K = g.K, nt = K / BK;
    unsigned voffA[2], voffB[2];
#pragma unroll
    for (int i = 0; i < 2; ++i) { int R, C; stage_rc(tid * 16 + i * 8192, R, C); const int Rb = Epi::PERM ? ((R & ~31) + perm32(R & 31)) : R;
        voffA[i] = (unsigned)(R * K + C) * 2u; voffB[i] = (unsigned)(Rb * K + C) * 2u; }
    const size_t kstep = (size_t)(BK * 2);
    const size_t hstep = (size_t)HALF * K * 2;
    const size_t tstep = 2 * hstep;
    const unsigned ldsw = (unsigned)wid * 1024u;
    const int aoff = lds_byte(wr * 64 + fr, fq * 8), boff = lds_byte(wc * 32 + fr, fq * 8);
#define PG8_SA(b, h) (((b) * 2 + (h)) * HTB)
#define PG8_SB(b, h) ((4 + (b) * 2 + (h)) * HTB)
#define PG8_STAGE(bufoff, gbase, voff) do { _Pragma("unroll") for (int _i = 0; _i < 2; ++_i) \
        __builtin_amdgcn_global_load_lds((const unsigned*)((const char*)(gbase) + (voff)[_i]), (PG8_LAS unsigned*)(lds + (bufoff) + ldsw + _i * 8192), 16, 0, 0); } while (0)
#define PG8_LDA(dst, b, h) do { _Pragma("unroll") for (int m = 0; m < 4; ++m) _Pragma("unroll") for (int k = 0; k < 2; ++k) dst[m][k] = *(const PG8_LAS bf16x8*)(lds + PG8_SA(b, h) + aoff + m * 2048 + k * 1024); } while (0)
#define PG8_LDB(dst, b, h) do { _Pragma("unroll") for (int n = 0; n < 2; ++n) _Pragma("unroll") for (int k = 0; k < 2; ++k) dst[n][k] = *(const PG8_LAS bf16x8*)(lds + PG8_SB(b, h) + boff + n * 2048 + k * 1024); } while (0)
#define PG8_MMA(ai, bj, At, Bt) do { __builtin_amdgcn_s_setprio(1); _Pragma("unroll") for (int m = 0; m < 4; ++m) _Pragma("unroll") for (int n = 0; n < 2; ++n) _Pragma("unroll") for (int k = 0; k < 2; ++k) \
        acc[ai][bj][m][n] = __builtin_amdgcn_mfma_f32_16x16x32_bf16(Bt[n][k], At[m][k], acc[ai][bj][m][n], 0, 0, 0); __builtin_amdgcn_s_setprio(0); } while (0)
#define PG8_WAIT_V(n) asm volatile("s_waitcnt vmcnt(" #n ")" ::: "memory")
#define PG8_WAIT_L(n) asm volatile("s_waitcnt lgkmcnt(" #n ")" ::: "memory")
#define PG8_BAR __builtin_amdgcn_s_barrier()
#define PG8_SCHED __builtin_amdgcn_sched_barrier(0)
    Unit cur, nxt; int ui = 0;
    if (!S.next(0, cur)) return;
    f32x4 acc[2][2][4][2];
#pragma unroll
    for (int a = 0; a < 2; ++a)
#pragma unroll
        for (int b = 0; b < 2; ++b)
#pragma unroll
            for (int m = 0; m < 4; ++m)
#pragma unroll
                for (int n = 0; n < 2; ++n) acc[a][b][m][n] = (f32x4){0.f, 0.f, 0.f, 0.f};
    bf16x8 At[4][2], B0[2][2], B1[2][2];
    const char* cA = (const char*)g.A + (size_t)cur.pm * tstep; const char* cB = (const char*)g.Bt + (size_t)cur.pn * tstep;
    S.a_ready(cur);
    if constexpr (SP2) {
        PG8_STAGE(PG8_SB(0, 0), cB, voffB); PG8_STAGE(PG8_SB(0, 1), cB + hstep, voffB); PG8_STAGE(PG8_SA(0, 0), cA, voffA); PG8_STAGE(PG8_SA(0, 1), cA + hstep, voffA);
        if (wr == 1) PG8_BAR;
        PG8_WAIT_V(2); PG8_BAR;
        PG8_STAGE(PG8_SB(1, 0), cB + kstep, voffB); PG8_STAGE(PG8_SA(1, 0), cA + kstep, voffA); PG8_STAGE(PG8_SB(1, 1), cB + hstep + kstep, voffB);
        PG8_WAIT_V(6); PG8_BAR;
    } else {
        PG8_STAGE(PG8_SB(0, 0), cB, voffB); PG8_STAGE(PG8_SA(0, 0), cA, voffA); PG8_STAGE(PG8_SB(0, 1), cB + hstep, voffB); PG8_STAGE(PG8_SA(0, 1), cA + hstep, voffA);
        if (wr == 1) PG8_BAR;
        PG8_WAIT_V(4); PG8_BAR;
        PG8_STAGE(PG8_SB(1, 0), cB + kstep, voffB); PG8_STAGE(PG8_SA(1, 0), cA + kstep, voffA); PG8_STAGE(PG8_SB(1, 1), cB + hstep + kstep, voffB);
        PG8_WAIT_V(6); PG8_BAR;
    }
    for (;;) {
        const bool has_next = S.next(ui + 1, nxt);
        const char* nA = has_next ? (const char*)g.A + (size_t)nxt.pm * tstep : cA; const char* nB = has_next ? (const char*)g.Bt + (size_t)nxt.pn * tstep : cB;
        for (int t = 0; t < nt; t += 2) {
            const bool last = (t == nt - 2);
            const char* a1 = cA + (size_t)(t + 1) * kstep;
            const char* a2 = last ? nA : cA + (size_t)(t + 2) * kstep; const char* b2 = last ? nB : cB + (size_t)(t + 2) * kstep;
            const char* a3 = a2 + kstep; const char* b3 = b2 + kstep;
            if (last && has_next) S.a_ready(nxt);
            if constexpr (SP2) {
            PG8_LDB(B0, 0, 0); PG8_LDB(B1, 0, 1); PG8_SCHED; PG8_LDA(At, 0, 0); PG8_STAGE(PG8_SA(1, 1), a1 + hstep, voffA);
            PG8_WAIT_V(8); PG8_WAIT_L(0); PG8_BAR; PG8_MMA(0, 0, At, B0); PG8_MMA(0, 1, At, B1); PG8_BAR; PG8_SCHED;
            PG8_LDA(At, 0, 1); PG8_STAGE(PG8_SB(0, 0), b2, voffB); PG8_STAGE(PG8_SB(0, 1), b2 + hstep, voffB); PG8_STAGE(PG8_SA(0, 0), a2, voffA);
            PG8_WAIT_V(8); PG8_WAIT_L(0); PG8_BAR; PG8_MMA(1, 0, At, B0); PG8_MMA(1, 1, At, B1); PG8_BAR; PG8_SCHED;
            PG8_LDB(B0, 1, 0); PG8_LDB(B1, 1, 1); PG8_SCHED; PG8_LDA(At, 1, 0); PG8_STAGE(PG8_SA(0, 1), a2 + hstep, voffA);
            PG8_WAIT_V(8); PG8_WAIT_L(0); PG8_BAR; PG8_MMA(0, 0, At, B0); PG8_MMA(0, 1, At, B1); PG8_BAR; PG8_SCHED;
            PG8_LDA(At, 1, 1); PG8_STAGE(PG8_SB(1, 0), b3, voffB); PG8_STAGE(PG8_SB(1, 1), b3 + hstep, voffB); PG8_STAGE(PG8_SA(1, 0), a3, voffA);
            PG8_WAIT_V(8); PG8_WAIT_L(0); PG8_BAR; PG8_MMA(1, 0, At, B0); PG8_MMA(1, 1, At, B1); PG8_BAR; PG8_SCHED;
            } else {
            PG8_LDB(B0, 0, 0); PG8_SCHED; PG8_LDA(At, 0, 0); PG8_STAGE(PG8_SA(1, 1), a1 + hstep, voffA);
            PG8_WAIT_L(8); PG8_BAR; PG8_WAIT_L(0); PG8_MMA(0, 0, At, B0); PG8_BAR; PG8_SCHED;
            PG8_LDB(B1, 0, 1); PG8_STAGE(PG8_SB(0, 0), b2, voffB);
            PG8_BAR; PG8_WAIT_L(0); PG8_MMA(0, 1, At, B1); PG8_BAR;
            PG8_LDA(At, 0, 1); PG8_STAGE(PG8_SA(0, 0), a2, voffA);
            PG8_BAR; PG8_WAIT_L(0); PG8_MMA(1, 0, At, B0); PG8_BAR; PG8_SCHED;
            PG8_STAGE(PG8_SB(0, 1), b2 + hstep, voffB);
            PG8_WAIT_V(6); PG8_BAR; PG8_MMA(1, 1, At, B1); PG8_BAR;
            PG8_LDB(B0, 1, 0); PG8_SCHED; PG8_LDA(At, 1, 0); PG8_STAGE(PG8_SA(0, 1), a2 + hstep, voffA);
            PG8_WAIT_L(8); PG8_BAR; PG8_WAIT_L(0); PG8_MMA(0, 0, At, B0); PG8_BAR; PG8_SCHED;
            PG8_LDB(B1, 1, 1); PG8_STAGE(PG8_SB(1, 0), b3, voffB);
            PG8_BAR; PG8_WAIT_L(0); PG8_MMA(0, 1, At, B1); PG8_BAR;
            PG8_LDA(At, 1, 1); PG8_STAGE(PG8_SA(1, 0), a3, voffA);
            PG8_BAR; PG8_WAIT_L(0); PG8_MMA(1, 0, At, B0); PG8_BAR; PG8_SCHED;
            PG8_STAGE(PG8_SB(1, 1), b3 + hstep, voffB);
            PG8_WAIT_V(6); PG8_BAR; PG8_MMA(1, 1, At, B1); PG8_BAR;
            }
        }
        if constexpr (ALIGN_EPI) { if (wr == 0) PG8_BAR; }
        if constexpr (!Epi::AFTER_DRAIN) { E(acc, cur, wr, wc, fr, fq); S.done(cur); }
        if (!has_next) break;
#pragma unroll
        for (int a = 0; a < 2; ++a)
#pragma unroll
            for (int b = 0; b < 2; ++b)
#pragma unroll
                for (int m = 0; m < 4; ++m)
#pragma unroll
                    for (int n = 0; n < 2; ++n) acc[a][b][m][n] = (f32x4){0.f, 0.f, 0.f, 0.f};
        cur = nxt; cA = nA; cB = nB; ++ui;
        if constexpr (ALIGN_EPI) { if (wr == 1) PG8_BAR; }
    }
    PG8_WAIT_V(0);
    if constexpr (!ALIGN_EPI) { if (wr == 0) PG8_BAR; }
    PG8_BAR;
    if constexpr (Epi::AFTER_DRAIN) { E.fused(acc, cur, wr, wc, fr, fq, lds, wid, lane); S.done(cur); }
#undef PG8_SA
#undef PG8_SB
#undef PG8_STAGE
#undef PG8_LDA
#undef PG8_LDB
#undef PG8_MMA
#undef PG8_WAIT_V
#undef PG8_WAIT_L
#undef PG8_BAR
#undef PG8_SCHED
}
}
constexpr int NWAVES = 8;
constexpr int BATCH = 4, SEQ = 4096, D = 1024, M = BATCH * SEQ;
constexpr int NPROJ = 4864;
constexpr float RMS_EPS = 1e-6f;
constexpr float LOG2E = 1.4426950408889634f;
constexpr float QSCALE = 0.125f * LOG2E;
constexpr int PMAX = 40960, NTMAX = 160;
constexpr int NPHASE = 11;
#ifndef MK_N_LAUNCHES
#define MK_N_LAUNCHES 1
#endif
constexpr int N_LAUNCHES = MK_N_LAUNCHES;

constexpr size_t MiB = 1u << 20;
constexpr size_t WS_CTL = 0, CTL_ZERO_BYTES = 1 * MiB;
constexpr size_t WS_MOD = 1 * MiB;
constexpr size_t WS_WRT = 1 * MiB + 256 * 1024;
constexpr size_t WS_TOKSLOT = 1 * MiB + 512 * 1024;
constexpr size_t WS_WROW = 1 * MiB + 768 * 1024;
constexpr size_t WS_COS = 2 * MiB, WS_SIN = 2 * MiB + 512 * 1024;
constexpr size_t WS_WI = 3 * MiB, WS_LOGF = 3 * MiB + 512 * 1024;
constexpr size_t WS_ROUTE = 4 * MiB;
constexpr size_t WS_WIN = 5 * MiB;
constexpr size_t WS_WOA = 15 * MiB, WS_WOB = 16 * MiB, WS_WO = 17 * MiB;
constexpr size_t WS_WGU = 19 * MiB, WS_WDN = 83 * MiB;
constexpr size_t WS_H = 115 * MiB;
constexpr size_t WS_OA = 115 * MiB, WS_OB = 131 * MiB, WS_H2 = 115 * MiB;
constexpr size_t WS_QA = 147 * MiB, WS_QI = 163 * MiB, WS_QB = 179 * MiB, WS_KB = 195 * MiB, WS_VB = 211 * MiB;
constexpr size_t WS_KA = 227 * MiB, WS_VA = 229 * MiB, WS_KI = 231 * MiB;
constexpr size_t WS_XS = 147 * MiB;
constexpr size_t WS_YC = 147 * MiB;
constexpr size_t WS_GA = 233 * MiB, WS_GB = 265 * MiB;
constexpr size_t WS_HID = 233 * MiB;
constexpr size_t WS_END = 297 * MiB;
constexpr int CW_BAR = 4096, CW_CNT = 8192, CW_SSQ = 16384;
constexpr int RING_OFF = 0, RING_BYTES = 131072;
constexpr int SEL_OFF = 131072;
constexpr int LX_OFF = 139264;
constexpr int LDS_BYTES = 143360;

#define GAS __attribute__((address_space(1)))
#define LAS __attribute__((address_space(3)))
typedef unsigned short bf16;
typedef unsigned v4u __attribute__((ext_vector_type(4)));
typedef float f32x4 __attribute__((ext_vector_type(4)));
typedef short bf16x8 __attribute__((ext_vector_type(8)));
typedef GAS unsigned gu32;
typedef GAS unsigned long long gu64;
#define RLX_AGENT __ATOMIC_RELAXED, __HIP_MEMORY_SCOPE_AGENT
#define LDS_WAIT() asm volatile("s_waitcnt lgkmcnt(0)" ::: "memory")
#define VM_WAIT() asm volatile("s_waitcnt vmcnt(0)" ::: "memory")
__device__ __forceinline__ unsigned long long rt() { return __builtin_amdgcn_s_memrealtime(); }
__device__ __forceinline__ unsigned f2bf(float f) { unsigned u = __builtin_bit_cast(unsigned, f); return (u + 0x7fffu + ((u >> 16) & 1u)) >> 16; }
__device__ __forceinline__ unsigned pk2(float lo, float hi) { return f2bf(lo) | (f2bf(hi) << 16); }

#define XB_TMO      128
#define XB_XCNT(j)  (256  + 64 * (j))
#define XB_XSUB(j)  (1280 + 64 * (j))
#define XB_XGEN(j)  (2304 + 64 * (j))
#define XB_TOP      3328
#define XB_TOPGEN   3392
#define XCD_BAR_WORDS 3456
#define XB_SPIN_CAP (1u << 18)

__device__ __forceinline__ unsigned xb_ld(unsigned* p)              { return __hip_atomic_load(p, __ATOMIC_RELAXED, __HIP_MEMORY_SCOPE_AGENT); }
__device__ __forceinline__ unsigned xb_add(unsigned* p, unsigned v) { return __hip_atomic_fetch_add(p, v, __ATOMIC_RELAXED, __HIP_MEMORY_SCOPE_AGENT); }
__device__ __forceinline__ unsigned xb_xcc_id() { return (unsigned)__builtin_amdgcn_s_getreg((3 << 11) | 20) & 0xFu; }
#define XB_SPIN(cond, bar) do { unsigned _sp = 0; while (cond) { __builtin_amdgcn_s_sleep(1); \
    if ((++_sp & 255u) == 0u) { if (xb_ld(&(bar)[XB_TMO])) break; if (_sp > XB_SPIN_CAP) { atomicAdd(&(bar)[XB_TMO], 1u); break; } } } } while (0)

struct XcdBarrier {
    unsigned* bar; unsigned x;
    volatile LAS unsigned* st;
};

__device__ __forceinline__ XcdBarrier xcd_barrier_post(unsigned* bar, volatile LAS unsigned* st) {
    XcdBarrier b; b.bar = bar; b.x = xb_xcc_id(); b.st = st;
    if (threadIdx.x == 0) (void)xb_add(&bar[XB_XCNT(b.x)], 1u);
    return b;
}
__device__ __forceinline__ void xcd_barrier_complete(unsigned* bar, unsigned x, unsigned& nloc, unsigned& nx) {
    const unsigned G = gridDim.x * gridDim.y * gridDim.z;
    unsigned sum, cnt, mine, sp = 0u;
    for (;;) {
        sum = 0u; cnt = 0u; mine = 0u;
#pragma unroll
        for (unsigned j = 0; j < 16; ++j) { const unsigned c = xb_ld(&bar[XB_XCNT(j)]); sum += c; cnt += (c > 0u) ? 1u : 0u; mine = (j == x) ? c : mine; }
        if (sum == G) break;
        __builtin_amdgcn_s_sleep(1);
        if ((++sp & 255u) == 0u) { if (xb_ld(&bar[XB_TMO])) break; if (sp > XB_SPIN_CAP) { atomicAdd(&bar[XB_TMO], 1u); break; } }
    }
    nloc = mine > 0u ? mine : 1u; nx = cnt > 0u ? cnt : 1u;
}

__device__ __forceinline__ void xcd_barrier(const XcdBarrier& b) {
    asm volatile("s_waitcnt vmcnt(0)" ::: "memory");
    __syncthreads();
    if (threadIdx.x == 0) {
        unsigned* bar = b.bar;
        __builtin_amdgcn_s_waitcnt(0);
        unsigned nloc = b.st[0], nx = b.st[1];
        if (nloc == 0u) { xcd_barrier_complete(bar, b.x, nloc, nx); b.st[0] = nloc; b.st[1] = nx; }
        const unsigned old = xb_add(&bar[XB_XSUB(b.x)], 1u);
        const unsigned gen = old / nloc;
        if (old + 1u == (gen + 1u) * nloc) {
            __builtin_amdgcn_fence(__ATOMIC_RELEASE, "agent");
            asm volatile("s_waitcnt vmcnt(0)" ::: "memory");
            const unsigned og = xb_add(&bar[XB_TOP], 1u);
            const unsigned tg = og / nx;
            if (og + 1u == (tg + 1u) * nx) xb_add(&bar[XB_TOPGEN], 1u);
            else XB_SPIN(xb_ld(&bar[XB_TOPGEN]) == tg, bar);
            __builtin_amdgcn_fence(__ATOMIC_ACQUIRE, "agent");
            xb_add(&bar[XB_XGEN(b.x)], 1u);
            asm volatile("s_waitcnt vmcnt(0)" ::: "memory");
        } else {
            XB_SPIN(xb_ld(&bar[XB_XGEN(b.x)]) == gen, bar);
            __builtin_amdgcn_fence(__ATOMIC_ACQUIRE, "agent");
            asm volatile("s_waitcnt vmcnt(0)" ::: "memory");
        }
    }
    __syncthreads();
}
typedef float f32x2_t __attribute__((ext_vector_type(2))); typedef __bf16 bf16x2_t __attribute__((ext_vector_type(2)));
typedef float f32x16 __attribute__((ext_vector_type(16)));
typedef short s16x4 __attribute__((ext_vector_type(4)));
__device__ __forceinline__ unsigned cvtpk(float lo, float hi) { f32x2_t v = {lo, hi}; bf16x2_t b = __builtin_convertvector(v, bf16x2_t); return __builtin_bit_cast(unsigned, b); }
__device__ __forceinline__ float bflo(unsigned w) { return __uint_as_float(w << 16); }
__device__ __forceinline__ float bfhi(unsigned w) { return __uint_as_float(w & 0xffff0000u); }
__device__ __forceinline__ float sigmoidf_(float v) { return 1.f / (1.f + __expf(-v)); }
#define MFMA32(a, b, c) __builtin_amdgcn_mfma_f32_32x32x16_bf16((a), (b), (c), 0, 0, 0)
#define MFMA16(a, b, c) __builtin_amdgcn_mfma_f32_16x16x32_bf16((a), (b), (c), 0, 0, 0)

struct Frame {
    unsigned char* lds;
    LAS unsigned char* ldsl;
    volatile LAS unsigned* LX;
    gu32* ctl;
    unsigned char* ws;
    int tid, lane, wave, vcu, G;
    const float *x, *c, *w_mod, *b_mod, *g_mix, *w_in, *b_forget, *w_out_a, *w_out_b, *w_out, *g_ffn, *w_group, *b_group, *w_router, *b_router, *w_e_gate, *w_e_up, *w_e_down, *g_final;
    const int* positions;
    float* out;
};
__device__ __forceinline__ float wave_sum(float v) {
#pragma unroll
    for (int o = 1; o < 64; o <<= 1) v += __shfl_xor(v, o);
    return v;
}

struct CmIn { __device__ __forceinline__ int operator()(int n) const { if (n < 1216) return n; if (n < 2752) return n + 8; if (n < 4800) return n + 16; if (n < 4808) return n - 4800 + 1216; if (n < 4816) return n - 4808 + 2760; return -1; } };
struct CmId { int base; __device__ __forceinline__ int operator()(int n) const { return n - base; } };
template <class CM>
__device__ __forceinline__ void transpose_item(const float* W, int ldw, bf16* WT, int K, int k0, int n0, const CM& cm, LAS float* scr, int lane) {
    const int sc = cm(n0 + (lane & 31));
#pragma unroll 8
    for (int i = 0; i < 32; ++i) { const int kk = 2 * i + (lane >> 5); scr[kk * 33 + (lane & 31)] = sc >= 0 ? W[(size_t)(k0 + kk) * ldw + sc] : 0.f; }
    LDS_WAIT(); asm volatile("" ::: "memory");
    const int c = lane & 7;
#pragma unroll
    for (int j = 0; j < 4; ++j) { const int n = (lane >> 3) + 8 * j; const LAS float* s = scr + (8 * c) * 33 + n;
        v4u o; o.x = pk2(s[0 * 33], s[1 * 33]); o.y = pk2(s[2 * 33], s[3 * 33]); o.z = pk2(s[4 * 33], s[5 * 33]); o.w = pk2(s[6 * 33], s[7 * 33]);
        *(GAS v4u*)(WT + (size_t)(n0 + n) * K + k0 + 8 * c) = o; }
    LDS_WAIT(); asm volatile("" ::: "memory");
}
__device__ __forceinline__ void p0_prologue(Frame& F) {
    __syncthreads();
    {
        LAS float* ca = (LAS float*)(F.ldsl + RING_OFF);
        LAS float* red = (LAS float*)(F.ldsl + RING_OFF + 16384);
        for (int i = F.tid; i < 4096; i += NWAVES * 64) { const float v = F.c[i]; ca[i] = v / (1.f + expf(-v)); }
        __syncthreads();
        float* MOD = (float*)(F.ws + WS_MOD);
        for (int cb = F.vcu; cb < 256; cb += F.G) {
            const int col0 = cb * 24;
            if (F.tid < 384) { const int j = F.tid % 24, ks = F.tid / 24; float a0 = 0.f, a1 = 0.f, a2 = 0.f, a3 = 0.f;
#pragma unroll 8
                for (int i = 0; i < 64; ++i) { const int k = ks + 16 * i; const float w = F.w_mod[(size_t)k * 6144 + col0 + j];
                    a0 += ca[k] * w; a1 += ca[1024 + k] * w; a2 += ca[2048 + k] * w; a3 += ca[3072 + k] * w; }
                LAS float* r = red + (ks * 24 + j) * 4; r[0] = a0; r[1] = a1; r[2] = a2; r[3] = a3; }
            __syncthreads();
            if (F.tid < 96) { const int j = F.tid % 24, bb = F.tid / 24; float s = 0.f;
#pragma unroll
                for (int ks = 0; ks < 16; ++ks) s += red[(ks * 24 + j) * 4 + bb];
                MOD[bb * 6144 + col0 + j] = s + F.b_mod[col0 + j]; }
            __syncthreads();
        }
    }
    LAS float* scr = (LAS float*)(F.ldsl + RING_OFF + F.wave * 16384);
    const int gw = F.vcu * NWAVES + F.wave, NGW = F.G * NWAVES;
    constexpr int I_IN = 16 * 152, I_OA = 8 * 32, I_O = 16 * 32, I_GU = 32 * 16 * 32, I_DN = 32 * 8 * 32;
    constexpr int NITEMS = I_IN + 2 * I_OA + I_O + I_GU + I_DN;
    bf16* WinT = (bf16*)(F.ws + WS_WIN); bf16* WoaT = (bf16*)(F.ws + WS_WOA); bf16* WobT = (bf16*)(F.ws + WS_WOB); bf16* WoT = (bf16*)(F.ws + WS_WO);
    bf16* WguT = (bf16*)(F.ws + WS_WGU); bf16* WdnT = (bf16*)(F.ws + WS_WDN);
    for (int it = gw; it < NITEMS; it += NGW) {
        int r = it;
        if (r < I_IN) { const int kb = r / 152, nb = r % 152; transpose_item(F.w_in, 4816, WinT, 1024, 64 * kb, 32 * nb, CmIn{}, scr, F.lane); continue; } r -= I_IN;
        if (r < I_OA) { const int kb = r / 32, nb = r % 32; transpose_item(F.w_out_a + 32 * nb, 1024, WoaT, 512, 64 * kb, 32 * nb, CmId{32 * nb}, scr, F.lane); continue; } r -= I_OA;
        if (r < I_OA) { const int kb = r / 32, nb = r % 32; transpose_item(F.w_out_b + 32 * nb, 1024, WobT, 512, 64 * kb, 32 * nb, CmId{32 * nb}, scr, F.lane); continue; } r -= I_OA;
        if (r < I_O) { const int kb = r / 32, nb = r % 32; transpose_item(F.w_out + 32 * nb, 1024, WoT, 1024, 64 * kb, 32 * nb, CmId{32 * nb}, scr, F.lane); continue; } r -= I_O;
        if (r < I_GU) { const int e = r / 512, q = r % 512, kb = q / 32, nb = q % 32;
            const int np = 32 * nb, ct = np >> 8, bj = (np >> 7) & 1, j0 = np & 127;
            const float* src = (bj ? F.w_e_up : F.w_e_gate) + (size_t)e * 1024 * 512 + ct * 128 + j0;
            transpose_item(src, 512, WguT, 1024, 64 * kb, e * 1024 + np, CmId{e * 1024 + np}, scr, F.lane); continue; } r -= I_GU;
        { const int e = r / 256, q = r % 256, kb = q / 32, nb = q % 32;
            const float* src = F.w_e_down + (size_t)e * 512 * 1024 + 32 * nb;
            transpose_item(src, 1024, WdnT, 512, 64 * kb, e * 1024 + 32 * nb, CmId{e * 1024 + 32 * nb}, scr, F.lane); }
    }
    { bf16* WrT = (bf16*)(F.ws + WS_WRT);
      for (int i = (F.vcu * NWAVES * 64 + F.tid); i < 64 * 1024; i += F.G * NWAVES * 64) { const int n = i >> 10, k = i & 1023;
          float v = 0.f; if (n < 32) v = F.w_router[k * 32 + n]; else if (n < 36) v = F.w_group[k * 4 + (n - 32)];
          WrT[i] = (bf16)f2bf(v); } }
}

__device__ __forceinline__ void p1_hnorm(Frame& F) {
    const int gw = F.vcu * NWAVES + F.wave, NGW = F.G * NWAVES;
    const float* MOD = (const float*)(F.ws + WS_MOD); bf16* H = (bf16*)(F.ws + WS_H);
    float* COS = (float*)(F.ws + WS_COS); float* SIN = (float*)(F.ws + WS_SIN);
    for (int m = gw; m < M; m += NGW) {
        const int b = m >> 12;
        const GAS f32x4* xr = (const GAS f32x4*)(F.x + (size_t)m * D) + F.lane;
        f32x4 v[4]; float s = 0.f;
#pragma unroll
        for (int j = 0; j < 4; ++j) { v[j] = xr[64 * j]; s += (v[j].x * v[j].x + v[j].y * v[j].y) + (v[j].z * v[j].z + v[j].w * v[j].w); }
        const float rstd = 1.f / sqrtf(wave_sum(s) * (1.f / D) + RMS_EPS);
        GAS unsigned long long* o8 = (GAS unsigned long long*)(H + (size_t)m * D) + F.lane;
#pragma unroll
        for (int j = 0; j < 4; ++j) { const int col = 4 * F.lane + 256 * j;
            const f32x4 g = *(const f32x4*)(F.g_mix + col), sc = *(const f32x4*)(MOD + b * 6144 + 1024 + col), sh = *(const f32x4*)(MOD + b * 6144 + col);
            const f32x4 h = v[j] * rstd * g * (sc + 1.0f) + sh;
            o8[64 * j] = (unsigned long long)cvtpk(h.x, h.y) | ((unsigned long long)cvtpk(h.z, h.w) << 32); }
        if (F.lane < 8) { const float invf = exp2f(-(float)F.lane * 2.3664460711655218f); const float ang = (float)F.positions[m] * invf;
            COS[m * 8 + F.lane] = cosf(ang); SIN[m * 8 + F.lane] = sinf(ang); }
    }
}

struct EpiProj {
    static constexpr bool PERM = true, AFTER_DRAIN = false;
    unsigned char* ws; const float* bfg;
    template <int BJ>
    __device__ __forceinline__ void part(const pg8::f32x4 (&acc)[2][2][4][2], const pg8::Unit& u, int wr, int wc, int fr, int fq) const {
        const float* COS = (const float*)(ws + WS_COS); const float* SIN = (const float*)(ws + WS_SIN);
        const int cg = __builtin_amdgcn_readfirstlane(u.pn * 256 + BJ * 128 + wc * 32);
        size_t boff = 0; int ld = 0, cofs = 0, kind = 4; float scale = 1.f;
        if (cg < 512)       { boff = WS_QA; ld = 512; cofs = 0;    kind = 1; scale = QSCALE; }
        else if (cg < 576)  { boff = WS_KA; ld = 64;  cofs = 512;  kind = 1; }
        else if (cg < 640)  { boff = WS_VA; ld = 64;  cofs = 576;  kind = 0; }
        else if (cg < 1152) { boff = WS_QI; ld = 512; cofs = 640;  kind = 1; scale = 0.125f; }
        else if (cg < 1216) { boff = WS_KI; ld = 64;  cofs = 1152; kind = 1; }
        else if (cg < 1728) { boff = WS_QB; ld = 512; cofs = 1216; kind = 0; scale = QSCALE; }
        else if (cg < 2240) { boff = WS_KB; ld = 512; cofs = 1728; kind = 0; }
        else if (cg < 2752) { boff = WS_VB; ld = 512; cofs = 2240; kind = 0; }
        else if (cg < 3776) { boff = WS_GA; ld = 1024; cofs = 2752; kind = 2; }
        else if (cg < 4800) { boff = WS_GB; ld = 1024; cofs = 3776; kind = 2; }
        else if (cg == 4800) { kind = 3; }
        if (kind == 4) return;
        if (kind == 3) {
#pragma unroll
            for (int ai = 0; ai < 2; ++ai)
#pragma unroll
                for (int m = 0; m < 4; ++m) {
                    const int row = u.pm * 256 + ai * 128 + wr * 64 + m * 16 + fr;
                    const pg8::f32x4 v0 = acc[ai][BJ][m][0], v1 = acc[ai][BJ][m][1];
                    if (fq == 0) { float* wi = (float*)(ws + WS_WI) + (size_t)row * 8; const float s = 0.35355339059327373f; *(pg8::f32x4*)wi = v0 * s; *(pg8::f32x4*)(wi + 4) = v1 * s; }
                    else if (fq == 1) { float* lf = (float*)(ws + WS_LOGF) + (size_t)(row >> 12) * 8 * SEQ + (row & (SEQ - 1));
#pragma unroll
                        for (int i = 0; i < 8; ++i) { const float z = (i < 4 ? v0[i & 3] : v1[i & 3]) + bfg[i];
                            const float ls = z >= 0.f ? -log1pf(expf(-z)) : z - log1pf(expf(z)); lf[(size_t)i * SEQ] = ls; } }
                }
            return;
        }
        const bool rope = (kind == 1) && ((cg & 63) == 0);
        bf16* base = (bf16*)(ws + boff);
        const int c0 = cg + 8 * fq - cofs;
#pragma unroll
        for (int ai = 0; ai < 2; ++ai)
#pragma unroll
            for (int m = 0; m < 4; ++m) {
                const int row = u.pm * 256 + ai * 128 + wr * 64 + m * 16 + fr;
                pg8::f32x4 v0 = acc[ai][BJ][m][0], v1 = acc[ai][BJ][m][1];
                if (rope) {
                    pg8::f32x4 o0, o1;
#pragma unroll
                    for (int i = 0; i < 4; ++i) { o0[i] = __shfl_xor(v0[i], 16); o1[i] = __shfl_xor(v1[i], 16); }
                    const pg8::f32x4 c0v = *(const pg8::f32x4*)(COS + (size_t)row * 8), c1v = *(const pg8::f32x4*)(COS + (size_t)row * 8 + 4);
                    const pg8::f32x4 s0v = *(const pg8::f32x4*)(SIN + (size_t)row * 8), s1v = *(const pg8::f32x4*)(SIN + (size_t)row * 8 + 4);
                    if (fq < 2) { const float sg = fq == 0 ? -1.f : 1.f; v0 = v0 * c0v + o0 * s0v * sg; v1 = v1 * c1v + o1 * s1v * sg; }
                }
                if (kind == 2) {
#pragma unroll
                    for (int i = 0; i < 4; ++i) { v0[i] = sigmoidf_(v0[i]); v1[i] = sigmoidf_(v1[i]); }
                }
                v0 = v0 * scale; v1 = v1 * scale;
                pg8::u32x4 w; w.x = cvtpk(v0[0], v0[1]); w.y = cvtpk(v0[2], v0[3]); w.z = cvtpk(v1[0], v1[1]); w.w = cvtpk(v1[2], v1[3]);
                *(pg8::u32x4*)(base + (size_t)row * ld + c0) = w;
            }
    }
    __device__ __forceinline__ void operator()(const pg8::f32x4 (&acc)[2][2][4][2], const pg8::Unit& u, int wr, int wc, int fr, int fq) const {
        part<0>(acc, u, wr, wc, fr, fq); part<1>(acc, u, wr, wc, fr, fq);
    }
};
template <int STEP> struct EpiMerge {
    static constexpr bool PERM = true, AFTER_DRAIN = false;
    unsigned char* ws;
    __device__ __forceinline__ void operator()(const pg8::f32x4 (&acc)[2][2][4][2], const pg8::Unit& u, int wr, int wc, int fr, int fq) const {
        bf16* GA = (bf16*)(ws + WS_GA); const bf16* GB = (const bf16*)(ws + WS_GB);
#pragma unroll
        for (int ai = 0; ai < 2; ++ai)
#pragma unroll
            for (int m = 0; m < 4; ++m) {
                const int row = u.pm * 256 + ai * 128 + wr * 64 + m * 16 + fr;
#pragma unroll
                for (int bj = 0; bj < 2; ++bj) {
                    const size_t off = (size_t)row * 1024 + u.pn * 256 + bj * 128 + wc * 32 + 8 * fq;
                    const pg8::f32x4 v0 = acc[ai][bj][m][0], v1 = acc[ai][bj][m][1];
                    const pg8::u32x4 a = *(const pg8::u32x4*)(GA + off);
                    float r[8];
                    if (STEP == 0) {
                        r[0] = bflo(a.x) * v0[0]; r[1] = bfhi(a.x) * v0[1]; r[2] = bflo(a.y) * v0[2]; r[3] = bfhi(a.y) * v0[3];
                        r[4] = bflo(a.z) * v1[0]; r[5] = bfhi(a.z) * v1[1]; r[6] = bflo(a.w) * v1[2]; r[7] = bfhi(a.w) * v1[3];
                    } else {
                        const pg8::u32x4 g = *(const pg8::u32x4*)(GB + off);
                        r[0] = bflo(a.x) + bflo(g.x) * v0[0]; r[1] = bfhi(a.x) + bfhi(g.x) * v0[1]; r[2] = bflo(a.y) + bflo(g.y) * v0[2]; r[3] = bfhi(a.y) + bfhi(g.y) * v0[3];
                        r[4] = bflo(a.z) + bflo(g.z) * v1[0]; r[5] = bfhi(a.z) + bfhi(g.z) * v1[1]; r[6] = bflo(a.w) + bflo(g.w) * v1[2]; r[7] = bfhi(a.w) + bfhi(g.w) * v1[3];
                    }
                    pg8::u32x4 w; w.x = cvtpk(r[0], r[1]); w.y = cvtpk(r[2], r[3]); w.z = cvtpk(r[4], r[5]); w.w = cvtpk(r[6], r[7]);
                    *(pg8::u32x4*)(GA + off) = w;
                }
            }
    }
};
struct EpiOut {
    static constexpr bool PERM = true, AFTER_DRAIN = false;
    unsigned char* ws; const float* x; float* out;
    __device__ __forceinline__ void operator()(const pg8::f32x4 (&acc)[2][2][4][2], const pg8::Unit& u, int wr, int wc, int fr, int fq) const {
        const float* MOD = (const float*)(ws + WS_MOD); float* SSQ = (float*)(ws + WS_CTL) + CW_SSQ;
        const int b = u.pm >> 4;
        const int colb = u.pn * 256 + wc * 32 + 8 * fq;
        pg8::f32x4 gt[2][2];
#pragma unroll
        for (int bj = 0; bj < 2; ++bj) { gt[bj][0] = *(const pg8::f32x4*)(MOD + b * 6144 + 2048 + colb + bj * 128); gt[bj][1] = *(const pg8::f32x4*)(MOD + b * 6144 + 2048 + colb + bj * 128 + 4); }
#pragma unroll
        for (int ai = 0; ai < 2; ++ai)
#pragma unroll
            for (int m = 0; m < 4; ++m) {
                const int row = u.pm * 256 + ai * 128 + wr * 64 + m * 16 + fr; float ss = 0.f;
#pragma unroll
                for (int bj = 0; bj < 2; ++bj) {
                    const size_t off = (size_t)row * 1024 + colb + bj * 128;
                    const pg8::f32x4 x0 = *(const pg8::f32x4*)(x + off), x1 = *(const pg8::f32x4*)(x + off + 4);
                    const pg8::f32x4 y0 = x0 + gt[bj][0] * acc[ai][bj][m][0], y1 = x1 + gt[bj][1] * acc[ai][bj][m][1];
                    *(pg8::f32x4*)(out + off) = y0; *(pg8::f32x4*)(out + off + 4) = y1;
                    ss += (y0[0] * y0[0] + y0[1] * y0[1]) + (y0[2] * y0[2] + y0[3] * y0[3]) + (y1[0] * y1[0] + y1[1] * y1[1]) + (y1[2] * y1[2] + y1[3] * y1[3]);
                }
                ss += __shfl_xor(ss, 16); ss += __shfl_xor(ss, 32);
                if (fq == 0) atomicAdd(SSQ + row, ss);
            }
    }
};
struct EpiGU {
    static constexpr bool PERM = true, AFTER_DRAIN = false;
    unsigned char* ws;
    __device__ __forceinline__ void operator()(const pg8::f32x4 (&acc)[2][2][4][2], const pg8::Unit& u, int wr, int wc, int fr, int fq) const {
        bf16* HID = (bf16*)(ws + WS_HID);
        const int col = (u.pn & 3) * 128 + wc * 32 + 8 * fq;
#pragma unroll
        for (int ai = 0; ai < 2; ++ai)
#pragma unroll
            for (int m = 0; m < 4; ++m) {
                const int row = u.pm * 256 + ai * 128 + wr * 64 + m * 16 + fr;
                float r[8];
#pragma unroll
                for (int i = 0; i < 8; ++i) { const float g = i < 4 ? acc[ai][0][m][0][i] : acc[ai][0][m][1][i - 4]; const float up = i < 4 ? acc[ai][1][m][0][i] : acc[ai][1][m][1][i - 4];
                    r[i] = g * sigmoidf_(g) * up; }
                pg8::u32x4 w; w.x = cvtpk(r[0], r[1]); w.y = cvtpk(r[2], r[3]); w.z = cvtpk(r[4], r[5]); w.w = cvtpk(r[6], r[7]);
                *(pg8::u32x4*)(HID + (size_t)row * 512 + col) = w;
            }
    }
};
struct EpiDown {
    static constexpr bool PERM = true, AFTER_DRAIN = false;
    unsigned char* ws;
    __device__ __forceinline__ void operator()(const pg8::f32x4 (&acc)[2][2][4][2], const pg8::Unit& u, int wr, int wc, int fr, int fq) const {
        bf16* YC = (bf16*)(ws + WS_YC); const int* TOKSLOT = (const int*)(ws + WS_TOKSLOT); const float* WROW = (const float*)(ws + WS_WROW);
        const int colb = (u.pn & 3) * 256 + wc * 32 + 8 * fq;
#pragma unroll
        for (int ai = 0; ai < 2; ++ai)
#pragma unroll
            for (int m = 0; m < 4; ++m) {
                const int row = u.pm * 256 + ai * 128 + wr * 64 + m * 16 + fr;
                const int ts = TOKSLOT[row]; const float gw = WROW[row];
                if (ts >= 0) {
#pragma unroll
                    for (int bj = 0; bj < 2; ++bj) { const pg8::f32x4 v0 = acc[ai][bj][m][0] * gw, v1 = acc[ai][bj][m][1] * gw;
                        pg8::u32x4 w; w.x = cvtpk(v0[0], v0[1]); w.y = cvtpk(v0[2], v0[3]); w.z = cvtpk(v1[0], v1[1]); w.w = cvtpk(v1[2], v1[3]);
                        *(pg8::u32x4*)(YC + (size_t)ts * 1024 + colb + bj * 128) = w; }
                }
            }
    }
};
struct MoeOrder {
    int G, c, nunits; const volatile LAS unsigned* tile_e;
    __device__ __forceinline__ bool next(int i, pg8::Unit& u) const { const int L = i * G + c; if (L >= nunits) return false; const int rt = L >> 2; u.pm = rt; u.pn = (int)tile_e[rt] * 4 + (L & 3); return true; }
    __device__ __forceinline__ void a_ready(const pg8::Unit&) const {}
    __device__ __forceinline__ void done(const pg8::Unit&) const {}
};
__device__ __forceinline__ void moe_table(Frame& F) {
    const gu32* CNT = F.ctl + CW_CNT;
    if (F.tid == 0) { unsigned p = 0;
        for (int e = 0; e < 32; ++e) { F.LX[96 + e] = p; const unsigned c = __hip_atomic_load(CNT + e, RLX_AGENT); const unsigned nt = (c + 255u) >> 8;
            for (unsigned t = 0; t < nt; ++t) if ((p >> 8) + t < (unsigned)NTMAX) F.LX[160 + (p >> 8) + t] = (unsigned)e;
            p += nt << 8; }
        F.LX[128] = p; F.LX[132] = (p >> 8) < (unsigned)NTMAX ? (p >> 8) : (unsigned)NTMAX; }
    __syncthreads();
}
#ifndef DUP_MASK
#define DUP_MASK 0
#endif
typedef short v4i16_t __attribute__((ext_vector_type(4)));
__device__ __forceinline__ s16x4 trread(LAS const unsigned char* p) { return __builtin_bit_cast(s16x4, __builtin_amdgcn_ds_read_tr16_b64_v4i16((LAS v4i16_t*)p)); }
constexpr int FX_CK = 0, FX_K = 16384, FX_V = 32768, FX_VROW = 144, FX_VBUF = 64 * FX_VROW;
__device__ __forceinline__ float xhalf(float v, int hi) { const auto rr = __builtin_amdgcn_permlane32_swap(__float_as_uint(v), __float_as_uint(v), false, false); return __uint_as_float(hi ? rr[0] : rr[1]); }
__device__ __forceinline__ void fox_tile(LAS unsigned char* L, LAS float* CK, int cur, int t, int r32, int hi, int lane, int q, int qminw,
                                         const pg8::bf16x8 (&qf)[4], float& m_run, float& l_run, f32x16& o0, f32x16& o1) {
    LAS const unsigned char* Kb = L + FX_K + cur * 8192; LAS const unsigned char* Vb = L + FX_V + cur * FX_VBUF;
    f32x16 p0, p1;
#pragma unroll
    for (int rq = 0; rq < 4; ++rq) { const f32x4 c0 = *(LAS const f32x4*)(CK + 64 * t + 8 * rq + 4 * hi), c1 = *(LAS const f32x4*)(CK + 64 * t + 32 + 8 * rq + 4 * hi);
#pragma unroll
        for (int i = 0; i < 4; ++i) { p0[4 * rq + i] = c0[i]; p1[4 * rq + i] = c1[i]; } }
#pragma unroll
    for (int d0 = 0; d0 < 4; ++d0) {
        const int co = ((2 * d0 + hi) ^ (r32 & 7)) * 16;
        const pg8::bf16x8 a0 = *(LAS const pg8::bf16x8*)(Kb + r32 * 128 + co);
        const pg8::bf16x8 a1 = *(LAS const pg8::bf16x8*)(Kb + (r32 + 32) * 128 + co);
        p0 = MFMA32(a0, qf[d0], p0); p1 = MFMA32(a1, qf[d0], p1);
    }
    if (64 * t + 63 > qminw) {
#pragma unroll
        for (int r = 0; r < 16; ++r) { const int key = 64 * t + (r & 3) + 8 * (r >> 2) + 4 * hi; if (key > q) p0[r] = -1e30f; if (key + 32 > q) p1[r] = -1e30f; } }
    float mx = p0[0];
#pragma unroll
    for (int r = 1; r < 16; ++r) mx = fmaxf(mx, p0[r]);
#pragma unroll
    for (int r = 0; r < 16; ++r) mx = fmaxf(mx, p1[r]);
    mx = fmaxf(mx, xhalf(mx, hi));
    const float mnew = fmaxf(m_run, mx), alpha = __builtin_amdgcn_exp2f(m_run - mnew); m_run = mnew;
    float rs = 0.f;
#pragma unroll
    for (int r = 0; r < 16; ++r) { p0[r] = __builtin_amdgcn_exp2f(p0[r] - mnew); p1[r] = __builtin_amdgcn_exp2f(p1[r] - mnew); rs += p0[r] + p1[r]; }
    rs += xhalf(rs, hi);
    l_run = l_run * alpha + rs;
#pragma unroll
    for (int r = 0; r < 16; ++r) { o0[r] *= alpha; o1[r] *= alpha; }
    pg8::bf16x8 pb[4];
#pragma unroll
    for (int s = 0; s < 2; ++s) { v4u w;
        w.x = cvtpk(p0[8 * s], p0[8 * s + 1]); w.y = cvtpk(p0[8 * s + 2], p0[8 * s + 3]); w.z = cvtpk(p0[8 * s + 4], p0[8 * s + 5]); w.w = cvtpk(p0[8 * s + 6], p0[8 * s + 7]); pb[s] = __builtin_bit_cast(pg8::bf16x8, w);
        w.x = cvtpk(p1[8 * s], p1[8 * s + 1]); w.y = cvtpk(p1[8 * s + 2], p1[8 * s + 3]); w.z = cvtpk(p1[8 * s + 4], p1[8 * s + 5]); w.w = cvtpk(p1[8 * s + 6], p1[8 * s + 7]); pb[2 + s] = __builtin_bit_cast(pg8::bf16x8, w); }
    LAS const unsigned char* vb = Vb + (4 * hi + ((lane & 15) >> 2)) * FX_VROW + (16 * ((lane >> 4) & 1) + 4 * (lane & 3)) * 2;
#pragma unroll
    for (int s = 0; s < 4; ++s) {
        const s16x4 l0 = trread(vb + (16 * s) * FX_VROW), h0 = trread(vb + (16 * s + 8) * FX_VROW);
        const s16x4 l1 = trread(vb + (16 * s) * FX_VROW + 64), h1 = trread(vb + (16 * s + 8) * FX_VROW + 64);
        const pg8::bf16x8 a0 = {l0[0], l0[1], l0[2], l0[3], h0[0], h0[1], h0[2], h0[3]};
        const pg8::bf16x8 a1 = {l1[0], l1[1], l1[2], l1[3], h1[0], h1[1], h1[2], h1[3]};
        o0 = MFMA32(a0, pb[s], o0); o1 = MFMA32(a1, pb[s], o1);
    }
}
__device__ __forceinline__ void fox_unit(Frame& F, int b, int h, int qb) {
    const int tid = F.tid, lane = F.lane, wave = F.wave, r32 = lane & 31, hi = lane >> 5;
    LAS unsigned char* L = F.ldsl + RING_OFF;
    LAS float* CK = (LAS float*)(L + FX_CK);
    const int nkeys = (qb + 1) * 256, NT = nkeys / 64;
    const bf16* QBp = (const bf16*)(F.ws + WS_QB); const bf16* KBp = (const bf16*)(F.ws + WS_KB); const bf16* VBp = (const bf16*)(F.ws + WS_VB);
    __syncthreads();
    {
        const float* lf = (const float*)(F.ws + WS_LOGF) + (size_t)(b * 8 + h) * SEQ;
        float v[8]; const int k0 = tid * 8;
        if (k0 < nkeys) { const f32x4 a = *(const f32x4*)(lf + k0), c = *(const f32x4*)(lf + k0 + 4); v[0] = a.x; v[1] = a.y; v[2] = a.z; v[3] = a.w; v[4] = c.x; v[5] = c.y; v[6] = c.z; v[7] = c.w; }
        else {
#pragma unroll
            for (int i = 0; i < 8; ++i) v[i] = 0.f; }
#pragma unroll
        for (int i = 1; i < 8; ++i) v[i] += v[i - 1];
        const float tot = v[7]; float sc = tot;
#pragma unroll
        for (int o = 1; o < 64; o <<= 1) { const float t = __shfl_up(sc, o); if (lane >= o) sc += t; }
        if (lane == 63) F.LX[8 + wave] = __float_as_uint(sc);
        __syncthreads();
        float woff = 0.f, cref = 0.f;
#pragma unroll
        for (int w = 0; w < 8; ++w) { const float t = __uint_as_float(F.LX[8 + w]); cref += t; if (w < wave) woff += t; }
        const float base = woff + sc - tot;
        if (k0 < nkeys) {
#pragma unroll
            for (int i = 0; i < 8; ++i) CK[k0 + i] = (cref - (base + v[i])) * LOG2E; }
    }
    const size_t qrow = (size_t)b * SEQ + qb * 256 + wave * 32 + r32;
    pg8::bf16x8 qf[4];
#pragma unroll
    for (int d0 = 0; d0 < 4; ++d0) qf[d0] = *(const pg8::bf16x8*)(QBp + qrow * 512 + h * 64 + d0 * 16 + hi * 8);
    float m_run = -1e30f, l_run = 0.f; f32x16 o0 = {}, o1 = {};
    const int kr = tid >> 3, ch = tid & 7;
    const bf16* Kg = KBp + ((size_t)b * SEQ + kr) * 512 + h * 64 + ch * 8;
    const bf16* Vg = VBp + ((size_t)b * SEQ + kr) * 512 + h * 64 + ch * 8;
    const int kwo = FX_K + kr * 128 + ((ch ^ (kr & 7)) * 16), vwo = FX_V + kr * FX_VROW + ch * 16;
    v4u kr0 = *(const v4u*)Kg, vr0 = *(const v4u*)Vg, kr1 = kr0, vr1 = vr0, kr2 = kr0, vr2 = vr0;
    if (1 < NT) { kr1 = *(const v4u*)(Kg + (size_t)1 * 64 * 512); vr1 = *(const v4u*)(Vg + (size_t)1 * 64 * 512); }
    if (2 < NT) { kr2 = *(const v4u*)(Kg + (size_t)2 * 64 * 512); vr2 = *(const v4u*)(Vg + (size_t)2 * 64 * 512); }
    *(LAS v4u*)(L + kwo) = kr0; *(LAS v4u*)(L + vwo) = vr0;
    __syncthreads();
    const int qminw = qb * 256 + wave * 32, qmaxw = qminw + 31, q = qminw + r32;
#define FOX_STEP(t, KRF, VRF, KRN, VRN) do { \
        const int cur = (t) & 1; \
        if ((t) + 3 < NT) { KRF = *(const v4u*)(Kg + (size_t)((t) + 3) * 64 * 512); VRF = *(const v4u*)(Vg + (size_t)((t) + 3) * 64 * 512); } \
        if (64 * (t) <= qmaxw) fox_tile(L, CK, cur, (t), r32, hi, lane, q, qminw, qf, m_run, l_run, o0, o1); \
        if ((t) + 1 < NT) { const int nb = cur ^ 1; *(LAS v4u*)(L + kwo + nb * 8192) = KRN; *(LAS v4u*)(L + vwo + nb * FX_VBUF) = VRN; } \
        __syncthreads(); } while (0)
    for (int t = 0; t < NT; t += 3) {
        FOX_STEP(t, kr0, vr0, kr1, vr1);
        if (t + 1 < NT) FOX_STEP(t + 1, kr1, vr1, kr2, vr2);
        if (t + 2 < NT) FOX_STEP(t + 2, kr2, vr2, kr0, vr0);
    }
#undef FOX_STEP
    const float inv = 1.f / l_run;
    bf16* Op = (bf16*)(F.ws + WS_OB) + qrow * 512 + h * 64;
#pragma unroll
    for (int rq = 0; rq < 4; ++rq) {
        const unsigned long long w0 = (unsigned long long)cvtpk(o0[4 * rq] * inv, o0[4 * rq + 1] * inv) | ((unsigned long long)cvtpk(o0[4 * rq + 2] * inv, o0[4 * rq + 3] * inv) << 32);
        const unsigned long long w1 = (unsigned long long)cvtpk(o1[4 * rq] * inv, o1[4 * rq + 1] * inv) | ((unsigned long long)cvtpk(o1[4 * rq + 2] * inv, o1[4 * rq + 3] * inv) << 32);
        *(unsigned long long*)(Op + 8 * rq + 4 * hi) = w0; *(unsigned long long*)(Op + 32 + 8 * rq + 4 * hi) = w1;
    }
}

constexpr int DS_VROW = 144, DS_VBUF = 64 * DS_VROW;
__device__ __forceinline__ void dsa_unit(Frame& F, int b, int c, int g) {
    const int lane = F.lane, wave = F.wave;
    LAS unsigned char* L = F.ldsl + RING_OFF;
    LAS float* SC = (LAS float*)L;
    LAS int* SEL = (LAS int*)(F.ldsl + SEL_OFF) + wave * 256;
    const int q0 = c * 64 + g * 8, Kn = (c + 1) * 64;
    const bf16* QI = (const bf16*)(F.ws + WS_QI); const bf16* KI = (const bf16*)(F.ws + WS_KI); const float* WI = (const float*)(F.ws + WS_WI);
    const bf16* QA = (const bf16*)(F.ws + WS_QA); const bf16* KA = (const bf16*)(F.ws + WS_KA); const bf16* VA = (const bf16*)(F.ws + WS_VA);
    __syncthreads();
    for (int repa_ = 0; repa_ <= ((DUP_MASK >> 12) & 1); ++repa_) {
        const int m = lane & 31, hi = lane >> 5;
        const int q4 = 2 * ((m >> 2) & 1) + (m >> 4), head = (m & 3) + 4 * ((m >> 3) & 1);
        pg8::bf16x8 af[2][4]; float wq[2][16];
#pragma unroll
        for (int mt = 0; mt < 2; ++mt) {
            const size_t arow = (size_t)b * SEQ + q0 + 4 * mt + q4;
#pragma unroll
            for (int s = 0; s < 4; ++s) af[mt][s] = *(const pg8::bf16x8*)(QI + arow * 512 + head * 64 + 16 * s + 8 * hi);
            const size_t wrow = (size_t)b * SEQ + q0 + 4 * mt + 2 * hi;
#pragma unroll
            for (int j = 0; j < 4; ++j) { const f32x4 t = *(const f32x4*)(WI + wrow * 8 + 4 * j); wq[mt][4 * j] = t.x; wq[mt][4 * j + 1] = t.y; wq[mt][4 * j + 2] = t.z; wq[mt][4 * j + 3] = t.w; }
        }
        const int nkt = Kn / 32;
        const bf16* kbase = KI + ((size_t)b * SEQ + m) * 64 + 8 * hi;
        LAS float* sp = SC + (2 * hi) * 4096 + m;
#define DSA_LOADK(dst, kt) do { _Pragma("unroll") for (int s_ = 0; s_ < 4; ++s_) dst[s_] = *(const pg8::bf16x8*)(kbase + (size_t)(kt) * 32 * 64 + 16 * s_); } while (0)
#define DSA_TILE(src, kt) do { _Pragma("unroll") for (int mt_ = 0; mt_ < 2; ++mt_) { f32x16 acc_ = {}; \
            _Pragma("unroll") for (int s_ = 0; s_ < 4; ++s_) acc_ = MFMA32(af[mt_][s_], src[s_], acc_); \
            float s0_ = 0.f, s1_ = 0.f; \
            _Pragma("unroll") for (int r_ = 0; r_ < 8; ++r_) { s0_ += wq[mt_][r_] * fmaxf(acc_[r_], 0.f); s1_ += wq[mt_][8 + r_] * fmaxf(acc_[8 + r_], 0.f); } \
            sp[(4 * mt_) * 4096 + 32 * (kt)] = s0_; sp[(4 * mt_ + 1) * 4096 + 32 * (kt)] = s1_; } } while (0)
        pg8::bf16x8 bA[4], bB[4];
        if (wave < nkt) DSA_LOADK(bA, wave);
        if (wave + 8 < nkt) DSA_LOADK(bB, wave + 8);
        for (int kt = wave; kt < nkt; kt += 16) {
            DSA_TILE(bA, kt);
            if (kt + 16 < nkt) DSA_LOADK(bA, kt + 16);
            if (kt + 8 < nkt) { DSA_TILE(bB, kt + 8); if (kt + 24 < nkt) DSA_LOADK(bB, kt + 24); }
        }
#undef DSA_LOADK
#undef DSA_TILE
    }
    __syncthreads();
    int nsel;
    for (int repb_ = 0; repb_ <= ((DUP_MASK >> 13) & 1); ++repb_)
    if (Kn <= 256) { nsel = Kn; for (int i = lane; i < Kn; i += 64) SEL[i] = i; }
    else {
        nsel = 256;
        unsigned key[64];
        LAS const float* sr = SC + wave * 4096;
        const int nj = Kn >> 6;
#pragma unroll
        for (int j = 0; j < 64; ++j) { unsigned u = 0u;
            if (j < nj) { u = __float_as_uint(sr[64 * j + lane] + 0.f); u = (u >> 31) ? ~u : (u | 0x80000000u); }
            key[j] = u; }
        unsigned T = 0u; int nge = 0;
        for (int bit = 31; bit >= 0; --bit) {
            const unsigned cand = T | (1u << bit); unsigned cl = 0u;
#pragma unroll
            for (int j = 0; j < 64; ++j) cl += (key[j] >= cand) ? 1u : 0u;
            int cnt = 0;
#pragma unroll
            for (int bb = 0; bb < 7; ++bb) cnt += __popcll(__ballot(((cl >> bb) & 1u) != 0u)) << bb;
            if (cnt >= 256) { T = cand; nge = cnt; }
            if (cnt == 256) break;
        }
        if (nge == 256) {
            unsigned cl = 0u;
#pragma unroll
            for (int j = 0; j < 64; ++j) cl += (key[j] >= T) ? 1u : 0u;
            int p = 0;
#pragma unroll
            for (int bb = 0; bb < 7; ++bb) { const unsigned long long mk = __ballot(((cl >> bb) & 1u) != 0u);
                p += (int)__builtin_amdgcn_mbcnt_hi((unsigned)(mk >> 32), __builtin_amdgcn_mbcnt_lo((unsigned)mk, 0u)) << bb; }
#pragma unroll
            for (int j = 0; j < 64; ++j) if (key[j] >= T) { SEL[p & 255] = 64 * j + lane; ++p; }
        } else {
            int ngt = 0;
#pragma unroll
            for (int j = 0; j < 64; ++j) ngt += __popcll(__ballot(key[j] > T));
            const int need_eq = 256 - ngt; int pos = 0, eq_seen = 0;
#pragma unroll
            for (int j = 0; j < 64; ++j) {
                const bool gt = key[j] > T, eq = key[j] == T;
                const unsigned long long meq = __ballot(eq);
                const int eq_rank = eq_seen + (int)__builtin_amdgcn_mbcnt_hi((unsigned)(meq >> 32), __builtin_amdgcn_mbcnt_lo((unsigned)meq, 0u));
                const bool take = gt || (eq && eq_rank < need_eq);
                const unsigned long long mt = __ballot(take);
                const int pr = (int)__builtin_amdgcn_mbcnt_hi((unsigned)(mt >> 32), __builtin_amdgcn_mbcnt_lo((unsigned)mt, 0u));
                if (take && pos + pr < 256) SEL[pos + pr] = 64 * j + lane;
                pos += __popcll(mt); eq_seen += __popcll(meq);
            }
        }
    }
    asm volatile("s_waitcnt lgkmcnt(0)" ::: "memory");
    for (int repc_ = 0; repc_ <= ((DUP_MASK >> 14) & 1); ++repc_) {
        const int n = lane & 15, kg = lane >> 4;
        const size_t qrow = (size_t)b * SEQ + q0 + wave;
        pg8::bf16x8 qf[2];
#pragma unroll
        for (int s = 0; s < 2; ++s) { qf[s] = (pg8::bf16x8){0, 0, 0, 0, 0, 0, 0, 0}; if (n < 8) qf[s] = *(const pg8::bf16x8*)(QA + qrow * 512 + n * 64 + 32 * s + 8 * kg); }
        const int ntile = nsel >> 4;
        const bf16* vgb = VA + (size_t)b * SEQ * 64 + 8 * (lane & 7);
        v4u vr[8];
#define DSA_LOADV(cc) do { _Pragma("unroll") for (int i_ = 0; i_ < 8; ++i_) { const int idx_ = SEL[64 * (cc) + (lane >> 3) + 8 * i_]; vr[i_] = *(const v4u*)(vgb + (size_t)idx_ * 64); } } while (0)
        DSA_LOADV(0);
        f32x4 x[16];
#pragma unroll
        for (int t = 0; t < 16; ++t) {
            x[t] = (f32x4){-1e30f, -1e30f, -1e30f, -1e30f};
            if (t < ntile) { const int idx = SEL[16 * t + n]; const bf16* kp = KA + ((size_t)b * SEQ + idx) * 64 + 8 * kg;
                const pg8::bf16x8 a0 = *(const pg8::bf16x8*)kp, a1 = *(const pg8::bf16x8*)(kp + 32);
                f32x4 z = {0.f, 0.f, 0.f, 0.f}; z = MFMA16(a0, qf[0], z); z = MFMA16(a1, qf[1], z); x[t] = z; }
        }
        float mx = -1e30f;
#pragma unroll
        for (int t = 0; t < 16; ++t) mx = fmaxf(fmaxf(mx, fmaxf(x[t][0], x[t][1])), fmaxf(x[t][2], x[t][3]));
        mx = fmaxf(mx, __shfl_xor(mx, 16)); mx = fmaxf(mx, __shfl_xor(mx, 32));
        float ls = 0.f;
#pragma unroll
        for (int t = 0; t < 16; ++t) {
#pragma unroll
            for (int i = 0; i < 4; ++i) { x[t][i] = __builtin_amdgcn_exp2f(x[t][i] - mx); ls += x[t][i]; } }
        ls += __shfl_xor(ls, 16); ls += __shfl_xor(ls, 32);
        pg8::bf16x8 pb[8];
#pragma unroll
        for (int s = 0; s < 8; ++s) { v4u w; w.x = cvtpk(x[2 * s][0], x[2 * s][1]); w.y = cvtpk(x[2 * s][2], x[2 * s][3]); w.z = cvtpk(x[2 * s + 1][0], x[2 * s + 1][1]); w.w = cvtpk(x[2 * s + 1][2], x[2 * s + 1][3]); pb[s] = __builtin_bit_cast(pg8::bf16x8, w); }
        LAS unsigned char* VS = L + wave * 16384;
        f32x4 o[4];
#pragma unroll
        for (int dt = 0; dt < 4; ++dt) o[dt] = (f32x4){0.f, 0.f, 0.f, 0.f};
        LAS const unsigned char* vb = VS + (4 * kg + (n >> 2)) * DS_VROW + (4 * (n & 3)) * 2;
#pragma unroll
        for (int cc = 0; cc < 4; ++cc) {
            if (cc * 64 < nsel) {
#pragma unroll
                for (int i = 0; i < 8; ++i) { const int kl = (lane >> 3) + 8 * i; *(LAS v4u*)(VS + kl * DS_VROW + 16 * (lane & 7)) = vr[i]; }
                if ((cc + 1) * 64 < nsel) DSA_LOADV(cc + 1);
                asm volatile("s_waitcnt lgkmcnt(0)" ::: "memory");
#pragma unroll
                for (int ks = 0; ks < 2; ++ks)
#pragma unroll
                    for (int dt = 0; dt < 4; ++dt) {
                        const s16x4 lo = trread(vb + (32 * ks) * DS_VROW + dt * 32), hh = trread(vb + (32 * ks + 16) * DS_VROW + dt * 32);
                        const pg8::bf16x8 a = {lo[0], lo[1], lo[2], lo[3], hh[0], hh[1], hh[2], hh[3]};
                        o[dt] = MFMA16(a, pb[2 * cc + ks], o[dt]);
                    }
                asm volatile("s_waitcnt lgkmcnt(0)" ::: "memory");
            }
        }
#undef DSA_LOADV
        if (n < 8) { const float inv = 1.f / ls; bf16* Op = (bf16*)(F.ws + WS_OA) + qrow * 512 + n * 64 + 4 * kg;
#pragma unroll
            for (int dt = 0; dt < 4; ++dt) *(unsigned long long*)(Op + 16 * dt) = (unsigned long long)cvtpk(o[dt][0] * inv, o[dt][1] * inv) | ((unsigned long long)cvtpk(o[dt][2] * inv, o[dt][3] * inv) << 32); }
    }
}
__device__ __forceinline__ void p3_fox(Frame& F) {
    for (int v = F.vcu; v < 256; v += F.G) {
        const int bh = v >> 3, s = v & 7;
        fox_unit(F, bh >> 3, bh & 7, 15 - s);
        fox_unit(F, bh >> 3, bh & 7, s);
    }
}
__device__ __forceinline__ void p3_dsa(Frame& F) {
    for (int v = F.vcu; v < 256; v += F.G) {
        const int b = v >> 6, t = v & 63, g0 = (t < 32) ? 0 : 4;
        for (int i = 0; i < 4; ++i) dsa_unit(F, b, 63 - t, g0 + i);
        for (int i = 0; i < 4; ++i) dsa_unit(F, b, t, g0 + i);
    }
}

__device__ __forceinline__ void p6_router(Frame& F) {
    const float* MOD = (const float*)(F.ws + WS_MOD); const float* X1 = F.out; const float* SSQ = (const float*)(F.ws + WS_CTL) + CW_SSQ;
    bf16* H2 = (bf16*)(F.ws + WS_H2); const bf16* WrT = (const bf16*)(F.ws + WS_WRT); unsigned* ROUTE = (unsigned*)(F.ws + WS_ROUTE);
    int* TOKSLOT = (int*)(F.ws + WS_TOKSLOT);
    for (int i = F.vcu * NWAVES * 64 + F.tid; i < PMAX; i += F.G * NWAVES * 64) TOKSLOT[i] = -1;
    const int lane = F.lane, r = lane & 15, kg = lane >> 4;
    const int it4 = F.wave & 3, kh = F.wave >> 2;
    LAS float* GS = (LAS float*)(F.ldsl + RING_OFF);
    LAS float* SH = GS + 1024;
    LAS float* LG = SH + 1024 + it4 * (16 * 52);
    LAS float* LG2 = SH + 1024 + 4 * (16 * 52) + it4 * (16 * 52);
    for (int base = F.vcu * 4; base < M / 16; base += F.G * 4) {
        __syncthreads();
        const int bb = (base * 16) >> 12;
        for (int i = F.tid; i < 1024; i += NWAVES * 64) { GS[i] = F.g_ffn[i] * (MOD[bb * 6144 + 4096 + i] + 1.0f); SH[i] = MOD[bb * 6144 + 3072 + i]; }
        if (F.tid < 32) F.LX[32 + F.tid] = 0u;
        __syncthreads();
        const int item = base + it4; const bool act = item < M / 16;
        int e1 = 0, e2 = 0, lr1 = 0, lr2 = 0; float w1 = 0.f, w2 = 0.f;
        if (act) {
            const int row = item * 16 + r;
            const float rstd = 1.f / sqrtf(SSQ[row] * (1.f / D) + RMS_EPS);
            f32x4 acc[3];
#pragma unroll
            for (int nt = 0; nt < 3; ++nt) acc[nt] = (f32x4){0.f, 0.f, 0.f, 0.f};
#pragma unroll 4
            for (int s = 0; s < 16; ++s) {
                const int k = 32 * (16 * kh + s) + 8 * kg;
                const f32x4 xa = *(const f32x4*)(X1 + (size_t)row * D + k), xb = *(const f32x4*)(X1 + (size_t)row * D + k + 4);
                const f32x4 ga = *(LAS const f32x4*)(GS + k), gb = *(LAS const f32x4*)(GS + k + 4);
                const f32x4 ha = *(LAS const f32x4*)(SH + k), hb = *(LAS const f32x4*)(SH + k + 4);
                const f32x4 ya = xa * rstd * ga + ha, yb = xb * rstd * gb + hb;
                v4u w; w.x = cvtpk(ya.x, ya.y); w.y = cvtpk(ya.z, ya.w); w.z = cvtpk(yb.x, yb.y); w.w = cvtpk(yb.z, yb.w);
                *(v4u*)(H2 + (size_t)row * D + k) = w;
                const pg8::bf16x8 a = __builtin_bit_cast(pg8::bf16x8, w);
#pragma unroll
                for (int nt = 0; nt < 3; ++nt) { const pg8::bf16x8 bw = *(const pg8::bf16x8*)(WrT + (size_t)(16 * nt + r) * D + k); acc[nt] = MFMA16(a, bw, acc[nt]); }
            }
            LAS float* dst = kh ? LG2 : LG;
#pragma unroll
            for (int nt = 0; nt < 3; ++nt)
#pragma unroll
                for (int i = 0; i < 4; ++i) dst[(4 * kg + i) * 52 + 16 * nt + r] = acc[nt][i];
        }
        __syncthreads();
        if (act && kh == 0 && lane < 16) {
            LAS const float* lg = LG + lane * 52; LAS const float* lg2 = LG2 + lane * 52;
            float gl[4]; int grp = 0;
#pragma unroll
            for (int i = 0; i < 4; ++i) gl[i] = lg[32 + i] + lg2[32 + i] + F.b_group[i];
#pragma unroll
            for (int i = 1; i < 4; ++i) if (gl[i] > gl[grp]) grp = i;
            const float gmax = (grp == 0) ? gl[0] : (grp == 1) ? gl[1] : (grp == 2) ? gl[2] : gl[3];
            float den = 0.f;
#pragma unroll
            for (int i = 0; i < 4; ++i) den += expf(gl[i] - gmax);
            const float pg = 1.f / den;
            float ev[8];
#pragma unroll
            for (int i = 0; i < 8; ++i) ev[i] = lg[grp * 8 + i] + lg2[grp * 8 + i] + F.b_router[grp * 8 + i];
            int i1 = 0; float v1 = ev[0];
#pragma unroll
            for (int i = 1; i < 8; ++i) if (ev[i] > v1) { v1 = ev[i]; i1 = i; }
            int i2 = -1; float v2 = -3.0e38f;
#pragma unroll
            for (int i = 0; i < 8; ++i) if (i != i1 && ev[i] > v2) { v2 = ev[i]; i2 = i; }
            const float t = expf(v2 - v1);
            w1 = pg / (1.f + t); w2 = pg * t / (1.f + t);
            e1 = grp * 8 + i1; e2 = grp * 8 + i2;
            lr1 = (int)atomicAdd((unsigned*)&F.LX[32 + e1], 1u); lr2 = (int)atomicAdd((unsigned*)&F.LX[32 + e2], 1u);
        }
        __syncthreads();
        if (F.tid < 32) { const unsigned c = F.LX[32 + F.tid]; F.LX[64 + F.tid] = c ? atomicAdd((unsigned*)(F.ctl + CW_CNT + F.tid), c) : 0u; }
        __syncthreads();
        if (act && kh == 0 && lane < 16) { const int row = item * 16 + lane; unsigned* rp = ROUTE + (size_t)row * 8;
            rp[0] = (unsigned)e1; rp[1] = F.LX[64 + e1] + (unsigned)lr1; rp[2] = __float_as_uint(w1); rp[3] = 0u;
            rp[4] = (unsigned)e2; rp[5] = F.LX[64 + e2] + (unsigned)lr2; rp[6] = __float_as_uint(w2); rp[7] = 0u; }
    }
}
__device__ __forceinline__ void p7_scatter(Frame& F) {
    moe_table(F);
    const int gw = F.vcu * NWAVES + F.wave, NGW = F.G * NWAVES;
    const bf16* H2 = (const bf16*)(F.ws + WS_H2); bf16* XS = (bf16*)(F.ws + WS_XS); const unsigned* ROUTE = (const unsigned*)(F.ws + WS_ROUTE);
    int* TOKSLOT = (int*)(F.ws + WS_TOKSLOT); float* WROW = (float*)(F.ws + WS_WROW);
    for (int m = gw; m < M; m += NGW) {
        const v4u ra = *(const v4u*)(ROUTE + (size_t)m * 8), rb = *(const v4u*)(ROUTE + (size_t)m * 8 + 4);
        const unsigned d0 = F.LX[96 + (ra.x & 31u)] + ra.y, d1 = F.LX[96 + (rb.x & 31u)] + rb.y;
        const v4u a = *((const v4u*)(H2 + (size_t)m * D) + F.lane), c = *((const v4u*)(H2 + (size_t)m * D) + 64 + F.lane);
        if (d0 < (unsigned)PMAX) { *((v4u*)(XS + (size_t)d0 * D) + F.lane) = a; *((v4u*)(XS + (size_t)d0 * D) + 64 + F.lane) = c; if (F.lane == 0) { TOKSLOT[d0] = 2 * m; WROW[d0] = __uint_as_float(ra.z); } }
        if (d1 < (unsigned)PMAX) { *((v4u*)(XS + (size_t)d1 * D) + F.lane) = a; *((v4u*)(XS + (size_t)d1 * D) + 64 + F.lane) = c; if (F.lane == 0) { TOKSLOT[d1] = 2 * m + 1; WROW[d1] = __uint_as_float(rb.z); } }
    }
}
__device__ __forceinline__ void p10_final(Frame& F) {
    const int gw = F.vcu * NWAVES + F.wave, NGW = F.G * NWAVES;
    const float* MOD = (const float*)(F.ws + WS_MOD); const bf16* YC = (const bf16*)(F.ws + WS_YC);
    for (int m = gw; m < M; m += NGW) {
        const int b = m >> 12;
        GAS f32x4* xr = (GAS f32x4*)(F.out + (size_t)m * D) + F.lane;
        const GAS unsigned long long* y0 = (const GAS unsigned long long*)(YC + (size_t)(2 * m) * D) + F.lane;
        const GAS unsigned long long* y1 = (const GAS unsigned long long*)(YC + (size_t)(2 * m + 1) * D) + F.lane;
        f32x4 v[4]; float s = 0.f;
#pragma unroll
        for (int j = 0; j < 4; ++j) { const int col = 4 * F.lane + 256 * j;
            const f32x4 x1 = xr[64 * j]; const unsigned long long a = y0[64 * j], c = y1[64 * j];
            const f32x4 gt = *(const f32x4*)(MOD + b * 6144 + 5120 + col);
            f32x4 y; y.x = bflo((unsigned)a) + bflo((unsigned)c); y.y = bfhi((unsigned)a) + bfhi((unsigned)c); y.z = bflo((unsigned)(a >> 32)) + bflo((unsigned)(c >> 32)); y.w = bfhi((unsigned)(a >> 32)) + bfhi((unsigned)(c >> 32));
            v[j] = x1 + gt * y; s += (v[j].x * v[j].x + v[j].y * v[j].y) + (v[j].z * v[j].z + v[j].w * v[j].w); }
        const float rstd = 1.f / sqrtf(wave_sum(s) * (1.f / D) + RMS_EPS);
#pragma unroll
        for (int j = 0; j < 4; ++j) { const int col = 4 * F.lane + 256 * j; const f32x4 g = *(const f32x4*)(F.g_final + col); xr[64 * j] = v[j] * rstd * g; }
    }
}

struct Args { const void* in[20]; float* out; unsigned char* ws; int ph_lo, ph_hi; };
__global__ void __launch_bounds__(NWAVES * 64, 2) hybrid_fwd(Args args) {
    extern __shared__ __attribute__((aligned(16))) unsigned char lds[];
    Frame F;
    F.lds = lds; F.ldsl = (LAS unsigned char*)lds; F.LX = (volatile LAS unsigned*)(F.ldsl + LX_OFF);
    F.tid = threadIdx.x; F.lane = F.tid & 63; F.wave = __builtin_amdgcn_readfirstlane(F.tid >> 6);
    F.G = gridDim.x; { const int bx = blockIdx.x; F.vcu = (F.G % 8 == 0) ? (bx % 8) * (F.G / 8) + bx / 8 : bx; }
    F.ws = args.ws; F.ctl = (gu32*)(args.ws + WS_CTL); F.out = args.out;
    F.x = (const float*)args.in[0]; F.c = (const float*)args.in[1]; F.positions = (const int*)args.in[2]; F.w_mod = (const float*)args.in[3]; F.b_mod = (const float*)args.in[4];
    F.g_mix = (const float*)args.in[5]; F.w_in = (const float*)args.in[6]; F.b_forget = (const float*)args.in[7]; F.w_out_a = (const float*)args.in[8]; F.w_out_b = (const float*)args.in[9];
    F.w_out = (const float*)args.in[10]; F.g_ffn = (const float*)args.in[11]; F.w_group = (const float*)args.in[12]; F.b_group = (const float*)args.in[13]; F.w_router = (const float*)args.in[14];
    F.b_router = (const float*)args.in[15]; F.w_e_gate = (const float*)args.in[16]; F.w_e_up = (const float*)args.in[17]; F.w_e_down = (const float*)args.in[18]; F.g_final = (const float*)args.in[19];
    for (int u = F.tid; u < (LDS_BYTES - LX_OFF) / 4; u += NWAVES * 64) F.LX[u] = 0u;
    __syncthreads();
    XcdBarrier bar; bar.bar = (unsigned*)(F.ctl + CW_BAR); bar.x = 0; bar.st = nullptr;
    if (N_LAUNCHES == 1) bar = xcd_barrier_post((unsigned*)(F.ctl + CW_BAR), F.LX);
    const int lo = args.ph_lo, hi = args.ph_hi;
#ifndef PH_MASK
#define PH_MASK 0xFFFF
#endif
#define IN(k) (((PH_MASK >> (k)) & 1) && lo <= (k) && (k) < hi)
#define REP(k) for (int rep_ = 0; rep_ <= ((DUP_MASK >> (k)) & 1); ++rep_)
#define SEAM(k) do { if (IN(k) && IN((k) + 1)) { xcd_barrier(bar); if ((DUP_MASK >> 15) & 1) xcd_barrier(bar); } } while (0)
    LAS unsigned char* ring = F.ldsl + RING_OFF;
    if (IN(0)) { REP(0) p0_prologue(F); } SEAM(0);
    if (IN(1)) { REP(1) p1_hnorm(F); } SEAM(1);
    if (IN(2)) {
        pg8::Gemm g{(const pg8::bf16_t*)(F.ws + WS_H), (const pg8::bf16_t*)(F.ws + WS_WIN), M, NPROJ, D}; pg8::StaticOrder S; S.init(M, NPROJ, F.G, (int)blockIdx.x);
        EpiProj E{F.ws, F.b_forget};
        pg8::gemm_phase<EpiProj, pg8::StaticOrder, true, true>(ring, g, S, E);
#if (DUP_MASK >> 2) & 1
        asm volatile("s_waitcnt vmcnt(0)" ::: "memory"); __syncthreads();
        pg8::gemm_phase<EpiProj, pg8::StaticOrder, true, true>(ring, g, S, E);
#endif
    } SEAM(2);
    if (IN(3)) { REP(3) p3_fox(F); REP(11) p3_dsa(F); } SEAM(3);
    if (IN(4)) {
        { pg8::Gemm g{(const pg8::bf16_t*)(F.ws + WS_OA), (const pg8::bf16_t*)(F.ws + WS_WOA), M, D, 512}; pg8::StaticOrder S; S.init(M, D, F.G, (int)blockIdx.x);
          EpiMerge<0> E{F.ws}; pg8::gemm_phase<EpiMerge<0>, pg8::StaticOrder, true, true>(ring, g, S, E); }
        asm volatile("s_waitcnt vmcnt(0)" ::: "memory"); __syncthreads();
        { pg8::Gemm g{(const pg8::bf16_t*)(F.ws + WS_OB), (const pg8::bf16_t*)(F.ws + WS_WOB), M, D, 512}; pg8::StaticOrder S; S.init(M, D, F.G, (int)blockIdx.x);
          EpiMerge<1> E{F.ws}; pg8::gemm_phase<EpiMerge<1>, pg8::StaticOrder, true, true>(ring, g, S, E); }
    } SEAM(4);
    if (IN(5)) {
        pg8::Gemm g{(const pg8::bf16_t*)(F.ws + WS_GA), (const pg8::bf16_t*)(F.ws + WS_WO), M, D, D}; pg8::StaticOrder S; S.init(M, D, F.G, (int)blockIdx.x);
        EpiOut E{F.ws, F.x, F.out}; pg8::gemm_phase<EpiOut, pg8::StaticOrder, true, true>(ring, g, S, E);
    } SEAM(5);
    if (IN(6)) { p6_router(F); } SEAM(6);
    if (IN(7)) { REP(7) p7_scatter(F); } SEAM(7);
    if (IN(8)) {
        moe_table(F);
        pg8::Gemm g{(const pg8::bf16_t*)(F.ws + WS_XS), (const pg8::bf16_t*)(F.ws + WS_WGU), PMAX, 32 * 1024, D};
        MoeOrder S{F.G, F.vcu, (int)F.LX[132] * 4, F.LX + 160};
        EpiGU E{F.ws}; REP(8) pg8::gemm_phase<EpiGU, MoeOrder, true, true>(ring, g, S, E);
    } SEAM(8);
    if (IN(9)) {
        moe_table(F);
        pg8::Gemm g{(const pg8::bf16_t*)(F.ws + WS_HID), (const pg8::bf16_t*)(F.ws + WS_WDN), PMAX, 32 * 1024, 512};
        MoeOrder S{F.G, F.vcu, (int)F.LX[132] * 4, F.LX + 160};
        EpiDown E{F.ws}; REP(9) pg8::gemm_phase<EpiDown, MoeOrder, true, true>(ring, g, S, E);
    } SEAM(9);
    if (IN(10)) { p10_final(F); }
#undef IN
#undef SEAM
}

extern "C" void kernel_launch(void* const* d_in, const int* in_sizes, int n_in, void* d_out, int out_size, void* d_ws, size_t ws_size, hipStream_t stream) {
    static int grid = 0;
    if (grid == 0) {
        if (n_in != 20 || in_sizes[0] != M * D || out_size != M * D || ws_size < WS_END) { fprintf(stderr, "kernel_launch: unexpected shapes (n_in %d, in0 %d, out %d, ws %zu); nothing launched\n", n_in, n_in > 0 ? in_sizes[0] : -1, out_size, ws_size); grid = -1; return; }
        int dev = 0, cus = 0, per_cu = 0;
        if (hipGetDevice(&dev) != hipSuccess || hipDeviceGetAttribute(&cus, hipDeviceAttributeMultiprocessorCount, dev) != hipSuccess) { grid = -1; return; }
        if (hipFuncSetAttribute((const void*)hybrid_fwd, hipFuncAttributeMaxDynamicSharedMemorySize, LDS_BYTES) != hipSuccess) { fprintf(stderr, "kernel_launch: hipFuncSetAttribute failed\n"); grid = -1; return; }
        if (hipOccupancyMaxActiveBlocksPerMultiprocessor(&per_cu, (const void*)hybrid_fwd, NWAVES * 64, LDS_BYTES) != hipSuccess || per_cu < 1)
            fprintf(stderr, "kernel_launch: note: occupancy query reports %d workgroups per CU\n", per_cu);
        (void)hipGetLastError();
        grid = cus;
    }
    if (grid < 0) return;
    if (hipMemsetAsync((char*)d_ws + WS_CTL, 0, CTL_ZERO_BYTES, stream) != hipSuccess) { fprintf(stderr, "kernel_launch: hipMemsetAsync failed\n"); return; }
    Args a{};
    for (int i = 0; i < 20; ++i) a.in[i] = d_in[i];
    a.out = (float*)d_out; a.ws = (unsigned char*)d_ws;
    for (int li = 0; li < N_LAUNCHES; ++li) {
        a.ph_lo = (N_LAUNCHES == 1) ? 0 : li; a.ph_hi = (N_LAUNCHES == 1) ? NPHASE : li + 1;
        hipLaunchKernelGGL(hybrid_fwd, dim3(grid), dim3(NWAVES * 64), LDS_BYTES, stream, a);
        const hipError_t le = hipPeekAtLastError();
        if (le != hipSuccess) { fprintf(stderr, "kernel_launch: launch %d failed: %s\n", li, hipGetErrorName(le)); break; }
    }
}
```

```cpp
#define MK_N_LAUNCHES 1
#include <hip/hip_runtime.h>
#include <hip/hip_bf16.h>
#include <cstdio>
#include <cstdint>
#include <cmath>
namespace pg8 {
#define PG8_LAS __attribute__((address_space(3)))
typedef unsigned short bf16_t;
typedef short bf16x8 __attribute__((ext_vector_type(8)));
typedef float f32x4 __attribute__((ext_vector_type(4)));
typedef unsigned u32x4 __attribute__((ext_vector_type(4)));
constexpr int BM = 256, BK = 64, HALF = 128, HTB = HALF * BK * 2  , STAGE_BYTES = 8 * HTB, NXCD = 8, WGM = 8;

__host__ __device__ __forceinline__ int lds_byte(int r, int c) { const int st = (r >> 4) * 2 + (c >> 5), rr = r & 15, cc = c & 31, ob = rr * 64 + cc * 2; return st * 1024 + (ob ^ (((ob >> 9) & 1) << 5)); }
__host__ __device__ __forceinline__ void stage_rc(int b, int& R, int& C) { const int st = b / 1024, sb = b % 1024, swz = sb ^ (((sb >> 9) & 1) << 5); R = (st >> 1) * 16 + swz / 64; C = (st & 1) * 32 + (swz % 64) / 2; }
__host__ __device__ __forceinline__ int perm32(int rho) { const int n = rho >> 4, i = rho & 15; return 8 * (i >> 2) + 4 * n + (i & 3); }

struct Unit { int pm, pn; };
struct Gemm { const bf16_t* A; const bf16_t* Bt; int M, N, K; };

struct StaticOrder {
    int nM, nN, nwg, G, c;
    __host__ __device__ void init(int M, int N, int G_, int c_) { nM = M / BM; nN = N / BM; nwg = nM * nN; G = G_; c = c_; }
    __host__ __device__ bool next(int i, Unit& u) const {
        const long L = (long)i * G + c; if (L >= nwg) return false;
        int wgid = (int)L; { const int q = nwg / NXCD, r = nwg % NXCD, xcd = wgid % NXCD, off = wgid / NXCD; wgid = (xcd < r ? xcd * (q + 1) : r * (q + 1) + (xcd - r) * q) + off; }
        const int nig = WGM * nN, gid = wgid / nig, fm = gid * WGM, gsz = (nM - fm) < WGM ? (nM - fm) : WGM;
        u.pm = fm + ((wgid % nig) % gsz); u.pn = (wgid % nig) / gsz; return true;
    }
    __device__ __forceinline__ void a_ready(const Unit&) const {}
    __device__ __forceinline__ void done(const Unit&) const {}
};

__device__ __forceinline__ unsigned cvt_pk_bf16(float lo, float hi) { unsigned r; asm volatile("v_cvt_pk_bf16_f32 %0, %1, %2" : "=v"(r) : "v"(lo), "v"(hi)); return r; }
typedef float f32x2 __attribute__((ext_vector_type(2)));
template <class Epi, class Sched, bool ALIGN_EPI = false, bool SP2 = false>
__device__ __forceinline__ void gemm_phase(PG8_LAS unsigned char* lds, const Gemm g, const Sched& S, const Epi& E) {
    const int tid = threadIdx.x, wid = __builtin_amdgcn_readfirstlane(tid >> 6), lane = tid & 63, wr = wid >> 2, wc = wid & 3, fr = lane & 15, fq = lane >> 4;
    const int K = g.K, nt = K / BK;
    unsigned voffA[2], voffB[2];
#pragma unroll
    for (int i = 0; i < 2; ++i) { int R, C; stage_rc(tid * 16 + i * 8192, R, C); const int Rb = Epi::PERM ? ((R & ~31) + perm32(R & 31)) : R;
        voffA[i] = (unsigned)(R * K + C) * 2u; voffB[i] = (unsigned)(Rb * K + C) * 2u; }
    const size_t kstep = (size_t)(BK * 2);
    const size_t hstep = (size_t)HALF * K * 2;
    const size_t tstep = 2 * hstep;
    const unsigned ldsw = (unsigned)wid * 1024u;
    const int aoff = lds_byte(wr * 64 + fr, fq * 8), boff = lds_byte(wc * 32 + fr, fq * 8);
#define PG8_SA(b, h) (((b) * 2 + (h)) * HTB)
#define PG8_SB(b, h) ((4 + (b) * 2 + (h)) * HTB)
#define PG8_STAGE(bufoff, gbase, voff) do { _Pragma("unroll") for (int _i = 0; _i < 2; ++_i) \
        __builtin_amdgcn_global_load_lds((const unsigned*)((const char*)(gbase) + (voff)[_i]), (PG8_LAS unsigned*)(lds + (bufoff) + ldsw + _i * 8192), 16, 0, 0); } while (0)
#define PG8_LDA(dst, b, h) do { _Pragma("unroll") for (int m = 0; m < 4; ++m) _Pragma("unroll") for (int k = 0; k < 2; ++k) dst[m][k] = *(const PG8_LAS bf16x8*)(lds + PG8_SA(b, h) + aoff + m * 2048 + k * 1024); } while (0)
#define PG8_LDB(dst, b, h) do { _Pragma("unroll") for (int n = 0; n < 2; ++n) _Pragma("unroll") for (int k = 0; k < 2; ++k) dst[n][k] = *(const PG8_LAS bf16x8*)(lds + PG8_SB(b, h) + boff + n * 2048 + k * 1024); } while (0)
#define PG8_MMA(ai, bj, At, Bt) do { __builtin_amdgcn_s_setprio(1); _Pragma("unroll") for (int m = 0; m < 4; ++m) _Pragma("unroll") for (int n = 0; n < 2; ++n) _Pragma("unroll") for (int k = 0; k < 2; ++k) \
        acc[ai][bj][m][n] = __builtin_amdgcn_mfma_f32_16x16x32_bf16(Bt[n][k], At[m][k], acc[ai][bj][m][n], 0, 0, 0); __builtin_amdgcn_s_setprio(0); } while (0)
#define PG8_WAIT_V(n) asm volatile("s_waitcnt vmcnt(" #n ")" ::: "memory")
#define PG8_WAIT_L(n) asm volatile("s_waitcnt lgkmcnt(" #n ")" ::: "memory")
#define PG8_BAR __builtin_amdgcn_s_barrier()
#define PG8_SCHED __builtin_amdgcn_sched_barrier(0)
    Unit cur, nxt; int ui = 0;
    if (!S.next(0, cur)) return;
    f32x4 acc[2][2][4][2];
#pragma unroll
    for (int a = 0; a < 2; ++a)
#pragma unroll
        for (int b = 0; b < 2; ++b)
#pragma unroll
            for (int m = 0; m < 4; ++m)
#pragma unroll
                for (int n = 0; n < 2; ++n) acc[a][b][m][n] = (f32x4){0.f, 0.f, 0.f, 0.f};
    bf16x8 At[4][2], B0[2][2], B1[2][2];
    const char* cA = (const char*)g.A + (size_t)cur.pm * tstep; const char* cB = (const char*)g.Bt + (size_t)cur.pn * tstep;
    S.a_ready(cur);
    if constexpr (SP2) {
        PG8_STAGE(PG8_SB(0, 0), cB, voffB); PG8_STAGE(PG8_SB(0, 1), cB + hstep, voffB); PG8_STAGE(PG8_SA(0, 0), cA, voffA); PG8_STAGE(PG8_SA(0, 1), cA + hstep, voffA);
        if (wr == 1) PG8_BAR;
        PG8_WAIT_V(2); PG8_BAR;
        PG8_STAGE(PG8_SB(1, 0), cB + kstep, voffB); PG8_STAGE(PG8_SA(1, 0), cA + kstep, voffA); PG8_STAGE(PG8_SB(1, 1), cB + hstep + kstep, voffB);
        PG8_WAIT_V(6); PG8_BAR;
    } else {
        PG8_STAGE(PG8_SB(0, 0), cB, voffB); PG8_STAGE(PG8_SA(0, 0), cA, voffA); PG8_STAGE(PG8_SB(0, 1), cB + hstep, voffB); PG8_STAGE(PG8_SA(0, 1), cA + hstep, voffA);
        if (wr == 1) PG8_BAR;
        PG8_WAIT_V(4); PG8_BAR;
        PG8_STAGE(PG8_SB(1, 0), cB + kstep, voffB); PG8_STAGE(PG8_SA(1, 0), cA + kstep, voffA); PG8_STAGE(PG8_SB(1, 1), cB + hstep + kstep, voffB);
        PG8_WAIT_V(6); PG8_BAR;
    }
    for (;;) {
        const bool has_next = S.next(ui + 1, nxt);
        const char* nA = has_next ? (const char*)g.A + (size_t)nxt.pm * tstep : cA; const char* nB = has_next ? (const char*)g.Bt + (size_t)nxt.pn * tstep : cB;
        for (int t = 0; t < nt; t += 2) {
            const bool last = (t == nt - 2);
            const char* a1 = cA + (size_t)(t + 1) * kstep;
            const char* a2 = last ? nA : cA + (size_t)(t + 2) * kstep; const char* b2 = last ? nB : cB + (size_t)(t + 2) * kstep;
            const char* a3 = a2 + kstep; const char* b3 = b2 + kstep;
            if (last && has_next) S.a_ready(nxt);
            if constexpr (SP2) {
            PG8_LDB(B0, 0, 0); PG8_LDB(B1, 0, 1); PG8_SCHED; PG8_LDA(At, 0, 0); PG8_STAGE(PG8_SA(1, 1), a1 + hstep, voffA);
            PG8_WAIT_V(8); PG8_WAIT_L(0); PG8_BAR; PG8_MMA(0, 0, At, B0); PG8_MMA(0, 1, At, B1); PG8_BAR; PG8_SCHED;
            PG8_LDA(At, 0, 1); PG8_STAGE(PG8_SB(0, 0), b2, voffB); PG8_STAGE(PG8_SB(0, 1), b2 + hstep, voffB); PG8_STAGE(PG8_SA(0, 0), a2, voffA);
            PG8_WAIT_V(8); PG8_WAIT_L(0); PG8_BAR; PG8_MMA(1, 0, At, B0); PG8_MMA(1, 1, At, B1); PG8_BAR; PG8_SCHED;
            PG8_LDB(B0, 1, 0); PG8_LDB(B1, 1, 1); PG8_SCHED; PG8_LDA(At, 1, 0); PG8_STAGE(PG8_SA(0, 1), a2 + hstep, voffA);
            PG8_WAIT_V(8); PG8_WAIT_L(0); PG8_BAR; PG8_MMA(0, 0, At, B0); PG8_MMA(0, 1, At, B1); PG8_BAR; PG8_SCHED;
            PG8_LDA(At, 1, 1); PG8_STAGE(PG8_SB(1, 0), b3, voffB); PG8_STAGE(PG8_SB(1, 1), b3 + hstep, voffB); PG8_STAGE(PG8_SA(1, 0), a3, voffA);
            PG8_WAIT_V(8); PG8_WAIT_L(0); PG8_BAR; PG8_MMA(1, 0, At, B0); PG8_MMA(1, 1, At, B1); PG8_BAR; PG8_SCHED;
            } else {
            PG8_LDB(B0, 0, 0); PG8_SCHED; PG8_LDA(At, 0, 0); PG8_STAGE(PG8_SA(1, 1), a1 + hstep, voffA);
            PG8_WAIT_L(8); PG8_BAR; PG8_WAIT_L(0); PG8_MMA(0, 0, At, B0); PG8_BAR; PG8_SCHED;
            PG8_LDB(B1, 0, 1); PG8_STAGE(PG8_SB(0, 0), b2, voffB);
            PG8_BAR; PG8_WAIT_L(0); PG8_MMA(0, 1, At, B1); PG8_BAR;
            PG8_LDA(At, 0, 1); PG8_STAGE(PG8_SA(0, 0), a2, voffA);
            PG8_BAR; PG8_WAIT_L(0); PG8_MMA(1, 0, At, B0); PG8_BAR; PG8_SCHED;
            PG8_STAGE(PG8_SB(0, 1), b2 + hstep, voffB);
            PG8_WAIT_V(6); PG8_BAR; PG8_MMA(1, 1, At, B1); PG8_BAR;
            PG8_LDB(B0, 1, 0); PG8_SCHED; PG8_LDA(At, 1, 0); PG8_STAGE(PG8_SA(0, 1), a2 + hstep, voffA);
            PG8_WAIT_L(8); PG8_BAR; PG8_WAIT_L(0); PG8_MMA(0, 0, At, B0); PG8_BAR; PG8_SCHED;
            PG8_LDB(B1, 1, 1); PG8_STAGE(PG8_SB(1, 0), b3, voffB);
            PG8_BAR; PG8_WAIT_L(0); PG8_MMA(0, 1, At, B1); PG8_BAR;
            PG8_LDA(At, 1, 1); PG8_STAGE(PG8_SA(1, 0), a3, voffA);
            PG8_BAR; PG8_WAIT_L(0); PG8_MMA(1, 0, At, B0); PG8_BAR; PG8_SCHED;
            PG8_STAGE(PG8_SB(1, 1), b3 + hstep, voffB);
            PG8_WAIT_V(6); PG8_BAR; PG8_MMA(1, 1, At, B1); PG8_BAR;
            }
        }
        if constexpr (ALIGN_EPI) { if (wr == 0) PG8_BAR; }
        if constexpr (!Epi::AFTER_DRAIN) { E(acc, cur, wr, wc, fr, fq); S.done(cur); }
        if (!has_next) break;
#pragma unroll
        for (int a = 0; a < 2; ++a)
#pragma unroll
            for (int b = 0; b < 2; ++b)
#pragma unroll
                for (int m = 0; m < 4; ++m)
#pragma unroll
                    for (int n = 0; n < 2; ++n) acc[a][b][m][n] = (f32x4){0.f, 0.f, 0.f, 0.f};
        cur = nxt; cA = nA; cB = nB; ++ui;
        if constexpr (ALIGN_EPI) { if (wr == 1) PG8_BAR; }
    }
    PG8_WAIT_V(0);
    if constexpr (!ALIGN_EPI) { if (wr == 0) PG8_BAR; }
    PG8_BAR;
    if constexpr (Epi::AFTER_DRAIN) { E.fused(acc, cur, wr, wc, fr, fq, lds, wid, lane); S.done(cur); }
#undef PG8_SA
#undef PG8_SB
#undef PG8_STAGE
#undef PG8_LDA
#undef PG8_LDB
#undef PG8_MMA
#undef PG8_WAIT_V
#undef PG8_WAIT_L
#undef PG8_BAR
#undef PG8_SCHED
}
}
constexpr int NWAVES = 8;
constexpr int BATCH = 4, SEQ = 4096, D = 1024, M = BATCH * SEQ;
constexpr int NPROJ = 4864;
constexpr float RMS_EPS = 1e-6f;
constexpr float LOG2E = 1.4426950408889634f;
constexpr float QSCALE = 0.125f * LOG2E;
constexpr int PMAX = 40960, NTMAX = 160;
constexpr int NPHASE = 11;
#ifndef MK_N_LAUNCHES
#define MK_N_LAUNCHES 1
#endif
constexpr int N_LAUNCHES = MK_N_LAUNCHES;

constexpr size_t MiB = 1u << 20;
constexpr size_t WS_CTL = 0, CTL_ZERO_BYTES = 1 * MiB;
constexpr size_t WS_MOD = 1 * MiB;
constexpr size_t WS_WRT = 1 * MiB + 256 * 1024;
constexpr size_t WS_TOKSLOT = 1 * MiB + 512 * 1024;
constexpr size_t WS_WROW = 1 * MiB + 768 * 1024;
constexpr size_t WS_COS = 2 * MiB, WS_SIN = 2 * MiB + 512 * 1024;
constexpr size_t WS_WI = 3 * MiB, WS_LOGF = 3 * MiB + 512 * 1024;
constexpr size_t WS_ROUTE = 4 * MiB;
constexpr size_t WS_WIN = 5 * MiB;
constexpr size_t WS_WOA = 15 * MiB, WS_WOB = 16 * MiB, WS_WO = 17 * MiB;
constexpr size_t WS_WGU = 19 * MiB, WS_WDN = 83 * MiB;
constexpr size_t WS_H = 115 * MiB;
constexpr size_t WS_OA = 115 * MiB, WS_OB = 131 * MiB, WS_H2 = 115 * MiB;
constexpr size_t WS_QA = 147 * MiB, WS_QI = 163 * MiB, WS_QB = 179 * MiB, WS_KB = 195 * MiB, WS_VB = 211 * MiB;
constexpr size_t WS_KA = 227 * MiB, WS_VA = 229 * MiB, WS_KI = 231 * MiB;
constexpr size_t WS_XS = 147 * MiB;
constexpr size_t WS_YC = 147 * MiB;
constexpr size_t WS_GA = 233 * MiB, WS_GB = 265 * MiB;
constexpr size_t WS_HID = 233 * MiB;
constexpr size_t WS_END = 297 * MiB;
constexpr int CW_BAR = 4096, CW_CNT = 8192, CW_SSQ = 16384;
constexpr int RING_OFF = 0, RING_BYTES = 131072;
constexpr int SEL_OFF = 131072;
constexpr int LX_OFF = 139264;
constexpr int HIST_OFF = 143360;
constexpr int LDS_BYTES = 151552;

#define GAS __attribute__((address_space(1)))
#define LAS __attribute__((address_space(3)))
typedef unsigned short bf16;
typedef unsigned v4u __attribute__((ext_vector_type(4)));
typedef float f32x4 __attribute__((ext_vector_type(4)));
typedef short bf16x8 __attribute__((ext_vector_type(8)));
typedef GAS unsigned gu32;
typedef GAS unsigned long long gu64;
#define RLX_AGENT __ATOMIC_RELAXED, __HIP_MEMORY_SCOPE_AGENT
#define LDS_WAIT() asm volatile("s_waitcnt lgkmcnt(0)" ::: "memory")
#define VM_WAIT() asm volatile("s_waitcnt vmcnt(0)" ::: "memory")
__device__ __forceinline__ unsigned long long rt() { return __builtin_amdgcn_s_memrealtime(); }
__device__ __forceinline__ unsigned f2bf(float f) { unsigned u = __builtin_bit_cast(unsigned, f); return (u + 0x7fffu + ((u >> 16) & 1u)) >> 16; }
__device__ __forceinline__ unsigned pk2(float lo, float hi) { return f2bf(lo) | (f2bf(hi) << 16); }

#define XB_TMO      128
#define XB_XCNT(j)  (256  + 64 * (j))
#define XB_XSUB(j)  (1280 + 64 * (j))
#define XB_XGEN(j)  (2304 + 64 * (j))
#define XB_TOP      3328
#define XB_TOPGEN   3392
#define XCD_BAR_WORDS 3456
#define XB_SPIN_CAP (1u << 18)

__device__ __forceinline__ unsigned xb_ld(unsigned* p)              { return __hip_atomic_load(p, __ATOMIC_RELAXED, __HIP_MEMORY_SCOPE_AGENT); }
__device__ __forceinline__ unsigned xb_add(unsigned* p, unsigned v) { return __hip_atomic_fetch_add(p, v, __ATOMIC_RELAXED, __HIP_MEMORY_SCOPE_AGENT); }
__device__ __forceinline__ unsigned xb_xcc_id() { return (unsigned)__builtin_amdgcn_s_getreg((3 << 11) | 20) & 0xFu; }
#define XB_SPIN(cond, bar) do { unsigned _sp = 0; while (cond) { __builtin_amdgcn_s_sleep(1); \
    if ((++_sp & 255u) == 0u) { if (xb_ld(&(bar)[XB_TMO])) break; if (_sp > XB_SPIN_CAP) { atomicAdd(&(bar)[XB_TMO], 1u); break; } } } } while (0)

struct XcdBarrier {
    unsigned* bar; unsigned x;
    volatile LAS unsigned* st;
};

__device__ __forceinline__ XcdBarrier xcd_barrier_post(unsigned* bar, volatile LAS unsigned* st) {
    XcdBarrier b; b.bar = bar; b.x = xb_xcc_id(); b.st = st;
    if (threadIdx.x == 0) (void)xb_add(&bar[XB_XCNT(b.x)], 1u);
    return b;
}
__device__ __forceinline__ void xcd_barrier_complete(unsigned* bar, unsigned x, unsigned& nloc, unsigned& nx) {
    const unsigned G = gridDim.x * gridDim.y * gridDim.z;
    unsigned sum, cnt, mine, sp = 0u;
    for (;;) {
        sum = 0u; cnt = 0u; mine = 0u;
#pragma unroll
        for (unsigned j = 0; j < 16; ++j) { const unsigned c = xb_ld(&bar[XB_XCNT(j)]); sum += c; cnt += (c > 0u) ? 1u : 0u; mine = (j == x) ? c : mine; }
        if (sum == G) break;
        __builtin_amdgcn_s_sleep(1);
        if ((++sp & 255u) == 0u) { if (xb_ld(&bar[XB_TMO])) break; if (sp > XB_SPIN_CAP) { atomicAdd(&bar[XB_TMO], 1u); break; } }
    }
    nloc = mine > 0u ? mine : 1u; nx = cnt > 0u ? cnt : 1u;
}

__device__ __forceinline__ void xcd_barrier(const XcdBarrier& b) {
    asm volatile("s_waitcnt vmcnt(0)" ::: "memory");
    __syncthreads();
    if (threadIdx.x == 0) {
        unsigned* bar = b.bar;
        __builtin_amdgcn_s_waitcnt(0);
        unsigned nloc = b.st[0], nx = b.st[1];
        if (nloc == 0u) { xcd_barrier_complete(bar, b.x, nloc, nx); b.st[0] = nloc; b.st[1] = nx; }
        const unsigned old = xb_add(&bar[XB_XSUB(b.x)], 1u);
        const unsigned gen = old / nloc;
        if (old + 1u == (gen + 1u) * nloc) {
            __builtin_amdgcn_fence(__ATOMIC_RELEASE, "agent");
            asm volatile("s_waitcnt vmcnt(0)" ::: "memory");
            const unsigned og = xb_add(&bar[XB_TOP], 1u);
            const unsigned tg = og / nx;
            if (og + 1u == (tg + 1u) * nx) xb_add(&bar[XB_TOPGEN], 1u);
            else XB_SPIN(xb_ld(&bar[XB_TOPGEN]) == tg, bar);
            __builtin_amdgcn_fence(__ATOMIC_ACQUIRE, "agent");
            xb_add(&bar[XB_XGEN(b.x)], 1u);
            asm volatile("s_waitcnt vmcnt(0)" ::: "memory");
        } else {
            XB_SPIN(xb_ld(&bar[XB_XGEN(b.x)]) == gen, bar);
            __builtin_amdgcn_fence(__ATOMIC_ACQUIRE, "agent");
            asm volatile("s_waitcnt vmcnt(0)" ::: "memory");
        }
    }
    __syncthreads();
}
typedef float f32x2_t __attribute__((ext_vector_type(2))); typedef __bf16 bf16x2_t __attribute__((ext_vector_type(2)));
typedef float f32x16 __attribute__((ext_vector_type(16)));
typedef short s16x4 __attribute__((ext_vector_type(4)));
__device__ __forceinline__ unsigned cvtpk(float lo, float hi) { f32x2_t v = {lo, hi}; bf16x2_t b = __builtin_convertvector(v, bf16x2_t); return __builtin_bit_cast(unsigned, b); }
__device__ __forceinline__ float bflo(unsigned w) { return __uint_as_float(w << 16); }
__device__ __forceinline__ float bfhi(unsigned w) { return __uint_as_float(w & 0xffff0000u); }
__device__ __forceinline__ float sigmoidf_(float v) { return 1.f / (1.f + __expf(-v)); }
#define MFMA32(a, b, c) __builtin_amdgcn_mfma_f32_32x32x16_bf16((a), (b), (c), 0, 0, 0)
#define MFMA16(a, b, c) __builtin_amdgcn_mfma_f32_16x16x32_bf16((a), (b), (c), 0, 0, 0)

struct Frame {
    unsigned char* lds;
    LAS unsigned char* ldsl;
    volatile LAS unsigned* LX;
    gu32* ctl;
    unsigned char* ws;
    int tid, lane, wave, vcu, G;
    const float *x, *c, *w_mod, *b_mod, *g_mix, *w_in, *b_forget, *w_out_a, *w_out_b, *w_out, *g_ffn, *w_group, *b_group, *w_router, *b_router, *w_e_gate, *w_e_up, *w_e_down, *g_final;
    const int* positions;
    float* out;
};
__device__ __forceinline__ float wave_sum(float v) {
#pragma unroll
    for (int o = 1; o < 64; o <<= 1) v += __shfl_xor(v, o);
    return v;
}

struct CmIn { __device__ __forceinline__ int operator()(int n) const { if (n < 1216) return n; if (n < 2752) return n + 8; if (n < 4800) return n + 16; if (n < 4808) return n - 4800 + 1216; if (n < 4816) return n - 4808 + 2760; return -1; } };
struct CmId { int base; __device__ __forceinline__ int operator()(int n) const { return n - base; } };
template <class CM>
__device__ __forceinline__ void transpose_item(const float* W, int ldw, bf16* WT, int K, int k0, int n0, const CM& cm, LAS float* scr, int lane) {
    const int sc = cm(n0 + (lane & 31));
#pragma unroll
    for (int i = 0; i < 32; ++i) { const int kk = 2 * i + (lane >> 5); scr[kk * 33 + (lane & 31)] = sc >= 0 ? W[(size_t)(k0 + kk) * ldw + sc] : 0.f; }
    LDS_WAIT(); asm volatile("" ::: "memory");
    const int c = lane & 7;
#pragma unroll
    for (int j = 0; j < 4; ++j) { const int n = (lane >> 3) + 8 * j; const LAS float* s = scr + (8 * c) * 33 + n;
        v4u o; o.x = pk2(s[0 * 33], s[1 * 33]); o.y = pk2(s[2 * 33], s[3 * 33]); o.z = pk2(s[4 * 33], s[5 * 33]); o.w = pk2(s[6 * 33], s[7 * 33]);
        *(GAS v4u*)(WT + (size_t)(n0 + n) * K + k0 + 8 * c) = o; }
    LDS_WAIT(); asm volatile("" ::: "memory");
}
__device__ __forceinline__ void p0_prologue(Frame& F) {
    __syncthreads();
    {
        LAS float* ca = (LAS float*)(F.ldsl + RING_OFF);
        LAS float* red = (LAS float*)(F.ldsl + RING_OFF + 16384);
        for (int i = F.tid; i < 4096; i += NWAVES * 64) { const float v = F.c[i]; ca[i] = v / (1.f + expf(-v)); }
        __syncthreads();
        float* MOD = (float*)(F.ws + WS_MOD);
        for (int cb = F.vcu; cb < 256; cb += F.G) {
            const int col0 = cb * 24;
            if (F.tid < 384) { const int j = F.tid % 24, ks = F.tid / 24; float a0 = 0.f, a1 = 0.f, a2 = 0.f, a3 = 0.f;
#pragma unroll 8
                for (int i = 0; i < 64; ++i) { const int k = ks + 16 * i; const float w = F.w_mod[(size_t)k * 6144 + col0 + j];
                    a0 += ca[k] * w; a1 += ca[1024 + k] * w; a2 += ca[2048 + k] * w; a3 += ca[3072 + k] * w; }
                LAS float* r = red + (ks * 24 + j) * 4; r[0] = a0; r[1] = a1; r[2] = a2; r[3] = a3; }
            __syncthreads();
            if (F.tid < 96) { const int j = F.tid % 24, bb = F.tid / 24; float s = 0.f;
#pragma unroll
                for (int ks = 0; ks < 16; ++ks) s += red[(ks * 24 + j) * 4 + bb];
                MOD[bb * 6144 + col0 + j] = s + F.b_mod[col0 + j]; }
            __syncthreads();
        }
    }
    LAS float* scr = (LAS float*)(F.ldsl + RING_OFF + F.wave * 16384);
    const int gw = F.vcu * NWAVES + F.wave, NGW = F.G * NWAVES;
    constexpr int I_IN = 16 * 152, I_OA = 8 * 32, I_O = 16 * 32, I_GU = 32 * 16 * 32, I_DN = 32 * 8 * 32;
    constexpr int NITEMS = I_IN + 2 * I_OA + I_O + I_GU + I_DN;
    bf16* WinT = (bf16*)(F.ws + WS_WIN); bf16* WoaT = (bf16*)(F.ws + WS_WOA); bf16* WobT = (bf16*)(F.ws + WS_WOB); bf16* WoT = (bf16*)(F.ws + WS_WO);
    bf16* WguT = (bf16*)(F.ws + WS_WGU); bf16* WdnT = (bf16*)(F.ws + WS_WDN);
    for (int it = gw; it < NITEMS; it += NGW) {
        int r = it;
        if (r < I_IN) { const int kb = r / 152, nb = r % 152; transpose_item(F.w_in, 4816, WinT, 1024, 64 * kb, 32 * nb, CmIn{}, scr, F.lane); continue; } r -= I_IN;
        if (r < I_OA) { const int kb = r / 32, nb = r % 32; transpose_item(F.w_out_a + 32 * nb, 1024, WoaT, 512, 64 * kb, 32 * nb, CmId{32 * nb}, scr, F.lane); continue; } r -= I_OA;
        if (r < I_OA) { const int kb = r / 32, nb = r % 32; transpose_item(F.w_out_b + 32 * nb, 1024, WobT, 512, 64 * kb, 32 * nb, CmId{32 * nb}, scr, F.lane); continue; } r -= I_OA;
        if (r < I_O) { const int kb = r / 32, nb = r % 32; transpose_item(F.w_out + 32 * nb, 1024, WoT, 1024, 64 * kb, 32 * nb, CmId{32 * nb}, scr, F.lane); continue; } r -= I_O;
        if (r < I_GU) { const int e = r / 512, q = r % 512, kb = q / 32, nb = q % 32;
            const int np = 32 * nb, ct = np >> 8, bj = (np >> 7) & 1, j0 = np & 127;
            const float* src = (bj ? F.w_e_up : F.w_e_gate) + (size_t)e * 1024 * 512 + ct * 128 + j0;
            transpose_item(src, 512, WguT, 1024, 64 * kb, e * 1024 + np, CmId{e * 1024 + np}, scr, F.lane); continue; } r -= I_GU;
        { const int e = r / 256, q = r % 256, kb = q / 32, nb = q % 32;
            const float* src = F.w_e_down + (size_t)e * 512 * 1024 + 32 * nb;
            transpose_item(src, 1024, WdnT, 512, 64 * kb, e * 1024 + 32 * nb, CmId{e * 1024 + 32 * nb}, scr, F.lane); }
    }
    { bf16* WrT = (bf16*)(F.ws + WS_WRT);
      for (int i = (F.vcu * NWAVES * 64 + F.tid); i < 64 * 1024; i += F.G * NWAVES * 64) { const int n = i >> 10, k = i & 1023;
          float v = 0.f; if (n < 32) v = F.w_router[k * 32 + n]; else if (n < 36) v = F.w_group[k * 4 + (n - 32)];
          WrT[i] = (bf16)f2bf(v); } }
}

__device__ __forceinline__ void p1_hnorm(Frame& F) {
    const int gw = F.vcu * NWAVES + F.wave, NGW = F.G * NWAVES;
    const float* MOD = (const float*)(F.ws + WS_MOD); bf16* H = (bf16*)(F.ws + WS_H);
    float* COS = (float*)(F.ws + WS_COS); float* SIN = (float*)(F.ws + WS_SIN);
    for (int m = gw; m < M; m += NGW) {
        const int b = m >> 12;
        const GAS f32x4* xr = (const GAS f32x4*)(F.x + (size_t)m * D) + F.lane;
        f32x4 v[4]; float s = 0.f;
#pragma unroll
        for (int j = 0; j < 4; ++j) { v[j] = xr[64 * j]; s += (v[j].x * v[j].x + v[j].y * v[j].y) + (v[j].z * v[j].z + v[j].w * v[j].w); }
        const float rstd = 1.f / sqrtf(wave_sum(s) * (1.f / D) + RMS_EPS);
        GAS unsigned long long* o8 = (GAS unsigned long long*)(H + (size_t)m * D) + F.lane;
#pragma unroll
        for (int j = 0; j < 4; ++j) { const int col = 4 * F.lane + 256 * j;
            const f32x4 g = *(const f32x4*)(F.g_mix + col), sc = *(const f32x4*)(MOD + b * 6144 + 1024 + col), sh = *(const f32x4*)(MOD + b * 6144 + col);
            const f32x4 h = v[j] * rstd * g * (sc + 1.0f) + sh;
            o8[64 * j] = (unsigned long long)cvtpk(h.x, h.y) | ((unsigned long long)cvtpk(h.z, h.w) << 32); }
        if (F.lane < 8) { const float invf = exp2f(-(float)F.lane * 2.3664460711655218f); const float ang = (float)F.positions[m] * invf;
            COS[m * 8 + F.lane] = cosf(ang); SIN[m * 8 + F.lane] = sinf(ang); }
    }
}

struct EpiProj {
    static constexpr bool PERM = true, AFTER_DRAIN = false;
    unsigned char* ws; const float* bfg;
    template <int BJ>
    __device__ __forceinline__ void part(const pg8::f32x4 (&acc)[2][2][4][2], const pg8::Unit& u, int wr, int wc, int fr, int fq) const {
        const float* COS = (const float*)(ws + WS_COS); const float* SIN = (const float*)(ws + WS_SIN);
        const int cg = __builtin_amdgcn_readfirstlane(u.pn * 256 + BJ * 128 + wc * 32);
        size_t boff = 0; int ld = 0, cofs = 0, kind = 4; float scale = 1.f;
        if (cg < 512)       { boff = WS_QA; ld = 512; cofs = 0;    kind = 1; scale = QSCALE; }
        else if (cg < 576)  { boff = WS_KA; ld = 64;  cofs = 512;  kind = 1; }
        else if (cg < 640)  { boff = WS_VA; ld = 64;  cofs = 576;  kind = 0; }
        else if (cg < 1152) { boff = WS_QI; ld = 512; cofs = 640;  kind = 1; scale = 0.125f; }
        else if (cg < 1216) { boff = WS_KI; ld = 64;  cofs = 1152; kind = 1; }
        else if (cg < 1728) { boff = WS_QB; ld = 512; cofs = 1216; kind = 0; scale = QSCALE; }
        else if (cg < 2240) { boff = WS_KB; ld = 512; cofs = 1728; kind = 0; }
        else if (cg < 2752) { boff = WS_VB; ld = 512; cofs = 2240; kind = 0; }
        else if (cg < 3776) { boff = WS_GA; ld = 1024; cofs = 2752; kind = 2; }
        else if (cg < 4800) { boff = WS_GB; ld = 1024; cofs = 3776; kind = 2; }
        else if (cg == 4800) { kind = 3; }
        if (kind == 4) return;
        if (kind == 3) {
#pragma unroll
            for (int ai = 0; ai < 2; ++ai)
#pragma unroll
                for (int m = 0; m < 4; ++m) {
                    const int row = u.pm * 256 + ai * 128 + wr * 64 + m * 16 + fr;
                    const pg8::f32x4 v0 = acc[ai][BJ][m][0], v1 = acc[ai][BJ][m][1];
                    if (fq == 0) { float* wi = (float*)(ws + WS_WI) + (size_t)row * 8; const float s = 0.35355339059327373f; *(pg8::f32x4*)wi = v0 * s; *(pg8::f32x4*)(wi + 4) = v1 * s; }
                    else if (fq == 1) { float* lf = (float*)(ws + WS_LOGF) + (size_t)(row >> 12) * 8 * SEQ + (row & (SEQ - 1));
#pragma unroll
                        for (int i = 0; i < 8; ++i) { const float z = (i < 4 ? v0[i & 3] : v1[i & 3]) + bfg[i];
                            const float ls = z >= 0.f ? -log1pf(expf(-z)) : z - log1pf(expf(z)); lf[(size_t)i * SEQ] = ls; } }
                }
            return;
        }
        const bool rope = (kind == 1) && ((cg & 63) == 0);
        bf16* base = (bf16*)(ws + boff);
        const int c0 = cg + 8 * fq - cofs;
#pragma unroll
        for (int ai = 0; ai < 2; ++ai)
#pragma unroll
            for (int m = 0; m < 4; ++m) {
                const int row = u.pm * 256 + ai * 128 + wr * 64 + m * 16 + fr;
                pg8::f32x4 v0 = acc[ai][BJ][m][0], v1 = acc[ai][BJ][m][1];
                if (rope) {
                    pg8::f32x4 o0, o1;
#pragma unroll
                    for (int i = 0; i < 4; ++i) { o0[i] = __shfl_xor(v0[i], 16); o1[i] = __shfl_xor(v1[i], 16); }
                    const pg8::f32x4 c0v = *(const pg8::f32x4*)(COS + (size_t)row * 8), c1v = *(const pg8::f32x4*)(COS + (size_t)row * 8 + 4);
                    const pg8::f32x4 s0v = *(const pg8::f32x4*)(SIN + (size_t)row * 8), s1v = *(const pg8::f32x4*)(SIN + (size_t)row * 8 + 4);
                    if (fq < 2) { const float sg = fq == 0 ? -1.f : 1.f; v0 = v0 * c0v + o0 * s0v * sg; v1 = v1 * c1v + o1 * s1v * sg; }
                }
                if (kind == 2) {
#pragma unroll
                    for (int i = 0; i < 4; ++i) { v0[i] = sigmoidf_(v0[i]); v1[i] = sigmoidf_(v1[i]); }
                }
                v0 = v0 * scale; v1 = v1 * scale;
                pg8::u32x4 w; w.x = cvtpk(v0[0], v0[1]); w.y = cvtpk(v0[2], v0[3]); w.z = cvtpk(v1[0], v1[1]); w.w = cvtpk(v1[2], v1[3]);
                *(pg8::u32x4*)(base + (size_t)row * ld + c0) = w;
            }
    }
    __device__ __forceinline__ void operator()(const pg8::f32x4 (&acc)[2][2][4][2], const pg8::Unit& u, int wr, int wc, int fr, int fq) const {
        part<0>(acc, u, wr, wc, fr, fq); part<1>(acc, u, wr, wc, fr, fq);
    }
};
template <int STEP> struct EpiMerge {
    static constexpr bool PERM = true, AFTER_DRAIN = false;
    unsigned char* ws;
    __device__ __forceinline__ void operator()(const pg8::f32x4 (&acc)[2][2][4][2], const pg8::Unit& u, int wr, int wc, int fr, int fq) const {
        bf16* GA = (bf16*)(ws + WS_GA); const bf16* GB = (const bf16*)(ws + WS_GB);
#pragma unroll
        for (int ai = 0; ai < 2; ++ai)
#pragma unroll
            for (int m = 0; m < 4; ++m) {
                const int row = u.pm * 256 + ai * 128 + wr * 64 + m * 16 + fr;
#pragma unroll
                for (int bj = 0; bj < 2; ++bj) {
                    const size_t off = (size_t)row * 1024 + u.pn * 256 + bj * 128 + wc * 32 + 8 * fq;
                    const pg8::f32x4 v0 = acc[ai][bj][m][0], v1 = acc[ai][bj][m][1];
                    const pg8::u32x4 a = *(const pg8::u32x4*)(GA + off);
                    float r[8];
                    if (STEP == 0) {
                        r[0] = bflo(a.x) * v0[0]; r[1] = bfhi(a.x) * v0[1]; r[2] = bflo(a.y) * v0[2]; r[3] = bfhi(a.y) * v0[3];
                        r[4] = bflo(a.z) * v1[0]; r[5] = bfhi(a.z) * v1[1]; r[6] = bflo(a.w) * v1[2]; r[7] = bfhi(a.w) * v1[3];
                    } else {
                        const pg8::u32x4 g = *(const pg8::u32x4*)(GB + off);
                        r[0] = bflo(a.x) + bflo(g.x) * v0[0]; r[1] = bfhi(a.x) + bfhi(g.x) * v0[1]; r[2] = bflo(a.y) + bflo(g.y) * v0[2]; r[3] = bfhi(a.y) + bfhi(g.y) * v0[3];
                        r[4] = bflo(a.z) + bflo(g.z) * v1[0]; r[5] = bfhi(a.z) + bfhi(g.z) * v1[1]; r[6] = bflo(a.w) + bflo(g.w) * v1[2]; r[7] = bfhi(a.w) + bfhi(g.w) * v1[3];
                    }
                    pg8::u32x4 w; w.x = cvtpk(r[0], r[1]); w.y = cvtpk(r[2], r[3]); w.z = cvtpk(r[4], r[5]); w.w = cvtpk(r[6], r[7]);
                    *(pg8::u32x4*)(GA + off) = w;
                }
            }
    }
};
struct EpiOut {
    static constexpr bool PERM = true, AFTER_DRAIN = false;
    unsigned char* ws; const float* x; float* out;
    __device__ __forceinline__ void operator()(const pg8::f32x4 (&acc)[2][2][4][2], const pg8::Unit& u, int wr, int wc, int fr, int fq) const {
        const float* MOD = (const float*)(ws + WS_MOD); float* SSQ = (float*)(ws + WS_CTL) + CW_SSQ;
        const int b = u.pm >> 4;
        const int colb = u.pn * 256 + wc * 32 + 8 * fq;
        pg8::f32x4 gt[2][2];
#pragma unroll
        for (int bj = 0; bj < 2; ++bj) { gt[bj][0] = *(const pg8::f32x4*)(MOD + b * 6144 + 2048 + colb + bj * 128); gt[bj][1] = *(const pg8::f32x4*)(MOD + b * 6144 + 2048 + colb + bj * 128 + 4); }
#pragma unroll
        for (int ai = 0; ai < 2; ++ai)
#pragma unroll
            for (int m = 0; m < 4; ++m) {
                const int row = u.pm * 256 + ai * 128 + wr * 64 + m * 16 + fr; float ss = 0.f;
#pragma unroll
                for (int bj = 0; bj < 2; ++bj) {
                    const size_t off = (size_t)row * 1024 + colb + bj * 128;
                    const pg8::f32x4 x0 = *(const pg8::f32x4*)(x + off), x1 = *(const pg8::f32x4*)(x + off + 4);
                    const pg8::f32x4 y0 = x0 + gt[bj][0] * acc[ai][bj][m][0], y1 = x1 + gt[bj][1] * acc[ai][bj][m][1];
                    *(pg8::f32x4*)(out + off) = y0; *(pg8::f32x4*)(out + off + 4) = y1;
                    ss += (y0[0] * y0[0] + y0[1] * y0[1]) + (y0[2] * y0[2] + y0[3] * y0[3]) + (y1[0] * y1[0] + y1[1] * y1[1]) + (y1[2] * y1[2] + y1[3] * y1[3]);
                }
                ss += __shfl_xor(ss, 16); ss += __shfl_xor(ss, 32);
                if (fq == 0) atomicAdd(SSQ + row, ss);
            }
    }
};
struct EpiGU {
    static constexpr bool PERM = true, AFTER_DRAIN = false;
    unsigned char* ws;
    __device__ __forceinline__ void operator()(const pg8::f32x4 (&acc)[2][2][4][2], const pg8::Unit& u, int wr, int wc, int fr, int fq) const {
        bf16* HID = (bf16*)(ws + WS_HID);
        const int col = (u.pn & 3) * 128 + wc * 32 + 8 * fq;
#pragma unroll
        for (int ai = 0; ai < 2; ++ai)
#pragma unroll
            for (int m = 0; m < 4; ++m) {
                const int row = u.pm * 256 + ai * 128 + wr * 64 + m * 16 + fr;
                float r[8];
#pragma unroll
                for (int i = 0; i < 8; ++i) { const float g = i < 4 ? acc[ai][0][m][0][i] : acc[ai][0][m][1][i - 4]; const float up = i < 4 ? acc[ai][1][m][0][i] : acc[ai][1][m][1][i - 4];
                    r[i] = g * sigmoidf_(g) * up; }
                pg8::u32x4 w; w.x = cvtpk(r[0], r[1]); w.y = cvtpk(r[2], r[3]); w.z = cvtpk(r[4], r[5]); w.w = cvtpk(r[6], r[7]);
                *(pg8::u32x4*)(HID + (size_t)row * 512 + col) = w;
            }
    }
};
struct EpiDown {
    static constexpr bool PERM = true, AFTER_DRAIN = false;
    unsigned char* ws;
    __device__ __forceinline__ void operator()(const pg8::f32x4 (&acc)[2][2][4][2], const pg8::Unit& u, int wr, int wc, int fr, int fq) const {
        bf16* YC = (bf16*)(ws + WS_YC); const int* TOKSLOT = (const int*)(ws + WS_TOKSLOT); const float* WROW = (const float*)(ws + WS_WROW);
        const int colb = (u.pn & 3) * 256 + wc * 32 + 8 * fq;
#pragma unroll
        for (int ai = 0; ai < 2; ++ai)
#pragma unroll
            for (int m = 0; m < 4; ++m) {
                const int row = u.pm * 256 + ai * 128 + wr * 64 + m * 16 + fr;
                const int ts = TOKSLOT[row]; const float gw = WROW[row];
                if (ts >= 0) {
#pragma unroll
                    for (int bj = 0; bj < 2; ++bj) { const pg8::f32x4 v0 = acc[ai][bj][m][0] * gw, v1 = acc[ai][bj][m][1] * gw;
                        pg8::u32x4 w; w.x = cvtpk(v0[0], v0[1]); w.y = cvtpk(v0[2], v0[3]); w.z = cvtpk(v1[0], v1[1]); w.w = cvtpk(v1[2], v1[3]);
                        *(pg8::u32x4*)(YC + (size_t)ts * 1024 + colb + bj * 128) = w; }
                }
            }
    }
};
struct MoeOrder {
    int G, c, nunits; const volatile LAS unsigned* tile_e;
    __device__ __forceinline__ bool next(int i, pg8::Unit& u) const { const int L = i * G + c; if (L >= nunits) return false; const int rt = L >> 2; u.pm = rt; u.pn = (int)tile_e[rt] * 4 + (L & 3); return true; }
    __device__ __forceinline__ void a_ready(const pg8::Unit&) const {}
    __device__ __forceinline__ void done(const pg8::Unit&) const {}
};
__device__ __forceinline__ void moe_table(Frame& F) {
    const gu32* CNT = F.ctl + CW_CNT;
    if (F.tid == 0) { unsigned p = 0;
        for (int e = 0; e < 32; ++e) { F.LX[96 + e] = p; const unsigned c = __hip_atomic_load(CNT + e, RLX_AGENT); const unsigned nt = (c + 255u) >> 8;
            for (unsigned t = 0; t < nt; ++t) if ((p >> 8) + t < (unsigned)NTMAX) F.LX[160 + (p >> 8) + t] = (unsigned)e;
            p += nt << 8; }
        F.LX[128] = p; F.LX[132] = (p >> 8) < (unsigned)NTMAX ? (p >> 8) : (unsigned)NTMAX; }
    __syncthreads();
}
#ifndef DUP_MASK
#define DUP_MASK 0
#endif
typedef short v4i16_t __attribute__((ext_vector_type(4)));
__device__ __forceinline__ s16x4 trread(LAS const unsigned char* p) { return __builtin_bit_cast(s16x4, __builtin_amdgcn_ds_read_tr16_b64_v4i16((LAS v4i16_t*)p)); }
constexpr int FX_CK = 0, FX_K = 16384, FX_V = 32768, FX_VROW = 144, FX_VBUF = 64 * FX_VROW;
__device__ __forceinline__ float xhalf(float v, int hi) { const auto rr = __builtin_amdgcn_permlane32_swap(__float_as_uint(v), __float_as_uint(v), false, false); return __uint_as_float(hi ? rr[0] : rr[1]); }
__device__ __forceinline__ void fox_tile(LAS unsigned char* L, LAS float* CK, int cur, int t, int r32, int hi, int lane, int q, int qminw,
                                         const pg8::bf16x8 (&qf)[4], float& m_run, float& l_run, f32x16& o0, f32x16& o1) {
    LAS const unsigned char* Kb = L + FX_K + cur * 8192; LAS const unsigned char* Vb = L + FX_V + cur * FX_VBUF;
    f32x16 p0, p1;
#pragma unroll
    for (int rq = 0; rq < 4; ++rq) { const f32x4 c0 = *(LAS const f32x4*)(CK + 64 * t + 8 * rq + 4 * hi), c1 = *(LAS const f32x4*)(CK + 64 * t + 32 + 8 * rq + 4 * hi);
#pragma unroll
        for (int i = 0; i < 4; ++i) { p0[4 * rq + i] = c0[i]; p1[4 * rq + i] = c1[i]; } }
#pragma unroll
    for (int d0 = 0; d0 < 4; ++d0) {
        const int co = ((2 * d0 + hi) ^ (r32 & 7)) * 16;
        const pg8::bf16x8 a0 = *(LAS const pg8::bf16x8*)(Kb + r32 * 128 + co);
        const pg8::bf16x8 a1 = *(LAS const pg8::bf16x8*)(Kb + (r32 + 32) * 128 + co);
        p0 = MFMA32(a0, qf[d0], p0); p1 = MFMA32(a1, qf[d0], p1);
    }
    if (64 * t + 63 > qminw) {
#pragma unroll
        for (int r = 0; r < 16; ++r) { const int key = 64 * t + (r & 3) + 8 * (r >> 2) + 4 * hi; if (key > q) p0[r] = -1e30f; if (key + 32 > q) p1[r] = -1e30f; } }
    float mx = p0[0];
#pragma unroll
    for (int r = 1; r < 16; ++r) mx = fmaxf(mx, p0[r]);
#pragma unroll
    for (int r = 0; r < 16; ++r) mx = fmaxf(mx, p1[r]);
    mx = fmaxf(mx, xhalf(mx, hi));
    const float mnew = fmaxf(m_run, mx), alpha = __builtin_amdgcn_exp2f(m_run - mnew); m_run = mnew;
    float rs = 0.f;
#pragma unroll
    for (int r = 0; r < 16; ++r) { p0[r] = __builtin_amdgcn_exp2f(p0[r] - mnew); p1[r] = __builtin_amdgcn_exp2f(p1[r] - mnew); rs += p0[r] + p1[r]; }
    rs += xhalf(rs, hi);
    l_run = l_run * alpha + rs;
#pragma unroll
    for (int r = 0; r < 16; ++r) { o0[r] *= alpha; o1[r] *= alpha; }
    pg8::bf16x8 pb[4];
#pragma unroll
    for (int s = 0; s < 2; ++s) { v4u w;
        w.x = cvtpk(p0[8 * s], p0[8 * s + 1]); w.y = cvtpk(p0[8 * s + 2], p0[8 * s + 3]); w.z = cvtpk(p0[8 * s + 4], p0[8 * s + 5]); w.w = cvtpk(p0[8 * s + 6], p0[8 * s + 7]); pb[s] = __builtin_bit_cast(pg8::bf16x8, w);
        w.x = cvtpk(p1[8 * s], p1[8 * s + 1]); w.y = cvtpk(p1[8 * s + 2], p1[8 * s + 3]); w.z = cvtpk(p1[8 * s + 4], p1[8 * s + 5]); w.w = cvtpk(p1[8 * s + 6], p1[8 * s + 7]); pb[2 + s] = __builtin_bit_cast(pg8::bf16x8, w); }
    LAS const unsigned char* vb = Vb + (4 * hi + ((lane & 15) >> 2)) * FX_VROW + (16 * ((lane >> 4) & 1) + 4 * (lane & 3)) * 2;
#pragma unroll
    for (int s = 0; s < 4; ++s) {
        const s16x4 l0 = trread(vb + (16 * s) * FX_VROW), h0 = trread(vb + (16 * s + 8) * FX_VROW);
        const s16x4 l1 = trread(vb + (16 * s) * FX_VROW + 64), h1 = trread(vb + (16 * s + 8) * FX_VROW + 64);
        const pg8::bf16x8 a0 = {l0[0], l0[1], l0[2], l0[3], h0[0], h0[1], h0[2], h0[3]};
        const pg8::bf16x8 a1 = {l1[0], l1[1], l1[2], l1[3], h1[0], h1[1], h1[2], h1[3]};
        o0 = MFMA32(a0, pb[s], o0); o1 = MFMA32(a1, pb[s], o1);
    }
}
__device__ __forceinline__ void fox_unit(Frame& F, int b, int h, int qb) {
    const int tid = F.tid, lane = F.lane, wave = F.wave, r32 = lane & 31, hi = lane >> 5;
    LAS unsigned char* L = F.ldsl + RING_OFF;
    LAS float* CK = (LAS float*)(L + FX_CK);
    const int nkeys = (qb + 1) * 256, NT = nkeys / 64;
    const bf16* QBp = (const bf16*)(F.ws + WS_QB); const bf16* KBp = (const bf16*)(F.ws + WS_KB); const bf16* VBp = (const bf16*)(F.ws + WS_VB);
    __syncthreads();
    {
        const float* lf = (const float*)(F.ws + WS_LOGF) + (size_t)(b * 8 + h) * SEQ;
        float v[8]; const int k0 = tid * 8;
        if (k0 < nkeys) { const f32x4 a = *(const f32x4*)(lf + k0), c = *(const f32x4*)(lf + k0 + 4); v[0] = a.x; v[1] = a.y; v[2] = a.z; v[3] = a.w; v[4] = c.x; v[5] = c.y; v[6] = c.z; v[7] = c.w; }
        else {
#pragma unroll
            for (int i = 0; i < 8; ++i) v[i] = 0.f; }
#pragma unroll
        for (int i = 1; i < 8; ++i) v[i] += v[i - 1];
        const float tot = v[7]; float sc = tot;
#pragma unroll
        for (int o = 1; o < 64; o <<= 1) { const float t = __shfl_up(sc, o); if (lane >= o) sc += t; }
        if (lane == 63) F.LX[8 + wave] = __float_as_uint(sc);
        __syncthreads();
        float woff = 0.f, cref = 0.f;
#pragma unroll
        for (int w = 0; w < 8; ++w) { const float t = __uint_as_float(F.LX[8 + w]); cref += t; if (w < wave) woff += t; }
        const float base = woff + sc - tot;
        if (k0 < nkeys) {
#pragma unroll
            for (int i = 0; i < 8; ++i) CK[k0 + i] = (cref - (base + v[i])) * LOG2E; }
    }
    const size_t qrow = (size_t)b * SEQ + qb * 256 + wave * 32 + r32;
    pg8::bf16x8 qf[4];
#pragma unroll
    for (int d0 = 0; d0 < 4; ++d0) qf[d0] = *(const pg8::bf16x8*)(QBp + qrow * 512 + h * 64 + d0 * 16 + hi * 8);
    float m_run = -1e30f, l_run = 0.f; f32x16 o0 = {}, o1 = {};
    const int kr = tid >> 3, ch = tid & 7;
    const bf16* Kg = KBp + ((size_t)b * SEQ + kr) * 512 + h * 64 + ch * 8;
    const bf16* Vg = VBp + ((size_t)b * SEQ + kr) * 512 + h * 64 + ch * 8;
    const int kwo = FX_K + kr * 128 + ((ch ^ (kr & 7)) * 16), vwo = FX_V + kr * FX_VROW + ch * 16;
    v4u kr0 = *(const v4u*)Kg, vr0 = *(const v4u*)Vg, kr1 = kr0, vr1 = vr0, kr2 = kr0, vr2 = vr0;
    if (1 < NT) { kr1 = *(const v4u*)(Kg + (size_t)1 * 64 * 512); vr1 = *(const v4u*)(Vg + (size_t)1 * 64 * 512); }
    if (2 < NT) { kr2 = *(const v4u*)(Kg + (size_t)2 * 64 * 512); vr2 = *(const v4u*)(Vg + (size_t)2 * 64 * 512); }
    *(LAS v4u*)(L + kwo) = kr0; *(LAS v4u*)(L + vwo) = vr0;
    __syncthreads();
    const int qminw = qb * 256 + wave * 32, qmaxw = qminw + 31, q = qminw + r32;
#define FOX_STEP(t, KRF, VRF, KRN, VRN) do { \
        const int cur = (t) & 1; \
        if ((t) + 3 < NT) { KRF = *(const v4u*)(Kg + (size_t)((t) + 3) * 64 * 512); VRF = *(const v4u*)(Vg + (size_t)((t) + 3) * 64 * 512); } \
        if (64 * (t) <= qmaxw) fox_tile(L, CK, cur, (t), r32, hi, lane, q, qminw, qf, m_run, l_run, o0, o1); \
        if ((t) + 1 < NT) { const int nb = cur ^ 1; *(LAS v4u*)(L + kwo + nb * 8192) = KRN; *(LAS v4u*)(L + vwo + nb * FX_VBUF) = VRN; } \
        __syncthreads(); } while (0)
    for (int t = 0; t < NT; t += 3) {
        FOX_STEP(t, kr0, vr0, kr1, vr1);
        if (t + 1 < NT) FOX_STEP(t + 1, kr1, vr1, kr2, vr2);
        if (t + 2 < NT) FOX_STEP(t + 2, kr2, vr2, kr0, vr0);
    }
#undef FOX_STEP
    const float inv = 1.f / l_run;
    bf16* Op = (bf16*)(F.ws + WS_OB) + qrow * 512 + h * 64;
#pragma unroll
    for (int rq = 0; rq < 4; ++rq) {
        const unsigned long long w0 = (unsigned long long)cvtpk(o0[4 * rq] * inv, o0[4 * rq + 1] * inv) | ((unsigned long long)cvtpk(o0[4 * rq + 2] * inv, o0[4 * rq + 3] * inv) << 32);
        const unsigned long long w1 = (unsigned long long)cvtpk(o1[4 * rq] * inv, o1[4 * rq + 1] * inv) | ((unsigned long long)cvtpk(o1[4 * rq + 2] * inv, o1[4 * rq + 3] * inv) << 32);
        *(unsigned long long*)(Op + 8 * rq + 4 * hi) = w0; *(unsigned long long*)(Op + 32 + 8 * rq + 4 * hi) = w1;
    }
}

template <int NJ>
__device__ __forceinline__ void dsa_select(LAS const unsigned* sr, LAS unsigned* hist, LAS int* SEL, int nj, int lane) {
    unsigned key[NJ];
#pragma unroll
    for (int j = 0; j < NJ; ++j) { unsigned u = 0u; if (j < NJ - 16 || j < nj) u = sr[64 * j + lane]; key[j] = u; }
    unsigned T = 0u; int nge = 0;
    {
        const v4u hv = *(LAS const v4u*)(hist + 4 * lane);
        *(LAS v4u*)(hist + 4 * lane) = (v4u){0u, 0u, 0u, 0u};
        const unsigned sl = hv.x + hv.y + hv.z + hv.w;
        unsigned suf = sl;
#pragma unroll
        for (int o = 1; o < 64; o <<= 1) { const unsigned t = __shfl_down(suf, o); if (lane + o < 64) suf += t; }
        const unsigned above = suf - sl;
        const bool here = (suf >= 256u) && (above < 256u);
        unsigned bsel = 0u, cge = 0u;
        if (here) { unsigned c = above;
            if (c + hv.w >= 256u) { bsel = 4 * lane + 3; cge = c + hv.w; }
            else if (c + hv.w + hv.z >= 256u) { bsel = 4 * lane + 2; cge = c + hv.w + hv.z; }
            else if (c + hv.w + hv.z + hv.y >= 256u) { bsel = 4 * lane + 1; cge = c + hv.w + hv.z + hv.y; }
            else { bsel = 4 * lane; cge = suf; } }
        const unsigned long long mh = __ballot(here);
        const int src = mh ? (int)__builtin_ctzll(mh) : 0;
        T = (unsigned)__shfl((int)bsel, src) << 24; nge = __shfl((int)cge, src);
    }
    for (int bit = 23; bit >= 0 && nge != 256; --bit) {
        const unsigned cand = T | (1u << bit); unsigned cl = 0u;
#pragma unroll
        for (int j = 0; j < NJ; ++j) cl += (key[j] >= cand) ? 1u : 0u;
        int cnt = 0;
#pragma unroll
        for (int bb = 0; bb < 7; ++bb) cnt += __popcll(__ballot(((cl >> bb) & 1u) != 0u)) << bb;
        if (cnt >= 256) { T = cand; nge = cnt; }
    }
    if (nge == 256) {
        unsigned cl = 0u;
#pragma unroll
        for (int j = 0; j < NJ; ++j) cl += (key[j] >= T) ? 1u : 0u;
        int p = 0;
#pragma unroll
        for (int bb = 0; bb < 7; ++bb) { const unsigned long long mk = __ballot(((cl >> bb) & 1u) != 0u);
            p += (int)__builtin_amdgcn_mbcnt_hi((unsigned)(mk >> 32), __builtin_amdgcn_mbcnt_lo((unsigned)mk, 0u)) << bb; }
#pragma unroll
        for (int j = 0; j < NJ; ++j) if (key[j] >= T) { SEL[p & 255] = 64 * j + lane; ++p; }
    } else {
        int ngt = 0;
#pragma unroll
        for (int j = 0; j < NJ; ++j) ngt += __popcll(__ballot(key[j] > T));
        const int need_eq = 256 - ngt; int pos = 0, eq_seen = 0;
#pragma unroll
        for (int j = 0; j < NJ; ++j) {
            const bool gt = key[j] > T, eq = key[j] == T;
            const unsigned long long meq = __ballot(eq);
            const int eq_rank = eq_seen + (int)__builtin_amdgcn_mbcnt_hi((unsigned)(meq >> 32), __builtin_amdgcn_mbcnt_lo((unsigned)meq, 0u));
            const bool take = gt || (eq && eq_rank < need_eq);
            const unsigned long long mt = __ballot(take);
            const int pr = (int)__builtin_amdgcn_mbcnt_hi((unsigned)(mt >> 32), __builtin_amdgcn_mbcnt_lo((unsigned)mt, 0u));
            if (take && pos + pr < 256) SEL[pos + pr] = 64 * j + lane;
            pos += __popcll(mt); eq_seen += __popcll(meq);
        }
    }
}
template <bool FULL>
__device__ __forceinline__ void dsa_attend(Frame& F, LAS unsigned char* L, LAS int* SEL, int b, size_t qrow, int nsel) {
    const int lane = F.lane, wave = F.wave;
    const bf16* QA = (const bf16*)(F.ws + WS_QA); const bf16* KA = (const bf16*)(F.ws + WS_KA); const bf16* VA = (const bf16*)(F.ws + WS_VA);
    const int n = lane & 15, kg = lane >> 4;
    pg8::bf16x8 qf[2];
#pragma unroll
    for (int s = 0; s < 2; ++s) { qf[s] = (pg8::bf16x8){0, 0, 0, 0, 0, 0, 0, 0}; if (n < 8) qf[s] = *(const pg8::bf16x8*)(QA + qrow * 512 + n * 64 + 32 * s + 8 * kg); }
    const int ntile = FULL ? 16 : (nsel >> 4);
    const bf16* vgb = VA + (size_t)b * SEQ * 64 + 8 * (lane & 7);
    LAS unsigned char* VS = L + wave * 16384;
    const int nsc = FULL ? 8 : (nsel >> 5);
#define DSA_DMAV(sc, slot) do { _Pragma("unroll") for (int i_ = 0; i_ < 4; ++i_) { const int idx_ = SEL[32 * (sc) + 8 * i_ + (lane >> 3)]; \
        __builtin_amdgcn_global_load_lds((const unsigned*)(vgb + (size_t)idx_ * 64), (LAS unsigned*)(VS + (slot) * 4096 + i_ * 1024), 16, 0, 0); } } while (0)
#define DSA_PV(slot, sc) do { _Pragma("unroll") for (int dt_ = 0; dt_ < 4; ++dt_) { \
        const s16x4 lo_ = trread(vb + (slot) * 4096 + dt_ * 32), hh_ = trread(vb + (slot) * 4096 + 16 * 128 + dt_ * 32); \
        const pg8::bf16x8 a_ = {lo_[0], lo_[1], lo_[2], lo_[3], hh_[0], hh_[1], hh_[2], hh_[3]}; \
        o[dt_] = MFMA16(a_, pb[(sc)], o[dt_]); } } while (0)
    DSA_DMAV(0, 0); DSA_DMAV(1, 1);
    if (FULL || nsc > 2) { DSA_DMAV(2, 2); DSA_DMAV(3, 3); }
    f32x4 x[16];
#pragma unroll
    for (int t = 0; t < 16; ++t) {
        x[t] = (f32x4){-1e30f, -1e30f, -1e30f, -1e30f};
        if (FULL || t < ntile) { const int idx = SEL[16 * t + n]; const bf16* kp = KA + ((size_t)b * SEQ + idx) * 64 + 8 * kg;
            const pg8::bf16x8 a0 = *(const pg8::bf16x8*)kp, a1 = *(const pg8::bf16x8*)(kp + 32);
            f32x4 z = {0.f, 0.f, 0.f, 0.f}; z = MFMA16(a0, qf[0], z); z = MFMA16(a1, qf[1], z); x[t] = z; }
    }
    float mx = -1e30f;
#pragma unroll
    for (int t = 0; t < 16; ++t) mx = fmaxf(fmaxf(mx, fmaxf(x[t][0], x[t][1])), fmaxf(x[t][2], x[t][3]));
    mx = fmaxf(mx, __shfl_xor(mx, 16)); mx = fmaxf(mx, __shfl_xor(mx, 32));
    float ls = 0.f;
#pragma unroll
    for (int t = 0; t < 16; ++t) {
#pragma unroll
        for (int i = 0; i < 4; ++i) { x[t][i] = __builtin_amdgcn_exp2f(x[t][i] - mx); ls += x[t][i]; } }
    ls += __shfl_xor(ls, 16); ls += __shfl_xor(ls, 32);
    pg8::bf16x8 pb[8];
#pragma unroll
    for (int s = 0; s < 8; ++s) { v4u w; w.x = cvtpk(x[2 * s][0], x[2 * s][1]); w.y = cvtpk(x[2 * s][2], x[2 * s][3]); w.z = cvtpk(x[2 * s + 1][0], x[2 * s + 1][1]); w.w = cvtpk(x[2 * s + 1][2], x[2 * s + 1][3]); pb[s] = __builtin_bit_cast(pg8::bf16x8, w); }
    f32x4 o[4];
#pragma unroll
    for (int dt = 0; dt < 4; ++dt) o[dt] = (f32x4){0.f, 0.f, 0.f, 0.f};
    LAS const unsigned char* vb = VS + (4 * kg + (n >> 2)) * 128 + (4 * (n & 3)) * 2;
    asm volatile("s_waitcnt vmcnt(0)" ::: "memory");
    DSA_PV(0, 0); asm volatile("s_waitcnt lgkmcnt(0)" ::: "memory"); if (FULL || nsc > 4) DSA_DMAV(4, 0);
    DSA_PV(1, 1); asm volatile("s_waitcnt lgkmcnt(0)" ::: "memory"); if (FULL || nsc > 4) DSA_DMAV(5, 1);
    if (FULL || nsc > 2) {
        DSA_PV(2, 2); asm volatile("s_waitcnt lgkmcnt(0)" ::: "memory"); if (FULL || nsc > 6) DSA_DMAV(6, 2);
        DSA_PV(3, 3); asm volatile("s_waitcnt lgkmcnt(0)" ::: "memory"); if (FULL || nsc > 6) DSA_DMAV(7, 3);
    }
    if (FULL || nsc > 4) {
        asm volatile("s_waitcnt vmcnt(0)" ::: "memory");
        DSA_PV(0, 4); DSA_PV(1, 5);
        if (FULL || nsc > 6) { DSA_PV(2, 6); DSA_PV(3, 7); }
    }
    asm volatile("s_waitcnt lgkmcnt(0)" ::: "memory");
#undef DSA_DMAV
#undef DSA_PV
    if (n < 8) { const float inv = 1.f / ls; bf16* Op = (bf16*)(F.ws + WS_OA) + qrow * 512 + n * 64 + 4 * kg;
#pragma unroll
        for (int dt = 0; dt < 4; ++dt) *(unsigned long long*)(Op + 16 * dt) = (unsigned long long)cvtpk(o[dt][0] * inv, o[dt][1] * inv) | ((unsigned long long)cvtpk(o[dt][2] * inv, o[dt][3] * inv) << 32); }
}
constexpr int DS_VROW = 144, DS_VBUF = 64 * DS_VROW;
__device__ __forceinline__ void dsa_unit(Frame& F, int b, int c, int g) {
    const int lane = F.lane, wave = F.wave;
    LAS unsigned char* L = F.ldsl + RING_OFF;
    LAS float* SC = (LAS float*)L;
    LAS int* SEL = (LAS int*)(F.ldsl + SEL_OFF) + wave * 256;
    const int q0 = c * 64 + g * 8, Kn = (c + 1) * 64;
    const bf16* QI = (const bf16*)(F.ws + WS_QI); const bf16* KI = (const bf16*)(F.ws + WS_KI); const float* WI = (const float*)(F.ws + WS_WI);
    const bf16* QA = (const bf16*)(F.ws + WS_QA); const bf16* KA = (const bf16*)(F.ws + WS_KA); const bf16* VA = (const bf16*)(F.ws + WS_VA);
    __syncthreads();
    for (int repa_ = 0; repa_ <= ((DUP_MASK >> 12) & 1); ++repa_) {
        const int m = lane & 31, hi = lane >> 5;
        const int q4 = 2 * ((m >> 2) & 1) + (m >> 4), head = (m & 3) + 4 * ((m >> 3) & 1);
        pg8::bf16x8 af[2][4]; float wq[2][16];
#pragma unroll
        for (int mt = 0; mt < 2; ++mt) {
            const size_t arow = (size_t)b * SEQ + q0 + 4 * mt + q4;
#pragma unroll
            for (int s = 0; s < 4; ++s) af[mt][s] = *(const pg8::bf16x8*)(QI + arow * 512 + head * 64 + 16 * s + 8 * hi);
            const size_t wrow = (size_t)b * SEQ + q0 + 4 * mt + 2 * hi;
#pragma unroll
            for (int j = 0; j < 4; ++j) { const f32x4 t = *(const f32x4*)(WI + wrow * 8 + 4 * j); wq[mt][4 * j] = t.x; wq[mt][4 * j + 1] = t.y; wq[mt][4 * j + 2] = t.z; wq[mt][4 * j + 3] = t.w; }
        }
        const int nkt = Kn / 32;
        const bf16* kbase = KI + ((size_t)b * SEQ + m) * 64 + 8 * hi;
        LAS unsigned* sp = (LAS unsigned*)SC + (2 * hi) * 4096 + m;
        LAS unsigned* hp = (LAS unsigned*)(F.ldsl + HIST_OFF) + (2 * hi) * 256;
#define DSA_LOADK(dst, kt) do { _Pragma("unroll") for (int s_ = 0; s_ < 4; ++s_) dst[s_] = *(const pg8::bf16x8*)(kbase + (size_t)(kt) * 32 * 64 + 16 * s_); } while (0)
#define DSA_TILE(src, kt) do { _Pragma("unroll") for (int mt_ = 0; mt_ < 2; ++mt_) { f32x16 acc_ = {}; \
            _Pragma("unroll") for (int s_ = 0; s_ < 4; ++s_) acc_ = MFMA32(af[mt_][s_], src[s_], acc_); \
            float s0_ = 0.f, s1_ = 0.f; \
            _Pragma("unroll") for (int r_ = 0; r_ < 8; ++r_) { s0_ += wq[mt_][r_] * fmaxf(acc_[r_], 0.f); s1_ += wq[mt_][8 + r_] * fmaxf(acc_[8 + r_], 0.f); } \
            unsigned u0_ = __float_as_uint(s0_ + 0.f), u1_ = __float_as_uint(s1_ + 0.f); u0_ = (u0_ >> 31) ? ~u0_ : (u0_ | 0x80000000u); u1_ = (u1_ >> 31) ? ~u1_ : (u1_ | 0x80000000u); \
            sp[(4 * mt_) * 4096 + 32 * (kt)] = u0_; sp[(4 * mt_ + 1) * 4096 + 32 * (kt)] = u1_; \
            __hip_atomic_fetch_add(hp + (4 * mt_) * 256 + (u0_ >> 24), 1u, __ATOMIC_RELAXED, __HIP_MEMORY_SCOPE_WORKGROUP); \
            __hip_atomic_fetch_add(hp + (4 * mt_ + 1) * 256 + (u1_ >> 24), 1u, __ATOMIC_RELAXED, __HIP_MEMORY_SCOPE_WORKGROUP); } } while (0)
        pg8::bf16x8 bA[4], bB[4];
        if (wave < nkt) DSA_LOADK(bA, wave);
        if (wave + 8 < nkt) DSA_LOADK(bB, wave + 8);
        for (int kt = wave; kt < nkt; kt += 16) {
            DSA_TILE(bA, kt);
            if (kt + 16 < nkt) DSA_LOADK(bA, kt + 16);
            if (kt + 8 < nkt) { DSA_TILE(bB, kt + 8); if (kt + 24 < nkt) DSA_LOADK(bB, kt + 24); }
        }
#undef DSA_LOADK
#undef DSA_TILE
    }
    __syncthreads();
    int nsel;
    for (int repb_ = 0; repb_ <= ((DUP_MASK >> 13) & 1); ++repb_)
    if (Kn <= 256) { nsel = Kn; for (int i = lane; i < Kn; i += 64) SEL[i] = i; *(LAS v4u*)((LAS unsigned*)(F.ldsl + HIST_OFF) + wave * 256 + 4 * lane) = (v4u){0u, 0u, 0u, 0u}; }
    else {
        nsel = 256;
        LAS const unsigned* sr = (LAS const unsigned*)SC + wave * 4096; LAS unsigned* hs = (LAS unsigned*)(F.ldsl + HIST_OFF) + wave * 256;
        const int nj = Kn >> 6;
        if (nj <= 16) dsa_select<16>(sr, hs, SEL, nj, lane);
        else if (nj <= 32) dsa_select<32>(sr, hs, SEL, nj, lane);
        else if (nj <= 48) dsa_select<48>(sr, hs, SEL, nj, lane);
        else dsa_select<64>(sr, hs, SEL, nj, lane);
    }
    asm volatile("s_waitcnt lgkmcnt(0)" ::: "memory");
    for (int repc_ = 0; repc_ <= ((DUP_MASK >> 14) & 1); ++repc_) {
        const size_t qrow = (size_t)b * SEQ + q0 + wave;
        if (nsel == 256) dsa_attend<true>(F, L, SEL, b, qrow, nsel); else dsa_attend<false>(F, L, SEL, b, qrow, nsel);
    }
}
__device__ __forceinline__ void p3_fox(Frame& F) {
    for (int v = F.vcu; v < 256; v += F.G) {
        const int bh = v >> 3, s = v & 7;
        fox_unit(F, bh >> 3, bh & 7, 15 - s);
        fox_unit(F, bh >> 3, bh & 7, s);
    }
}
__device__ __forceinline__ void p3_dsa(Frame& F) {
    for (int i = F.tid; i < 2048; i += NWAVES * 64) ((LAS unsigned*)(F.ldsl + HIST_OFF))[i] = 0u;
    __syncthreads();
    for (int v = F.vcu; v < 256; v += F.G) {
        const int b = v >> 6, t = v & 63, g0 = (t < 32) ? 0 : 4;
        for (int i = 0; i < 4; ++i) dsa_unit(F, b, 63 - t, g0 + i);
        for (int i = 0; i < 4; ++i) dsa_unit(F, b, t, g0 + i);
    }
}

__device__ __forceinline__ void p6_router(Frame& F) {
    const float* MOD = (const float*)(F.ws + WS_MOD); const float* X1 = F.out; const float* SSQ = (const float*)(F.ws + WS_CTL) + CW_SSQ;
    bf16* H2 = (bf16*)(F.ws + WS_H2); const bf16* WrT = (const bf16*)(F.ws + WS_WRT); unsigned* ROUTE = (unsigned*)(F.ws + WS_ROUTE);
    int* TOKSLOT = (int*)(F.ws + WS_TOKSLOT);
    for (int i = F.vcu * NWAVES * 64 + F.tid; i < PMAX; i += F.G * NWAVES * 64) TOKSLOT[i] = -1;
    const int lane = F.lane, r = lane & 15, kg = lane >> 4;
    const int it4 = F.wave & 3, kh = F.wave >> 2;
    LAS float* GS = (LAS float*)(F.ldsl + RING_OFF);
    LAS float* SH = GS + 1024;
    LAS float* LG = SH + 1024 + it4 * (16 * 52);
    LAS float* LG2 = SH + 1024 + 4 * (16 * 52) + it4 * (16 * 52);
    for (int base = F.vcu * 4; base < M / 16; base += F.G * 4) {
        __syncthreads();
        const int bb = (base * 16) >> 12;
        for (int i = F.tid; i < 1024; i += NWAVES * 64) { GS[i] = F.g_ffn[i] * (MOD[bb * 6144 + 4096 + i] + 1.0f); SH[i] = MOD[bb * 6144 + 3072 + i]; }
        if (F.tid < 32) F.LX[32 + F.tid] = 0u;
        __syncthreads();
        const int item = base + it4; const bool act = item < M / 16;
        int e1 = 0, e2 = 0, lr1 = 0, lr2 = 0; float w1 = 0.f, w2 = 0.f;
        if (act) {
            const int row = item * 16 + r;
            const float rstd = 1.f / sqrtf(SSQ[row] * (1.f / D) + RMS_EPS);
            f32x4 acc[3];
#pragma unroll
            for (int nt = 0; nt < 3; ++nt) acc[nt] = (f32x4){0.f, 0.f, 0.f, 0.f};
#pragma unroll 4
            for (int s = 0; s < 16; ++s) {
                const int k = 32 * (16 * kh + s) + 8 * kg;
                const f32x4 xa = *(const f32x4*)(X1 + (size_t)row * D + k), xb = *(const f32x4*)(X1 + (size_t)row * D + k + 4);
                const f32x4 ga = *(LAS const f32x4*)(GS + k), gb = *(LAS const f32x4*)(GS + k + 4);
                const f32x4 ha = *(LAS const f32x4*)(SH + k), hb = *(LAS const f32x4*)(SH + k + 4);
                const f32x4 ya = xa * rstd * ga + ha, yb = xb * rstd * gb + hb;
                v4u w; w.x = cvtpk(ya.x, ya.y); w.y = cvtpk(ya.z, ya.w); w.z = cvtpk(yb.x, yb.y); w.w = cvtpk(yb.z, yb.w);
                *(v4u*)(H2 + (size_t)row * D + k) = w;
                const pg8::bf16x8 a = __builtin_bit_cast(pg8::bf16x8, w);
#pragma unroll
                for (int nt = 0; nt < 3; ++nt) { const pg8::bf16x8 bw = *(const pg8::bf16x8*)(WrT + (size_t)(16 * nt + r) * D + k); acc[nt] = MFMA16(a, bw, acc[nt]); }
            }
            LAS float* dst = kh ? LG2 : LG;
#pragma unroll
            for (int nt = 0; nt < 3; ++nt)
#pragma unroll
                for (int i = 0; i < 4; ++i) dst[(4 * kg + i) * 52 + 16 * nt + r] = acc[nt][i];
        }
        __syncthreads();
        if (act && kh == 0 && lane < 16) {
            LAS const float* lg = LG + lane * 52; LAS const float* lg2 = LG2 + lane * 52;
            float gl[4]; int grp = 0;
#pragma unroll
            for (int i = 0; i < 4; ++i) gl[i] = lg[32 + i] + lg2[32 + i] + F.b_group[i];
#pragma unroll
            for (int i = 1; i < 4; ++i) if (gl[i] > gl[grp]) grp = i;
            const float gmax = (grp == 0) ? gl[0] : (grp == 1) ? gl[1] : (grp == 2) ? gl[2] : gl[3];
            float den = 0.f;
#pragma unroll
            for (int i = 0; i < 4; ++i) den += expf(gl[i] - gmax);
            const float pg = 1.f / den;
            float ev[8];
#pragma unroll
            for (int i = 0; i < 8; ++i) ev[i] = lg[grp * 8 + i] + lg2[grp * 8 + i] + F.b_router[grp * 8 + i];
            int i1 = 0; float v1 = ev[0];
#pragma unroll
            for (int i = 1; i < 8; ++i) if (ev[i] > v1) { v1 = ev[i]; i1 = i; }
            int i2 = -1; float v2 = -3.0e38f;
#pragma unroll
            for (int i = 0; i < 8; ++i) if (i != i1 && ev[i] > v2) { v2 = ev[i]; i2 = i; }
            const float t = expf(v2 - v1);
            w1 = pg / (1.f + t); w2 = pg * t / (1.f + t);
            e1 = grp * 8 + i1; e2 = grp * 8 + i2;
            lr1 = (int)atomicAdd((unsigned*)&F.LX[32 + e1], 1u); lr2 = (int)atomicAdd((unsigned*)&F.LX[32 + e2], 1u);
        }
        __syncthreads();
        if (F.tid < 32) { const unsigned c = F.LX[32 + F.tid]; F.LX[64 + F.tid] = c ? atomicAdd((unsigned*)(F.ctl + CW_CNT + F.tid), c) : 0u; }
        __syncthreads();
        if (act && kh == 0 && lane < 16) { const int row = item * 16 + lane; unsigned* rp = ROUTE + (size_t)row * 8;
            rp[0] = (unsigned)e1; rp[1] = F.LX[64 + e1] + (unsigned)lr1; rp[2] = __float_as_uint(w1); rp[3] = 0u;
            rp[4] = (unsigned)e2; rp[5] = F.LX[64 + e2] + (unsigned)lr2; rp[6] = __float_as_uint(w2); rp[7] = 0u; }
    }
}
__device__ __forceinline__ void p7_scatter(Frame& F) {
    moe_table(F);
    const int gw = F.vcu * NWAVES + F.wave, NGW = F.G * NWAVES;
    const bf16* H2 = (const bf16*)(F.ws + WS_H2); bf16* XS = (bf16*)(F.ws + WS_XS); const unsigned* ROUTE = (const unsigned*)(F.ws + WS_ROUTE);
    int* TOKSLOT = (int*)(F.ws + WS_TOKSLOT); float* WROW = (float*)(F.ws + WS_WROW);
    for (int m = gw; m < M; m += NGW) {
        const v4u ra = *(const v4u*)(ROUTE + (size_t)m * 8), rb = *(const v4u*)(ROUTE + (size_t)m * 8 + 4);
        const unsigned d0 = F.LX[96 + (ra.x & 31u)] + ra.y, d1 = F.LX[96 + (rb.x & 31u)] + rb.y;
        const v4u a = *((const v4u*)(H2 + (size_t)m * D) + F.lane), c = *((const v4u*)(H2 + (size_t)m * D) + 64 + F.lane);
        if (d0 < (unsigned)PMAX) { *((v4u*)(XS + (size_t)d0 * D) + F.lane) = a; *((v4u*)(XS + (size_t)d0 * D) + 64 + F.lane) = c; if (F.lane == 0) { TOKSLOT[d0] = 2 * m; WROW[d0] = __uint_as_float(ra.z); } }
        if (d1 < (unsigned)PMAX) { *((v4u*)(XS + (size_t)d1 * D) + F.lane) = a; *((v4u*)(XS + (size_t)d1 * D) + 64 + F.lane) = c; if (F.lane == 0) { TOKSLOT[d1] = 2 * m + 1; WROW[d1] = __uint_as_float(rb.z); } }
    }
}
__device__ __forceinline__ void p10_final(Frame& F) {
    const int gw = F.vcu * NWAVES + F.wave, NGW = F.G * NWAVES;
    const float* MOD = (const float*)(F.ws + WS_MOD); const bf16* YC = (const bf16*)(F.ws + WS_YC);
    for (int m = gw; m < M; m += NGW) {
        const int b = m >> 12;
        GAS f32x4* xr = (GAS f32x4*)(F.out + (size_t)m * D) + F.lane;
        const GAS unsigned long long* y0 = (const GAS unsigned long long*)(YC + (size_t)(2 * m) * D) + F.lane;
        const GAS unsigned long long* y1 = (const GAS unsigned long long*)(YC + (size_t)(2 * m + 1) * D) + F.lane;
        f32x4 v[4]; float s = 0.f;
#pragma unroll
        for (int j = 0; j < 4; ++j) { const int col = 4 * F.lane + 256 * j;
            const f32x4 x1 = xr[64 * j]; const unsigned long long a = y0[64 * j], c = y1[64 * j];
            const f32x4 gt = *(const f32x4*)(MOD + b * 6144 + 5120 + col);
            f32x4 y; y.x = bflo((unsigned)a) + bflo((unsigned)c); y.y = bfhi((unsigned)a) + bfhi((unsigned)c); y.z = bflo((unsigned)(a >> 32)) + bflo((unsigned)(c >> 32)); y.w = bfhi((unsigned)(a >> 32)) + bfhi((unsigned)(c >> 32));
            v[j] = x1 + gt * y; s += (v[j].x * v[j].x + v[j].y * v[j].y) + (v[j].z * v[j].z + v[j].w * v[j].w); }
        const float rstd = 1.f / sqrtf(wave_sum(s) * (1.f / D) + RMS_EPS);
#pragma unroll
        for (int j = 0; j < 4; ++j) { const int col = 4 * F.lane + 256 * j; const f32x4 g = *(const f32x4*)(F.g_final + col); xr[64 * j] = v[j] * rstd * g; }
    }
}

struct Args { const void* in[20]; float* out; unsigned char* ws; int ph_lo, ph_hi; };
__global__ void __launch_bounds__(NWAVES * 64, 2) hybrid_fwd(Args args) {
    extern __shared__ __attribute__((aligned(16))) unsigned char lds[];
    Frame F;
    F.lds = lds; F.ldsl = (LAS unsigned char*)lds; F.LX = (volatile LAS unsigned*)(F.ldsl + LX_OFF);
    F.tid = threadIdx.x; F.lane = F.tid & 63; F.wave = __builtin_amdgcn_readfirstlane(F.tid >> 6);
    F.G = gridDim.x; { const int bx = blockIdx.x; F.vcu = (F.G % 8 == 0) ? (bx % 8) * (F.G / 8) + bx / 8 : bx; }
    F.ws = args.ws; F.ctl = (gu32*)(args.ws + WS_CTL); F.out = args.out;
    F.x = (const float*)args.in[0]; F.c = (const float*)args.in[1]; F.positions = (const int*)args.in[2]; F.w_mod = (const float*)args.in[3]; F.b_mod = (const float*)args.in[4];
    F.g_mix = (const float*)args.in[5]; F.w_in = (const float*)args.in[6]; F.b_forget = (const float*)args.in[7]; F.w_out_a = (const float*)args.in[8]; F.w_out_b = (const float*)args.in[9];
    F.w_out = (const float*)args.in[10]; F.g_ffn = (const float*)args.in[11]; F.w_group = (const float*)args.in[12]; F.b_group = (const float*)args.in[13]; F.w_router = (const float*)args.in[14];
    F.b_router = (const float*)args.in[15]; F.w_e_gate = (const float*)args.in[16]; F.w_e_up = (const float*)args.in[17]; F.w_e_down = (const float*)args.in[18]; F.g_final = (const float*)args.in[19];
    for (int u = F.tid; u < (LDS_BYTES - LX_OFF) / 4; u += NWAVES * 64) F.LX[u] = 0u;
    __syncthreads();
    XcdBarrier bar; bar.bar = (unsigned*)(F.ctl + CW_BAR); bar.x = 0; bar.st = nullptr;
    if (N_LAUNCHES == 1) bar = xcd_barrier_post((unsigned*)(F.ctl + CW_BAR), F.LX);
    const int lo = args.ph_lo, hi = args.ph_hi;
#ifndef PH_MASK
#define PH_MASK 0xFFFF
#endif
#define IN(k) (((PH_MASK >> (k)) & 1) && lo <= (k) && (k) < hi)
#define REP(k) for (int rep_ = 0; rep_ <= ((DUP_MASK >> (k)) & 1); ++rep_)
#define SEAM(k) do { if (IN(k) && IN((k) + 1)) { xcd_barrier(bar); if ((DUP_MASK >> 15) & 1) xcd_barrier(bar); } } while (0)
    LAS unsigned char* ring = F.ldsl + RING_OFF;
    if (IN(0)) { REP(0) p0_prologue(F); } SEAM(0);
    if (IN(1)) { REP(1) p1_hnorm(F); } SEAM(1);
    if (IN(2)) {
        pg8::Gemm g{(const pg8::bf16_t*)(F.ws + WS_H), (const pg8::bf16_t*)(F.ws + WS_WIN), M, NPROJ, D}; pg8::StaticOrder S; S.init(M, NPROJ, F.G, (int)blockIdx.x);
        EpiProj E{F.ws, F.b_forget};
        pg8::gemm_phase<EpiProj, pg8::StaticOrder, true, true>(ring, g, S, E);
#if (DUP_MASK >> 2) & 1
        asm volatile("s_waitcnt vmcnt(0)" ::: "memory"); __syncthreads();
        pg8::gemm_phase<EpiProj, pg8::StaticOrder, true, true>(ring, g, S, E);
#endif
    } SEAM(2);
    if (IN(3)) { REP(3) p3_fox(F); REP(11) p3_dsa(F); } SEAM(3);
    if (IN(4)) {
        { pg8::Gemm g{(const pg8::bf16_t*)(F.ws + WS_OA), (const pg8::bf16_t*)(F.ws + WS_WOA), M, D, 512}; pg8::StaticOrder S; S.init(M, D, F.G, (int)blockIdx.x);
          EpiMerge<0> E{F.ws}; pg8::gemm_phase<EpiMerge<0>, pg8::StaticOrder, true, true>(ring, g, S, E); }
        asm volatile("s_waitcnt vmcnt(0)" ::: "memory"); __syncthreads();
        { pg8::Gemm g{(const pg8::bf16_t*)(F.ws + WS_OB), (const pg8::bf16_t*)(F.ws + WS_WOB), M, D, 512}; pg8::StaticOrder S; S.init(M, D, F.G, (int)blockIdx.x);
          EpiMerge<1> E{F.ws}; pg8::gemm_phase<EpiMerge<1>, pg8::StaticOrder, true, true>(ring, g, S, E); }
    } SEAM(4);
    if (IN(5)) {
        pg8::Gemm g{(const pg8::bf16_t*)(F.ws + WS_GA), (const pg8::bf16_t*)(F.ws + WS_WO), M, D, D}; pg8::StaticOrder S; S.init(M, D, F.G, (int)blockIdx.x);
        EpiOut E{F.ws, F.x, F.out}; pg8::gemm_phase<EpiOut, pg8::StaticOrder, true, true>(ring, g, S, E);
    } SEAM(5);
    if (IN(6)) { p6_router(F); } SEAM(6);
    if (IN(7)) { REP(7) p7_scatter(F); } SEAM(7);
    if (IN(8)) {
        moe_table(F);
        pg8::Gemm g{(const pg8::bf16_t*)(F.ws + WS_XS), (const pg8::bf16_t*)(F.ws + WS_WGU), PMAX, 32 * 1024, D};
        MoeOrder S{F.G, F.vcu, (int)F.LX[132] * 4, F.LX + 160};
        EpiGU E{F.ws}; REP(8) pg8::gemm_phase<EpiGU, MoeOrder, true, true>(ring, g, S, E);
    } SEAM(8);
    if (IN(9)) {
        moe_table(F);
        pg8::Gemm g{(const pg8::bf16_t*)(F.ws + WS_HID), (const pg8::bf16_t*)(F.ws + WS_WDN), PMAX, 32 * 1024, 512};
        MoeOrder S{F.G, F.vcu, (int)F.LX[132] * 4, F.LX + 160};
        EpiDown E{F.ws}; REP(9) pg8::gemm_phase<EpiDown, MoeOrder, true, true>(ring, g, S, E);
    } SEAM(9);
    if (IN(10)) { p10_final(F); }
#undef IN
#undef SEAM
}

extern "C" void kernel_launch(void* const* d_in, const int* in_sizes, int n_in, void* d_out, int out_size, void* d_ws, size_t ws_size, hipStream_t stream) {
    static int grid = 0;
    if (grid == 0) {
        if (n_in != 20 || in_sizes[0] != M * D || out_size != M * D || ws_size < WS_END) { fprintf(stderr, "kernel_launch: unexpected shapes (n_in %d, in0 %d, out %d, ws %zu); nothing launched\n", n_in, n_in > 0 ? in_sizes[0] : -1, out_size, ws_size); grid = -1; return; }
        int dev = 0, cus = 0, per_cu = 0;
        if (hipGetDevice(&dev) != hipSuccess || hipDeviceGetAttribute(&cus, hipDeviceAttributeMultiprocessorCount, dev) != hipSuccess) { grid = -1; return; }
        if (hipFuncSetAttribute((const void*)hybrid_fwd, hipFuncAttributeMaxDynamicSharedMemorySize, LDS_BYTES) != hipSuccess) { fprintf(stderr, "kernel_launch: hipFuncSetAttribute failed\n"); grid = -1; return; }
        if (hipOccupancyMaxActiveBlocksPerMultiprocessor(&per_cu, (const void*)hybrid_fwd, NWAVES * 64, LDS_BYTES) != hipSuccess || per_cu < 1)
            fprintf(stderr, "kernel_launch: note: occupancy query reports %d workgroups per CU\n", per_cu);
        (void)hipGetLastError();
        grid = cus;
    }
    if (grid < 0) return;
    if (hipMemsetAsync((char*)d_ws + WS_CTL, 0, CTL_ZERO_BYTES, stream) != hipSuccess) { fprintf(stderr, "kernel_launch: hipMemsetAsync failed\n"); return; }
    Args a{};
    for (int i = 0; i < 20; ++i) a.in[i] = d_in[i];
    a.out = (float*)d_out; a.ws = (unsigned char*)d_ws;
    for (int li = 0; li < N_LAUNCHES; ++li) {
        a.ph_lo = (N_LAUNCHES == 1) ? 0 : li; a.ph_hi = (N_LAUNCHES == 1) ? NPHASE : li + 1;
        hipLaunchKernelGGL(hybrid_fwd, dim3(grid), dim3(NWAVES * 64), LDS_BYTES, stream, a);
        const hipError_t le = hipPeekAtLastError();
        if (le != hipSuccess) { fprintf(stderr, "kernel_launch: launch %d failed: %s\n", li, hipGetErrorName(le)); break; }
    }
}
```

```cpp
#define MK_N_LAUNCHES 1
#include <hip/hip_runtime.h>
#include <hip/hip_bf16.h>
#include <cstdio>
#include <cstdint>
#include <cmath>
namespace pg8 {
#define PG8_LAS __attribute__((address_space(3)))
typedef unsigned short bf16_t;
typedef short bf16x8 __attribute__((ext_vector_type(8)));
typedef float f32x4 __attribute__((ext_vector_type(4)));
typedef unsigned u32x4 __attribute__((ext_vector_type(4)));
constexpr int BM = 256, BK = 64, HALF = 128, HTB = HALF * BK * 2  , STAGE_BYTES = 8 * HTB, NXCD = 8, WGM = 8;

__host__ __device__ __forceinline__ int lds_byte(int r, int c) { const int st = (r >> 4) * 2 + (c >> 5), rr = r & 15, cc = c & 31, ob = rr * 64 + cc * 2; return st * 1024 + (ob ^ (((ob >> 9) & 1) << 5)); }
__host__ __device__ __forceinline__ void stage_rc(int b, int& R, int& C) { const int st = b / 1024, sb = b % 1024, swz = sb ^ (((sb >> 9) & 1) << 5); R = (st >> 1) * 16 + swz / 64; C = (st & 1) * 32 + (swz % 64) / 2; }
__host__ __device__ __forceinline__ int perm32(int rho) { const int n = rho >> 4, i = rho & 15; return 8 * (i >> 2) + 4 * n + (i & 3); }

struct Unit { int pm, pn; };
struct Gemm { const bf16_t* A; const bf16_t* Bt; int M, N, K; };

struct StaticOrder {
    int nM, nN, nwg, G, c;
    __host__ __device__ void init(int M, int N, int G_, int c_) { nM = M / BM; nN = N / BM; nwg = nM * nN; G = G_; c = c_; }
    __host__ __device__ bool next(int i, Unit& u) const {
        const long L = (long)i * G + c; if (L >= nwg) return false;
        int wgid = (int)L; { const int q = nwg / NXCD, r = nwg % NXCD, xcd = wgid % NXCD, off = wgid / NXCD; wgid = (xcd < r ? xcd * (q + 1) : r * (q + 1) + (xcd - r) * q) + off; }
        const int nig = WGM * nN, gid = wgid / nig, fm = gid * WGM, gsz = (nM - fm) < WGM ? (nM - fm) : WGM;
        u.pm = fm + ((wgid % nig) % gsz); u.pn = (wgid % nig) / gsz; return true;
    }
    __device__ __forceinline__ void a_ready(const Unit&) const {}
    __device__ __forceinline__ void done(const Unit&) const {}
};

__device__ __forceinline__ unsigned cvt_pk_bf16(float lo, float hi) { unsigned r; asm volatile("v_cvt_pk_bf16_f32 %0, %1, %2" : "=v"(r) : "v"(lo), "v"(hi)); return r; }
typedef float f32x2 __attribute__((ext_vector_type(2)));
template <class Epi, class Sched, bool ALIGN_EPI = false, bool SP2 = false>
__device__ __forceinline__ void gemm_phase(PG8_LAS unsigned char* lds, const Gemm g, const Sched& S, const Epi& E) {
    const int tid = threadIdx.x, wid = __builtin_amdgcn_readfirstlane(tid >> 6), lane = tid & 63, wr = wid >> 2, wc = wid & 3, fr = lane & 15, fq = lane >> 4;
    const int K = g.K, nt = K / BK;
    unsigned voffA[2], voffB[2];
#pragma unroll
    for (int i = 0; i < 2; ++i) { int R, C; stage_rc(tid * 16 + i * 8192, R, C); const int Rb = Epi::PERM ? ((R & ~31) + perm32(R & 31)) : R;
        voffA[i] = (unsigned)(R * K + C) * 2u; voffB[i] = (unsigned)(Rb * K + C) * 2u; }
    const size_t kstep = (size_t)(BK * 2);
    const size_t hstep = (size_t)HALF * K * 2;
    const size_t tstep = 2 * hstep;
    const unsigned ldsw = (unsigned)wid * 1024u;
    const int aoff = lds_byte(wr * 64 + fr, fq * 8), boff = lds_byte(wc * 32 + fr, fq * 8);
#define PG8_SA(b, h) (((b) * 2 + (h)) * HTB)
#define PG8_SB(b, h) ((4 + (b) * 2 + (h)) * HTB)
#define PG8_STAGE(bufoff, gbase, voff) do { _Pragma("unroll") for (int _i = 0; _i < 2; ++_i) \
        __builtin_amdgcn_global_load_lds((const unsigned*)((const char*)(gbase) + (voff)[_i]), (PG8_LAS unsigned*)(lds + (bufoff) + ldsw + _i * 8192), 16, 0, 0); } while (0)
#define PG8_LDA(dst, b, h) do { _Pragma("unroll") for (int m = 0; m < 4; ++m) _Pragma("unroll") for (int k = 0; k < 2; ++k) dst[m][k] = *(const PG8_LAS bf16x8*)(lds + PG8_SA(b, h) + aoff + m * 2048 + k * 1024); } while (0)
#define PG8_LDB(dst, b, h) do { _Pragma("unroll") for (int n = 0; n < 2; ++n) _Pragma("unroll") for (int k = 0; k < 2; ++k) dst[n][k] = *(const PG8_LAS bf16x8*)(lds + PG8_SB(b, h) + boff + n * 2048 + k * 1024); } while (0)
#define PG8_MMA(ai, bj, At, Bt) do { __builtin_amdgcn_s_setprio(1); _Pragma("unroll") for (int m = 0; m < 4; ++m) _Pragma("unroll") for (int n = 0; n < 2; ++n) _Pragma("unroll") for (int k = 0; k < 2; ++k) \
        acc[ai][bj][m][n] = __builtin_amdgcn_mfma_f32_16x16x32_bf16(Bt[n][k], At[m][k], acc[ai][bj][m][n], 0, 0, 0); __builtin_amdgcn_s_setprio(0); } while (0)
#define PG8_WAIT_V(n) asm volatile("s_waitcnt vmcnt(" #n ")" ::: "memory")
#define PG8_WAIT_L(n) asm volatile("s_waitcnt lgkmcnt(" #n ")" ::: "memory")
#define PG8_BAR __builtin_amdgcn_s_barrier()
#define PG8_SCHED __builtin_amdgcn_sched_barrier(0)
    Unit cur, nxt; int ui = 0;
    if (!S.next(0, cur)) return;
    f32x4 acc[2][2][4][2];
#pragma unroll
    for (int a = 0; a < 2; ++a)
#pragma unroll
        for (int b = 0; b < 2; ++b)
#pragma unroll
            for (int m = 0; m < 4; ++m)
#pragma unroll
                for (int n = 0; n < 2; ++n) acc[a][b][m][n] = (f32x4){0.f, 0.f, 0.f, 0.f};
    bf16x8 At[4][2], B0[2][2], B1[2][2];
    const char* cA = (const char*)g.A + (size_t)cur.pm * tstep; const char* cB = (const char*)g.Bt + (size_t)cur.pn * tstep;
    S.a_ready(cur);
    if constexpr (SP2) {
        PG8_STAGE(PG8_SB(0, 0), cB, voffB); PG8_STAGE(PG8_SB(0, 1), cB + hstep, voffB); PG8_STAGE(PG8_SA(0, 0), cA, voffA); PG8_STAGE(PG8_SA(0, 1), cA + hstep, voffA);
        if (wr == 1) PG8_BAR;
        PG8_WAIT_V(2); PG8_BAR;
        PG8_STAGE(PG8_SB(1, 0), cB + kstep, voffB); PG8_STAGE(PG8_SA(1, 0), cA + kstep, voffA); PG8_STAGE(PG8_SB(1, 1), cB + hstep + kstep, voffB);
        PG8_WAIT_V(6); PG8_BAR;
    } else {
        PG8_STAGE(PG8_SB(0, 0), cB, voffB); PG8_STAGE(PG8_SA(0, 0), cA, voffA); PG8_STAGE(PG8_SB(0, 1), cB + hstep, voffB); PG8_STAGE(PG8_SA(0, 1), cA + hstep, voffA);
        if (wr == 1) PG8_BAR;
        PG8_WAIT_V(4); PG8_BAR;
        PG8_STAGE(PG8_SB(1, 0), cB + kstep, voffB); PG8_STAGE(PG8_SA(1, 0), cA + kstep, voffA); PG8_STAGE(PG8_SB(1, 1), cB + hstep + kstep, voffB);
        PG8_WAIT_V(6); PG8_BAR;
    }
    for (;;) {
        const bool has_next = S.next(ui + 1, nxt);
        const char* nA = has_next ? (const char*)g.A + (size_t)nxt.pm * tstep : cA; const char* nB = has_next ? (const char*)g.Bt + (size_t)nxt.pn * tstep : cB;
        for (int t = 0; t < nt; t += 2) {
            const bool last = (t == nt - 2);
            const char* a1 = cA + (size_t)(t + 1) * kstep;
            const char* a2 = last ? nA : cA + (size_t)(t + 2) * kstep; const char* b2 = last ? nB : cB + (size_t)(t + 2) * kstep;
            const char* a3 = a2 + kstep; const char* b3 = b2 + kstep;
            if (last && has_next) S.a_ready(nxt);
            if constexpr (SP2) {
            PG8_LDB(B0, 0, 0); PG8_LDB(B1, 0, 1); PG8_SCHED; PG8_LDA(At, 0, 0); PG8_STAGE(PG8_SA(1, 1), a1 + hstep, voffA);
            PG8_WAIT_V(8); PG8_WAIT_L(0); PG8_BAR; PG8_MMA(0, 0, At, B0); PG8_MMA(0, 1, At, B1); PG8_BAR; PG8_SCHED;
            PG8_LDA(At, 0, 1); PG8_STAGE(PG8_SB(0, 0), b2, voffB); PG8_STAGE(PG8_SB(0, 1), b2 + hstep, voffB); PG8_STAGE(PG8_SA(0, 0), a2, voffA);
            PG8_WAIT_V(8); PG8_WAIT_L(0); PG8_BAR; PG8_MMA(1, 0, At, B0); PG8_MMA(1, 1, At, B1); PG8_BAR; PG8_SCHED;
            PG8_LDB(B0, 1, 0); PG8_LDB(B1, 1, 1); PG8_SCHED; PG8_LDA(At, 1, 0); PG8_STAGE(PG8_SA(0, 1), a2 + hstep, voffA);
            PG8_WAIT_V(8); PG8_WAIT_L(0); PG8_BAR; PG8_MMA(0, 0, At, B0); PG8_MMA(0, 1, At, B1); PG8_BAR; PG8_SCHED;
            PG8_LDA(At, 1, 1); PG8_STAGE(PG8_SB(1, 0), b3, voffB); PG8_STAGE(PG8_SB(1, 1), b3 + hstep, voffB); PG8_STAGE(PG8_SA(1, 0), a3, voffA);
            PG8_WAIT_V(8); PG8_WAIT_L(0); PG8_BAR; PG8_MMA(1, 0, At, B0); PG8_MMA(1, 1, At, B1); PG8_BAR; PG8_SCHED;
            } else {
            PG8_LDB(B0, 0, 0); PG8_SCHED; PG8_LDA(At, 0, 0); PG8_STAGE(PG8_SA(1, 1), a1 + hstep, voffA);
            PG8_WAIT_L(8); PG8_BAR; PG8_WAIT_L(0); PG8_MMA(0, 0, At, B0); PG8_BAR; PG8_SCHED;
            PG8_LDB(B1, 0, 1); PG8_STAGE(PG8_SB(0, 0), b2, voffB);
            PG8_BAR; PG8_WAIT_L(0); PG8_MMA(0, 1, At, B1); PG8_BAR;
            PG8_LDA(At, 0, 1); PG8_STAGE(PG8_SA(0, 0), a2, voffA);
            PG8_BAR; PG8_WAIT_L(0); PG8_MMA(1, 0, At, B0); PG8_BAR; PG8_SCHED;
            PG8_STAGE(PG8_SB(0, 1), b2 + hstep, voffB);
            PG8_WAIT_V(6); PG8_BAR; PG8_MMA(1, 1, At, B1); PG8_BAR;
            PG8_LDB(B0, 1, 0); PG8_SCHED; PG8_LDA(At, 1, 0); PG8_STAGE(PG8_SA(0, 1), a2 + hstep, voffA);
            PG8_WAIT_L(8); PG8_BAR; PG8_WAIT_L(0); PG8_MMA(0, 0, At, B0); PG8_BAR; PG8_SCHED;
            PG8_LDB(B1, 1, 1); PG8_STAGE(PG8_SB(1, 0), b3, voffB);
            PG8_BAR; PG8_WAIT_L(0); PG8_MMA(0, 1, At, B1); PG8_BAR;
            PG8_LDA(At, 1, 1); PG8_STAGE(PG8_SA(1, 0), a3, voffA);
            PG8_BAR; PG8_WAIT_L(0); PG8_MMA(1, 0, At, B0); PG8_BAR; PG8_SCHED;
            PG8_STAGE(PG8_SB(1, 1), b3 + hstep, voffB);
            PG8_WAIT_V(6); PG8_BAR; PG8_MMA(1, 1, At, B1); PG8_BAR;
            }
        }
        if constexpr (ALIGN_EPI) { if (wr == 0) PG8_BAR; }
        bool keep_acc = false;
        if constexpr (Epi::CHAIN) { keep_acc = E.chain(acc, cur, wr, wc, fr, fq); S.done(cur); }
        else if constexpr (!Epi::AFTER_DRAIN) { E(acc, cur, wr, wc, fr, fq); S.done(cur); }
        if (!has_next) break;
        if (!keep_acc)
#pragma unroll
        for (int a = 0; a < 2; ++a)
#pragma unroll
            for (int b = 0; b < 2; ++b)
#pragma unroll
                for (int m = 0; m < 4; ++m)
#pragma unroll
                    for (int n = 0; n < 2; ++n) acc[a][b][m][n] = (f32x4){0.f, 0.f, 0.f, 0.f};
        cur = nxt; cA = nA; cB = nB; ++ui;
        if constexpr (ALIGN_EPI) { if (wr == 1) PG8_BAR; }
    }
    PG8_WAIT_V(0);
    if constexpr (!ALIGN_EPI) { if (wr == 0) PG8_BAR; }
    PG8_BAR;
    if constexpr (Epi::AFTER_DRAIN) { E.fused(acc, cur, wr, wc, fr, fq, lds, wid, lane); S.done(cur); }
#undef PG8_SA
#undef PG8_SB
#undef PG8_STAGE
#undef PG8_LDA
#undef PG8_LDB
#undef PG8_MMA
#undef PG8_WAIT_V
#undef PG8_WAIT_L
#undef PG8_BAR
#undef PG8_SCHED
}
template <class Epi, class Sched, class RowMap, bool ALIGN_EPI = false, bool SP2 = true>
__device__ __forceinline__ void gemm_phase_g(PG8_LAS unsigned char* lds, const Gemm g, const Sched& S, const Epi& E, const RowMap& RM) {
    static_assert(SP2, "gather variant: SP2 path only");
    const int tid = threadIdx.x, wid = __builtin_amdgcn_readfirstlane(tid >> 6), lane = tid & 63, wr = wid >> 2, wc = wid & 3, fr = lane & 15, fq = lane >> 4;
    const int K = g.K, nt = K / BK;
    unsigned voffA[2], voffB[2]; int rAg[2]; unsigned cAg[2]; unsigned vC[2][2], vN[2][2];
#pragma unroll
    for (int i = 0; i < 2; ++i) { int R, C; stage_rc(tid * 16 + i * 8192, R, C); const int Rb = Epi::PERM ? ((R & ~31) + perm32(R & 31)) : R;
        voffA[i] = (unsigned)(R * K + C) * 2u; voffB[i] = (unsigned)(Rb * K + C) * 2u; rAg[i] = R; cAg[i] = (unsigned)C * 2u; }
    const size_t kstep = (size_t)(BK * 2);
    const size_t hstep = (size_t)HALF * K * 2;
    const size_t tstep = 2 * hstep;
    const unsigned ldsw = (unsigned)wid * 1024u;
    const int aoff = lds_byte(wr * 64 + fr, fq * 8), boff = lds_byte(wc * 32 + fr, fq * 8);
#define PG8_SA(b, h) (((b) * 2 + (h)) * HTB)
#define PG8_SB(b, h) ((4 + (b) * 2 + (h)) * HTB)
#define PG8_STAGE(bufoff, gbase, voff) do { _Pragma("unroll") for (int _i = 0; _i < 2; ++_i) \
        __builtin_amdgcn_global_load_lds((const unsigned*)((const char*)(gbase) + (voff)[_i]), (PG8_LAS unsigned*)(lds + (bufoff) + ldsw + _i * 8192), 16, 0, 0); } while (0)
#define PG8_LDA(dst, b, h) do { _Pragma("unroll") for (int m = 0; m < 4; ++m) _Pragma("unroll") for (int k = 0; k < 2; ++k) dst[m][k] = *(const PG8_LAS bf16x8*)(lds + PG8_SA(b, h) + aoff + m * 2048 + k * 1024); } while (0)
#define PG8_LDB(dst, b, h) do { _Pragma("unroll") for (int n = 0; n < 2; ++n) _Pragma("unroll") for (int k = 0; k < 2; ++k) dst[n][k] = *(const PG8_LAS bf16x8*)(lds + PG8_SB(b, h) + boff + n * 2048 + k * 1024); } while (0)
#define PG8_MMA(ai, bj, At, Bt) do { __builtin_amdgcn_s_setprio(1); _Pragma("unroll") for (int m = 0; m < 4; ++m) _Pragma("unroll") for (int n = 0; n < 2; ++n) _Pragma("unroll") for (int k = 0; k < 2; ++k) \
        acc[ai][bj][m][n] = __builtin_amdgcn_mfma_f32_16x16x32_bf16(Bt[n][k], At[m][k], acc[ai][bj][m][n], 0, 0, 0); __builtin_amdgcn_s_setprio(0); } while (0)
#define PG8_WAIT_V(n) asm volatile("s_waitcnt vmcnt(" #n ")" ::: "memory")
#define PG8_WAIT_L(n) asm volatile("s_waitcnt lgkmcnt(" #n ")" ::: "memory")
#define PG8_BAR __builtin_amdgcn_s_barrier()
#define PG8_SCHED __builtin_amdgcn_sched_barrier(0)
    Unit cur, nxt; int ui = 0;
    if (!S.next(0, cur)) return;
#define PG8_FILL(v, uu) do { _Pragma("unroll") for (int h_ = 0; h_ < 2; ++h_) _Pragma("unroll") for (int i_ = 0; i_ < 2; ++i_) v[h_][i_] = RM.rowoff(uu, h_ * HALF + rAg[i_]) + cAg[i_]; } while (0)
    PG8_FILL(vC, cur);
    const char* gA = (const char*)g.A;
    f32x4 acc[2][2][4][2];
#pragma unroll
    for (int a = 0; a < 2; ++a)
#pragma unroll
        for (int b = 0; b < 2; ++b)
#pragma unroll
            for (int m = 0; m < 4; ++m)
#pragma unroll
                for (int n = 0; n < 2; ++n) acc[a][b][m][n] = (f32x4){0.f, 0.f, 0.f, 0.f};
    bf16x8 At[4][2], B0[2][2], B1[2][2];
    const char* cA = (const char*)g.A + (size_t)cur.pm * tstep; const char* cB = (const char*)g.Bt + (size_t)cur.pn * tstep;
    S.a_ready(cur);
    if constexpr (SP2) {
        PG8_STAGE(PG8_SB(0, 0), cB, voffB); PG8_STAGE(PG8_SB(0, 1), cB + hstep, voffB); PG8_STAGE(PG8_SA(0, 0), gA, vC[0]); PG8_STAGE(PG8_SA(0, 1), gA, vC[1]);
        if (wr == 1) PG8_BAR;
        PG8_WAIT_V(2); PG8_BAR;
        PG8_STAGE(PG8_SB(1, 0), cB + kstep, voffB); PG8_STAGE(PG8_SA(1, 0), gA + kstep, vC[0]); PG8_STAGE(PG8_SB(1, 1), cB + hstep + kstep, voffB);
        PG8_WAIT_V(6); PG8_BAR;
    } else {
        PG8_STAGE(PG8_SB(0, 0), cB, voffB); PG8_STAGE(PG8_SA(0, 0), cA, voffA); PG8_STAGE(PG8_SB(0, 1), cB + hstep, voffB); PG8_STAGE(PG8_SA(0, 1), cA + hstep, voffA);
        if (wr == 1) PG8_BAR;
        PG8_WAIT_V(4); PG8_BAR;
        PG8_STAGE(PG8_SB(1, 0), cB + kstep, voffB); PG8_STAGE(PG8_SA(1, 0), cA + kstep, voffA); PG8_STAGE(PG8_SB(1, 1), cB + hstep + kstep, voffB);
        PG8_WAIT_V(6); PG8_BAR;
    }
    for (;;) {
        const bool has_next = S.next(ui + 1, nxt);
        if (has_next) PG8_FILL(vN, nxt); else { vN[0][0] = vC[0][0]; vN[0][1] = vC[0][1]; vN[1][0] = vC[1][0]; vN[1][1] = vC[1][1]; }
        const char* nA = has_next ? (const char*)g.A + (size_t)nxt.pm * tstep : cA; const char* nB = has_next ? (const char*)g.Bt + (size_t)nxt.pn * tstep : cB;
        for (int t = 0; t < nt; t += 2) {
            const bool last = (t == nt - 2);
            const char* a1 = cA + (size_t)(t + 1) * kstep;
            const char* a2 = last ? nA : cA + (size_t)(t + 2) * kstep; const char* b2 = last ? nB : cB + (size_t)(t + 2) * kstep;
            const char* a3 = a2 + kstep; const char* b3 = b2 + kstep;
            const char* ga2 = last ? gA : gA + (size_t)(t + 2) * kstep;
            unsigned vs0[2] = {last ? vN[0][0] : vC[0][0], last ? vN[0][1] : vC[0][1]}, vs1[2] = {last ? vN[1][0] : vC[1][0], last ? vN[1][1] : vC[1][1]};
            if (last && has_next) S.a_ready(nxt);
            if constexpr (SP2) {
            PG8_LDB(B0, 0, 0); PG8_LDB(B1, 0, 1); PG8_SCHED; PG8_LDA(At, 0, 0); PG8_STAGE(PG8_SA(1, 1), gA + (size_t)(t + 1) * kstep, vC[1]);
            PG8_WAIT_V(8); PG8_WAIT_L(0); PG8_BAR; PG8_MMA(0, 0, At, B0); PG8_MMA(0, 1, At, B1); PG8_BAR; PG8_SCHED;
            PG8_LDA(At, 0, 1); PG8_STAGE(PG8_SB(0, 0), b2, voffB); PG8_STAGE(PG8_SB(0, 1), b2 + hstep, voffB); PG8_STAGE(PG8_SA(0, 0), ga2, vs0);
            PG8_WAIT_V(8); PG8_WAIT_L(0); PG8_BAR; PG8_MMA(1, 0, At, B0); PG8_MMA(1, 1, At, B1); PG8_BAR; PG8_SCHED;
            PG8_LDB(B0, 1, 0); PG8_LDB(B1, 1, 1); PG8_SCHED; PG8_LDA(At, 1, 0); PG8_STAGE(PG8_SA(0, 1), ga2, vs1);
            PG8_WAIT_V(8); PG8_WAIT_L(0); PG8_BAR; PG8_MMA(0, 0, At, B0); PG8_MMA(0, 1, At, B1); PG8_BAR; PG8_SCHED;
            PG8_LDA(At, 1, 1); PG8_STAGE(PG8_SB(1, 0), b3, voffB); PG8_STAGE(PG8_SB(1, 1), b3 + hstep, voffB); PG8_STAGE(PG8_SA(1, 0), ga2 + kstep, vs0);
            PG8_WAIT_V(8); PG8_WAIT_L(0); PG8_BAR; PG8_MMA(1, 0, At, B0); PG8_MMA(1, 1, At, B1); PG8_BAR; PG8_SCHED;
            } else {
            PG8_LDB(B0, 0, 0); PG8_SCHED; PG8_LDA(At, 0, 0); PG8_STAGE(PG8_SA(1, 1), a1 + hstep, voffA);
            PG8_WAIT_L(8); PG8_BAR; PG8_WAIT_L(0); PG8_MMA(0, 0, At, B0); PG8_BAR; PG8_SCHED;
            PG8_LDB(B1, 0, 1); PG8_STAGE(PG8_SB(0, 0), b2, voffB);
            PG8_BAR; PG8_WAIT_L(0); PG8_MMA(0, 1, At, B1); PG8_BAR;
            PG8_LDA(At, 0, 1); PG8_STAGE(PG8_SA(0, 0), a2, voffA);
            PG8_BAR; PG8_WAIT_L(0); PG8_MMA(1, 0, At, B0); PG8_BAR; PG8_SCHED;
            PG8_STAGE(PG8_SB(0, 1), b2 + hstep, voffB);
            PG8_WAIT_V(6); PG8_BAR; PG8_MMA(1, 1, At, B1); PG8_BAR;
            PG8_LDB(B0, 1, 0); PG8_SCHED; PG8_LDA(At, 1, 0); PG8_STAGE(PG8_SA(0, 1), a2 + hstep, voffA);
            PG8_WAIT_L(8); PG8_BAR; PG8_WAIT_L(0); PG8_MMA(0, 0, At, B0); PG8_BAR; PG8_SCHED;
            PG8_LDB(B1, 1, 1); PG8_STAGE(PG8_SB(1, 0), b3, voffB);
            PG8_BAR; PG8_WAIT_L(0); PG8_MMA(0, 1, At, B1); PG8_BAR;
            PG8_LDA(At, 1, 1); PG8_STAGE(PG8_SA(1, 0), a3, voffA);
            PG8_BAR; PG8_WAIT_L(0); PG8_MMA(1, 0, At, B0); PG8_BAR; PG8_SCHED;
            PG8_STAGE(PG8_SB(1, 1), b3 + hstep, voffB);
            PG8_WAIT_V(6); PG8_BAR; PG8_MMA(1, 1, At, B1); PG8_BAR;
            }
        }
        if constexpr (ALIGN_EPI) { if (wr == 0) PG8_BAR; }
        if constexpr (!Epi::AFTER_DRAIN) { E(acc, cur, wr, wc, fr, fq); S.done(cur); }
        if (!has_next) break;
#pragma unroll
        for (int a = 0; a < 2; ++a)
#pragma unroll
            for (int b = 0; b < 2; ++b)
#pragma unroll
                for (int m = 0; m < 4; ++m)
#pragma unroll
                    for (int n = 0; n < 2; ++n) acc[a][b][m][n] = (f32x4){0.f, 0.f, 0.f, 0.f};
        cur = nxt; cA = nA; cB = nB; ++ui; vC[0][0] = vN[0][0]; vC[0][1] = vN[0][1]; vC[1][0] = vN[1][0]; vC[1][1] = vN[1][1];
        if constexpr (ALIGN_EPI) { if (wr == 1) PG8_BAR; }
    }
    PG8_WAIT_V(0);
    if constexpr (!ALIGN_EPI) { if (wr == 0) PG8_BAR; }
    PG8_BAR;
    if constexpr (Epi::AFTER_DRAIN) { E.fused(acc, cur, wr, wc, fr, fq, lds, wid, lane); S.done(cur); }
#undef PG8_FILL
#undef PG8_SA
#undef PG8_SB
#undef PG8_STAGE
#undef PG8_LDA
#undef PG8_LDB
#undef PG8_MMA
#undef PG8_WAIT_V
#undef PG8_WAIT_L
#undef PG8_BAR
#undef PG8_SCHED
}
}
constexpr int NWAVES = 8;
constexpr int BATCH = 4, SEQ = 4096, D = 1024, M = BATCH * SEQ;
constexpr int NPROJ = 4864;
constexpr float RMS_EPS = 1e-6f;
constexpr float LOG2E = 1.4426950408889634f;
constexpr float QSCALE = 0.125f * LOG2E;
constexpr int PMAX = 40960, NTMAX = 160;
constexpr int NPHASE = 11;
#ifndef MK_N_LAUNCHES
#define MK_N_LAUNCHES 1
#endif
constexpr int N_LAUNCHES = MK_N_LAUNCHES;

constexpr size_t MiB = 1u << 20;
constexpr size_t WS_CTL = 0, CTL_ZERO_BYTES = 1 * MiB;
constexpr size_t WS_MOD = 1 * MiB;
constexpr size_t WS_WRT = 1 * MiB + 256 * 1024;
constexpr int ECAP = 16384;
constexpr size_t WS_TOKSLOT = 212 * MiB;
constexpr size_t WS_WROW = 214 * MiB;
constexpr size_t WS_COS = 2 * MiB, WS_SIN = 2 * MiB + 512 * 1024;
constexpr size_t WS_WI = 3 * MiB, WS_LOGF = 3 * MiB + 512 * 1024;
constexpr size_t WS_ROUTE = 4 * MiB;
constexpr size_t WS_WIN = 5 * MiB;
constexpr size_t WS_WOA = 15 * MiB, WS_WOB = 16 * MiB, WS_WO = 17 * MiB;
constexpr size_t WS_WGU = 19 * MiB, WS_WDN = 83 * MiB;
constexpr size_t WS_H = 115 * MiB;
constexpr size_t WS_OA = 115 * MiB, WS_OB = 131 * MiB, WS_H2 = 115 * MiB;
constexpr size_t WS_QA = 147 * MiB, WS_QI = 163 * MiB, WS_QB = 179 * MiB, WS_KB = 195 * MiB, WS_VB = 211 * MiB;
constexpr size_t WS_KA = 227 * MiB, WS_VA = 229 * MiB, WS_KI = 231 * MiB;
constexpr size_t WS_XS = 147 * MiB;
constexpr size_t WS_YC = 147 * MiB;
constexpr size_t WS_GA = 233 * MiB, WS_GB = 265 * MiB;
constexpr size_t WS_HID = 233 * MiB;
constexpr size_t WS_END = 297 * MiB;
constexpr int CW_BAR = 4096, CW_CNT = 8192, CW_SSQ = 16384;
constexpr int RING_OFF = 0, RING_BYTES = 131072;
constexpr int SEL_OFF = 131072;
constexpr int LX_OFF = 139264;
constexpr int HIST_OFF = 143360;
constexpr int LDS_BYTES = 151552;

#define GAS __attribute__((address_space(1)))
#define LAS __attribute__((address_space(3)))
typedef unsigned short bf16;
typedef unsigned v4u __attribute__((ext_vector_type(4)));
typedef float f32x4 __attribute__((ext_vector_type(4)));
typedef short bf16x8 __attribute__((ext_vector_type(8)));
typedef GAS unsigned gu32;
typedef GAS unsigned long long gu64;
#define RLX_AGENT __ATOMIC_RELAXED, __HIP_MEMORY_SCOPE_AGENT
#define LDS_WAIT() asm volatile("s_waitcnt lgkmcnt(0)" ::: "memory")
#define VM_WAIT() asm volatile("s_waitcnt vmcnt(0)" ::: "memory")
__device__ __forceinline__ unsigned long long rt() { return __builtin_amdgcn_s_memrealtime(); }
__device__ __forceinline__ unsigned f2bf(float f) { unsigned u = __builtin_bit_cast(unsigned, f); return (u + 0x7fffu + ((u >> 16) & 1u)) >> 16; }
__device__ __forceinline__ unsigned pk2(float lo, float hi) { return f2bf(lo) | (f2bf(hi) << 16); }

#define XB_TMO      128
#define XB_XCNT(j)  (256  + 64 * (j))
#define XB_XSUB(j)  (1280 + 64 * (j))
#define XB_XGEN(j)  (2304 + 64 * (j))
#define XB_TOP      3328
#define XB_TOPGEN   3392
#define XCD_BAR_WORDS 3456
#define XB_SPIN_CAP (1u << 18)

__device__ __forceinline__ unsigned xb_ld(unsigned* p)              { return __hip_atomic_load(p, __ATOMIC_RELAXED, __HIP_MEMORY_SCOPE_AGENT); }
__device__ __forceinline__ unsigned xb_add(unsigned* p, unsigned v) { return __hip_atomic_fetch_add(p, v, __ATOMIC_RELAXED, __HIP_MEMORY_SCOPE_AGENT); }
__device__ __forceinline__ unsigned xb_xcc_id() { return (unsigned)__builtin_amdgcn_s_getreg((3 << 11) | 20) & 0xFu; }
#define XB_SPIN(cond, bar) do { unsigned _sp = 0; while (cond) { __builtin_amdgcn_s_sleep(1); \
    if ((++_sp & 255u) == 0u) { if (xb_ld(&(bar)[XB_TMO])) break; if (_sp > XB_SPIN_CAP) { atomicAdd(&(bar)[XB_TMO], 1u); break; } } } } while (0)

struct XcdBarrier {
    unsigned* bar; unsigned x;
    volatile LAS unsigned* st;
};

__device__ __forceinline__ XcdBarrier xcd_barrier_post(unsigned* bar, volatile LAS unsigned* st) {
    XcdBarrier b; b.bar = bar; b.x = xb_xcc_id(); b.st = st;
    if (threadIdx.x == 0) (void)xb_add(&bar[XB_XCNT(b.x)], 1u);
    return b;
}
__device__ __forceinline__ void xcd_barrier_complete(unsigned* bar, unsigned x, unsigned& nloc, unsigned& nx) {
    const unsigned G = gridDim.x * gridDim.y * gridDim.z;
    unsigned sum, cnt, mine, sp = 0u;
    for (;;) {
        sum = 0u; cnt = 0u; mine = 0u;
#pragma unroll
        for (unsigned j = 0; j < 16; ++j) { const unsigned c = xb_ld(&bar[XB_XCNT(j)]); sum += c; cnt += (c > 0u) ? 1u : 0u; mine = (j == x) ? c : mine; }
        if (sum == G) break;
        __builtin_amdgcn_s_sleep(1);
        if ((++sp & 255u) == 0u) { if (xb_ld(&bar[XB_TMO])) break; if (sp > XB_SPIN_CAP) { atomicAdd(&bar[XB_TMO], 1u); break; } }
    }
    nloc = mine > 0u ? mine : 1u; nx = cnt > 0u ? cnt : 1u;
}

__device__ __forceinline__ void xcd_barrier(const XcdBarrier& b) {
    asm volatile("s_waitcnt vmcnt(0)" ::: "memory");
    __syncthreads();
    if (threadIdx.x == 0) {
        unsigned* bar = b.bar;
        __builtin_amdgcn_s_waitcnt(0);
        unsigned nloc = b.st[0], nx = b.st[1];
        if (nloc == 0u) { xcd_barrier_complete(bar, b.x, nloc, nx); b.st[0] = nloc; b.st[1] = nx; }
        const unsigned old = xb_add(&bar[XB_XSUB(b.x)], 1u);
        const unsigned gen = old / nloc;
        if (old + 1u == (gen + 1u) * nloc) {
            __builtin_amdgcn_fence(__ATOMIC_RELEASE, "agent");
            asm volatile("s_waitcnt vmcnt(0)" ::: "memory");
            const unsigned og = xb_add(&bar[XB_TOP], 1u);
            const unsigned tg = og / nx;
            if (og + 1u == (tg + 1u) * nx) xb_add(&bar[XB_TOPGEN], 1u);
            else XB_SPIN(xb_ld(&bar[XB_TOPGEN]) == tg, bar);
            __builtin_amdgcn_fence(__ATOMIC_ACQUIRE, "agent");
            xb_add(&bar[XB_XGEN(b.x)], 1u);
            asm volatile("s_waitcnt vmcnt(0)" ::: "memory");
        } else {
            XB_SPIN(xb_ld(&bar[XB_XGEN(b.x)]) == gen, bar);
            __builtin_amdgcn_fence(__ATOMIC_ACQUIRE, "agent");
            asm volatile("s_waitcnt vmcnt(0)" ::: "memory");
        }
    }
    __syncthreads();
}
typedef float f32x2_t __attribute__((ext_vector_type(2))); typedef __bf16 bf16x2_t __attribute__((ext_vector_type(2)));
typedef float f32x16 __attribute__((ext_vector_type(16)));
typedef short s16x4 __attribute__((ext_vector_type(4)));
__device__ __forceinline__ unsigned cvtpk(float lo, float hi) { f32x2_t v = {lo, hi}; bf16x2_t b = __builtin_convertvector(v, bf16x2_t); return __builtin_bit_cast(unsigned, b); }
__device__ __forceinline__ float bflo(unsigned w) { return __uint_as_float(w << 16); }
__device__ __forceinline__ float bfhi(unsigned w) { return __uint_as_float(w & 0xffff0000u); }
__device__ __forceinline__ float sigmoidf_(float v) { return 1.f / (1.f + __expf(-v)); }
#define MFMA32(a, b, c) __builtin_amdgcn_mfma_f32_32x32x16_bf16((a), (b), (c), 0, 0, 0)
#define MFMA16(a, b, c) __builtin_amdgcn_mfma_f32_16x16x32_bf16((a), (b), (c), 0, 0, 0)

struct Frame {
    unsigned char* lds;
    LAS unsigned char* ldsl;
    volatile LAS unsigned* LX;
    gu32* ctl;
    unsigned char* ws;
    int tid, lane, wave, vcu, G;
    const float *x, *c, *w_mod, *b_mod, *g_mix, *w_in, *b_forget, *w_out_a, *w_out_b, *w_out, *g_ffn, *w_group, *b_group, *w_router, *b_router, *w_e_gate, *w_e_up, *w_e_down, *g_final;
    const int* positions;
    float* out;
};
__device__ __forceinline__ float wave_sum(float v) {
#pragma unroll
    for (int o = 1; o < 64; o <<= 1) v += __shfl_xor(v, o);
    return v;
}

struct CmIn { __device__ __forceinline__ int operator()(int n) const { if (n < 1216) return n; if (n < 2752) return n + 8; if (n < 4800) return n + 16; if (n < 4808) return n - 4800 + 1216; if (n < 4816) return n - 4808 + 2760; return -1; } };
struct CmId { int base; __device__ __forceinline__ int operator()(int n) const { return n - base; } };
template <class CM>
__device__ __forceinline__ void transpose_item(const float* W, int ldw, bf16* WT, int K, int k0, int n0, const CM& cm, LAS float* scr, int lane) {
    const int sc = cm(n0 + (lane & 31));
#pragma unroll
    for (int i = 0; i < 32; ++i) { const int kk = 2 * i + (lane >> 5); scr[kk * 33 + (lane & 31)] = sc >= 0 ? W[(size_t)(k0 + kk) * ldw + sc] : 0.f; }
    LDS_WAIT(); asm volatile("" ::: "memory");
    const int c = lane & 7;
#pragma unroll
    for (int j = 0; j < 4; ++j) { const int n = (lane >> 3) + 8 * j; const LAS float* s = scr + (8 * c) * 33 + n;
        v4u o; o.x = pk2(s[0 * 33], s[1 * 33]); o.y = pk2(s[2 * 33], s[3 * 33]); o.z = pk2(s[4 * 33], s[5 * 33]); o.w = pk2(s[6 * 33], s[7 * 33]);
        *(GAS v4u*)(WT + (size_t)(n0 + n) * K + k0 + 8 * c) = o; }
    LDS_WAIT(); asm volatile("" ::: "memory");
}
__device__ __forceinline__ void p0_prologue(Frame& F) {
    __syncthreads();
    {
        LAS float* ca = (LAS float*)(F.ldsl + RING_OFF);
        LAS float* red = (LAS float*)(F.ldsl + RING_OFF + 16384);
        for (int i = F.tid; i < 4096; i += NWAVES * 64) { const float v = F.c[i]; ca[i] = v / (1.f + expf(-v)); }
        __syncthreads();
        float* MOD = (float*)(F.ws + WS_MOD);
        for (int cb = F.vcu; cb < 256; cb += F.G) {
            const int col0 = cb * 24;
            if (F.tid < 384) { const int j = F.tid % 24, ks = F.tid / 24; float a0 = 0.f, a1 = 0.f, a2 = 0.f, a3 = 0.f;
#pragma unroll 8
                for (int i = 0; i < 64; ++i) { const int k = ks + 16 * i; const float w = F.w_mod[(size_t)k * 6144 + col0 + j];
                    a0 += ca[k] * w; a1 += ca[1024 + k] * w; a2 += ca[2048 + k] * w; a3 += ca[3072 + k] * w; }
                LAS float* r = red + (ks * 24 + j) * 4; r[0] = a0; r[1] = a1; r[2] = a2; r[3] = a3; }
            __syncthreads();
            if (F.tid < 96) { const int j = F.tid % 24, bb = F.tid / 24; float s = 0.f;
#pragma unroll
                for (int ks = 0; ks < 16; ++ks) s += red[(ks * 24 + j) * 4 + bb];
                MOD[bb * 6144 + col0 + j] = s + F.b_mod[col0 + j]; }
            __syncthreads();
        }
    }
    LAS float* scr = (LAS float*)(F.ldsl + RING_OFF + F.wave * 16384);
    const int gw = F.vcu * NWAVES + F.wave, NGW = F.G * NWAVES;
    constexpr int I_IN = 16 * 152, I_OA = 8 * 32, I_O = 16 * 32, I_GU = 32 * 16 * 32, I_DN = 32 * 8 * 32;
    constexpr int NITEMS = I_IN + 2 * I_OA + I_O + I_GU + I_DN;
    bf16* WinT = (bf16*)(F.ws + WS_WIN); bf16* WoaT = (bf16*)(F.ws + WS_WOA); bf16* WobT = (bf16*)(F.ws + WS_WOB); bf16* WoT = (bf16*)(F.ws + WS_WO);
    bf16* WguT = (bf16*)(F.ws + WS_WGU); bf16* WdnT = (bf16*)(F.ws + WS_WDN);
    for (int it = gw; it < NITEMS; it += NGW) {
        int r = it;
        if (r < I_IN) { const int kb = r / 152, nb = r % 152; transpose_item(F.w_in, 4816, WinT, 1024, 64 * kb, 32 * nb, CmIn{}, scr, F.lane); continue; } r -= I_IN;
        if (r < I_OA) { const int kb = r / 32, nb = r % 32; transpose_item(F.w_out_a + 32 * nb, 1024, WoaT, 512, 64 * kb, 32 * nb, CmId{32 * nb}, scr, F.lane); continue; } r -= I_OA;
        if (r < I_OA) { const int kb = r / 32, nb = r % 32; transpose_item(F.w_out_b + 32 * nb, 1024, WobT, 512, 64 * kb, 32 * nb, CmId{32 * nb}, scr, F.lane); continue; } r -= I_OA;
        if (r < I_O) { const int kb = r / 32, nb = r % 32; transpose_item(F.w_out + 32 * nb, 1024, WoT, 1024, 64 * kb, 32 * nb, CmId{32 * nb}, scr, F.lane); continue; } r -= I_O;
        if (r < I_GU) { const int e = r / 512, q = r % 512, kb = q / 32, nb = q % 32;
            const int np = 32 * nb, ct = np >> 8, bj = (np >> 7) & 1, j0 = np & 127;
            const float* src = (bj ? F.w_e_up : F.w_e_gate) + (size_t)e * 1024 * 512 + ct * 128 + j0;
            transpose_item(src, 512, WguT, 1024, 64 * kb, e * 1024 + np, CmId{e * 1024 + np}, scr, F.lane); continue; } r -= I_GU;
        { const int e = r / 256, q = r % 256, kb = q / 32, nb = q % 32;
            const float* src = F.w_e_down + (size_t)e * 512 * 1024 + 32 * nb;
            transpose_item(src, 1024, WdnT, 512, 64 * kb, e * 1024 + 32 * nb, CmId{e * 1024 + 32 * nb}, scr, F.lane); }
    }
    { bf16* WrT = (bf16*)(F.ws + WS_WRT);
      for (int i = (F.vcu * NWAVES * 64 + F.tid); i < 64 * 1024; i += F.G * NWAVES * 64) { const int n = i >> 10, k = i & 1023;
          float v = 0.f; if (n < 32) v = F.w_router[k * 32 + n]; else if (n < 36) v = F.w_group[k * 4 + (n - 32)];
          WrT[i] = (bf16)f2bf(v); } }
}

__device__ __forceinline__ void p1_hnorm(Frame& F) {
    const int gw = F.vcu * NWAVES + F.wave, NGW = F.G * NWAVES;
    const float* MOD = (const float*)(F.ws + WS_MOD); bf16* H = (bf16*)(F.ws + WS_H);
    float* COS = (float*)(F.ws + WS_COS); float* SIN = (float*)(F.ws + WS_SIN);
    for (int m = gw; m < M; m += NGW) {
        const int b = m >> 12;
        const GAS f32x4* xr = (const GAS f32x4*)(F.x + (size_t)m * D) + F.lane;
        f32x4 v[4]; float s = 0.f;
#pragma unroll
        for (int j = 0; j < 4; ++j) { v[j] = xr[64 * j]; s += (v[j].x * v[j].x + v[j].y * v[j].y) + (v[j].z * v[j].z + v[j].w * v[j].w); }
        const float rstd = 1.f / sqrtf(wave_sum(s) * (1.f / D) + RMS_EPS);
        GAS unsigned long long* o8 = (GAS unsigned long long*)(H + (size_t)m * D) + F.lane;
#pragma unroll
        for (int j = 0; j < 4; ++j) { const int col = 4 * F.lane + 256 * j;
            const f32x4 g = *(const f32x4*)(F.g_mix + col), sc = *(const f32x4*)(MOD + b * 6144 + 1024 + col), sh = *(const f32x4*)(MOD + b * 6144 + col);
            const f32x4 h = v[j] * rstd * g * (sc + 1.0f) + sh;
            o8[64 * j] = (unsigned long long)cvtpk(h.x, h.y) | ((unsigned long long)cvtpk(h.z, h.w) << 32); }
        if (F.lane < 8) { const float invf = exp2f(-(float)F.lane * 2.3664460711655218f); const float ang = (float)F.positions[m] * invf;
            COS[m * 8 + F.lane] = cosf(ang); SIN[m * 8 + F.lane] = sinf(ang); }
    }
}

struct EpiProj {
    static constexpr bool PERM = true, AFTER_DRAIN = false, CHAIN = false;
    unsigned char* ws; const float* bfg;
    template <int BJ>
    __device__ __forceinline__ void part(const pg8::f32x4 (&acc)[2][2][4][2], const pg8::Unit& u, int wr, int wc, int fr, int fq) const {
        const float* COS = (const float*)(ws + WS_COS); const float* SIN = (const float*)(ws + WS_SIN);
        const int cg = __builtin_amdgcn_readfirstlane(u.pn * 256 + BJ * 128 + wc * 32);
        size_t boff = 0; int ld = 0, cofs = 0, kind = 4; float scale = 1.f;
        if (cg < 512)       { boff = WS_QA; ld = 512; cofs = 0;    kind = 1; scale = QSCALE; }
        else if (cg < 576)  { boff = WS_KA; ld = 64;  cofs = 512;  kind = 1; }
        else if (cg < 640)  { boff = WS_VA; ld = 64;  cofs = 576;  kind = 0; }
        else if (cg < 1152) { boff = WS_QI; ld = 512; cofs = 640;  kind = 1; scale = 0.125f; }
        else if (cg < 1216) { boff = WS_KI; ld = 64;  cofs = 1152; kind = 1; }
        else if (cg < 1728) { boff = WS_QB; ld = 512; cofs = 1216; kind = 0; scale = QSCALE; }
        else if (cg < 2240) { boff = WS_KB; ld = 512; cofs = 1728; kind = 0; }
        else if (cg < 2752) { boff = WS_VB; ld = 512; cofs = 2240; kind = 0; }
        else if (cg < 3776) { boff = WS_GA; ld = 1024; cofs = 2752; kind = 2; }
        else if (cg < 4800) { boff = WS_GB; ld = 1024; cofs = 3776; kind = 2; }
        else if (cg == 4800) { kind = 3; }
        if (kind == 4) return;
        if (kind == 3) {
#pragma unroll
            for (int ai = 0; ai < 2; ++ai)
#pragma unroll
                for (int m = 0; m < 4; ++m) {
                    const int row = u.pm * 256 + ai * 128 + wr * 64 + m * 16 + fr;
                    const pg8::f32x4 v0 = acc[ai][BJ][m][0], v1 = acc[ai][BJ][m][1];
                    if (fq == 0) { float* wi = (float*)(ws + WS_WI) + (size_t)row * 8; const float s = 0.35355339059327373f; *(pg8::f32x4*)wi = v0 * s; *(pg8::f32x4*)(wi + 4) = v1 * s; }
                    else if (fq == 1) { float* lf = (float*)(ws + WS_LOGF) + (size_t)(row >> 12) * 8 * SEQ + (row & (SEQ - 1));
#pragma unroll
                        for (int i = 0; i < 8; ++i) { const float z = (i < 4 ? v0[i & 3] : v1[i & 3]) + bfg[i];
                            const float ls = z >= 0.f ? -log1pf(expf(-z)) : z - log1pf(expf(z)); lf[(size_t)i * SEQ] = ls; } }
                }
            return;
        }
        const bool rope = (kind == 1) && ((cg & 63) == 0);
        bf16* base = (bf16*)(ws + boff);
        const int c0 = cg + 8 * fq - cofs;
#pragma unroll
        for (int ai = 0; ai < 2; ++ai)
#pragma unroll
            for (int m = 0; m < 4; ++m) {
                const int row = u.pm * 256 + ai * 128 + wr * 64 + m * 16 + fr;
                pg8::f32x4 v0 = acc[ai][BJ][m][0], v1 = acc[ai][BJ][m][1];
                if (rope) {
                    pg8::f32x4 o0, o1;
#pragma unroll
                    for (int i = 0; i < 4; ++i) { o0[i] = __shfl_xor(v0[i], 16); o1[i] = __shfl_xor(v1[i], 16); }
                    const pg8::f32x4 c0v = *(const pg8::f32x4*)(COS + (size_t)row * 8), c1v = *(const pg8::f32x4*)(COS + (size_t)row * 8 + 4);
                    const pg8::f32x4 s0v = *(const pg8::f32x4*)(SIN + (size_t)row * 8), s1v = *(const pg8::f32x4*)(SIN + (size_t)row * 8 + 4);
                    if (fq < 2) { const float sg = fq == 0 ? -1.f : 1.f; v0 = v0 * c0v + o0 * s0v * sg; v1 = v1 * c1v + o1 * s1v * sg; }
                }
                if (kind == 2) {
#pragma unroll
                    for (int i = 0; i < 4; ++i) { v0[i] = sigmoidf_(v0[i]); v1[i] = sigmoidf_(v1[i]); }
                }
                v0 = v0 * scale; v1 = v1 * scale;
                pg8::u32x4 w; w.x = cvtpk(v0[0], v0[1]); w.y = cvtpk(v0[2], v0[3]); w.z = cvtpk(v1[0], v1[1]); w.w = cvtpk(v1[2], v1[3]);
                *(pg8::u32x4*)(base + (size_t)row * ld + c0) = w;
            }
    }
    __device__ __forceinline__ void operator()(const pg8::f32x4 (&acc)[2][2][4][2], const pg8::Unit& u, int wr, int wc, int fr, int fq) const {
        part<0>(acc, u, wr, wc, fr, fq); part<1>(acc, u, wr, wc, fr, fq);
    }
};
struct EpiMerge {
    static constexpr bool PERM = true, AFTER_DRAIN = false, CHAIN = true;
    unsigned char* ws;
    __device__ __forceinline__ bool chain(pg8::f32x4 (&acc)[2][2][4][2], const pg8::Unit& u, int wr, int wc, int fr, int fq) const {
        bf16* GA = (bf16*)(ws + WS_GA); const bf16* GB = (const bf16*)(ws + WS_GB);
        const int half = u.pn >> 2, pm = u.pm & 63, pn = u.pn & 3;
#pragma unroll
        for (int ai = 0; ai < 2; ++ai)
#pragma unroll
            for (int m = 0; m < 4; ++m) {
                const int row = pm * 256 + ai * 128 + wr * 64 + m * 16 + fr;
#pragma unroll
                for (int bj = 0; bj < 2; ++bj) {
                    const size_t off = (size_t)row * 1024 + pn * 256 + bj * 128 + wc * 32 + 8 * fq;
                    const pg8::u32x4 g = *(const pg8::u32x4*)(GB + off);
                    if (half == 0) {
                        const pg8::u32x4 a = *(const pg8::u32x4*)(GA + off);
                        pg8::f32x4 r0, r1;
                        r0[0] = bflo(a.x) * __builtin_amdgcn_rcpf(bflo(g.x)); r0[1] = bfhi(a.x) * __builtin_amdgcn_rcpf(bfhi(g.x)); r0[2] = bflo(a.y) * __builtin_amdgcn_rcpf(bflo(g.y)); r0[3] = bfhi(a.y) * __builtin_amdgcn_rcpf(bfhi(g.y));
                        r1[0] = bflo(a.z) * __builtin_amdgcn_rcpf(bflo(g.z)); r1[1] = bfhi(a.z) * __builtin_amdgcn_rcpf(bfhi(g.z)); r1[2] = bflo(a.w) * __builtin_amdgcn_rcpf(bflo(g.w)); r1[3] = bfhi(a.w) * __builtin_amdgcn_rcpf(bfhi(g.w));
                        acc[ai][bj][m][0] = acc[ai][bj][m][0] * r0; acc[ai][bj][m][1] = acc[ai][bj][m][1] * r1;
                    } else {
                        const pg8::f32x4 v0 = acc[ai][bj][m][0], v1 = acc[ai][bj][m][1];
                        pg8::u32x4 w; w.x = cvtpk(bflo(g.x) * v0[0], bfhi(g.x) * v0[1]); w.y = cvtpk(bflo(g.y) * v0[2], bfhi(g.y) * v0[3]);
                        w.z = cvtpk(bflo(g.z) * v1[0], bfhi(g.z) * v1[1]); w.w = cvtpk(bflo(g.w) * v1[2], bfhi(g.w) * v1[3]);
                        *(pg8::u32x4*)(GA + off) = w;
                    }
                }
            }
        return half == 0;
    }
    __device__ __forceinline__ void operator()(const pg8::f32x4 (&)[2][2][4][2], const pg8::Unit&, int, int, int, int) const {}
};
struct MergeOrder {
    pg8::StaticOrder S;
    __device__ __forceinline__ bool next(int i, pg8::Unit& u) const { if (!S.next(i >> 1, u)) return false; const int h = i & 1; u.pm += 64 * h; u.pn += 4 * h; return true; }
    __device__ __forceinline__ void a_ready(const pg8::Unit&) const {}
    __device__ __forceinline__ void done(const pg8::Unit&) const {}
};
struct EpiOut {
    static constexpr bool PERM = true, AFTER_DRAIN = false, CHAIN = false;
    unsigned char* ws; const float* x; float* out;
    __device__ __forceinline__ void operator()(const pg8::f32x4 (&acc)[2][2][4][2], const pg8::Unit& u, int wr, int wc, int fr, int fq) const {
        const float* MOD = (const float*)(ws + WS_MOD); float* SSQ = (float*)(ws + WS_CTL) + CW_SSQ;
        const int b = u.pm >> 4;
        const int colb = u.pn * 256 + wc * 32 + 8 * fq;
        pg8::f32x4 gt[2][2];
#pragma unroll
        for (int bj = 0; bj < 2; ++bj) { gt[bj][0] = *(const pg8::f32x4*)(MOD + b * 6144 + 2048 + colb + bj * 128); gt[bj][1] = *(const pg8::f32x4*)(MOD + b * 6144 + 2048 + colb + bj * 128 + 4); }
#pragma unroll
        for (int ai = 0; ai < 2; ++ai)
#pragma unroll
            for (int m = 0; m < 4; ++m) {
                const int row = u.pm * 256 + ai * 128 + wr * 64 + m * 16 + fr; float ss = 0.f;
#pragma unroll
                for (int bj = 0; bj < 2; ++bj) {
                    const size_t off = (size_t)row * 1024 + colb + bj * 128;
                    const pg8::f32x4 x0 = *(const pg8::f32x4*)(x + off), x1 = *(const pg8::f32x4*)(x + off + 4);
                    const pg8::f32x4 y0 = x0 + gt[bj][0] * acc[ai][bj][m][0], y1 = x1 + gt[bj][1] * acc[ai][bj][m][1];
                    *(pg8::f32x4*)(out + off) = y0; *(pg8::f32x4*)(out + off + 4) = y1;
                    ss += (y0[0] * y0[0] + y0[1] * y0[1]) + (y0[2] * y0[2] + y0[3] * y0[3]) + (y1[0] * y1[0] + y1[1] * y1[1]) + (y1[2] * y1[2] + y1[3] * y1[3]);
                }
                ss += __shfl_xor(ss, 16); ss += __shfl_xor(ss, 32);
                if (fq == 0) atomicAdd(SSQ + row, ss);
            }
    }
};
struct EpiGU {
    static constexpr bool PERM = true, AFTER_DRAIN = false, CHAIN = false;
    unsigned char* ws;
    __device__ __forceinline__ void operator()(const pg8::f32x4 (&acc)[2][2][4][2], const pg8::Unit& u, int wr, int wc, int fr, int fq) const {
        bf16* HID = (bf16*)(ws + WS_HID);
        const int col = (u.pn & 3) * 128 + wc * 32 + 8 * fq;
#pragma unroll
        for (int ai = 0; ai < 2; ++ai)
#pragma unroll
            for (int m = 0; m < 4; ++m) {
                const int row = u.pm * 256 + ai * 128 + wr * 64 + m * 16 + fr;
                float r[8];
#pragma unroll
                for (int i = 0; i < 8; ++i) { const float g = i < 4 ? acc[ai][0][m][0][i] : acc[ai][0][m][1][i - 4]; const float up = i < 4 ? acc[ai][1][m][0][i] : acc[ai][1][m][1][i - 4];
                    r[i] = g * sigmoidf_(g) * up; }
                pg8::u32x4 w; w.x = cvtpk(r[0], r[1]); w.y = cvtpk(r[2], r[3]); w.z = cvtpk(r[4], r[5]); w.w = cvtpk(r[6], r[7]);
                *(pg8::u32x4*)(HID + (size_t)row * 512 + col) = w;
            }
    }
};
struct EpiDown {
    static constexpr bool PERM = true, AFTER_DRAIN = false, CHAIN = false;
    unsigned char* ws; const volatile LAS unsigned* LX;
    __device__ __forceinline__ void operator()(const pg8::f32x4 (&acc)[2][2][4][2], const pg8::Unit& u, int wr, int wc, int fr, int fq) const {
        bf16* YC = (bf16*)(ws + WS_YC); const int* TOKSLOT = (const int*)(ws + WS_TOKSLOT); const float* WROW = (const float*)(ws + WS_WROW);
        const int colb = (u.pn & 3) * 256 + wc * 32 + 8 * fq;
        const int e = u.pn >> 2; const int lbase = (u.pm - (int)(LX[96 + e] >> 8)) * 256, cnt = (int)LX[320 + e];
#pragma unroll
        for (int ai = 0; ai < 2; ++ai)
#pragma unroll
            for (int m = 0; m < 4; ++m) {
                const int local = lbase + ai * 128 + wr * 64 + m * 16 + fr;
                if (local < cnt) {
                    const int ts = TOKSLOT[e * ECAP + local]; const float gw = WROW[e * ECAP + local];
#pragma unroll
                    for (int bj = 0; bj < 2; ++bj) { const pg8::f32x4 v0 = acc[ai][bj][m][0] * gw, v1 = acc[ai][bj][m][1] * gw;
                        pg8::u32x4 w; w.x = cvtpk(v0[0], v0[1]); w.y = cvtpk(v0[2], v0[3]); w.z = cvtpk(v1[0], v1[1]); w.w = cvtpk(v1[2], v1[3]);
                        *(pg8::u32x4*)(YC + (size_t)ts * 1024 + colb + bj * 128) = w; }
                }
            }
    }
};
struct MoeRowMap {
    const int* TOKSLOT; const volatile LAS unsigned* LX;
    __device__ __forceinline__ unsigned rowoff(const pg8::Unit& u, int r) const {
        const int e = u.pn >> 2; const int local = (u.pm - (int)(LX[96 + e] >> 8)) * 256 + r;
        const int tok = local < (int)LX[320 + e] ? (TOKSLOT[e * ECAP + local] >> 1) : 0;
        return (unsigned)tok * (unsigned)(D * 2);
    }
};
struct MoeOrder {
    int G, c, nunits; const volatile LAS unsigned* tile_e;
    __device__ __forceinline__ bool next(int i, pg8::Unit& u) const { const int L = i * G + c; if (L >= nunits) return false; const int rt = L >> 2; u.pm = rt; u.pn = (int)tile_e[rt] * 4 + (L & 3); return true; }
    __device__ __forceinline__ void a_ready(const pg8::Unit&) const {}
    __device__ __forceinline__ void done(const pg8::Unit&) const {}
};
__device__ __forceinline__ void moe_table(Frame& F) {
    const gu32* CNT = F.ctl + CW_CNT;
    if (F.tid == 0) { unsigned p = 0;
        for (int e = 0; e < 32; ++e) { F.LX[96 + e] = p; const unsigned c = __hip_atomic_load(CNT + e, RLX_AGENT); F.LX[320 + e] = c; const unsigned nt = (c + 255u) >> 8;
            for (unsigned t = 0; t < nt; ++t) if ((p >> 8) + t < (unsigned)NTMAX) F.LX[160 + (p >> 8) + t] = (unsigned)e;
            p += nt << 8; }
        F.LX[128] = p; F.LX[132] = (p >> 8) < (unsigned)NTMAX ? (p >> 8) : (unsigned)NTMAX; }
    __syncthreads();
}
#ifndef DUP_MASK
#define DUP_MASK 0
#endif
typedef short v4i16_t __attribute__((ext_vector_type(4)));
__device__ __forceinline__ s16x4 trread(LAS const unsigned char* p) { return __builtin_bit_cast(s16x4, __builtin_amdgcn_ds_read_tr16_b64_v4i16((LAS v4i16_t*)p)); }
constexpr int FX_CK = 0, FX_K = 16384, FX_V = 32768, FX_VROW = 144, FX_VBUF = 64 * FX_VROW;
__device__ __forceinline__ float xhalf(float v, int hi) { const auto rr = __builtin_amdgcn_permlane32_swap(__float_as_uint(v), __float_as_uint(v), false, false); return __uint_as_float(hi ? rr[0] : rr[1]); }
__device__ __forceinline__ void fox_tile(LAS unsigned char* L, LAS float* CK, int cur, int t, int r32, int hi, int lane, int q, int qminw,
                                         const pg8::bf16x8 (&qf)[4], float& m_run, float& l_run, f32x16& o0, f32x16& o1) {
    LAS const unsigned char* Kb = L + FX_K + cur * 8192; LAS const unsigned char* Vb = L + FX_V + cur * FX_VBUF;
    f32x16 p0, p1;
#pragma unroll
    for (int rq = 0; rq < 4; ++rq) { const f32x4 c0 = *(LAS const f32x4*)(CK + 64 * t + 8 * rq + 4 * hi), c1 = *(LAS const f32x4*)(CK + 64 * t + 32 + 8 * rq + 4 * hi);
#pragma unroll
        for (int i = 0; i < 4; ++i) { p0[4 * rq + i] = c0[i]; p1[4 * rq + i] = c1[i]; } }
#pragma unroll
    for (int d0 = 0; d0 < 4; ++d0) {
        const int co = ((2 * d0 + hi) ^ (r32 & 7)) * 16;
        const pg8::bf16x8 a0 = *(LAS const pg8::bf16x8*)(Kb + r32 * 128 + co);
        const pg8::bf16x8 a1 = *(LAS const pg8::bf16x8*)(Kb + (r32 + 32) * 128 + co);
        p0 = MFMA32(a0, qf[d0], p0); p1 = MFMA32(a1, qf[d0], p1);
    }
    if (64 * t + 63 > qminw) {
#pragma unroll
        for (int r = 0; r < 16; ++r) { const int key = 64 * t + (r & 3) + 8 * (r >> 2) + 4 * hi; if (key > q) p0[r] = -1e30f; if (key + 32 > q) p1[r] = -1e30f; } }
    float mx = p0[0];
#pragma unroll
    for (int r = 1; r < 16; ++r) mx = fmaxf(mx, p0[r]);
#pragma unroll
    for (int r = 0; r < 16; ++r) mx = fmaxf(mx, p1[r]);
    mx = fmaxf(mx, xhalf(mx, hi));
    const float mnew = fmaxf(m_run, mx), alpha = __builtin_amdgcn_exp2f(m_run - mnew); m_run = mnew;
    float rs = 0.f;
#pragma unroll
    for (int r = 0; r < 16; ++r) { p0[r] = __builtin_amdgcn_exp2f(p0[r] - mnew); p1[r] = __builtin_amdgcn_exp2f(p1[r] - mnew); rs += p0[r] + p1[r]; }
    rs += xhalf(rs, hi);
    l_run = l_run * alpha + rs;
#pragma unroll
    for (int r = 0; r < 16; ++r) { o0[r] *= alpha; o1[r] *= alpha; }
    pg8::bf16x8 pb[4];
#pragma unroll
    for (int s = 0; s < 2; ++s) { v4u w;
        w.x = cvtpk(p0[8 * s], p0[8 * s + 1]); w.y = cvtpk(p0[8 * s + 2], p0[8 * s + 3]); w.z = cvtpk(p0[8 * s + 4], p0[8 * s + 5]); w.w = cvtpk(p0[8 * s + 6], p0[8 * s + 7]); pb[s] = __builtin_bit_cast(pg8::bf16x8, w);
        w.x = cvtpk(p1[8 * s], p1[8 * s + 1]); w.y = cvtpk(p1[8 * s + 2], p1[8 * s + 3]); w.z = cvtpk(p1[8 * s + 4], p1[8 * s + 5]); w.w = cvtpk(p1[8 * s + 6], p1[8 * s + 7]); pb[2 + s] = __builtin_bit_cast(pg8::bf16x8, w); }
    LAS const unsigned char* vb = Vb + (4 * hi + ((lane & 15) >> 2)) * FX_VROW + (16 * ((lane >> 4) & 1) + 4 * (lane & 3)) * 2;
#pragma unroll
    for (int s = 0; s < 4; ++s) {
        const s16x4 l0 = trread(vb + (16 * s) * FX_VROW), h0 = trread(vb + (16 * s + 8) * FX_VROW);
        const s16x4 l1 = trread(vb + (16 * s) * FX_VROW + 64), h1 = trread(vb + (16 * s + 8) * FX_VROW + 64);
        const pg8::bf16x8 a0 = {l0[0], l0[1], l0[2], l0[3], h0[0], h0[1], h0[2], h0[3]};
        const pg8::bf16x8 a1 = {l1[0], l1[1], l1[2], l1[3], h1[0], h1[1], h1[2], h1[3]};
        o0 = MFMA32(a0, pb[s], o0); o1 = MFMA32(a1, pb[s], o1);
    }
}
__device__ __forceinline__ void fox_unit(Frame& F, int b, int h, int qb) {
    const int tid = F.tid, lane = F.lane, wave = F.wave, r32 = lane & 31, hi = lane >> 5;
    LAS unsigned char* L = F.ldsl + RING_OFF;
    LAS float* CK = (LAS float*)(L + FX_CK);
    const int nkeys = (qb + 1) * 256, NT = nkeys / 64;
    const bf16* QBp = (const bf16*)(F.ws + WS_QB); const bf16* KBp = (const bf16*)(F.ws + WS_KB); const bf16* VBp = (const bf16*)(F.ws + WS_VB);
    __syncthreads();
    {
        const float* lf = (const float*)(F.ws + WS_LOGF) + (size_t)(b * 8 + h) * SEQ;
        float v[8]; const int k0 = tid * 8;
        if (k0 < nkeys) { const f32x4 a = *(const f32x4*)(lf + k0), c = *(const f32x4*)(lf + k0 + 4); v[0] = a.x; v[1] = a.y; v[2] = a.z; v[3] = a.w; v[4] = c.x; v[5] = c.y; v[6] = c.z; v[7] = c.w; }
        else {
#pragma unroll
            for (int i = 0; i < 8; ++i) v[i] = 0.f; }
#pragma unroll
        for (int i = 1; i < 8; ++i) v[i] += v[i - 1];
        const float tot = v[7]; float sc = tot;
#pragma unroll
        for (int o = 1; o < 64; o <<= 1) { const float t = __shfl_up(sc, o); if (lane >= o) sc += t; }
        if (lane == 63) F.LX[8 + wave] = __float_as_uint(sc);
        __syncthreads();
        float woff = 0.f, cref = 0.f;
#pragma unroll
        for (int w = 0; w < 8; ++w) { const float t = __uint_as_float(F.LX[8 + w]); cref += t; if (w < wave) woff += t; }
        const float base = woff + sc - tot;
        if (k0 < nkeys) {
#pragma unroll
            for (int i = 0; i < 8; ++i) CK[k0 + i] = (cref - (base + v[i])) * LOG2E; }
    }
    const size_t qrow = (size_t)b * SEQ + qb * 256 + wave * 32 + r32;
    pg8::bf16x8 qf[4];
#pragma unroll
    for (int d0 = 0; d0 < 4; ++d0) qf[d0] = *(const pg8::bf16x8*)(QBp + qrow * 512 + h * 64 + d0 * 16 + hi * 8);
    float m_run = -1e30f, l_run = 0.f; f32x16 o0 = {}, o1 = {};
    const int kr = tid >> 3, ch = tid & 7;
    const bf16* Kg = KBp + ((size_t)b * SEQ + kr) * 512 + h * 64 + ch * 8;
    const bf16* Vg = VBp + ((size_t)b * SEQ + kr) * 512 + h * 64 + ch * 8;
    const int kwo = FX_K + kr * 128 + ((ch ^ (kr & 7)) * 16), vwo = FX_V + kr * FX_VROW + ch * 16;
    v4u kr0 = *(const v4u*)Kg, vr0 = *(const v4u*)Vg, kr1 = kr0, vr1 = vr0, kr2 = kr0, vr2 = vr0;
    if (1 < NT) { kr1 = *(const v4u*)(Kg + (size_t)1 * 64 * 512); vr1 = *(const v4u*)(Vg + (size_t)1 * 64 * 512); }
    if (2 < NT) { kr2 = *(const v4u*)(Kg + (size_t)2 * 64 * 512); vr2 = *(const v4u*)(Vg + (size_t)2 * 64 * 512); }
    *(LAS v4u*)(L + kwo) = kr0; *(LAS v4u*)(L + vwo) = vr0;
    __syncthreads();
    const int qminw = qb * 256 + wave * 32, qmaxw = qminw + 31, q = qminw + r32;
#define FOX_STEP(t, KRF, VRF, KRN, VRN) do { \
        const int cur = (t) & 1; \
        if ((t) + 3 < NT) { KRF = *(const v4u*)(Kg + (size_t)((t) + 3) * 64 * 512); VRF = *(const v4u*)(Vg + (size_t)((t) + 3) * 64 * 512); } \
        if (64 * (t) <= qmaxw) fox_tile(L, CK, cur, (t), r32, hi, lane, q, qminw, qf, m_run, l_run, o0, o1); \
        if ((t) + 1 < NT) { const int nb = cur ^ 1; *(LAS v4u*)(L + kwo + nb * 8192) = KRN; *(LAS v4u*)(L + vwo + nb * FX_VBUF) = VRN; } \
        __syncthreads(); } while (0)
    for (int t = 0; t < NT; t += 3) {
        FOX_STEP(t, kr0, vr0, kr1, vr1);
        if (t + 1 < NT) FOX_STEP(t + 1, kr1, vr1, kr2, vr2);
        if (t + 2 < NT) FOX_STEP(t + 2, kr2, vr2, kr0, vr0);
    }
#undef FOX_STEP
    const float inv = 1.f / l_run;
    bf16* Op = (bf16*)(F.ws + WS_OB) + qrow * 512 + h * 64;
#pragma unroll
    for (int rq = 0; rq < 4; ++rq) {
        const unsigned long long w0 = (unsigned long long)cvtpk(o0[4 * rq] * inv, o0[4 * rq + 1] * inv) | ((unsigned long long)cvtpk(o0[4 * rq + 2] * inv, o0[4 * rq + 3] * inv) << 32);
        const unsigned long long w1 = (unsigned long long)cvtpk(o1[4 * rq] * inv, o1[4 * rq + 1] * inv) | ((unsigned long long)cvtpk(o1[4 * rq + 2] * inv, o1[4 * rq + 3] * inv) << 32);
        *(unsigned long long*)(Op + 8 * rq + 4 * hi) = w0; *(unsigned long long*)(Op + 32 + 8 * rq + 4 * hi) = w1;
    }
}

template <int NJ>
__device__ __forceinline__ void dsa_select(LAS const unsigned* sr, LAS unsigned* hist, LAS int* SEL, int nj, int lane) {
    unsigned key[NJ];
#pragma unroll
    for (int j = 0; j < NJ; ++j) { unsigned u = 0u; if (j < NJ - 16 || j < nj) u = sr[64 * j + lane]; key[j] = u; }
    unsigned T = 0u; int nge = 0;
    {
        const v4u hv = *(LAS const v4u*)(hist + 4 * lane);
        *(LAS v4u*)(hist + 4 * lane) = (v4u){0u, 0u, 0u, 0u};
        const unsigned sl = hv.x + hv.y + hv.z + hv.w;
        unsigned suf = sl;
#pragma unroll
        for (int o = 1; o < 64; o <<= 1) { const unsigned t = __shfl_down(suf, o); if (lane + o < 64) suf += t; }
        const unsigned above = suf - sl;
        const bool here = (suf >= 256u) && (above < 256u);
        unsigned bsel = 0u, cge = 0u;
        if (here) { unsigned c = above;
            if (c + hv.w >= 256u) { bsel = 4 * lane + 3; cge = c + hv.w; }
            else if (c + hv.w + hv.z >= 256u) { bsel = 4 * lane + 2; cge = c + hv.w + hv.z; }
            else if (c + hv.w + hv.z + hv.y >= 256u) { bsel = 4 * lane + 1; cge = c + hv.w + hv.z + hv.y; }
            else { bsel = 4 * lane; cge = suf; } }
        const unsigned long long mh = __ballot(here);
        const int src = mh ? (int)__builtin_ctzll(mh) : 0;
        T = (unsigned)__shfl((int)bsel, src) << 24; nge = __shfl((int)cge, src);
    }
    for (int bit = 23; bit >= 0 && nge != 256; --bit) {
        const unsigned cand = T | (1u << bit); unsigned cl = 0u;
#pragma unroll
        for (int j = 0; j < NJ; ++j) cl += (key[j] >= cand) ? 1u : 0u;
        int cnt = 0;
#pragma unroll
        for (int bb = 0; bb < 7; ++bb) cnt += __popcll(__ballot(((cl >> bb) & 1u) != 0u)) << bb;
        if (cnt >= 256) { T = cand; nge = cnt; }
    }
    if (nge == 256) {
        unsigned cl = 0u;
#pragma unroll
        for (int j = 0; j < NJ; ++j) cl += (key[j] >= T) ? 1u : 0u;
        int p = 0;
#pragma unroll
        for (int bb = 0; bb < 7; ++bb) { const unsigned long long mk = __ballot(((cl >> bb) & 1u) != 0u);
            p += (int)__builtin_amdgcn_mbcnt_hi((unsigned)(mk >> 32), __builtin_amdgcn_mbcnt_lo((unsigned)mk, 0u)) << bb; }
#pragma unroll
        for (int j = 0; j < NJ; ++j) if (key[j] >= T) { SEL[p & 255] = 64 * j + lane; ++p; }
    } else {
        int ngt = 0;
#pragma unroll
        for (int j = 0; j < NJ; ++j) ngt += __popcll(__ballot(key[j] > T));
        const int need_eq = 256 - ngt; int pos = 0, eq_seen = 0;
#pragma unroll
        for (int j = 0; j < NJ; ++j) {
            const bool gt = key[j] > T, eq = key[j] == T;
            const unsigned long long meq = __ballot(eq);
            const int eq_rank = eq_seen + (int)__builtin_amdgcn_mbcnt_hi((unsigned)(meq >> 32), __builtin_amdgcn_mbcnt_lo((unsigned)meq, 0u));
            const bool take = gt || (eq && eq_rank < need_eq);
            const unsigned long long mt = __ballot(take);
            const int pr = (int)__builtin_amdgcn_mbcnt_hi((unsigned)(mt >> 32), __builtin_amdgcn_mbcnt_lo((unsigned)mt, 0u));
            if (take && pos + pr < 256) SEL[pos + pr] = 64 * j + lane;
            pos += __popcll(mt); eq_seen += __popcll(meq);
        }
    }
}
template <bool FULL>
__device__ __forceinline__ void dsa_attend(Frame& F, LAS unsigned char* L, LAS int* SEL, int b, size_t qrow, int nsel) {
    const int lane = F.lane, wave = F.wave;
    const bf16* QA = (const bf16*)(F.ws + WS_QA); const bf16* KA = (const bf16*)(F.ws + WS_KA); const bf16* VA = (const bf16*)(F.ws + WS_VA);
    const int n = lane & 15, kg = lane >> 4;
    pg8::bf16x8 qf[2];
#pragma unroll
    for (int s = 0; s < 2; ++s) { qf[s] = (pg8::bf16x8){0, 0, 0, 0, 0, 0, 0, 0}; if (n < 8) qf[s] = *(const pg8::bf16x8*)(QA + qrow * 512 + n * 64 + 32 * s + 8 * kg); }
    const int ntile = FULL ? 16 : (nsel >> 4);
    const bf16* vgb = VA + (size_t)b * SEQ * 64 + 8 * (lane & 7);
    LAS unsigned char* VS = L + wave * 16384;
    const int nsc = FULL ? 8 : (nsel >> 5);
#define DSA_DMAV(sc, slot) do { _Pragma("unroll") for (int i_ = 0; i_ < 4; ++i_) { const int idx_ = SEL[32 * (sc) + 8 * i_ + (lane >> 3)]; \
        __builtin_amdgcn_global_load_lds((const unsigned*)(vgb + (size_t)idx_ * 64), (LAS unsigned*)(VS + (slot) * 4096 + i_ * 1024), 16, 0, 0); } } while (0)
#define DSA_PV(slot, sc) do { _Pragma("unroll") for (int dt_ = 0; dt_ < 4; ++dt_) { \
        const s16x4 lo_ = trread(vb + (slot) * 4096 + dt_ * 32), hh_ = trread(vb + (slot) * 4096 + 16 * 128 + dt_ * 32); \
        const pg8::bf16x8 a_ = {lo_[0], lo_[1], lo_[2], lo_[3], hh_[0], hh_[1], hh_[2], hh_[3]}; \
        o[dt_] = MFMA16(a_, pb[(sc)], o[dt_]); } } while (0)
    DSA_DMAV(0, 0); DSA_DMAV(1, 1);
    if (FULL || nsc > 2) { DSA_DMAV(2, 2); DSA_DMAV(3, 3); }
    f32x4 x[16];
#pragma unroll
    for (int t = 0; t < 16; ++t) {
        x[t] = (f32x4){-1e30f, -1e30f, -1e30f, -1e30f};
        if (FULL || t < ntile) { const int idx = SEL[16 * t + n]; const bf16* kp = KA + ((size_t)b * SEQ + idx) * 64 + 8 * kg;
            const pg8::bf16x8 a0 = *(const pg8::bf16x8*)kp, a1 = *(const pg8::bf16x8*)(kp + 32);
            f32x4 z = {0.f, 0.f, 0.f, 0.f}; z = MFMA16(a0, qf[0], z); z = MFMA16(a1, qf[1], z); x[t] = z; }
    }
    float mx = -1e30f;
#pragma unroll
    for (int t = 0; t < 16; ++t) mx = fmaxf(fmaxf(mx, fmaxf(x[t][0], x[t][1])), fmaxf(x[t][2], x[t][3]));
    mx = fmaxf(mx, __shfl_xor(mx, 16)); mx = fmaxf(mx, __shfl_xor(mx, 32));
    float ls = 0.f;
#pragma unroll
    for (int t = 0; t < 16; ++t) {
#pragma unroll
        for (int i = 0; i < 4; ++i) { x[t][i] = __builtin_amdgcn_exp2f(x[t][i] - mx); ls += x[t][i]; } }
    ls += __shfl_xor(ls, 16); ls += __shfl_xor(ls, 32);
    pg8::bf16x8 pb[8];
#pragma unroll
    for (int s = 0; s < 8; ++s) { v4u w; w.x = cvtpk(x[2 * s][0], x[2 * s][1]); w.y = cvtpk(x[2 * s][2], x[2 * s][3]); w.z = cvtpk(x[2 * s + 1][0], x[2 * s + 1][1]); w.w = cvtpk(x[2 * s + 1][2], x[2 * s + 1][3]); pb[s] = __builtin_bit_cast(pg8::bf16x8, w); }
    f32x4 o[4];
#pragma unroll
    for (int dt = 0; dt < 4; ++dt) o[dt] = (f32x4){0.f, 0.f, 0.f, 0.f};
    LAS const unsigned char* vb = VS + (4 * kg + (n >> 2)) * 128 + (4 * (n & 3)) * 2;
    asm volatile("s_waitcnt vmcnt(0)" ::: "memory");
    DSA_PV(0, 0); asm volatile("s_waitcnt lgkmcnt(0)" ::: "memory"); if (FULL || nsc > 4) DSA_DMAV(4, 0);
    DSA_PV(1, 1); asm volatile("s_waitcnt lgkmcnt(0)" ::: "memory"); if (FULL || nsc > 4) DSA_DMAV(5, 1);
    if (FULL || nsc > 2) {
        DSA_PV(2, 2); asm volatile("s_waitcnt lgkmcnt(0)" ::: "memory"); if (FULL || nsc > 6) DSA_DMAV(6, 2);
        DSA_PV(3, 3); asm volatile("s_waitcnt lgkmcnt(0)" ::: "memory"); if (FULL || nsc > 6) DSA_DMAV(7, 3);
    }
    if (FULL || nsc > 4) {
        asm volatile("s_waitcnt vmcnt(0)" ::: "memory");
        DSA_PV(0, 4); DSA_PV(1, 5);
        if (FULL || nsc > 6) { DSA_PV(2, 6); DSA_PV(3, 7); }
    }
    asm volatile("s_waitcnt lgkmcnt(0)" ::: "memory");
#undef DSA_DMAV
#undef DSA_PV
    if (n < 8) { const float inv = 1.f / ls; bf16* Op = (bf16*)(F.ws + WS_OA) + qrow * 512 + n * 64 + 4 * kg;
#pragma unroll
        for (int dt = 0; dt < 4; ++dt) *(unsigned long long*)(Op + 16 * dt) = (unsigned long long)cvtpk(o[dt][0] * inv, o[dt][1] * inv) | ((unsigned long long)cvtpk(o[dt][2] * inv, o[dt][3] * inv) << 32); }
}
constexpr int DS_VROW = 144, DS_VBUF = 64 * DS_VROW;
__device__ __forceinline__ void dsa_unit(Frame& F, int b, int c, int g) {
    const int lane = F.lane, wave = F.wave;
    LAS unsigned char* L = F.ldsl + RING_OFF;
    LAS float* SC = (LAS float*)L;
    LAS int* SEL = (LAS int*)(F.ldsl + SEL_OFF) + wave * 256;
    const int q0 = c * 64 + g * 8, Kn = (c + 1) * 64;
    const bf16* QI = (const bf16*)(F.ws + WS_QI); const bf16* KI = (const bf16*)(F.ws + WS_KI); const float* WI = (const float*)(F.ws + WS_WI);
    const bf16* QA = (const bf16*)(F.ws + WS_QA); const bf16* KA = (const bf16*)(F.ws + WS_KA); const bf16* VA = (const bf16*)(F.ws + WS_VA);
    __syncthreads();
    for (int repa_ = 0; repa_ <= ((DUP_MASK >> 12) & 1); ++repa_) {
        const int m = lane & 31, hi = lane >> 5;
        const int q4 = 2 * ((m >> 2) & 1) + (m >> 4), head = (m & 3) + 4 * ((m >> 3) & 1);
        pg8::bf16x8 af[2][4]; float wq[2][16];
#pragma unroll
        for (int mt = 0; mt < 2; ++mt) {
            const size_t arow = (size_t)b * SEQ + q0 + 4 * mt + q4;
#pragma unroll
            for (int s = 0; s < 4; ++s) af[mt][s] = *(const pg8::bf16x8*)(QI + arow * 512 + head * 64 + 16 * s + 8 * hi);
            const size_t wrow = (size_t)b * SEQ + q0 + 4 * mt + 2 * hi;
#pragma unroll
            for (int j = 0; j < 4; ++j) { const f32x4 t = *(const f32x4*)(WI + wrow * 8 + 4 * j); wq[mt][4 * j] = t.x; wq[mt][4 * j + 1] = t.y; wq[mt][4 * j + 2] = t.z; wq[mt][4 * j + 3] = t.w; }
        }
        const int nkt = Kn / 32;
        const bf16* kbase = KI + ((size_t)b * SEQ + m) * 64 + 8 * hi;
        LAS unsigned* sp = (LAS unsigned*)SC + (2 * hi) * 4096 + m;
        LAS unsigned* hp = (LAS unsigned*)(F.ldsl + HIST_OFF) + (2 * hi) * 256;
#define DSA_LOADK(dst, kt) do { _Pragma("unroll") for (int s_ = 0; s_ < 4; ++s_) dst[s_] = *(const pg8::bf16x8*)(kbase + (size_t)(kt) * 32 * 64 + 16 * s_); } while (0)
#define DSA_TILE(src, kt) do { _Pragma("unroll") for (int mt_ = 0; mt_ < 2; ++mt_) { f32x16 acc_ = {}; \
            _Pragma("unroll") for (int s_ = 0; s_ < 4; ++s_) acc_ = MFMA32(af[mt_][s_], src[s_], acc_); \
            float s0_ = 0.f, s1_ = 0.f; \
            _Pragma("unroll") for (int r_ = 0; r_ < 8; ++r_) { s0_ += wq[mt_][r_] * fmaxf(acc_[r_], 0.f); s1_ += wq[mt_][8 + r_] * fmaxf(acc_[8 + r_], 0.f); } \
            unsigned u0_ = __float_as_uint(s0_ + 0.f), u1_ = __float_as_uint(s1_ + 0.f); u0_ = (u0_ >> 31) ? ~u0_ : (u0_ | 0x80000000u); u1_ = (u1_ >> 31) ? ~u1_ : (u1_ | 0x80000000u); \
            sp[(4 * mt_) * 4096 + 32 * (kt)] = u0_; sp[(4 * mt_ + 1) * 4096 + 32 * (kt)] = u1_; \
            __hip_atomic_fetch_add(hp + (4 * mt_) * 256 + (u0_ >> 24), 1u, __ATOMIC_RELAXED, __HIP_MEMORY_SCOPE_WORKGROUP); \
            __hip_atomic_fetch_add(hp + (4 * mt_ + 1) * 256 + (u1_ >> 24), 1u, __ATOMIC_RELAXED, __HIP_MEMORY_SCOPE_WORKGROUP); } } while (0)
        pg8::bf16x8 bA[4], bB[4];
        if (wave < nkt) DSA_LOADK(bA, wave);
        if (wave + 8 < nkt) DSA_LOADK(bB, wave + 8);
        for (int kt = wave; kt < nkt; kt += 16) {
            DSA_TILE(bA, kt);
            if (kt + 16 < nkt) DSA_LOADK(bA, kt + 16);
            if (kt + 8 < nkt) { DSA_TILE(bB, kt + 8); if (kt + 24 < nkt) DSA_LOADK(bB, kt + 24); }
        }
#undef DSA_LOADK
#undef DSA_TILE
    }
    __syncthreads();
    int nsel;
    for (int repb_ = 0; repb_ <= ((DUP_MASK >> 13) & 1); ++repb_)
    if (Kn <= 256) { nsel = Kn; for (int i = lane; i < Kn; i += 64) SEL[i] = i; *(LAS v4u*)((LAS unsigned*)(F.ldsl + HIST_OFF) + wave * 256 + 4 * lane) = (v4u){0u, 0u, 0u, 0u}; }
    else {
        nsel = 256;
        LAS const unsigned* sr = (LAS const unsigned*)SC + wave * 4096; LAS unsigned* hs = (LAS unsigned*)(F.ldsl + HIST_OFF) + wave * 256;
        const int nj = Kn >> 6;
        if (nj <= 16) dsa_select<16>(sr, hs, SEL, nj, lane);
        else if (nj <= 32) dsa_select<32>(sr, hs, SEL, nj, lane);
        else if (nj <= 48) dsa_select<48>(sr, hs, SEL, nj, lane);
        else dsa_select<64>(sr, hs, SEL, nj, lane);
    }
    asm volatile("s_waitcnt lgkmcnt(0)" ::: "memory");
    for (int repc_ = 0; repc_ <= ((DUP_MASK >> 14) & 1); ++repc_) {
        const size_t qrow = (size_t)b * SEQ + q0 + wave;
        if (nsel == 256) dsa_attend<true>(F, L, SEL, b, qrow, nsel); else dsa_attend<false>(F, L, SEL, b, qrow, nsel);
    }
}
__device__ __forceinline__ void p3_fox(Frame& F) {
    for (int v = F.vcu; v < 256; v += F.G) {
        const int bh = v >> 3, s = v & 7;
        fox_unit(F, bh >> 3, bh & 7, 15 - s);
        fox_unit(F, bh >> 3, bh & 7, s);
    }
}
__device__ __forceinline__ void p3_dsa(Frame& F) {
    for (int i = F.tid; i < 2048; i += NWAVES * 64) ((LAS unsigned*)(F.ldsl + HIST_OFF))[i] = 0u;
    __syncthreads();
    for (int v = F.vcu; v < 256; v += F.G) {
        const int b = v >> 6, t = v & 63, g0 = (t < 32) ? 0 : 4;
        for (int i = 0; i < 4; ++i) dsa_unit(F, b, 63 - t, g0 + i);
        for (int i = 0; i < 4; ++i) dsa_unit(F, b, t, g0 + i);
    }
}

__device__ __forceinline__ void p6_router(Frame& F) {
    const float* MOD = (const float*)(F.ws + WS_MOD); const float* X1 = F.out; const float* SSQ = (const float*)(F.ws + WS_CTL) + CW_SSQ;
    bf16* H2 = (bf16*)(F.ws + WS_H2); const bf16* WrT = (const bf16*)(F.ws + WS_WRT);
    int* TOKSLOT = (int*)(F.ws + WS_TOKSLOT); float* WROW = (float*)(F.ws + WS_WROW);
    const int lane = F.lane, r = lane & 15, kg = lane >> 4;
    const int it4 = F.wave & 3, kh = F.wave >> 2;
    LAS float* GS = (LAS float*)(F.ldsl + RING_OFF);
    LAS float* SH = GS + 1024;
    LAS float* LG = SH + 1024 + it4 * (16 * 52);
    LAS float* LG2 = SH + 1024 + 4 * (16 * 52) + it4 * (16 * 52);
    for (int base = F.vcu * 4; base < M / 16; base += F.G * 4) {
        __syncthreads();
        const int bb = (base * 16) >> 12;
        for (int i = F.tid; i < 1024; i += NWAVES * 64) { GS[i] = F.g_ffn[i] * (MOD[bb * 6144 + 4096 + i] + 1.0f); SH[i] = MOD[bb * 6144 + 3072 + i]; }
        if (F.tid < 32) F.LX[32 + F.tid] = 0u;
        __syncthreads();
        const int item = base + it4; const bool act = item < M / 16;
        int e1 = 0, e2 = 0, lr1 = 0, lr2 = 0; float w1 = 0.f, w2 = 0.f;
        if (act) {
            const int row = item * 16 + r;
            const float rstd = 1.f / sqrtf(SSQ[row] * (1.f / D) + RMS_EPS);
            f32x4 acc[3];
#pragma unroll
            for (int nt = 0; nt < 3; ++nt) acc[nt] = (f32x4){0.f, 0.f, 0.f, 0.f};
#pragma unroll 4
            for (int s = 0; s < 16; ++s) {
                const int k = 32 * (16 * kh + s) + 8 * kg;
                const f32x4 xa = *(const f32x4*)(X1 + (size_t)row * D + k), xb = *(const f32x4*)(X1 + (size_t)row * D + k + 4);
                const f32x4 ga = *(LAS const f32x4*)(GS + k), gb = *(LAS const f32x4*)(GS + k + 4);
                const f32x4 ha = *(LAS const f32x4*)(SH + k), hb = *(LAS const f32x4*)(SH + k + 4);
                const f32x4 ya = xa * rstd * ga + ha, yb = xb * rstd * gb + hb;
                v4u w; w.x = cvtpk(ya.x, ya.y); w.y = cvtpk(ya.z, ya.w); w.z = cvtpk(yb.x, yb.y); w.w = cvtpk(yb.z, yb.w);
                *(v4u*)(H2 + (size_t)row * D + k) = w;
                const pg8::bf16x8 a = __builtin_bit_cast(pg8::bf16x8, w);
#pragma unroll
                for (int nt = 0; nt < 3; ++nt) { const pg8::bf16x8 bw = *(const pg8::bf16x8*)(WrT + (size_t)(16 * nt + r) * D + k); acc[nt] = MFMA16(a, bw, acc[nt]); }
            }
            LAS float* dst = kh ? LG2 : LG;
#pragma unroll
            for (int nt = 0; nt < 3; ++nt)
#pragma unroll
                for (int i = 0; i < 4; ++i) dst[(4 * kg + i) * 52 + 16 * nt + r] = acc[nt][i];
        }
        __syncthreads();
        if (act && kh == 0 && lane < 16) {
            LAS const float* lg = LG + lane * 52; LAS const float* lg2 = LG2 + lane * 52;
            float gl[4]; int grp = 0;
#pragma unroll
            for (int i = 0; i < 4; ++i) gl[i] = lg[32 + i] + lg2[32 + i] + F.b_group[i];
#pragma unroll
            for (int i = 1; i < 4; ++i) if (gl[i] > gl[grp]) grp = i;
            const float gmax = (grp == 0) ? gl[0] : (grp == 1) ? gl[1] : (grp == 2) ? gl[2] : gl[3];
            float den = 0.f;
#pragma unroll
            for (int i = 0; i < 4; ++i) den += expf(gl[i] - gmax);
            const float pg = 1.f / den;
            float ev[8];
#pragma unroll
            for (int i = 0; i < 8; ++i) ev[i] = lg[grp * 8 + i] + lg2[grp * 8 + i] + F.b_router[grp * 8 + i];
            int i1 = 0; float v1 = ev[0];
#pragma unroll
            for (int i = 1; i < 8; ++i) if (ev[i] > v1) { v1 = ev[i]; i1 = i; }
            int i2 = -1; float v2 = -3.0e38f;
#pragma unroll
            for (int i = 0; i < 8; ++i) if (i != i1 && ev[i] > v2) { v2 = ev[i]; i2 = i; }
            const float t = expf(v2 - v1);
            w1 = pg / (1.f + t); w2 = pg * t / (1.f + t);
            e1 = grp * 8 + i1; e2 = grp * 8 + i2;
            lr1 = (int)atomicAdd((unsigned*)&F.LX[32 + e1], 1u); lr2 = (int)atomicAdd((unsigned*)&F.LX[32 + e2], 1u);
        }
        __syncthreads();
        if (F.tid < 32) { const unsigned c = F.LX[32 + F.tid]; F.LX[64 + F.tid] = c ? atomicAdd((unsigned*)(F.ctl + CW_CNT + F.tid), c) : 0u; }
        __syncthreads();
        if (act && kh == 0 && lane < 16) { const int row = item * 16 + lane;
            const int p1 = e1 * ECAP + (int)F.LX[64 + e1] + lr1, p2 = e2 * ECAP + (int)F.LX[64 + e2] + lr2;
            TOKSLOT[p1] = 2 * row; WROW[p1] = w1; TOKSLOT[p2] = 2 * row + 1; WROW[p2] = w2; }
    }
}
__device__ __forceinline__ void p10_final(Frame& F) {
    const int gw = F.vcu * NWAVES + F.wave, NGW = F.G * NWAVES;
    const float* MOD = (const float*)(F.ws + WS_MOD); const bf16* YC = (const bf16*)(F.ws + WS_YC);
    for (int m = gw; m < M; m += NGW) {
        const int b = m >> 12;
        GAS f32x4* xr = (GAS f32x4*)(F.out + (size_t)m * D) + F.lane;
        const GAS unsigned long long* y0 = (const GAS unsigned long long*)(YC + (size_t)(2 * m) * D) + F.lane;
        const GAS unsigned long long* y1 = (const GAS unsigned long long*)(YC + (size_t)(2 * m + 1) * D) + F.lane;
        f32x4 v[4]; float s = 0.f;
#pragma unroll
        for (int j = 0; j < 4; ++j) { const int col = 4 * F.lane + 256 * j;
            const f32x4 x1 = xr[64 * j]; const unsigned long long a = y0[64 * j], c = y1[64 * j];
            const f32x4 gt = *(const f32x4*)(MOD + b * 6144 + 5120 + col);
            f32x4 y; y.x = bflo((unsigned)a) + bflo((unsigned)c); y.y = bfhi((unsigned)a) + bfhi((unsigned)c); y.z = bflo((unsigned)(a >> 32)) + bflo((unsigned)(c >> 32)); y.w = bfhi((unsigned)(a >> 32)) + bfhi((unsigned)(c >> 32));
            v[j] = x1 + gt * y; s += (v[j].x * v[j].x + v[j].y * v[j].y) + (v[j].z * v[j].z + v[j].w * v[j].w); }
        const float rstd = 1.f / sqrtf(wave_sum(s) * (1.f / D) + RMS_EPS);
#pragma unroll
        for (int j = 0; j < 4; ++j) { const int col = 4 * F.lane + 256 * j; const f32x4 g = *(const f32x4*)(F.g_final + col); xr[64 * j] = v[j] * rstd * g; }
    }
}

struct Args { const void* in[20]; float* out; unsigned char* ws; int ph_lo, ph_hi; };
__global__ void __launch_bounds__(NWAVES * 64, 2) hybrid_fwd(Args args) {
    extern __shared__ __attribute__((aligned(16))) unsigned char lds[];
    Frame F;
    F.lds = lds; F.ldsl = (LAS unsigned char*)lds; F.LX = (volatile LAS unsigned*)(F.ldsl + LX_OFF);
    F.tid = threadIdx.x; F.lane = F.tid & 63; F.wave = __builtin_amdgcn_readfirstlane(F.tid >> 6);
    F.G = gridDim.x; { const int bx = blockIdx.x; F.vcu = (F.G % 8 == 0) ? (bx % 8) * (F.G / 8) + bx / 8 : bx; }
    F.ws = args.ws; F.ctl = (gu32*)(args.ws + WS_CTL); F.out = args.out;
    F.x = (const float*)args.in[0]; F.c = (const float*)args.in[1]; F.positions = (const int*)args.in[2]; F.w_mod = (const float*)args.in[3]; F.b_mod = (const float*)args.in[4];
    F.g_mix = (const float*)args.in[5]; F.w_in = (const float*)args.in[6]; F.b_forget = (const float*)args.in[7]; F.w_out_a = (const float*)args.in[8]; F.w_out_b = (const float*)args.in[9];
    F.w_out = (const float*)args.in[10]; F.g_ffn = (const float*)args.in[11]; F.w_group = (const float*)args.in[12]; F.b_group = (const float*)args.in[13]; F.w_router = (const float*)args.in[14];
    F.b_router = (const float*)args.in[15]; F.w_e_gate = (const float*)args.in[16]; F.w_e_up = (const float*)args.in[17]; F.w_e_down = (const float*)args.in[18]; F.g_final = (const float*)args.in[19];
    for (int u = F.tid; u < (LDS_BYTES - LX_OFF) / 4; u += NWAVES * 64) F.LX[u] = 0u;
    __syncthreads();
    XcdBarrier bar; bar.bar = (unsigned*)(F.ctl + CW_BAR); bar.x = 0; bar.st = nullptr;
    if (N_LAUNCHES == 1) bar = xcd_barrier_post((unsigned*)(F.ctl + CW_BAR), F.LX);
    const int lo = args.ph_lo, hi = args.ph_hi;
#ifndef PH_MASK
#define PH_MASK 0xFFFF
#endif
#define IN(k) (((PH_MASK >> (k)) & 1) && lo <= (k) && (k) < hi)
#define REP(k) for (int rep_ = 0; rep_ <= ((DUP_MASK >> (k)) & 1); ++rep_)
#define SEAM(k) do { if (IN(k) && IN((k) + 1)) { xcd_barrier(bar); if ((DUP_MASK >> 15) & 1) xcd_barrier(bar); } } while (0)
    LAS unsigned char* ring = F.ldsl + RING_OFF;
    if (IN(0)) { REP(0) p0_prologue(F); } SEAM(0);
    if (IN(1)) { REP(1) p1_hnorm(F); } SEAM(1);
    if (IN(2)) {
        pg8::Gemm g{(const pg8::bf16_t*)(F.ws + WS_H), (const pg8::bf16_t*)(F.ws + WS_WIN), M, NPROJ, D}; pg8::StaticOrder S; S.init(M, NPROJ, F.G, (int)blockIdx.x);
        EpiProj E{F.ws, F.b_forget};
        pg8::gemm_phase<EpiProj, pg8::StaticOrder, true, true>(ring, g, S, E);
#if (DUP_MASK >> 2) & 1
        asm volatile("s_waitcnt vmcnt(0)" ::: "memory"); __syncthreads();
        pg8::gemm_phase<EpiProj, pg8::StaticOrder, true, true>(ring, g, S, E);
#endif
    } SEAM(2);
    if (IN(3)) { REP(3) p3_fox(F); REP(11) p3_dsa(F); } SEAM(3);
    if (IN(4)) {
        static_assert(WS_OB == WS_OA + (size_t)M * 512 * 2 && WS_WOB == WS_WOA + (size_t)1024 * 512 * 2, "stacked operands of the merge GEMM");
        pg8::Gemm g{(const pg8::bf16_t*)(F.ws + WS_OA), (const pg8::bf16_t*)(F.ws + WS_WOA), 2 * M, 2 * D, 512}; MergeOrder S; S.S.init(M, D, F.G, (int)blockIdx.x);
        EpiMerge E{F.ws}; pg8::gemm_phase<EpiMerge, MergeOrder, true, true>(ring, g, S, E);
    } SEAM(4);
    if (IN(5)) {
        pg8::Gemm g{(const pg8::bf16_t*)(F.ws + WS_GA), (const pg8::bf16_t*)(F.ws + WS_WO), M, D, D}; pg8::StaticOrder S; S.init(M, D, F.G, (int)blockIdx.x);
        EpiOut E{F.ws, F.x, F.out}; pg8::gemm_phase<EpiOut, pg8::StaticOrder, true, true>(ring, g, S, E);
    } SEAM(5);
    if (IN(6)) { p6_router(F); } SEAM(6);
    if (IN(8)) {
        moe_table(F);
        pg8::Gemm g{(const pg8::bf16_t*)(F.ws + WS_H2), (const pg8::bf16_t*)(F.ws + WS_WGU), PMAX, 32 * 1024, D};
        MoeOrder S{F.G, F.vcu, (int)F.LX[132] * 4, F.LX + 160};
        MoeRowMap RM{(const int*)(F.ws + WS_TOKSLOT), F.LX};
        EpiGU E{F.ws}; REP(8) pg8::gemm_phase_g<EpiGU, MoeOrder, MoeRowMap, true, true>(ring, g, S, E, RM);
    } SEAM(8);
    if (IN(9)) {
        moe_table(F);
        pg8::Gemm g{(const pg8::bf16_t*)(F.ws + WS_HID), (const pg8::bf16_t*)(F.ws + WS_WDN), PMAX, 32 * 1024, 512};
        MoeOrder S{F.G, F.vcu, (int)F.LX[132] * 4, F.LX + 160};
        EpiDown E{F.ws, F.LX}; REP(9) pg8::gemm_phase<EpiDown, MoeOrder, true, true>(ring, g, S, E);
    } SEAM(9);
    if (IN(10)) { p10_final(F); }
#undef IN
#undef SEAM
}

extern "C" void kernel_launch(void* const* d_in, const int* in_sizes, int n_in, void* d_out, int out_size, void* d_ws, size_t ws_size, hipStream_t stream) {
    static int grid = 0;
    if (grid == 0) {
        if (n_in != 20 || in_sizes[0] != M * D || out_size != M * D || ws_size < WS_END) { fprintf(stderr, "kernel_launch: unexpected shapes (n_in %d, in0 %d, out %d, ws %zu); nothing launched\n", n_in, n_in > 0 ? in_sizes[0] : -1, out_size, ws_size); grid = -1; return; }
        int dev = 0, cus = 0, per_cu = 0;
        if (hipGetDevice(&dev) != hipSuccess || hipDeviceGetAttribute(&cus, hipDeviceAttributeMultiprocessorCount, dev) != hipSuccess) { grid = -1; return; }
        if (hipFuncSetAttribute((const void*)hybrid_fwd, hipFuncAttributeMaxDynamicSharedMemorySize, LDS_BYTES) != hipSuccess) { fprintf(stderr, "kernel_launch: hipFuncSetAttribute failed\n"); grid = -1; return; }
        if (hipOccupancyMaxActiveBlocksPerMultiprocessor(&per_cu, (const void*)hybrid_fwd, NWAVES * 64, LDS_BYTES) != hipSuccess || per_cu < 1)
            fprintf(stderr, "kernel_launch: note: occupancy query reports %d workgroups per CU\n", per_cu);
        (void)hipGetLastError();
        grid = cus;
    }
    if (grid < 0) return;
    if (hipMemsetAsync((char*)d_ws + WS_CTL, 0, CTL_ZERO_BYTES, stream) != hipSuccess) { fprintf(stderr, "kernel_launch: hipMemsetAsync failed\n"); return; }
    Args a{};
    for (int i = 0; i < 20; ++i) a.in[i] = d_in[i];
    a.out = (float*)d_out; a.ws = (unsigned char*)d_ws;
    for (int li = 0; li < N_LAUNCHES; ++li) {
        a.ph_lo = (N_LAUNCHES == 1) ? 0 : li; a.ph_hi = (N_LAUNCHES == 1) ? NPHASE : li + 1;
        hipLaunchKernelGGL(hybrid_fwd, dim3(grid), dim3(NWAVES * 64), LDS_BYTES, stream, a);
        const hipError_t le = hipPeekAtLastError();
        if (le != hipSuccess) { fprintf(stderr, "kernel_launch: launch %d failed: %s\n", li, hipGetErrorName(le)); break; }
    }
}
```

```cpp
#define MK_N_LAUNCHES 1
#include <hip/hip_runtime.h>
#include <hip/hip_bf16.h>
#include <cstdio>
#include <cstdint>
#include <cmath>
namespace pg8 {
#define PG8_LAS __attribute__((address_space(3)))
typedef unsigned short bf16_t;
typedef short bf16x8 __attribute__((ext_vector_type(8)));
typedef float f32x4 __attribute__((ext_vector_type(4)));
typedef unsigned u32x4 __attribute__((ext_vector_type(4)));
constexpr int BM = 256, BK = 64, HALF = 128, HTB = HALF * BK * 2  , STAGE_BYTES = 8 * HTB, NXCD = 8, WGM = 8;

__host__ __device__ __forceinline__ int lds_byte(int r, int c) { const int st = (r >> 4) * 2 + (c >> 5), rr = r & 15, cc = c & 31, ob = rr * 64 + cc * 2; return st * 1024 + (ob ^ (((ob >> 9) & 1) << 5)); }
__host__ __device__ __forceinline__ void stage_rc(int b, int& R, int& C) { const int st = b / 1024, sb = b % 1024, swz = sb ^ (((sb >> 9) & 1) << 5); R = (st >> 1) * 16 + swz / 64; C = (st & 1) * 32 + (swz % 64) / 2; }
__host__ __device__ __forceinline__ int perm32(int rho) { const int n = rho >> 4, i = rho & 15; return 8 * (i >> 2) + 4 * n + (i & 3); }

struct Unit { int pm, pn; };
struct Gemm { const bf16_t* A; const bf16_t* Bt; int M, N, K; };

struct StaticOrder {
    int nM, nN, nwg, G, c;
    __host__ __device__ void init(int M, int N, int G_, int c_) { nM = M / BM; nN = N / BM; nwg = nM * nN; G = G_; c = c_; }
    __host__ __device__ bool next(int i, Unit& u) const {
        const long L = (long)i * G + c; if (L >= nwg) return false;
        int wgid = (int)L; { const int q = nwg / NXCD, r = nwg % NXCD, xcd = wgid % NXCD, off = wgid / NXCD; wgid = (xcd < r ? xcd * (q + 1) : r * (q + 1) + (xcd - r) * q) + off; }
        const int nig = WGM * nN, gid = wgid / nig, fm = gid * WGM, gsz = (nM - fm) < WGM ? (nM - fm) : WGM;
        u.pm = fm + ((wgid % nig) % gsz); u.pn = (wgid % nig) / gsz; return true;
    }
    __device__ __forceinline__ void a_ready(const Unit&) const {}
    __device__ __forceinline__ void done(const Unit&) const {}
};

__device__ __forceinline__ unsigned cvt_pk_bf16(float lo, float hi) { unsigned r; asm volatile("v_cvt_pk_bf16_f32 %0, %1, %2" : "=v"(r) : "v"(lo), "v"(hi)); return r; }
typedef float f32x2 __attribute__((ext_vector_type(2)));
template <class Epi, class Sched, bool ALIGN_EPI = false, bool SP2 = false>
__device__ __forceinline__ void gemm_phase(PG8_LAS unsigned char* lds, const Gemm g, const Sched& S, const Epi& E) {
    const int tid = threadIdx.x, wid = __builtin_amdgcn_readfirstlane(tid >> 6), lane = tid & 63, wr = wid >> 2, wc = wid & 3, fr = lane & 15, fq = lane >> 4;
    const int K = g.K, nt = K / BK;
    unsigned voffA[2], voffB[2];
#pragma unroll
    for (int i = 0; i < 2; ++i) { int R, C; stage_rc(tid * 16 + i * 8192, R, C); const int Rb = Epi::PERM ? ((R & ~31) + perm32(R & 31)) : R;
        voffA[i] = (unsigned)(R * K + C) * 2u; voffB[i] = (unsigned)(Rb * K + C) * 2u; }
    const size_t kstep = (size_t)(BK * 2);
    const size_t hstep = (size_t)HALF * K * 2;
    const size_t tstep = 2 * hstep;
    const unsigned ldsw = (unsigned)wid * 1024u;
    const int aoff = lds_byte(wr * 64 + fr, fq * 8), boff = lds_byte(wc * 32 + fr, fq * 8);
#define PG8_SA(b, h) (((b) * 2 + (h)) * HTB)
#define PG8_SB(b, h) ((4 + (b) * 2 + (h)) * HTB)
#define PG8_STAGE(bufoff, gbase, voff) do { _Pragma("unroll") for (int _i = 0; _i < 2; ++_i) \
        __builtin_amdgcn_global_load_lds((const unsigned*)((const char*)(gbase) + (voff)[_i]), (PG8_LAS unsigned*)(lds + (bufoff) + ldsw + _i * 8192), 16, 0, 0); } while (0)
#define PG8_LDA(dst, b, h) do { _Pragma("unroll") for (int m = 0; m < 4; ++m) _Pragma("unroll") for (int k = 0; k < 2; ++k) dst[m][k] = *(const PG8_LAS bf16x8*)(lds + PG8_SA(b, h) + aoff + m * 2048 + k * 1024); } while (0)
#define PG8_LDB(dst, b, h) do { _Pragma("unroll") for (int n = 0; n < 2; ++n) _Pragma("unroll") for (int k = 0; k < 2; ++k) dst[n][k] = *(const PG8_LAS bf16x8*)(lds + PG8_SB(b, h) + boff + n * 2048 + k * 1024); } while (0)
#define PG8_MMA(ai, bj, At, Bt) do { __builtin_amdgcn_s_setprio(1); _Pragma("unroll") for (int m = 0; m < 4; ++m) _Pragma("unroll") for (int n = 0; n < 2; ++n) _Pragma("unroll") for (int k = 0; k < 2; ++k) \
        acc[ai][bj][m][n] = __builtin_amdgcn_mfma_f32_16x16x32_bf16(Bt[n][k], At[m][k], acc[ai][bj][m][n], 0, 0, 0); __builtin_amdgcn_s_setprio(0); } while (0)
#define PG8_WAIT_V(n) asm volatile("s_waitcnt vmcnt(" #n ")" ::: "memory")
#define PG8_WAIT_L(n) asm volatile("s_waitcnt lgkmcnt(" #n ")" ::: "memory")
#define PG8_BAR __builtin_amdgcn_s_barrier()
#define PG8_SCHED __builtin_amdgcn_sched_barrier(0)
    Unit cur, nxt; int ui = 0;
    if (!S.next(0, cur)) return;
    f32x4 acc[2][2][4][2];
#pragma unroll
    for (int a = 0; a < 2; ++a)
#pragma unroll
        for (int b = 0; b < 2; ++b)
#pragma unroll
            for (int m = 0; m < 4; ++m)
#pragma unroll
                for (int n = 0; n < 2; ++n) acc[a][b][m][n] = (f32x4){0.f, 0.f, 0.f, 0.f};
    bf16x8 At[4][2], B0[2][2], B1[2][2];
    const char* cA = (const char*)g.A + (size_t)cur.pm * tstep; const char* cB = (const char*)g.Bt + (size_t)cur.pn * tstep;
    S.a_ready(cur);
    if constexpr (SP2) {
        PG8_STAGE(PG8_SB(0, 0), cB, voffB); PG8_STAGE(PG8_SB(0, 1), cB + hstep, voffB); PG8_STAGE(PG8_SA(0, 0), cA, voffA); PG8_STAGE(PG8_SA(0, 1), cA + hstep, voffA);
        if (wr == 1) PG8_BAR;
        PG8_WAIT_V(2); PG8_BAR;
        PG8_STAGE(PG8_SB(1, 0), cB + kstep, voffB); PG8_STAGE(PG8_SA(1, 0), cA + kstep, voffA); PG8_STAGE(PG8_SB(1, 1), cB + hstep + kstep, voffB);
        PG8_WAIT_V(6); PG8_BAR;
    } else {
        PG8_STAGE(PG8_SB(0, 0), cB, voffB); PG8_STAGE(PG8_SA(0, 0), cA, voffA); PG8_STAGE(PG8_SB(0, 1), cB + hstep, voffB); PG8_STAGE(PG8_SA(0, 1), cA + hstep, voffA);
        if (wr == 1) PG8_BAR;
        PG8_WAIT_V(4); PG8_BAR;
        PG8_STAGE(PG8_SB(1, 0), cB + kstep, voffB); PG8_STAGE(PG8_SA(1, 0), cA + kstep, voffA); PG8_STAGE(PG8_SB(1, 1), cB + hstep + kstep, voffB);
        PG8_WAIT_V(6); PG8_BAR;
    }
    for (;;) {
        const bool has_next = S.next(ui + 1, nxt);
        const char* nA = has_next ? (const char*)g.A + (size_t)nxt.pm * tstep : cA; const char* nB = has_next ? (const char*)g.Bt + (size_t)nxt.pn * tstep : cB;
        for (int t = 0; t < nt; t += 2) {
            const bool last = (t == nt - 2);
            const char* a1 = cA + (size_t)(t + 1) * kstep;
            const char* a2 = last ? nA : cA + (size_t)(t + 2) * kstep; const char* b2 = last ? nB : cB + (size_t)(t + 2) * kstep;
            const char* a3 = a2 + kstep; const char* b3 = b2 + kstep;
            if (last && has_next) S.a_ready(nxt);
            if constexpr (SP2) {
            PG8_LDB(B0, 0, 0); PG8_LDB(B1, 0, 1); PG8_SCHED; PG8_LDA(At, 0, 0); PG8_STAGE(PG8_SA(1, 1), a1 + hstep, voffA);
            PG8_WAIT_V(8); PG8_WAIT_L(0); PG8_BAR; PG8_MMA(0, 0, At, B0); PG8_MMA(0, 1, At, B1); PG8_BAR; PG8_SCHED;
            PG8_LDA(At, 0, 1); PG8_STAGE(PG8_SB(0, 0), b2, voffB); PG8_STAGE(PG8_SB(0, 1), b2 + hstep, voffB); PG8_STAGE(PG8_SA(0, 0), a2, voffA);
            PG8_WAIT_V(8); PG8_WAIT_L(0); PG8_BAR; PG8_MMA(1, 0, At, B0); PG8_MMA(1, 1, At, B1); PG8_BAR; PG8_SCHED;
            PG8_LDB(B0, 1, 0); PG8_LDB(B1, 1, 1); PG8_SCHED; PG8_LDA(At, 1, 0); PG8_STAGE(PG8_SA(0, 1), a2 + hstep, voffA);
            PG8_WAIT_V(8); PG8_WAIT_L(0); PG8_BAR; PG8_MMA(0, 0, At, B0); PG8_MMA(0, 1, At, B1); PG8_BAR; PG8_SCHED;
            PG8_LDA(At, 1, 1); PG8_STAGE(PG8_SB(1, 0), b3, voffB); PG8_STAGE(PG8_SB(1, 1), b3 + hstep, voffB); PG8_STAGE(PG8_SA(1, 0), a3, voffA);
            PG8_WAIT_V(8); PG8_WAIT_L(0); PG8_BAR; PG8_MMA(1, 0, At, B0); PG8_MMA(1, 1, At, B1); PG8_BAR; PG8_SCHED;
            } else {
            PG8_LDB(B0, 0, 0); PG8_SCHED; PG8_LDA(At, 0, 0); PG8_STAGE(PG8_SA(1, 1), a1 + hstep, voffA);
            PG8_WAIT_L(8); PG8_BAR; PG8_WAIT_L(0); PG8_MMA(0, 0, At, B0); PG8_BAR; PG8_SCHED;
            PG8_LDB(B1, 0, 1); PG8_STAGE(PG8_SB(0, 0), b2, voffB);
            PG8_BAR; PG8_WAIT_L(0); PG8_MMA(0, 1, At, B1); PG8_BAR;
            PG8_LDA(At, 0, 1); PG8_STAGE(PG8_SA(0, 0), a2, voffA);
            PG8_BAR; PG8_WAIT_L(0); PG8_MMA(1, 0, At, B0); PG8_BAR; PG8_SCHED;
            PG8_STAGE(PG8_SB(0, 1), b2 + hstep, voffB);
            PG8_WAIT_V(6); PG8_BAR; PG8_MMA(1, 1, At, B1); PG8_BAR;
            PG8_LDB(B0, 1, 0); PG8_SCHED; PG8_LDA(At, 1, 0); PG8_STAGE(PG8_SA(0, 1), a2 + hstep, voffA);
            PG8_WAIT_L(8); PG8_BAR; PG8_WAIT_L(0); PG8_MMA(0, 0, At, B0); PG8_BAR; PG8_SCHED;
            PG8_LDB(B1, 1, 1); PG8_STAGE(PG8_SB(1, 0), b3, voffB);
            PG8_BAR; PG8_WAIT_L(0); PG8_MMA(0, 1, At, B1); PG8_BAR;
            PG8_LDA(At, 1, 1); PG8_STAGE(PG8_SA(1, 0), a3, voffA);
            PG8_BAR; PG8_WAIT_L(0); PG8_MMA(1, 0, At, B0); PG8_BAR; PG8_SCHED;
            PG8_STAGE(PG8_SB(1, 1), b3 + hstep, voffB);
            PG8_WAIT_V(6); PG8_BAR; PG8_MMA(1, 1, At, B1); PG8_BAR;
            }
        }
        if constexpr (ALIGN_EPI) { if (wr == 0) PG8_BAR; }
        bool keep_acc = false;
        if constexpr (Epi::CHAIN) { keep_acc = E.chain(acc, cur, wr, wc, fr, fq); S.done(cur); }
        else if constexpr (!Epi::AFTER_DRAIN) { E(acc, cur, wr, wc, fr, fq); S.done(cur); }
        if (!has_next) break;
        if (!keep_acc)
#pragma unroll
        for (int a = 0; a < 2; ++a)
#pragma unroll
            for (int b = 0; b < 2; ++b)
#pragma unroll
                for (int m = 0; m < 4; ++m)
#pragma unroll
                    for (int n = 0; n < 2; ++n) acc[a][b][m][n] = (f32x4){0.f, 0.f, 0.f, 0.f};
        cur = nxt; cA = nA; cB = nB; ++ui;
        if constexpr (ALIGN_EPI) { if (wr == 1) PG8_BAR; }
    }
    PG8_WAIT_V(0);
    if constexpr (!ALIGN_EPI) { if (wr == 0) PG8_BAR; }
    PG8_BAR;
    if constexpr (Epi::AFTER_DRAIN) { E.fused(acc, cur, wr, wc, fr, fq, lds, wid, lane); S.done(cur); }
#undef PG8_SA
#undef PG8_SB
#undef PG8_STAGE
#undef PG8_LDA
#undef PG8_LDB
#undef PG8_MMA
#undef PG8_WAIT_V
#undef PG8_WAIT_L
#undef PG8_BAR
#undef PG8_SCHED
}
template <class Epi, class Sched, class RowMap, bool ALIGN_EPI = false, bool SP2 = true>
__device__ __forceinline__ void gemm_phase_g(PG8_LAS unsigned char* lds, const Gemm g, const Sched& S, const Epi& E, const RowMap& RM) {
    static_assert(SP2, "gather variant: SP2 path only");
    const int tid = threadIdx.x, wid = __builtin_amdgcn_readfirstlane(tid >> 6), lane = tid & 63, wr = wid >> 2, wc = wid & 3, fr = lane & 15, fq = lane >> 4;
    const int K = g.K, nt = K / BK;
    unsigned voffA[2], voffB[2]; int rAg[2]; unsigned cAg[2]; unsigned vC[2][2], vN[2][2];
#pragma unroll
    for (int i = 0; i < 2; ++i) { int R, C; stage_rc(tid * 16 + i * 8192, R, C); const int Rb = Epi::PERM ? ((R & ~31) + perm32(R & 31)) : R;
        voffA[i] = (unsigned)(R * K + C) * 2u; voffB[i] = (unsigned)(Rb * K + C) * 2u; rAg[i] = R; cAg[i] = (unsigned)C * 2u; }
    const size_t kstep = (size_t)(BK * 2);
    const size_t hstep = (size_t)HALF * K * 2;
    const size_t tstep = 2 * hstep;
    const unsigned ldsw = (unsigned)wid * 1024u;
    const int aoff = lds_byte(wr * 64 + fr, fq * 8), boff = lds_byte(wc * 32 + fr, fq * 8);
#define PG8_SA(b, h) (((b) * 2 + (h)) * HTB)
#define PG8_SB(b, h) ((4 + (b) * 2 + (h)) * HTB)
#define PG8_STAGE(bufoff, gbase, voff) do { _Pragma("unroll") for (int _i = 0; _i < 2; ++_i) \
        __builtin_amdgcn_global_load_lds((const unsigned*)((const char*)(gbase) + (voff)[_i]), (PG8_LAS unsigned*)(lds + (bufoff) + ldsw + _i * 8192), 16, 0, 0); } while (0)
#define PG8_LDA(dst, b, h) do { _Pragma("unroll") for (int m = 0; m < 4; ++m) _Pragma("unroll") for (int k = 0; k < 2; ++k) dst[m][k] = *(const PG8_LAS bf16x8*)(lds + PG8_SA(b, h) + aoff + m * 2048 + k * 1024); } while (0)
#define PG8_LDB(dst, b, h) do { _Pragma("unroll") for (int n = 0; n < 2; ++n) _Pragma("unroll") for (int k = 0; k < 2; ++k) dst[n][k] = *(const PG8_LAS bf16x8*)(lds + PG8_SB(b, h) + boff + n * 2048 + k * 1024); } while (0)
#define PG8_MMA(ai, bj, At, Bt) do { __builtin_amdgcn_s_setprio(1); _Pragma("unroll") for (int m = 0; m < 4; ++m) _Pragma("unroll") for (int n = 0; n < 2; ++n) _Pragma("unroll") for (int k = 0; k < 2; ++k) \
        acc[ai][bj][m][n] = __builtin_amdgcn_mfma_f32_16x16x32_bf16(Bt[n][k], At[m][k], acc[ai][bj][m][n], 0, 0, 0); __builtin_amdgcn_s_setprio(0); } while (0)
#define PG8_WAIT_V(n) asm volatile("s_waitcnt vmcnt(" #n ")" ::: "memory")
#define PG8_WAIT_L(n) asm volatile("s_waitcnt lgkmcnt(" #n ")" ::: "memory")
#define PG8_BAR __builtin_amdgcn_s_barrier()
#define PG8_SCHED __builtin_amdgcn_sched_barrier(0)
    Unit cur, nxt; int ui = 0;
    if (!S.next(0, cur)) return;
#define PG8_FILL(v, uu) do { _Pragma("unroll") for (int h_ = 0; h_ < 2; ++h_) _Pragma("unroll") for (int i_ = 0; i_ < 2; ++i_) v[h_][i_] = RM.rowoff(uu, h_ * HALF + rAg[i_]) + cAg[i_]; } while (0)
    PG8_FILL(vC, cur);
    const char* gA = (const char*)g.A;
    f32x4 acc[2][2][4][2];
#pragma unroll
    for (int a = 0; a < 2; ++a)
#pragma unroll
        for (int b = 0; b < 2; ++b)
#pragma unroll
            for (int m = 0; m < 4; ++m)
#pragma unroll
                for (int n = 0; n < 2; ++n) acc[a][b][m][n] = (f32x4){0.f, 0.f, 0.f, 0.f};
    bf16x8 At[4][2], B0[2][2], B1[2][2];
    const char* cA = (const char*)g.A + (size_t)cur.pm * tstep; const char* cB = (const char*)g.Bt + (size_t)cur.pn * tstep;
    S.a_ready(cur);
    if constexpr (SP2) {
        PG8_STAGE(PG8_SB(0, 0), cB, voffB); PG8_STAGE(PG8_SB(0, 1), cB + hstep, voffB); PG8_STAGE(PG8_SA(0, 0), gA, vC[0]); PG8_STAGE(PG8_SA(0, 1), gA, vC[1]);
        if (wr == 1) PG8_BAR;
        PG8_WAIT_V(2); PG8_BAR;
        PG8_STAGE(PG8_SB(1, 0), cB + kstep, voffB); PG8_STAGE(PG8_SA(1, 0), gA + kstep, vC[0]); PG8_STAGE(PG8_SB(1, 1), cB + hstep + kstep, voffB);
        PG8_WAIT_V(6); PG8_BAR;
    } else {
        PG8_STAGE(PG8_SB(0, 0), cB, voffB); PG8_STAGE(PG8_SA(0, 0), cA, voffA); PG8_STAGE(PG8_SB(0, 1), cB + hstep, voffB); PG8_STAGE(PG8_SA(0, 1), cA + hstep, voffA);
        if (wr == 1) PG8_BAR;
        PG8_WAIT_V(4); PG8_BAR;
        PG8_STAGE(PG8_SB(1, 0), cB + kstep, voffB); PG8_STAGE(PG8_SA(1, 0), cA + kstep, voffA); PG8_STAGE(PG8_SB(1, 1), cB + hstep + kstep, voffB);
        PG8_WAIT_V(6); PG8_BAR;
    }
    for (;;) {
        const bool has_next = S.next(ui + 1, nxt);
        if (has_next) PG8_FILL(vN, nxt); else { vN[0][0] = vC[0][0]; vN[0][1] = vC[0][1]; vN[1][0] = vC[1][0]; vN[1][1] = vC[1][1]; }
        const char* nA = has_next ? (const char*)g.A + (size_t)nxt.pm * tstep : cA; const char* nB = has_next ? (const char*)g.Bt + (size_t)nxt.pn * tstep : cB;
        for (int t = 0; t < nt; t += 2) {
            const bool last = (t == nt - 2);
            const char* a1 = cA + (size_t)(t + 1) * kstep;
            const char* a2 = last ? nA : cA + (size_t)(t + 2) * kstep; const char* b2 = last ? nB : cB + (size_t)(t + 2) * kstep;
            const char* a3 = a2 + kstep; const char* b3 = b2 + kstep;
            const char* ga2 = last ? gA : gA + (size_t)(t + 2) * kstep;
            unsigned vs0[2] = {last ? vN[0][0] : vC[0][0], last ? vN[0][1] : vC[0][1]}, vs1[2] = {last ? vN[1][0] : vC[1][0], last ? vN[1][1] : vC[1][1]};
            if (last && has_next) S.a_ready(nxt);
            if constexpr (SP2) {
            PG8_LDB(B0, 0, 0); PG8_LDB(B1, 0, 1); PG8_SCHED; PG8_LDA(At, 0, 0); PG8_STAGE(PG8_SA(1, 1), gA + (size_t)(t + 1) * kstep, vC[1]);
            PG8_WAIT_V(8); PG8_WAIT_L(0); PG8_BAR; PG8_MMA(0, 0, At, B0); PG8_MMA(0, 1, At, B1); PG8_BAR; PG8_SCHED;
            PG8_LDA(At, 0, 1); PG8_STAGE(PG8_SB(0, 0), b2, voffB); PG8_STAGE(PG8_SB(0, 1), b2 + hstep, voffB); PG8_STAGE(PG8_SA(0, 0), ga2, vs0);
            PG8_WAIT_V(8); PG8_WAIT_L(0); PG8_BAR; PG8_MMA(1, 0, At, B0); PG8_MMA(1, 1, At, B1); PG8_BAR; PG8_SCHED;
            PG8_LDB(B0, 1, 0); PG8_LDB(B1, 1, 1); PG8_SCHED; PG8_LDA(At, 1, 0); PG8_STAGE(PG8_SA(0, 1), ga2, vs1);
            PG8_WAIT_V(8); PG8_WAIT_L(0); PG8_BAR; PG8_MMA(0, 0, At, B0); PG8_MMA(0, 1, At, B1); PG8_BAR; PG8_SCHED;
            PG8_LDA(At, 1, 1); PG8_STAGE(PG8_SB(1, 0), b3, voffB); PG8_STAGE(PG8_SB(1, 1), b3 + hstep, voffB); PG8_STAGE(PG8_SA(1, 0), ga2 + kstep, vs0);
            PG8_WAIT_V(8); PG8_WAIT_L(0); PG8_BAR; PG8_MMA(1, 0, At, B0); PG8_MMA(1, 1, At, B1); PG8_BAR; PG8_SCHED;
            } else {
            PG8_LDB(B0, 0, 0); PG8_SCHED; PG8_LDA(At, 0, 0); PG8_STAGE(PG8_SA(1, 1), a1 + hstep, voffA);
            PG8_WAIT_L(8); PG8_BAR; PG8_WAIT_L(0); PG8_MMA(0, 0, At, B0); PG8_BAR; PG8_SCHED;
            PG8_LDB(B1, 0, 1); PG8_STAGE(PG8_SB(0, 0), b2, voffB);
            PG8_BAR; PG8_WAIT_L(0); PG8_MMA(0, 1, At, B1); PG8_BAR;
            PG8_LDA(At, 0, 1); PG8_STAGE(PG8_SA(0, 0), a2, voffA);
            PG8_BAR; PG8_WAIT_L(0); PG8_MMA(1, 0, At, B0); PG8_BAR; PG8_SCHED;
            PG8_STAGE(PG8_SB(0, 1), b2 + hstep, voffB);
            PG8_WAIT_V(6); PG8_BAR; PG8_MMA(1, 1, At, B1); PG8_BAR;
            PG8_LDB(B0, 1, 0); PG8_SCHED; PG8_LDA(At, 1, 0); PG8_STAGE(PG8_SA(0, 1), a2 + hstep, voffA);
            PG8_WAIT_L(8); PG8_BAR; PG8_WAIT_L(0); PG8_MMA(0, 0, At, B0); PG8_BAR; PG8_SCHED;
            PG8_LDB(B1, 1, 1); PG8_STAGE(PG8_SB(1, 0), b3, voffB);
            PG8_BAR; PG8_WAIT_L(0); PG8_MMA(0, 1, At, B1); PG8_BAR;
            PG8_LDA(At, 1, 1); PG8_STAGE(PG8_SA(1, 0), a3, voffA);
            PG8_BAR; PG8_WAIT_L(0); PG8_MMA(1, 0, At, B0); PG8_BAR; PG8_SCHED;
            PG8_STAGE(PG8_SB(1, 1), b3 + hstep, voffB);
            PG8_WAIT_V(6); PG8_BAR; PG8_MMA(1, 1, At, B1); PG8_BAR;
            }
        }
        if constexpr (ALIGN_EPI) { if (wr == 0) PG8_BAR; }
        if constexpr (!Epi::AFTER_DRAIN) { E(acc, cur, wr, wc, fr, fq); S.done(cur); }
        if (!has_next) break;
#pragma unroll
        for (int a = 0; a < 2; ++a)
#pragma unroll
            for (int b = 0; b < 2; ++b)
#pragma unroll
                for (int m = 0; m < 4; ++m)
#pragma unroll
                    for (int n = 0; n < 2; ++n) acc[a][b][m][n] = (f32x4){0.f, 0.f, 0.f, 0.f};
        cur = nxt; cA = nA; cB = nB; ++ui; vC[0][0] = vN[0][0]; vC[0][1] = vN[0][1]; vC[1][0] = vN[1][0]; vC[1][1] = vN[1][1];
        if constexpr (ALIGN_EPI) { if (wr == 1) PG8_BAR; }
    }
    PG8_WAIT_V(0);
    if constexpr (!ALIGN_EPI) { if (wr == 0) PG8_BAR; }
    PG8_BAR;
    if constexpr (Epi::AFTER_DRAIN) { E.fused(acc, cur, wr, wc, fr, fq, lds, wid, lane); S.done(cur); }
#undef PG8_FILL
#undef PG8_SA
#undef PG8_SB
#undef PG8_STAGE
#undef PG8_LDA
#undef PG8_LDB
#undef PG8_MMA
#undef PG8_WAIT_V
#undef PG8_WAIT_L
#undef PG8_BAR
#undef PG8_SCHED
}
}
constexpr int NWAVES = 8;
constexpr int BATCH = 4, SEQ = 4096, D = 1024, M = BATCH * SEQ;
constexpr int NPROJ = 4864;
constexpr float RMS_EPS = 1e-6f;
constexpr float LOG2E = 1.4426950408889634f;
constexpr float QSCALE = 0.125f * LOG2E;
constexpr int PMAX = 40960, NTMAX = 160;
constexpr int NPHASE = 11;
#ifndef MK_N_LAUNCHES
#define MK_N_LAUNCHES 1
#endif
constexpr int N_LAUNCHES = MK_N_LAUNCHES;

constexpr size_t MiB = 1u << 20;
constexpr size_t WS_CTL = 0, CTL_ZERO_BYTES = 1 * MiB;
constexpr size_t WS_MOD = 1 * MiB;
constexpr size_t WS_WRT = 1 * MiB + 256 * 1024;
constexpr int ECAP = 16384;
constexpr size_t WS_TOKSLOT = 212 * MiB;
constexpr size_t WS_WROW = 214 * MiB;
constexpr size_t WS_COS = 2 * MiB, WS_SIN = 2 * MiB + 512 * 1024;
constexpr size_t WS_WI = 3 * MiB, WS_LOGF = 3 * MiB + 512 * 1024;
constexpr size_t WS_ROUTE = 4 * MiB;
constexpr size_t WS_WIN = 5 * MiB;
constexpr size_t WS_WOA = 15 * MiB, WS_WOB = 16 * MiB, WS_WO = 17 * MiB;
constexpr size_t WS_WGU = 19 * MiB, WS_WDN = 83 * MiB;
constexpr size_t WS_H = 115 * MiB;
constexpr size_t WS_OA = 115 * MiB, WS_OB = 131 * MiB, WS_H2 = 115 * MiB;
constexpr size_t WS_QA = 147 * MiB, WS_QI = 163 * MiB, WS_QB = 179 * MiB, WS_KB = 195 * MiB, WS_VB = 211 * MiB;
constexpr size_t WS_KA = 227 * MiB, WS_VA = 229 * MiB, WS_KI = 231 * MiB;
constexpr size_t WS_XS = 147 * MiB;
constexpr size_t WS_YC = 147 * MiB;
constexpr size_t WS_GA = 233 * MiB, WS_GB = 265 * MiB;
constexpr size_t WS_HID = 233 * MiB;
constexpr size_t WS_END = 297 * MiB;
constexpr int CW_BAR = 4096, CW_CNT = 8192, CW_SSQ = 16384, CW_KN2 = 131072;
constexpr int RING_OFF = 0, RING_BYTES = 131072;
constexpr int SEL_OFF = 131072;
constexpr int LX_OFF = 139264;
constexpr int HIST_OFF = 143360;
constexpr int LDS_BYTES = 151552;

#define GAS __attribute__((address_space(1)))
#define LAS __attribute__((address_space(3)))
typedef unsigned short bf16;
typedef unsigned v4u __attribute__((ext_vector_type(4)));
typedef float f32x4 __attribute__((ext_vector_type(4)));
typedef short bf16x8 __attribute__((ext_vector_type(8)));
typedef GAS unsigned gu32;
typedef GAS unsigned long long gu64;
#define RLX_AGENT __ATOMIC_RELAXED, __HIP_MEMORY_SCOPE_AGENT
#define LDS_WAIT() asm volatile("s_waitcnt lgkmcnt(0)" ::: "memory")
#define VM_WAIT() asm volatile("s_waitcnt vmcnt(0)" ::: "memory")
__device__ __forceinline__ unsigned long long rt() { return __builtin_amdgcn_s_memrealtime(); }
__device__ __forceinline__ unsigned f2bf(float f) { unsigned u = __builtin_bit_cast(unsigned, f); return (u + 0x7fffu + ((u >> 16) & 1u)) >> 16; }
__device__ __forceinline__ unsigned pk2(float lo, float hi) { return f2bf(lo) | (f2bf(hi) << 16); }

#define XB_TMO      128
#define XB_XCNT(j)  (256  + 64 * (j))
#define XB_XSUB(j)  (1280 + 64 * (j))
#define XB_XGEN(j)  (2304 + 64 * (j))
#define XB_TOP      3328
#define XB_TOPGEN   3392
#define XCD_BAR_WORDS 3456
#define XB_SPIN_CAP (1u << 18)

__device__ __forceinline__ unsigned xb_ld(unsigned* p)              { return __hip_atomic_load(p, __ATOMIC_RELAXED, __HIP_MEMORY_SCOPE_AGENT); }
__device__ __forceinline__ unsigned xb_add(unsigned* p, unsigned v) { return __hip_atomic_fetch_add(p, v, __ATOMIC_RELAXED, __HIP_MEMORY_SCOPE_AGENT); }
__device__ __forceinline__ unsigned xb_xcc_id() { return (unsigned)__builtin_amdgcn_s_getreg((3 << 11) | 20) & 0xFu; }
#define XB_SPIN(cond, bar) do { unsigned _sp = 0; while (cond) { __builtin_amdgcn_s_sleep(1); \
    if ((++_sp & 255u) == 0u) { if (xb_ld(&(bar)[XB_TMO])) break; if (_sp > XB_SPIN_CAP) { atomicAdd(&(bar)[XB_TMO], 1u); break; } } } } while (0)

struct XcdBarrier {
    unsigned* bar; unsigned x;
    volatile LAS unsigned* st;
};

__device__ __forceinline__ XcdBarrier xcd_barrier_post(unsigned* bar, volatile LAS unsigned* st) {
    XcdBarrier b; b.bar = bar; b.x = xb_xcc_id(); b.st = st;
    if (threadIdx.x == 0) (void)xb_add(&bar[XB_XCNT(b.x)], 1u);
    return b;
}
__device__ __forceinline__ void xcd_barrier_complete(unsigned* bar, unsigned x, unsigned& nloc, unsigned& nx) {
    const unsigned G = gridDim.x * gridDim.y * gridDim.z;
    unsigned sum, cnt, mine, sp = 0u;
    for (;;) {
        sum = 0u; cnt = 0u; mine = 0u;
#pragma unroll
        for (unsigned j = 0; j < 16; ++j) { const unsigned c = xb_ld(&bar[XB_XCNT(j)]); sum += c; cnt += (c > 0u) ? 1u : 0u; mine = (j == x) ? c : mine; }
        if (sum == G) break;
        __builtin_amdgcn_s_sleep(1);
        if ((++sp & 255u) == 0u) { if (xb_ld(&bar[XB_TMO])) break; if (sp > XB_SPIN_CAP) { atomicAdd(&bar[XB_TMO], 1u); break; } }
    }
    nloc = mine > 0u ? mine : 1u; nx = cnt > 0u ? cnt : 1u;
}

__device__ __forceinline__ void xcd_barrier(const XcdBarrier& b) {
    asm volatile("s_waitcnt vmcnt(0)" ::: "memory");
    __syncthreads();
    if (threadIdx.x == 0) {
        unsigned* bar = b.bar;
        __builtin_amdgcn_s_waitcnt(0);
        unsigned nloc = b.st[0], nx = b.st[1];
        if (nloc == 0u) { xcd_barrier_complete(bar, b.x, nloc, nx); b.st[0] = nloc; b.st[1] = nx; }
        const unsigned old = xb_add(&bar[XB_XSUB(b.x)], 1u);
        const unsigned gen = old / nloc;
        if (old + 1u == (gen + 1u) * nloc) {
            __builtin_amdgcn_fence(__ATOMIC_RELEASE, "agent");
            asm volatile("s_waitcnt vmcnt(0)" ::: "memory");
            const unsigned og = xb_add(&bar[XB_TOP], 1u);
            const unsigned tg = og / nx;
            if (og + 1u == (tg + 1u) * nx) xb_add(&bar[XB_TOPGEN], 1u);
            else XB_SPIN(xb_ld(&bar[XB_TOPGEN]) == tg, bar);
            __builtin_amdgcn_fence(__ATOMIC_ACQUIRE, "agent");
            xb_add(&bar[XB_XGEN(b.x)], 1u);
            asm volatile("s_waitcnt vmcnt(0)" ::: "memory");
        } else {
            XB_SPIN(xb_ld(&bar[XB_XGEN(b.x)]) == gen, bar);
            __builtin_amdgcn_fence(__ATOMIC_ACQUIRE, "agent");
            asm volatile("s_waitcnt vmcnt(0)" ::: "memory");
        }
    }
    __syncthreads();
}
typedef float f32x2_t __attribute__((ext_vector_type(2))); typedef __bf16 bf16x2_t __attribute__((ext_vector_type(2)));
typedef float f32x16 __attribute__((ext_vector_type(16)));
typedef short s16x4 __attribute__((ext_vector_type(4)));
__device__ __forceinline__ unsigned cvtpk(float lo, float hi) { f32x2_t v = {lo, hi}; bf16x2_t b = __builtin_convertvector(v, bf16x2_t); return __builtin_bit_cast(unsigned, b); }
__device__ __forceinline__ float bflo(unsigned w) { return __uint_as_float(w << 16); }
__device__ __forceinline__ float bfhi(unsigned w) { return __uint_as_float(w & 0xffff0000u); }
__device__ __forceinline__ float sigmoidf_(float v) { return 1.f / (1.f + __expf(-v)); }
#define MFMA32(a, b, c) __builtin_amdgcn_mfma_f32_32x32x16_bf16((a), (b), (c), 0, 0, 0)
#define MFMA16(a, b, c) __builtin_amdgcn_mfma_f32_16x16x32_bf16((a), (b), (c), 0, 0, 0)

struct Frame {
    unsigned char* lds;
    LAS unsigned char* ldsl;
    volatile LAS unsigned* LX;
    gu32* ctl;
    unsigned char* ws;
    int tid, lane, wave, vcu, G;
    const float *x, *c, *w_mod, *b_mod, *g_mix, *w_in, *b_forget, *w_out_a, *w_out_b, *w_out, *g_ffn, *w_group, *b_group, *w_router, *b_router, *w_e_gate, *w_e_up, *w_e_down, *g_final;
    const int* positions;
    float* out;
};
__device__ __forceinline__ float wave_sum(float v) {
#pragma unroll
    for (int o = 1; o < 64; o <<= 1) v += __shfl_xor(v, o);
    return v;
}

struct CmIn { __device__ __forceinline__ int operator()(int n) const { if (n < 1216) return n; if (n < 2752) return n + 8; if (n < 4800) return n + 16; if (n < 4808) return n - 4800 + 1216; if (n < 4816) return n - 4808 + 2760; return -1; } };
struct CmId { int base; __device__ __forceinline__ int operator()(int n) const { return n - base; } };
template <class CM>
__device__ __forceinline__ void transpose_item(const float* W, int ldw, bf16* WT, int K, int k0, int n0, const CM& cm, LAS float* scr, int lane) {
    const int sc = cm(n0 + (lane & 31));
#pragma unroll
    for (int i = 0; i < 32; ++i) { const int kk = 2 * i + (lane >> 5); scr[kk * 33 + (lane & 31)] = sc >= 0 ? W[(size_t)(k0 + kk) * ldw + sc] : 0.f; }
    LDS_WAIT(); asm volatile("" ::: "memory");
    const int c = lane & 7;
#pragma unroll
    for (int j = 0; j < 4; ++j) { const int n = (lane >> 3) + 8 * j; const LAS float* s = scr + (8 * c) * 33 + n;
        v4u o; o.x = pk2(s[0 * 33], s[1 * 33]); o.y = pk2(s[2 * 33], s[3 * 33]); o.z = pk2(s[4 * 33], s[5 * 33]); o.w = pk2(s[6 * 33], s[7 * 33]);
        *(GAS v4u*)(WT + (size_t)(n0 + n) * K + k0 + 8 * c) = o; }
    LDS_WAIT(); asm volatile("" ::: "memory");
}
__device__ __forceinline__ void p0_prologue(Frame& F) {
    __syncthreads();
    {
        LAS float* ca = (LAS float*)(F.ldsl + RING_OFF);
        LAS float* red = (LAS float*)(F.ldsl + RING_OFF + 16384);
        for (int i = F.tid; i < 4096; i += NWAVES * 64) { const float v = F.c[i]; ca[i] = v / (1.f + expf(-v)); }
        __syncthreads();
        float* MOD = (float*)(F.ws + WS_MOD);
        for (int cb = F.vcu; cb < 256; cb += F.G) {
            const int col0 = cb * 24;
            if (F.tid < 384) { const int j = F.tid % 24, ks = F.tid / 24; float a0 = 0.f, a1 = 0.f, a2 = 0.f, a3 = 0.f;
#pragma unroll 8
                for (int i = 0; i < 64; ++i) { const int k = ks + 16 * i; const float w = F.w_mod[(size_t)k * 6144 + col0 + j];
                    a0 += ca[k] * w; a1 += ca[1024 + k] * w; a2 += ca[2048 + k] * w; a3 += ca[3072 + k] * w; }
                LAS float* r = red + (ks * 24 + j) * 4; r[0] = a0; r[1] = a1; r[2] = a2; r[3] = a3; }
            __syncthreads();
            if (F.tid < 96) { const int j = F.tid % 24, bb = F.tid / 24; float s = 0.f;
#pragma unroll
                for (int ks = 0; ks < 16; ++ks) s += red[(ks * 24 + j) * 4 + bb];
                MOD[bb * 6144 + col0 + j] = s + F.b_mod[col0 + j]; }
            __syncthreads();
        }
    }
    LAS float* scr = (LAS float*)(F.ldsl + RING_OFF + F.wave * 16384);
    const int gw = F.vcu * NWAVES + F.wave, NGW = F.G * NWAVES;
    constexpr int I_IN = 16 * 152, I_OA = 8 * 32, I_O = 16 * 32, I_GU = 32 * 16 * 32, I_DN = 32 * 8 * 32;
    constexpr int NITEMS = I_IN + 2 * I_OA + I_O + I_GU + I_DN;
    bf16* WinT = (bf16*)(F.ws + WS_WIN); bf16* WoaT = (bf16*)(F.ws + WS_WOA); bf16* WobT = (bf16*)(F.ws + WS_WOB); bf16* WoT = (bf16*)(F.ws + WS_WO);
    bf16* WguT = (bf16*)(F.ws + WS_WGU); bf16* WdnT = (bf16*)(F.ws + WS_WDN);
    for (int it = gw; it < NITEMS; it += NGW) {
        int r = it;
        if (r < I_IN) { const int kb = r / 152, nb = r % 152; transpose_item(F.w_in, 4816, WinT, 1024, 64 * kb, 32 * nb, CmIn{}, scr, F.lane); continue; } r -= I_IN;
        if (r < I_OA) { const int kb = r / 32, nb = r % 32; transpose_item(F.w_out_a + 32 * nb, 1024, WoaT, 512, 64 * kb, 32 * nb, CmId{32 * nb}, scr, F.lane); continue; } r -= I_OA;
        if (r < I_OA) { const int kb = r / 32, nb = r % 32; transpose_item(F.w_out_b + 32 * nb, 1024, WobT, 512, 64 * kb, 32 * nb, CmId{32 * nb}, scr, F.lane); continue; } r -= I_OA;
        if (r < I_O) { const int kb = r / 32, nb = r % 32; transpose_item(F.w_out + 32 * nb, 1024, WoT, 1024, 64 * kb, 32 * nb, CmId{32 * nb}, scr, F.lane); continue; } r -= I_O;
        if (r < I_GU) { const int e = r / 512, q = r % 512, kb = q / 32, nb = q % 32;
            const int np = 32 * nb, ct = np >> 8, bj = (np >> 7) & 1, j0 = np & 127;
            const float* src = (bj ? F.w_e_up : F.w_e_gate) + (size_t)e * 1024 * 512 + ct * 128 + j0;
            transpose_item(src, 512, WguT, 1024, 64 * kb, e * 1024 + np, CmId{e * 1024 + np}, scr, F.lane); continue; } r -= I_GU;
        { const int e = r / 256, q = r % 256, kb = q / 32, nb = q % 32;
            const float* src = F.w_e_down + (size_t)e * 512 * 1024 + 32 * nb;
            transpose_item(src, 1024, WdnT, 512, 64 * kb, e * 1024 + 32 * nb, CmId{e * 1024 + 32 * nb}, scr, F.lane); }
    }
    { bf16* WrT = (bf16*)(F.ws + WS_WRT);
      for (int i = (F.vcu * NWAVES * 64 + F.tid); i < 64 * 1024; i += F.G * NWAVES * 64) { const int n = i >> 10, k = i & 1023;
          float v = 0.f; if (n < 32) v = F.w_router[k * 32 + n]; else if (n < 36) v = F.w_group[k * 4 + (n - 32)];
          WrT[i] = (bf16)f2bf(v); } }
}

__device__ __forceinline__ void p1_hnorm(Frame& F) {
    const int gw = F.vcu * NWAVES + F.wave, NGW = F.G * NWAVES;
    const float* MOD = (const float*)(F.ws + WS_MOD); bf16* H = (bf16*)(F.ws + WS_H);
    float* COS = (float*)(F.ws + WS_COS); float* SIN = (float*)(F.ws + WS_SIN);
    for (int m = gw; m < M; m += NGW) {
        const int b = m >> 12;
        const GAS f32x4* xr = (const GAS f32x4*)(F.x + (size_t)m * D) + F.lane;
        f32x4 v[4]; float s = 0.f;
#pragma unroll
        for (int j = 0; j < 4; ++j) { v[j] = xr[64 * j]; s += (v[j].x * v[j].x + v[j].y * v[j].y) + (v[j].z * v[j].z + v[j].w * v[j].w); }
        const float rstd = 1.f / sqrtf(wave_sum(s) * (1.f / D) + RMS_EPS);
        GAS unsigned long long* o8 = (GAS unsigned long long*)(H + (size_t)m * D) + F.lane;
#pragma unroll
        for (int j = 0; j < 4; ++j) { const int col = 4 * F.lane + 256 * j;
            const f32x4 g = *(const f32x4*)(F.g_mix + col), sc = *(const f32x4*)(MOD + b * 6144 + 1024 + col), sh = *(const f32x4*)(MOD + b * 6144 + col);
            const f32x4 h = v[j] * rstd * g * (sc + 1.0f) + sh;
            o8[64 * j] = (unsigned long long)cvtpk(h.x, h.y) | ((unsigned long long)cvtpk(h.z, h.w) << 32); }
        if (F.lane < 8) { const float invf = exp2f(-(float)F.lane * 2.3664460711655218f); const float ang = (float)F.positions[m] * invf;
            COS[m * 8 + F.lane] = cosf(ang); SIN[m * 8 + F.lane] = sinf(ang); }
    }
}

struct EpiProj {
    static constexpr bool PERM = true, AFTER_DRAIN = false, CHAIN = false;
    unsigned char* ws; const float* bfg;
    template <int BJ>
    __device__ __forceinline__ void part(const pg8::f32x4 (&acc)[2][2][4][2], const pg8::Unit& u, int wr, int wc, int fr, int fq) const {
        const float* COS = (const float*)(ws + WS_COS); const float* SIN = (const float*)(ws + WS_SIN);
        const int cg = __builtin_amdgcn_readfirstlane(u.pn * 256 + BJ * 128 + wc * 32);
        size_t boff = 0; int ld = 0, cofs = 0, kind = 4; float scale = 1.f;
        if (cg < 512)       { boff = WS_QA; ld = 512; cofs = 0;    kind = 1; scale = QSCALE; }
        else if (cg < 576)  { boff = WS_KA; ld = 64;  cofs = 512;  kind = 1; }
        else if (cg < 640)  { boff = WS_VA; ld = 64;  cofs = 576;  kind = 0; }
        else if (cg < 1152) { boff = WS_QI; ld = 512; cofs = 640;  kind = 1; scale = 0.125f; }
        else if (cg < 1216) { boff = WS_KI; ld = 64;  cofs = 1152; kind = 1; }
        else if (cg < 1728) { boff = WS_QB; ld = 512; cofs = 1216; kind = 0; scale = QSCALE; }
        else if (cg < 2240) { boff = WS_KB; ld = 512; cofs = 1728; kind = 0; }
        else if (cg < 2752) { boff = WS_VB; ld = 512; cofs = 2240; kind = 0; }
        else if (cg < 3776) { boff = WS_GA; ld = 1024; cofs = 2752; kind = 2; }
        else if (cg < 4800) { boff = WS_GB; ld = 1024; cofs = 3776; kind = 2; }
        else if (cg == 4800) { kind = 3; }
        if (kind == 4) return;
        if (kind == 3) {
#pragma unroll
            for (int ai = 0; ai < 2; ++ai)
#pragma unroll
                for (int m = 0; m < 4; ++m) {
                    const int row = u.pm * 256 + ai * 128 + wr * 64 + m * 16 + fr;
                    const pg8::f32x4 v0 = acc[ai][BJ][m][0], v1 = acc[ai][BJ][m][1];
                    if (fq == 0) { float* wi = (float*)(ws + WS_WI) + (size_t)row * 8; const float s = 0.35355339059327373f; *(pg8::f32x4*)wi = v0 * s; *(pg8::f32x4*)(wi + 4) = v1 * s; }
                    else if (fq == 1) { float* lf = (float*)(ws + WS_LOGF) + (size_t)(row >> 12) * 8 * SEQ + (row & (SEQ - 1));
#pragma unroll
                        for (int i = 0; i < 8; ++i) { const float z = (i < 4 ? v0[i & 3] : v1[i & 3]) + bfg[i];
                            const float ls = z >= 0.f ? -log1pf(expf(-z)) : z - log1pf(expf(z)); lf[(size_t)i * SEQ] = ls; } }
                }
            return;
        }
        const bool rope = (kind == 1) && ((cg & 63) == 0);
        const bool isKB = (cg >= 1728) && (cg < 2240);
        bf16* base = (bf16*)(ws + boff);
        const int c0 = cg + 8 * fq - cofs;
#pragma unroll
        for (int ai = 0; ai < 2; ++ai)
#pragma unroll
            for (int m = 0; m < 4; ++m) {
                const int row = u.pm * 256 + ai * 128 + wr * 64 + m * 16 + fr;
                pg8::f32x4 v0 = acc[ai][BJ][m][0], v1 = acc[ai][BJ][m][1];
                if (rope) {
                    pg8::f32x4 o0, o1;
#pragma unroll
                    for (int i = 0; i < 4; ++i) { o0[i] = __shfl_xor(v0[i], 16); o1[i] = __shfl_xor(v1[i], 16); }
                    const pg8::f32x4 c0v = *(const pg8::f32x4*)(COS + (size_t)row * 8), c1v = *(const pg8::f32x4*)(COS + (size_t)row * 8 + 4);
                    const pg8::f32x4 s0v = *(const pg8::f32x4*)(SIN + (size_t)row * 8), s1v = *(const pg8::f32x4*)(SIN + (size_t)row * 8 + 4);
                    if (fq < 2) { const float sg = fq == 0 ? -1.f : 1.f; v0 = v0 * c0v + o0 * s0v * sg; v1 = v1 * c1v + o1 * s1v * sg; }
                }
                if (kind == 2) {
#pragma unroll
                    for (int i = 0; i < 4; ++i) { v0[i] = sigmoidf_(v0[i]); v1[i] = sigmoidf_(v1[i]); }
                }
                v0 = v0 * scale; v1 = v1 * scale;
                pg8::u32x4 w; w.x = cvtpk(v0[0], v0[1]); w.y = cvtpk(v0[2], v0[3]); w.z = cvtpk(v1[0], v1[1]); w.w = cvtpk(v1[2], v1[3]);
                *(pg8::u32x4*)(base + (size_t)row * ld + c0) = w;
                if (isKB) {
                    float ss = (v0[0] * v0[0] + v0[1] * v0[1]) + (v0[2] * v0[2] + v0[3] * v0[3]) + (v1[0] * v1[0] + v1[1] * v1[1]) + (v1[2] * v1[2] + v1[3] * v1[3]);
                    ss += __shfl_xor(ss, 16); ss += __shfl_xor(ss, 32);
                    if (fq == 0) atomicAdd((float*)(ws + WS_CTL) + CW_KN2 + ((size_t)(row >> 12) * 8 + ((cg - 1728) >> 6)) * SEQ + (row & (SEQ - 1)), ss);
                }
            }
    }
    __device__ __forceinline__ void operator()(const pg8::f32x4 (&acc)[2][2][4][2], const pg8::Unit& u, int wr, int wc, int fr, int fq) const {
        part<0>(acc, u, wr, wc, fr, fq); part<1>(acc, u, wr, wc, fr, fq);
    }
};
struct EpiMerge {
    static constexpr bool PERM = true, AFTER_DRAIN = false, CHAIN = true;
    unsigned char* ws; size_t dst_off;
    __device__ __forceinline__ bool chain(pg8::f32x4 (&acc)[2][2][4][2], const pg8::Unit& u, int wr, int wc, int fr, int fq) const {
        bf16* GA = (bf16*)(ws + WS_GA); const bf16* GB = (const bf16*)(ws + WS_GB);
        const int half = u.pn >> 2, pm = u.pm & 63, pn = u.pn & 3;
#pragma unroll
        for (int ai = 0; ai < 2; ++ai)
#pragma unroll
            for (int m = 0; m < 4; ++m) {
                const int row = pm * 256 + ai * 128 + wr * 64 + m * 16 + fr;
#pragma unroll
                for (int bj = 0; bj < 2; ++bj) {
                    const size_t off = (size_t)row * 1024 + pn * 256 + bj * 128 + wc * 32 + 8 * fq;
                    const pg8::u32x4 g = *(const pg8::u32x4*)(GB + off);
                    if (half == 0) {
                        const pg8::u32x4 a = *(const pg8::u32x4*)(GA + off);
                        pg8::f32x4 r0, r1;
                        r0[0] = bflo(a.x) * __builtin_amdgcn_rcpf(bflo(g.x)); r0[1] = bfhi(a.x) * __builtin_amdgcn_rcpf(bfhi(g.x)); r0[2] = bflo(a.y) * __builtin_amdgcn_rcpf(bflo(g.y)); r0[3] = bfhi(a.y) * __builtin_amdgcn_rcpf(bfhi(g.y));
                        r1[0] = bflo(a.z) * __builtin_amdgcn_rcpf(bflo(g.z)); r1[1] = bfhi(a.z) * __builtin_amdgcn_rcpf(bfhi(g.z)); r1[2] = bflo(a.w) * __builtin_amdgcn_rcpf(bflo(g.w)); r1[3] = bfhi(a.w) * __builtin_amdgcn_rcpf(bfhi(g.w));
                        acc[ai][bj][m][0] = acc[ai][bj][m][0] * r0; acc[ai][bj][m][1] = acc[ai][bj][m][1] * r1;
                    } else {
                        const pg8::f32x4 v0 = acc[ai][bj][m][0], v1 = acc[ai][bj][m][1];
                        pg8::u32x4 w; w.x = cvtpk(bflo(g.x) * v0[0], bfhi(g.x) * v0[1]); w.y = cvtpk(bflo(g.y) * v0[2], bfhi(g.y) * v0[3]);
                        w.z = cvtpk(bflo(g.z) * v1[0], bfhi(g.z) * v1[1]); w.w = cvtpk(bflo(g.w) * v1[2], bfhi(g.w) * v1[3]);
                        *(pg8::u32x4*)((bf16*)(ws + dst_off) + off) = w;
                    }
                }
            }
        return half == 0;
    }
    __device__ __forceinline__ void operator()(const pg8::f32x4 (&)[2][2][4][2], const pg8::Unit&, int, int, int, int) const {}
};
struct MergeOrder {
    pg8::StaticOrder S;
    __device__ __forceinline__ bool next(int i, pg8::Unit& u) const { if (!S.next(i >> 1, u)) return false; const int h = i & 1; u.pm += 64 * h; u.pn += 4 * h; return true; }
    __device__ __forceinline__ void a_ready(const pg8::Unit&) const {}
    __device__ __forceinline__ void done(const pg8::Unit&) const {}
};
struct EpiOut {
    static constexpr bool PERM = true, AFTER_DRAIN = false, CHAIN = false;
    unsigned char* ws; const float* x; float* out; bool stats;
    __device__ __forceinline__ void operator()(const pg8::f32x4 (&acc)[2][2][4][2], const pg8::Unit& u, int wr, int wc, int fr, int fq) const {
        const float* MOD = (const float*)(ws + WS_MOD); float* SSQ = (float*)(ws + WS_CTL) + CW_SSQ;
        const int b = u.pm >> 4;
        const int colb = u.pn * 256 + wc * 32 + 8 * fq;
        pg8::f32x4 gt[2][2];
#pragma unroll
        for (int bj = 0; bj < 2; ++bj) { gt[bj][0] = *(const pg8::f32x4*)(MOD + b * 6144 + 2048 + colb + bj * 128); gt[bj][1] = *(const pg8::f32x4*)(MOD + b * 6144 + 2048 + colb + bj * 128 + 4); }
#pragma unroll
        for (int ai = 0; ai < 2; ++ai)
#pragma unroll
            for (int m = 0; m < 4; ++m) {
                const int row = u.pm * 256 + ai * 128 + wr * 64 + m * 16 + fr; float ss = 0.f;
#pragma unroll
                for (int bj = 0; bj < 2; ++bj) {
                    const size_t off = (size_t)row * 1024 + colb + bj * 128;
                    const pg8::f32x4 x0 = *(const pg8::f32x4*)(x + off), x1 = *(const pg8::f32x4*)(x + off + 4);
                    const pg8::f32x4 y0 = x0 + gt[bj][0] * acc[ai][bj][m][0], y1 = x1 + gt[bj][1] * acc[ai][bj][m][1];
                    *(pg8::f32x4*)(out + off) = y0; *(pg8::f32x4*)(out + off + 4) = y1;
                    ss += (y0[0] * y0[0] + y0[1] * y0[1]) + (y0[2] * y0[2] + y0[3] * y0[3]) + (y1[0] * y1[0] + y1[1] * y1[1]) + (y1[2] * y1[2] + y1[3] * y1[3]);
                }
                ss += __shfl_xor(ss, 16); ss += __shfl_xor(ss, 32);
                if (fq == 0 && stats) atomicAdd(SSQ + row, ss);
            }
    }
};
struct EpiGU {
    static constexpr bool PERM = true, AFTER_DRAIN = false, CHAIN = false;
    unsigned char* ws;
    __device__ __forceinline__ void operator()(const pg8::f32x4 (&acc)[2][2][4][2], const pg8::Unit& u, int wr, int wc, int fr, int fq) const {
        bf16* HID = (bf16*)(ws + WS_HID);
        const int col = (u.pn & 3) * 128 + wc * 32 + 8 * fq;
#pragma unroll
        for (int ai = 0; ai < 2; ++ai)
#pragma unroll
            for (int m = 0; m < 4; ++m) {
                const int row = u.pm * 256 + ai * 128 + wr * 64 + m * 16 + fr;
                float r[8];
#pragma unroll
                for (int i = 0; i < 8; ++i) { const float g = i < 4 ? acc[ai][0][m][0][i] : acc[ai][0][m][1][i - 4]; const float up = i < 4 ? acc[ai][1][m][0][i] : acc[ai][1][m][1][i - 4];
                    r[i] = g * sigmoidf_(g) * up; }
                pg8::u32x4 w; w.x = cvtpk(r[0], r[1]); w.y = cvtpk(r[2], r[3]); w.z = cvtpk(r[4], r[5]); w.w = cvtpk(r[6], r[7]);
                *(pg8::u32x4*)(HID + (size_t)row * 512 + col) = w;
            }
    }
};
struct EpiDown {
    static constexpr bool PERM = true, AFTER_DRAIN = false, CHAIN = false;
    unsigned char* ws; const volatile LAS unsigned* LX;
    __device__ __forceinline__ void operator()(const pg8::f32x4 (&acc)[2][2][4][2], const pg8::Unit& u, int wr, int wc, int fr, int fq) const {
        bf16* YC = (bf16*)(ws + WS_YC); const int* TOKSLOT = (const int*)(ws + WS_TOKSLOT); const float* WROW = (const float*)(ws + WS_WROW);
        const int colb = (u.pn & 3) * 256 + wc * 32 + 8 * fq;
        const int e = u.pn >> 2; const int lbase = (u.pm - (int)(LX[96 + e] >> 8)) * 256, cnt = (int)LX[320 + e];
#pragma unroll
        for (int ai = 0; ai < 2; ++ai)
#pragma unroll
            for (int m = 0; m < 4; ++m) {
                const int local = lbase + ai * 128 + wr * 64 + m * 16 + fr;
                if (local < cnt) {
                    const int ts = TOKSLOT[e * ECAP + local]; const float gw = WROW[e * ECAP + local];
#pragma unroll
                    for (int bj = 0; bj < 2; ++bj) { const pg8::f32x4 v0 = acc[ai][bj][m][0] * gw, v1 = acc[ai][bj][m][1] * gw;
                        pg8::u32x4 w; w.x = cvtpk(v0[0], v0[1]); w.y = cvtpk(v0[2], v0[3]); w.z = cvtpk(v1[0], v1[1]); w.w = cvtpk(v1[2], v1[3]);
                        *(pg8::u32x4*)(YC + (size_t)ts * 1024 + colb + bj * 128) = w; }
                }
            }
    }
};
struct MoeRowMap {
    const int* TOKSLOT; const volatile LAS unsigned* LX;
    __device__ __forceinline__ unsigned rowoff(const pg8::Unit& u, int r) const {
        const int e = u.pn >> 2; const int local = (u.pm - (int)(LX[96 + e] >> 8)) * 256 + r;
        const int tok = local < (int)LX[320 + e] ? (TOKSLOT[e * ECAP + local] >> 1) : 0;
        return (unsigned)tok * (unsigned)(D * 2);
    }
};
struct MoeOrder {
    int G, c, nunits; const volatile LAS unsigned* tile_e;
    __device__ __forceinline__ bool next(int i, pg8::Unit& u) const { const int L = i * G + c; if (L >= nunits) return false; const int rt = L >> 2; u.pm = rt; u.pn = (int)tile_e[rt] * 4 + (L & 3); return true; }
    __device__ __forceinline__ void a_ready(const pg8::Unit&) const {}
    __device__ __forceinline__ void done(const pg8::Unit&) const {}
};
__device__ __forceinline__ void moe_table(Frame& F) {
    const gu32* CNT = F.ctl + CW_CNT;
    if (F.tid == 0) { unsigned p = 0;
        for (int e = 0; e < 32; ++e) { F.LX[96 + e] = p; const unsigned c = __hip_atomic_load(CNT + e, RLX_AGENT); F.LX[320 + e] = c; const unsigned nt = (c + 255u) >> 8;
            for (unsigned t = 0; t < nt; ++t) if ((p >> 8) + t < (unsigned)NTMAX) F.LX[160 + (p >> 8) + t] = (unsigned)e;
            p += nt << 8; }
        F.LX[128] = p; F.LX[132] = (p >> 8) < (unsigned)NTMAX ? (p >> 8) : (unsigned)NTMAX; }
    __syncthreads();
}
#ifndef DUP_MASK
#define DUP_MASK 0
#endif
typedef short v4i16_t __attribute__((ext_vector_type(4)));
__device__ __forceinline__ s16x4 trread(LAS const unsigned char* p) { return __builtin_bit_cast(s16x4, __builtin_amdgcn_ds_read_tr16_b64_v4i16((LAS v4i16_t*)p)); }
constexpr int FX_CK = 0, FX_K = 16384, FX_V = 32768, FX_VROW = 144, FX_VBUF = 64 * FX_VROW;
__device__ __forceinline__ float xhalf(float v, int hi) { const auto rr = __builtin_amdgcn_permlane32_swap(__float_as_uint(v), __float_as_uint(v), false, false); return __uint_as_float(hi ? rr[0] : rr[1]); }
__device__ __forceinline__ void fox_tile(LAS unsigned char* L, LAS float* CK, int cur, int t, int r32, int hi, int lane, int q, int qminw,
                                         const pg8::bf16x8 (&qf)[4], float& m_run, float& l_run, f32x16& o0, f32x16& o1) {
    LAS const unsigned char* Kb = L + FX_K + cur * 8192; LAS const unsigned char* Vb = L + FX_V + cur * FX_VBUF;
    f32x16 p0, p1;
#pragma unroll
    for (int rq = 0; rq < 4; ++rq) { const f32x4 c0 = *(LAS const f32x4*)(CK + 64 * t + 8 * rq + 4 * hi), c1 = *(LAS const f32x4*)(CK + 64 * t + 32 + 8 * rq + 4 * hi);
#pragma unroll
        for (int i = 0; i < 4; ++i) { p0[4 * rq + i] = c0[i]; p1[4 * rq + i] = c1[i]; } }
#pragma unroll
    for (int d0 = 0; d0 < 4; ++d0) {
        const int co = ((2 * d0 + hi) ^ (r32 & 7)) * 16;
        const pg8::bf16x8 a0 = *(LAS const pg8::bf16x8*)(Kb + r32 * 128 + co);
        const pg8::bf16x8 a1 = *(LAS const pg8::bf16x8*)(Kb + (r32 + 32) * 128 + co);
        p0 = MFMA32(a0, qf[d0], p0); p1 = MFMA32(a1, qf[d0], p1);
    }
    if (64 * t + 63 > qminw) {
#pragma unroll
        for (int r = 0; r < 16; ++r) { const int key = 64 * t + (r & 3) + 8 * (r >> 2) + 4 * hi; if (key > q) p0[r] = -1e30f; if (key + 32 > q) p1[r] = -1e30f; } }
    float mx = p0[0];
#pragma unroll
    for (int r = 1; r < 16; ++r) mx = fmaxf(mx, p0[r]);
#pragma unroll
    for (int r = 0; r < 16; ++r) mx = fmaxf(mx, p1[r]);
    mx = fmaxf(mx, xhalf(mx, hi));
    const float mnew = fmaxf(m_run, mx), alpha = __builtin_amdgcn_exp2f(m_run - mnew); m_run = mnew;
    float rs = 0.f;
#pragma unroll
    for (int r = 0; r < 16; ++r) { p0[r] = __builtin_amdgcn_exp2f(p0[r] - mnew); p1[r] = __builtin_amdgcn_exp2f(p1[r] - mnew); rs += p0[r] + p1[r]; }
    rs += xhalf(rs, hi);
    l_run = l_run * alpha + rs;
#pragma unroll
    for (int r = 0; r < 16; ++r) { o0[r] *= alpha; o1[r] *= alpha; }
    pg8::bf16x8 pb[4];
#pragma unroll
    for (int s = 0; s < 2; ++s) { v4u w;
        w.x = cvtpk(p0[8 * s], p0[8 * s + 1]); w.y = cvtpk(p0[8 * s + 2], p0[8 * s + 3]); w.z = cvtpk(p0[8 * s + 4], p0[8 * s + 5]); w.w = cvtpk(p0[8 * s + 6], p0[8 * s + 7]); pb[s] = __builtin_bit_cast(pg8::bf16x8, w);
        w.x = cvtpk(p1[8 * s], p1[8 * s + 1]); w.y = cvtpk(p1[8 * s + 2], p1[8 * s + 3]); w.z = cvtpk(p1[8 * s + 4], p1[8 * s + 5]); w.w = cvtpk(p1[8 * s + 6], p1[8 * s + 7]); pb[2 + s] = __builtin_bit_cast(pg8::bf16x8, w); }
    LAS const unsigned char* vb = Vb + (4 * hi + ((lane & 15) >> 2)) * FX_VROW + (16 * ((lane >> 4) & 1) + 4 * (lane & 3)) * 2;
#pragma unroll
    for (int s = 0; s < 4; ++s) {
        const s16x4 l0 = trread(vb + (16 * s) * FX_VROW), h0 = trread(vb + (16 * s + 8) * FX_VROW);
        const s16x4 l1 = trread(vb + (16 * s) * FX_VROW + 64), h1 = trread(vb + (16 * s + 8) * FX_VROW + 64);
        const pg8::bf16x8 a0 = {l0[0], l0[1], l0[2], l0[3], h0[0], h0[1], h0[2], h0[3]};
        const pg8::bf16x8 a1 = {l1[0], l1[1], l1[2], l1[3], h1[0], h1[1], h1[2], h1[3]};
        o0 = MFMA32(a0, pb[s], o0); o1 = MFMA32(a1, pb[s], o1);
    }
}
constexpr int FX_PM = 51200;
constexpr float FX_SKIP = 64.f;
__device__ __forceinline__ void fox_unit(Frame& F, int b, int h, int qb) {
    const int tid = F.tid, lane = F.lane, wave = F.wave, r32 = lane & 31, hi = lane >> 5;
    LAS unsigned char* L = F.ldsl + RING_OFF;
    LAS float* CK = (LAS float*)(L + FX_CK); LAS float* PM = (LAS float*)(L + FX_PM);
    const int nkeys = (qb + 1) * 256, NT = nkeys / 64;
    const bf16* QBp = (const bf16*)(F.ws + WS_QB); const bf16* KBp = (const bf16*)(F.ws + WS_KB); const bf16* VBp = (const bf16*)(F.ws + WS_VB);
    __syncthreads();
    {
        const float* lf = (const float*)(F.ws + WS_LOGF) + (size_t)(b * 8 + h) * SEQ;
        const float* kn = (const float*)(F.ws + WS_CTL) + CW_KN2 + (size_t)(b * 8 + h) * SEQ;
        float v[8]; const int k0 = tid * 8; float pm = 0.f;
        if (k0 < nkeys) { const f32x4 a = *(const f32x4*)(lf + k0), c = *(const f32x4*)(lf + k0 + 4); v[0] = a.x; v[1] = a.y; v[2] = a.z; v[3] = a.w; v[4] = c.x; v[5] = c.y; v[6] = c.z; v[7] = c.w;
            const f32x4 n0 = *(const f32x4*)(kn + k0), n1 = *(const f32x4*)(kn + k0 + 4); pm = fmaxf(fmaxf(fmaxf(n0.x, n0.y), fmaxf(n0.z, n0.w)), fmaxf(fmaxf(n1.x, n1.y), fmaxf(n1.z, n1.w))); }
        else {
#pragma unroll
            for (int i = 0; i < 8; ++i) v[i] = 0.f; }
#pragma unroll
        for (int i = 1; i < 8; ++i) v[i] += v[i - 1];
        const float tot = v[7]; float sc = tot;
#pragma unroll
        for (int o = 1; o < 64; o <<= 1) { const float t = __shfl_up(sc, o); if (lane >= o) sc += t; const float u = __shfl_up(pm, o); if (lane >= o) pm = fmaxf(pm, u); }
        if (lane == 63) { F.LX[8 + wave] = __float_as_uint(sc); F.LX[24 + wave] = __float_as_uint(pm); }
        __syncthreads();
        float woff = 0.f, cref = 0.f, pmo = 0.f;
#pragma unroll
        for (int w = 0; w < 8; ++w) { const float t = __uint_as_float(F.LX[8 + w]); cref += t; if (w < wave) { woff += t; pmo = fmaxf(pmo, __uint_as_float(F.LX[24 + w])); } }
        const float base = woff + sc - tot;
        if (k0 < nkeys) {
#pragma unroll
            for (int i = 0; i < 8; ++i) CK[k0 + i] = (cref - (base + v[i])) * LOG2E; }
        PM[tid] = fmaxf(pm, pmo);
    }
    const size_t qrow = (size_t)b * SEQ + qb * 256 + wave * 32 + r32;
    pg8::bf16x8 qf[4]; float qn = 0.f;
#pragma unroll
    for (int d0 = 0; d0 < 4; ++d0) { qf[d0] = *(const pg8::bf16x8*)(QBp + qrow * 512 + h * 64 + d0 * 16 + hi * 8);
#pragma unroll
        for (int j = 0; j < 8; ++j) { const float e = __uint_as_float((unsigned)(unsigned short)qf[d0][j] << 16); qn += e * e; } }
    qn += xhalf(qn, hi); qn = sqrtf(qn) * 1.02f;
    float m_run = -1e30f, l_run = 0.f; f32x16 o0 = {}, o1 = {};
    const int kr = tid >> 3, ch = tid & 7;
    const bf16* Kg = KBp + ((size_t)b * SEQ + kr) * 512 + h * 64 + ch * 8;
    const bf16* Vg = VBp + ((size_t)b * SEQ + kr) * 512 + h * 64 + ch * 8;
    const int kwo = FX_K + kr * 128 + ((ch ^ (kr & 7)) * 16), vwo = FX_V + kr * FX_VROW + ch * 16;
#define FOX_TILE_OFF(i) ((size_t)(NT - 1 - (i)) * 64 * 512)
    v4u kr0 = *(const v4u*)(Kg + FOX_TILE_OFF(0)), vr0 = *(const v4u*)(Vg + FOX_TILE_OFF(0)), kr1 = kr0, vr1 = vr0, kr2 = kr0, vr2 = vr0;
    if (1 < NT) { kr1 = *(const v4u*)(Kg + FOX_TILE_OFF(1)); vr1 = *(const v4u*)(Vg + FOX_TILE_OFF(1)); }
    if (2 < NT) { kr2 = *(const v4u*)(Kg + FOX_TILE_OFF(2)); vr2 = *(const v4u*)(Vg + FOX_TILE_OFF(2)); }
    *(LAS v4u*)(L + kwo) = kr0; *(LAS v4u*)(L + vwo) = vr0;
    __syncthreads();
    const int qminw = qb * 256 + wave * 32, qmaxw = qminw + 31, q = qminw + r32;
    bool stop = false;
#define FOX_STEP(i, KRF, VRF, KRN, VRN) do { \
        const int cur = (i) & 1, t_ = NT - 1 - (i); \
        if ((i) + 3 < NT) { KRF = *(const v4u*)(Kg + FOX_TILE_OFF((i) + 3)); VRF = *(const v4u*)(Vg + FOX_TILE_OFF((i) + 3)); } \
        bool done_ = false; \
        if (64 * t_ <= qmaxw) { fox_tile(L, CK, cur, t_, r32, hi, lane, q, qminw, qf, m_run, l_run, o0, o1); \
            if (t_ > 0) { const float bnd_ = qn * sqrtf(PM[8 * t_ - 1]) + CK[64 * t_ - 1]; done_ = __all(bnd_ < m_run - FX_SKIP); } } \
        if (lane == 0) F.LX[40 + cur * 8 + wave] = done_ ? 1u : 0u; \
        if ((i) + 1 < NT) { const int nb = cur ^ 1; *(LAS v4u*)(L + kwo + nb * 8192) = KRN; *(LAS v4u*)(L + vwo + nb * FX_VBUF) = VRN; } \
        __syncthreads(); \
        { unsigned all_ = 1u; _Pragma("unroll") for (int w_ = 0; w_ < 8; ++w_) all_ &= F.LX[40 + cur * 8 + w_]; stop = all_ != 0u; } } while (0)
    for (int i = 0; i < NT && !stop; i += 3) {
        FOX_STEP(i, kr0, vr0, kr1, vr1);
        if (!stop && i + 1 < NT) FOX_STEP(i + 1, kr1, vr1, kr2, vr2);
        if (!stop && i + 2 < NT) FOX_STEP(i + 2, kr2, vr2, kr0, vr0);
    }
#undef FOX_STEP
#undef FOX_TILE_OFF
    const float inv = 1.f / l_run;
    bf16* Op = (bf16*)(F.ws + WS_OB) + qrow * 512 + h * 64;
#pragma unroll
    for (int rq = 0; rq < 4; ++rq) {
        const unsigned long long w0 = (unsigned long long)cvtpk(o0[4 * rq] * inv, o0[4 * rq + 1] * inv) | ((unsigned long long)cvtpk(o0[4 * rq + 2] * inv, o0[4 * rq + 3] * inv) << 32);
        const unsigned long long w1 = (unsigned long long)cvtpk(o1[4 * rq] * inv, o1[4 * rq + 1] * inv) | ((unsigned long long)cvtpk(o1[4 * rq + 2] * inv, o1[4 * rq + 3] * inv) << 32);
        *(unsigned long long*)(Op + 8 * rq + 4 * hi) = w0; *(unsigned long long*)(Op + 32 + 8 * rq + 4 * hi) = w1;
    }
}
__device__ __forceinline__ void hist_pick(LAS unsigned* hist, int lane, unsigned target, unsigned& bsel_o, unsigned& cge_o, unsigned& cb_o) {
    const v4u hv = *(LAS const v4u*)(hist + 4 * lane);
    *(LAS v4u*)(hist + 4 * lane) = (v4u){0u, 0u, 0u, 0u};
    const unsigned sl = hv.x + hv.y + hv.z + hv.w;
    unsigned suf = sl;
#pragma unroll
    for (int o = 1; o < 64; o <<= 1) { const unsigned t = __shfl_down(suf, o); if (lane + o < 64) suf += t; }
    const unsigned above = suf - sl;
    const bool here = (suf >= target) && (above < target);
    unsigned bsel = 0u, cge = 0u, cb = 0u;
    if (here) {
        if (above + hv.w >= target) { bsel = 4 * lane + 3; cge = above + hv.w; cb = hv.w; }
        else if (above + hv.w + hv.z >= target) { bsel = 4 * lane + 2; cge = above + hv.w + hv.z; cb = hv.z; }
        else if (above + hv.w + hv.z + hv.y >= target) { bsel = 4 * lane + 1; cge = above + hv.w + hv.z + hv.y; cb = hv.y; }
        else { bsel = 4 * lane; cge = suf; cb = hv.x; } }
    const unsigned long long mh = __ballot(here);
    const int src = mh ? (int)__builtin_ctzll(mh) : 0;
    bsel_o = (unsigned)__shfl((int)bsel, src); cge_o = (unsigned)__shfl((int)cge, src); cb_o = (unsigned)__shfl((int)cb, src);
}
template <int NJ>
__device__ __forceinline__ void dsa_select(LAS const unsigned* sr, LAS unsigned* hist, LAS int* SEL, int nj, int lane) {
    unsigned key[NJ];
#pragma unroll
    for (int j = 0; j < NJ; ++j) { unsigned u = 0u; if (j < NJ - 16 || j < nj) u = sr[64 * j + lane]; key[j] = u; }
    unsigned T = 0u; int nge = 0;
    {
        unsigned b1, cge1, c1;
        hist_pick(hist, lane, 256u, b1, cge1, c1);
        T = b1 << 24; nge = (int)cge1;
        unsigned above = cge1 - c1;
#pragma unroll
        for (int sh = 16; sh >= 8; sh -= 8) {
            if (nge != 256) {
                const unsigned pre = T >> (sh + 8);
#pragma unroll
                for (int j = 0; j < NJ; ++j) if ((key[j] >> (sh + 8)) == pre) __hip_atomic_fetch_add(hist + ((key[j] >> sh) & 255u), 1u, __ATOMIC_RELAXED, __HIP_MEMORY_SCOPE_WORKGROUP);
                asm volatile("s_waitcnt lgkmcnt(0)" ::: "memory");
                unsigned b2, cge2, c2;
                hist_pick(hist, lane, 256u - above, b2, cge2, c2);
                T |= b2 << sh; nge = (int)(above + cge2); above += cge2 - c2;
            }
        }
    }
    for (int bit = 7; bit >= 0 && nge != 256; --bit) {
        const unsigned cand = T | (1u << bit); unsigned cl = 0u;
#pragma unroll
        for (int j = 0; j < NJ; ++j) cl += (key[j] >= cand) ? 1u : 0u;
        int cnt = 0;
#pragma unroll
        for (int bb = 0; bb < 7; ++bb) cnt += __popcll(__ballot(((cl >> bb) & 1u) != 0u)) << bb;
        if (cnt >= 256) { T = cand; nge = cnt; }
    }
    if (nge == 256) {
        unsigned cl = 0u;
#pragma unroll
        for (int j = 0; j < NJ; ++j) cl += (key[j] >= T) ? 1u : 0u;
        int p = 0;
#pragma unroll
        for (int bb = 0; bb < 7; ++bb) { const unsigned long long mk = __ballot(((cl >> bb) & 1u) != 0u);
            p += (int)__builtin_amdgcn_mbcnt_hi((unsigned)(mk >> 32), __builtin_amdgcn_mbcnt_lo((unsigned)mk, 0u)) << bb; }
#pragma unroll
        for (int j = 0; j < NJ; ++j) if (key[j] >= T) { SEL[p & 255] = 64 * j + lane; ++p; }
    } else {
        int ngt = 0;
#pragma unroll
        for (int j = 0; j < NJ; ++j) ngt += __popcll(__ballot(key[j] > T));
        const int need_eq = 256 - ngt; int pos = 0, eq_seen = 0;
#pragma unroll
        for (int j = 0; j < NJ; ++j) {
            const bool gt = key[j] > T, eq = key[j] == T;
            const unsigned long long meq = __ballot(eq);
            const int eq_rank = eq_seen + (int)__builtin_amdgcn_mbcnt_hi((unsigned)(meq >> 32), __builtin_amdgcn_mbcnt_lo((unsigned)meq, 0u));
            const bool take = gt || (eq && eq_rank < need_eq);
            const unsigned long long mt = __ballot(take);
            const int pr = (int)__builtin_amdgcn_mbcnt_hi((unsigned)(mt >> 32), __builtin_amdgcn_mbcnt_lo((unsigned)mt, 0u));
            if (take && pos + pr < 256) SEL[pos + pr] = 64 * j + lane;
            pos += __popcll(mt); eq_seen += __popcll(meq);
        }
    }
}
template <bool FULL>
__device__ __forceinline__ void dsa_attend(Frame& F, LAS unsigned char* L, LAS int* SEL, int b, size_t qrow, int nsel) {
    const int lane = F.lane, wave = F.wave;
    const bf16* QA = (const bf16*)(F.ws + WS_QA); const bf16* KA = (const bf16*)(F.ws + WS_KA); const bf16* VA = (const bf16*)(F.ws + WS_VA);
    const int n = lane & 15, kg = lane >> 4;
    pg8::bf16x8 qf[2];
#pragma unroll
    for (int s = 0; s < 2; ++s) { qf[s] = (pg8::bf16x8){0, 0, 0, 0, 0, 0, 0, 0}; if (n < 8) qf[s] = *(const pg8::bf16x8*)(QA + qrow * 512 + n * 64 + 32 * s + 8 * kg); }
    const int ntile = FULL ? 16 : (nsel >> 4);
    const bf16* vgb = VA + (size_t)b * SEQ * 64 + 8 * (lane & 7);
    LAS unsigned char* VS = L + wave * 16384;
    const int nsc = FULL ? 8 : (nsel >> 5);
#define DSA_DMAV(sc, slot) do { _Pragma("unroll") for (int i_ = 0; i_ < 4; ++i_) { const int idx_ = SEL[32 * (sc) + 8 * i_ + (lane >> 3)]; \
        __builtin_amdgcn_global_load_lds((const unsigned*)(vgb + (size_t)idx_ * 64), (LAS unsigned*)(VS + (slot) * 4096 + i_ * 1024), 16, 0, 0); } } while (0)
#define DSA_PV(slot, sc) do { _Pragma("unroll") for (int dt_ = 0; dt_ < 4; ++dt_) { \
        const s16x4 lo_ = trread(vb + (slot) * 4096 + dt_ * 32), hh_ = trread(vb + (slot) * 4096 + 16 * 128 + dt_ * 32); \
        const pg8::bf16x8 a_ = {lo_[0], lo_[1], lo_[2], lo_[3], hh_[0], hh_[1], hh_[2], hh_[3]}; \
        o[dt_] = MFMA16(a_, pb[(sc)], o[dt_]); } } while (0)
    DSA_DMAV(0, 0); DSA_DMAV(1, 1);
    if (FULL || nsc > 2) { DSA_DMAV(2, 2); DSA_DMAV(3, 3); }
    f32x4 x[16];
#pragma unroll
    for (int t = 0; t < 16; ++t) {
        x[t] = (f32x4){-1e30f, -1e30f, -1e30f, -1e30f};
        if (FULL || t < ntile) { const int idx = SEL[16 * t + n]; const bf16* kp = KA + ((size_t)b * SEQ + idx) * 64 + 8 * kg;
            const pg8::bf16x8 a0 = *(const pg8::bf16x8*)kp, a1 = *(const pg8::bf16x8*)(kp + 32);
            f32x4 z = {0.f, 0.f, 0.f, 0.f}; z = MFMA16(a0, qf[0], z); z = MFMA16(a1, qf[1], z); x[t] = z; }
    }
    float mx = -1e30f;
#pragma unroll
    for (int t = 0; t < 16; ++t) mx = fmaxf(fmaxf(mx, fmaxf(x[t][0], x[t][1])), fmaxf(x[t][2], x[t][3]));
    mx = fmaxf(mx, __shfl_xor(mx, 16)); mx = fmaxf(mx, __shfl_xor(mx, 32));
    float ls = 0.f;
#pragma unroll
    for (int t = 0; t < 16; ++t) {
#pragma unroll
        for (int i = 0; i < 4; ++i) { x[t][i] = __builtin_amdgcn_exp2f(x[t][i] - mx); ls += x[t][i]; } }
    ls += __shfl_xor(ls, 16); ls += __shfl_xor(ls, 32);
    pg8::bf16x8 pb[8];
#pragma unroll
    for (int s = 0; s < 8; ++s) { v4u w; w.x = cvtpk(x[2 * s][0], x[2 * s][1]); w.y = cvtpk(x[2 * s][2], x[2 * s][3]); w.z = cvtpk(x[2 * s + 1][0], x[2 * s + 1][1]); w.w = cvtpk(x[2 * s + 1][2], x[2 * s + 1][3]); pb[s] = __builtin_bit_cast(pg8::bf16x8, w); }
    f32x4 o[4];
#pragma unroll
    for (int dt = 0; dt < 4; ++dt) o[dt] = (f32x4){0.f, 0.f, 0.f, 0.f};
    LAS const unsigned char* vb = VS + (4 * kg + (n >> 2)) * 128 + (4 * (n & 3)) * 2;
    asm volatile("s_waitcnt vmcnt(0)" ::: "memory");
    DSA_PV(0, 0); asm volatile("s_waitcnt lgkmcnt(0)" ::: "memory"); if (FULL || nsc > 4) DSA_DMAV(4, 0);
    DSA_PV(1, 1); asm volatile("s_waitcnt lgkmcnt(0)" ::: "memory"); if (FULL || nsc > 4) DSA_DMAV(5, 1);
    if (FULL || nsc > 2) {
        DSA_PV(2, 2); asm volatile("s_waitcnt lgkmcnt(0)" ::: "memory"); if (FULL || nsc > 6) DSA_DMAV(6, 2);
        DSA_PV(3, 3); asm volatile("s_waitcnt lgkmcnt(0)" ::: "memory"); if (FULL || nsc > 6) DSA_DMAV(7, 3);
    }
    if (FULL || nsc > 4) {
        asm volatile("s_waitcnt vmcnt(0)" ::: "memory");
        DSA_PV(0, 4); DSA_PV(1, 5);
        if (FULL || nsc > 6) { DSA_PV(2, 6); DSA_PV(3, 7); }
    }
    asm volatile("s_waitcnt lgkmcnt(0)" ::: "memory");
#undef DSA_DMAV
#undef DSA_PV
    if (n < 8) { const float inv = 1.f / ls; bf16* Op = (bf16*)(F.ws + WS_OA) + qrow * 512 + n * 64 + 4 * kg;
#pragma unroll
        for (int dt = 0; dt < 4; ++dt) *(unsigned long long*)(Op + 16 * dt) = (unsigned long long)cvtpk(o[dt][0] * inv, o[dt][1] * inv) | ((unsigned long long)cvtpk(o[dt][2] * inv, o[dt][3] * inv) << 32); }
}
constexpr int DS_VROW = 144, DS_VBUF = 64 * DS_VROW;
__device__ __forceinline__ void dsa_unit(Frame& F, int b, int c, int g) {
    const int lane = F.lane, wave = F.wave;
    LAS unsigned char* L = F.ldsl + RING_OFF;
    LAS float* SC = (LAS float*)L;
    LAS int* SEL = (LAS int*)(F.ldsl + SEL_OFF) + wave * 256;
    const int q0 = c * 64 + g * 8, Kn = (c + 1) * 64;
    const bf16* QI = (const bf16*)(F.ws + WS_QI); const bf16* KI = (const bf16*)(F.ws + WS_KI); const float* WI = (const float*)(F.ws + WS_WI);
    const bf16* QA = (const bf16*)(F.ws + WS_QA); const bf16* KA = (const bf16*)(F.ws + WS_KA); const bf16* VA = (const bf16*)(F.ws + WS_VA);
    __syncthreads();
    for (int repa_ = 0; repa_ <= ((DUP_MASK >> 12) & 1); ++repa_) {
        const int m = lane & 31, hi = lane >> 5;
        const int q4 = 2 * ((m >> 2) & 1) + (m >> 4), head = (m & 3) + 4 * ((m >> 3) & 1);
        pg8::bf16x8 af[2][4]; float wq[2][16];
#pragma unroll
        for (int mt = 0; mt < 2; ++mt) {
            const size_t arow = (size_t)b * SEQ + q0 + 4 * mt + q4;
#pragma unroll
            for (int s = 0; s < 4; ++s) af[mt][s] = *(const pg8::bf16x8*)(QI + arow * 512 + head * 64 + 16 * s + 8 * hi);
            const size_t wrow = (size_t)b * SEQ + q0 + 4 * mt + 2 * hi;
#pragma unroll
            for (int j = 0; j < 4; ++j) { const f32x4 t = *(const f32x4*)(WI + wrow * 8 + 4 * j); wq[mt][4 * j] = t.x; wq[mt][4 * j + 1] = t.y; wq[mt][4 * j + 2] = t.z; wq[mt][4 * j + 3] = t.w; }
        }
        const int nkt = Kn / 32;
        const bf16* kbase = KI + ((size_t)b * SEQ + m) * 64 + 8 * hi;
        LAS unsigned* sp = (LAS unsigned*)SC + (2 * hi) * 4096 + m;
        LAS unsigned* hp = (LAS unsigned*)(F.ldsl + HIST_OFF) + (2 * hi) * 256;
#define DSA_LOADK(dst, kt) do { _Pragma("unroll") for (int s_ = 0; s_ < 4; ++s_) dst[s_] = *(const pg8::bf16x8*)(kbase + (size_t)(kt) * 32 * 64 + 16 * s_); } while (0)
#define DSA_TILE(src, kt) do { _Pragma("unroll") for (int mt_ = 0; mt_ < 2; ++mt_) { f32x16 acc_ = {}; \
            _Pragma("unroll") for (int s_ = 0; s_ < 4; ++s_) acc_ = MFMA32(af[mt_][s_], src[s_], acc_); \
            float s0_ = 0.f, s1_ = 0.f; \
            _Pragma("unroll") for (int r_ = 0; r_ < 8; ++r_) { s0_ += wq[mt_][r_] * fmaxf(acc_[r_], 0.f); s1_ += wq[mt_][8 + r_] * fmaxf(acc_[8 + r_], 0.f); } \
            unsigned u0_ = __float_as_uint(s0_ + 0.f), u1_ = __float_as_uint(s1_ + 0.f); u0_ = (u0_ >> 31) ? ~u0_ : (u0_ | 0x80000000u); u1_ = (u1_ >> 31) ? ~u1_ : (u1_ | 0x80000000u); \
            sp[(4 * mt_) * 4096 + 32 * (kt)] = u0_; sp[(4 * mt_ + 1) * 4096 + 32 * (kt)] = u1_; \
            __hip_atomic_fetch_add(hp + (4 * mt_) * 256 + (u0_ >> 24), 1u, __ATOMIC_RELAXED, __HIP_MEMORY_SCOPE_WORKGROUP); \
            __hip_atomic_fetch_add(hp + (4 * mt_ + 1) * 256 + (u1_ >> 24), 1u, __ATOMIC_RELAXED, __HIP_MEMORY_SCOPE_WORKGROUP); } } while (0)
        pg8::bf16x8 bA[4], bB[4];
        if (wave < nkt) DSA_LOADK(bA, wave);
        if (wave + 8 < nkt) DSA_LOADK(bB, wave + 8);
        for (int kt = wave; kt < nkt; kt += 16) {
            DSA_TILE(bA, kt);
            if (kt + 16 < nkt) DSA_LOADK(bA, kt + 16);
            if (kt + 8 < nkt) { DSA_TILE(bB, kt + 8); if (kt + 24 < nkt) DSA_LOADK(bB, kt + 24); }
        }
#undef DSA_LOADK
#undef DSA_TILE
    }
    __syncthreads();
    int nsel;
    for (int repb_ = 0; repb_ <= ((DUP_MASK >> 13) & 1); ++repb_)
    if (Kn <= 256) { nsel = Kn; for (int i = lane; i < Kn; i += 64) SEL[i] = i; *(LAS v4u*)((LAS unsigned*)(F.ldsl + HIST_OFF) + wave * 256 + 4 * lane) = (v4u){0u, 0u, 0u, 0u}; }
    else {
        nsel = 256;
        LAS const unsigned* sr = (LAS const unsigned*)SC + wave * 4096; LAS unsigned* hs = (LAS unsigned*)(F.ldsl + HIST_OFF) + wave * 256;
        const int nj = Kn >> 6;
        if (nj <= 16) dsa_select<16>(sr, hs, SEL, nj, lane);
        else if (nj <= 32) dsa_select<32>(sr, hs, SEL, nj, lane);
        else if (nj <= 48) dsa_select<48>(sr, hs, SEL, nj, lane);
        else dsa_select<64>(sr, hs, SEL, nj, lane);
    }
    asm volatile("s_waitcnt lgkmcnt(0)" ::: "memory");
    for (int repc_ = 0; repc_ <= ((DUP_MASK >> 14) & 1); ++repc_) {
        const size_t qrow = (size_t)b * SEQ + q0 + wave;
        if (nsel == 256) dsa_attend<true>(F, L, SEL, b, qrow, nsel); else dsa_attend<false>(F, L, SEL, b, qrow, nsel);
    }
}
__device__ __forceinline__ void p3_fox(Frame& F) {
    for (int v = F.vcu; v < 256; v += F.G) {
        const int bh = v >> 3, s = v & 7;
        fox_unit(F, bh >> 3, bh & 7, 15 - s);
        fox_unit(F, bh >> 3, bh & 7, s);
    }
}
__device__ __forceinline__ void p3_dsa(Frame& F) {
    for (int i = F.tid; i < 2048; i += NWAVES * 64) ((LAS unsigned*)(F.ldsl + HIST_OFF))[i] = 0u;
    __syncthreads();
    for (int v = F.vcu; v < 256; v += F.G) {
        const int b = v >> 6, t = v & 63, g0 = (t < 32) ? 0 : 4;
        for (int i = 0; i < 4; ++i) dsa_unit(F, b, 63 - t, g0 + i);
        for (int i = 0; i < 4; ++i) dsa_unit(F, b, t, g0 + i);
    }
}

__device__ __forceinline__ void p6_router(Frame& F) {
    const float* MOD = (const float*)(F.ws + WS_MOD); const float* X1 = F.out; const float* SSQ = (const float*)(F.ws + WS_CTL) + CW_SSQ;
    bf16* H2 = (bf16*)(F.ws + WS_H2); const bf16* WrT = (const bf16*)(F.ws + WS_WRT);
    int* TOKSLOT = (int*)(F.ws + WS_TOKSLOT); float* WROW = (float*)(F.ws + WS_WROW);
    const int lane = F.lane, r = lane & 15, kg = lane >> 4;
    const int it4 = F.wave & 3, kh = F.wave >> 2;
    LAS float* GS = (LAS float*)(F.ldsl + RING_OFF);
    LAS float* SH = GS + 1024;
    LAS float* LG = SH + 1024 + it4 * (16 * 52);
    LAS float* LG2 = SH + 1024 + 4 * (16 * 52) + it4 * (16 * 52);
    for (int base = F.vcu * 4; base < M / 16; base += F.G * 4) {
        __syncthreads();
        const int bb = (base * 16) >> 12;
        for (int i = F.tid; i < 1024; i += NWAVES * 64) { GS[i] = F.g_ffn[i] * (MOD[bb * 6144 + 4096 + i] + 1.0f); SH[i] = MOD[bb * 6144 + 3072 + i]; }
        if (F.tid < 32) F.LX[32 + F.tid] = 0u;
        __syncthreads();
        const int item = base + it4; const bool act = item < M / 16;
        int e1 = 0, e2 = 0, lr1 = 0, lr2 = 0; float w1 = 0.f, w2 = 0.f;
        if (act) {
            const int row = item * 16 + r;
            const float rstd = 1.f / sqrtf(SSQ[row] * (1.f / D) + RMS_EPS);
            f32x4 acc[3];
#pragma unroll
            for (int nt = 0; nt < 3; ++nt) acc[nt] = (f32x4){0.f, 0.f, 0.f, 0.f};
#pragma unroll 4
            for (int s = 0; s < 16; ++s) {
                const int k = 32 * (16 * kh + s) + 8 * kg;
                const f32x4 xa = *(const f32x4*)(X1 + (size_t)row * D + k), xb = *(const f32x4*)(X1 + (size_t)row * D + k + 4);
                const f32x4 ga = *(LAS const f32x4*)(GS + k), gb = *(LAS const f32x4*)(GS + k + 4);
                const f32x4 ha = *(LAS const f32x4*)(SH + k), hb = *(LAS const f32x4*)(SH + k + 4);
                const f32x4 ya = xa * rstd * ga + ha, yb = xb * rstd * gb + hb;
                v4u w; w.x = cvtpk(ya.x, ya.y); w.y = cvtpk(ya.z, ya.w); w.z = cvtpk(yb.x, yb.y); w.w = cvtpk(yb.z, yb.w);
                *(v4u*)(H2 + (size_t)row * D + k) = w;
                const pg8::bf16x8 a = __builtin_bit_cast(pg8::bf16x8, w);
#pragma unroll
                for (int nt = 0; nt < 3; ++nt) { const pg8::bf16x8 bw = *(const pg8::bf16x8*)(WrT + (size_t)(16 * nt + r) * D + k); acc[nt] = MFMA16(a, bw, acc[nt]); }
            }
            LAS float* dst = kh ? LG2 : LG;
#pragma unroll
            for (int nt = 0; nt < 3; ++nt)
#pragma unroll
                for (int i = 0; i < 4; ++i) dst[(4 * kg + i) * 52 + 16 * nt + r] = acc[nt][i];
        }
        __syncthreads();
        if (act && kh == 0 && lane < 16) {
            LAS const float* lg = LG + lane * 52; LAS const float* lg2 = LG2 + lane * 52;
            float gl[4]; int grp = 0;
#pragma unroll
            for (int i = 0; i < 4; ++i) gl[i] = lg[32 + i] + lg2[32 + i] + F.b_group[i];
#pragma unroll
            for (int i = 1; i < 4; ++i) if (gl[i] > gl[grp]) grp = i;
            const float gmax = (grp == 0) ? gl[0] : (grp == 1) ? gl[1] : (grp == 2) ? gl[2] : gl[3];
            float den = 0.f;
#pragma unroll
            for (int i = 0; i < 4; ++i) den += expf(gl[i] - gmax);
            const float pg = 1.f / den;
            float ev[8];
#pragma unroll
            for (int i = 0; i < 8; ++i) ev[i] = lg[grp * 8 + i] + lg2[grp * 8 + i] + F.b_router[grp * 8 + i];
            int i1 = 0; float v1 = ev[0];
#pragma unroll
            for (int i = 1; i < 8; ++i) if (ev[i] > v1) { v1 = ev[i]; i1 = i; }
            int i2 = -1; float v2 = -3.0e38f;
#pragma unroll
            for (int i = 0; i < 8; ++i) if (i != i1 && ev[i] > v2) { v2 = ev[i]; i2 = i; }
            const float t = expf(v2 - v1);
            w1 = pg / (1.f + t); w2 = pg * t / (1.f + t);
            e1 = grp * 8 + i1; e2 = grp * 8 + i2;
            lr1 = (int)atomicAdd((unsigned*)&F.LX[32 + e1], 1u); lr2 = (int)atomicAdd((unsigned*)&F.LX[32 + e2], 1u);
        }
        __syncthreads();
        if (F.tid < 32) { const unsigned c = F.LX[32 + F.tid]; F.LX[64 + F.tid] = c ? atomicAdd((unsigned*)(F.ctl + CW_CNT + F.tid), c) : 0u; }
        __syncthreads();
        if (act && kh == 0 && lane < 16) { const int row = item * 16 + lane;
            const int p1 = e1 * ECAP + (int)F.LX[64 + e1] + lr1, p2 = e2 * ECAP + (int)F.LX[64 + e2] + lr2;
            TOKSLOT[p1] = 2 * row; WROW[p1] = w1; TOKSLOT[p2] = 2 * row + 1; WROW[p2] = w2; }
    }
}
__device__ __forceinline__ void p10_final(Frame& F, float* dst) {
    const int gw = F.vcu * NWAVES + F.wave, NGW = F.G * NWAVES;
    const float* MOD = (const float*)(F.ws + WS_MOD); const bf16* YC = (const bf16*)(F.ws + WS_YC);
    for (int m = gw; m < M; m += NGW) {
        const int b = m >> 12;
        GAS f32x4* xr = (GAS f32x4*)(F.out + (size_t)m * D) + F.lane;
        const GAS unsigned long long* y0 = (const GAS unsigned long long*)(YC + (size_t)(2 * m) * D) + F.lane;
        const GAS unsigned long long* y1 = (const GAS unsigned long long*)(YC + (size_t)(2 * m + 1) * D) + F.lane;
        f32x4 v[4]; float s = 0.f;
#pragma unroll
        for (int j = 0; j < 4; ++j) { const int col = 4 * F.lane + 256 * j;
            const f32x4 x1 = xr[64 * j]; const unsigned long long a = y0[64 * j], c = y1[64 * j];
            const f32x4 gt = *(const f32x4*)(MOD + b * 6144 + 5120 + col);
            f32x4 y; y.x = bflo((unsigned)a) + bflo((unsigned)c); y.y = bfhi((unsigned)a) + bfhi((unsigned)c); y.z = bflo((unsigned)(a >> 32)) + bflo((unsigned)(c >> 32)); y.w = bfhi((unsigned)(a >> 32)) + bfhi((unsigned)(c >> 32));
            v[j] = x1 + gt * y; s += (v[j].x * v[j].x + v[j].y * v[j].y) + (v[j].z * v[j].z + v[j].w * v[j].w); }
        const float rstd = 1.f / sqrtf(wave_sum(s) * (1.f / D) + RMS_EPS);
        GAS f32x4* orow = (GAS f32x4*)(dst + (size_t)m * D) + F.lane;
#pragma unroll
        for (int j = 0; j < 4; ++j) { const int col = 4 * F.lane + 256 * j; const f32x4 g = *(const f32x4*)(F.g_final + col); orow[64 * j] = v[j] * rstd * g; }
    }
}

struct Args { const void* in[20]; float* out; unsigned char* ws; int ph_lo, ph_hi; };
__global__ void __launch_bounds__(NWAVES * 64, 2) hybrid_fwd(Args args) {
    extern __shared__ __attribute__((aligned(16))) unsigned char lds[];
    Frame F;
    F.lds = lds; F.ldsl = (LAS unsigned char*)lds; F.LX = (volatile LAS unsigned*)(F.ldsl + LX_OFF);
    F.tid = threadIdx.x; F.lane = F.tid & 63; F.wave = __builtin_amdgcn_readfirstlane(F.tid >> 6);
    F.G = gridDim.x; { const int bx = blockIdx.x; F.vcu = (F.G % 8 == 0) ? (bx % 8) * (F.G / 8) + bx / 8 : bx; }
    F.ws = args.ws; F.ctl = (gu32*)(args.ws + WS_CTL); F.out = args.out;
    F.x = (const float*)args.in[0]; F.c = (const float*)args.in[1]; F.positions = (const int*)args.in[2]; F.w_mod = (const float*)args.in[3]; F.b_mod = (const float*)args.in[4];
    F.g_mix = (const float*)args.in[5]; F.w_in = (const float*)args.in[6]; F.b_forget = (const float*)args.in[7]; F.w_out_a = (const float*)args.in[8]; F.w_out_b = (const float*)args.in[9];
    F.w_out = (const float*)args.in[10]; F.g_ffn = (const float*)args.in[11]; F.w_group = (const float*)args.in[12]; F.b_group = (const float*)args.in[13]; F.w_router = (const float*)args.in[14];
    F.b_router = (const float*)args.in[15]; F.w_e_gate = (const float*)args.in[16]; F.w_e_up = (const float*)args.in[17]; F.w_e_down = (const float*)args.in[18]; F.g_final = (const float*)args.in[19];
    for (int u = F.tid; u < (LDS_BYTES - LX_OFF) / 4; u += NWAVES * 64) F.LX[u] = 0u;
    __syncthreads();
    XcdBarrier bar; bar.bar = (unsigned*)(F.ctl + CW_BAR); bar.x = 0; bar.st = nullptr;
    if (N_LAUNCHES == 1) bar = xcd_barrier_post((unsigned*)(F.ctl + CW_BAR), F.LX);
    const int lo = args.ph_lo, hi = args.ph_hi;
#ifndef PH_MASK
#define PH_MASK 0xFFFF
#endif
#define IN(k) (((PH_MASK >> (k)) & 1) && lo <= (k) && (k) < hi)
#define REP(k) for (int rep_ = 0; rep_ <= ((DUP_MASK >> (k)) & 1); ++rep_)
#define SEAM(k) do { if (IN(k) && IN((k) + 1)) { xcd_barrier(bar); if ((DUP_MASK >> 15) & 1) xcd_barrier(bar); } } while (0)
    LAS unsigned char* ring = F.ldsl + RING_OFF;
    if (IN(0)) { REP(0) p0_prologue(F); } SEAM(0);
    if (IN(1)) { REP(1) p1_hnorm(F); } SEAM(1);
    if (IN(2)) {
        pg8::Gemm g{(const pg8::bf16_t*)(F.ws + WS_H), (const pg8::bf16_t*)(F.ws + WS_WIN), M, NPROJ, D}; pg8::StaticOrder S; S.init(M, NPROJ, F.G, (int)blockIdx.x);
        EpiProj E{F.ws, F.b_forget};
        pg8::gemm_phase<EpiProj, pg8::StaticOrder, true, true>(ring, g, S, E);
#if (DUP_MASK >> 2) & 1
        asm volatile("s_waitcnt vmcnt(0)" ::: "memory"); __syncthreads();
        pg8::gemm_phase<EpiProj, pg8::StaticOrder, true, true>(ring, g, S, E);
#endif
    } SEAM(2);
    if (IN(3)) { REP(3) p3_fox(F); REP(11) p3_dsa(F); } SEAM(3);
    if (IN(4)) {
        static_assert(WS_OB == WS_OA + (size_t)M * 512 * 2 && WS_WOB == WS_WOA + (size_t)1024 * 512 * 2, "stacked operands of the merge GEMM");
        pg8::Gemm g{(const pg8::bf16_t*)(F.ws + WS_OA), (const pg8::bf16_t*)(F.ws + WS_WOA), 2 * M, 2 * D, 512}; MergeOrder S; S.S.init(M, D, F.G, (int)blockIdx.x);
#if (DUP_MASK >> 4) & 1
        { EpiMerge E0{F.ws, WS_QA}; pg8::gemm_phase<EpiMerge, MergeOrder, true, true>(ring, g, S, E0); asm volatile("s_waitcnt vmcnt(0)" ::: "memory"); __syncthreads(); }
#endif
        EpiMerge E{F.ws, WS_GA}; pg8::gemm_phase<EpiMerge, MergeOrder, true, true>(ring, g, S, E);
    } SEAM(4);
    if (IN(5)) {
        pg8::Gemm g{(const pg8::bf16_t*)(F.ws + WS_GA), (const pg8::bf16_t*)(F.ws + WS_WO), M, D, D}; pg8::StaticOrder S; S.init(M, D, F.G, (int)blockIdx.x);
#if (DUP_MASK >> 5) & 1
        { EpiOut E0{F.ws, F.x, (float*)(F.ws + WS_QA), false}; pg8::gemm_phase<EpiOut, pg8::StaticOrder, true, true>(ring, g, S, E0); asm volatile("s_waitcnt vmcnt(0)" ::: "memory"); __syncthreads(); }
#endif
        EpiOut E{F.ws, F.x, F.out, true}; pg8::gemm_phase<EpiOut, pg8::StaticOrder, true, true>(ring, g, S, E);
    } SEAM(5);
    if (IN(6)) { p6_router(F); } SEAM(6);
    if (IN(8)) {
        moe_table(F);
        pg8::Gemm g{(const pg8::bf16_t*)(F.ws + WS_H2), (const pg8::bf16_t*)(F.ws + WS_WGU), PMAX, 32 * 1024, D};
        MoeOrder S{F.G, F.vcu, (int)F.LX[132] * 4, F.LX + 160};
        MoeRowMap RM{(const int*)(F.ws + WS_TOKSLOT), F.LX};
        EpiGU E{F.ws}; REP(8) pg8::gemm_phase_g<EpiGU, MoeOrder, MoeRowMap, true, true>(ring, g, S, E, RM);
    } SEAM(8);
    if (IN(9)) {
        moe_table(F);
        pg8::Gemm g{(const pg8::bf16_t*)(F.ws + WS_HID), (const pg8::bf16_t*)(F.ws + WS_WDN), PMAX, 32 * 1024, 512};
        MoeOrder S{F.G, F.vcu, (int)F.LX[132] * 4, F.LX + 160};
        EpiDown E{F.ws, F.LX}; REP(9) pg8::gemm_phase<EpiDown, MoeOrder, true, true>(ring, g, S, E);
    } SEAM(9);
    if (IN(10)) {
#if (DUP_MASK >> 10) & 1
        p10_final(F, (float*)(F.ws + WS_GA));
#endif
        p10_final(F, F.out); }
#undef IN
#undef SEAM
}

extern "C" void kernel_launch(void* const* d_in, const int* in_sizes, int n_in, void* d_out, int out_size, void* d_ws, size_t ws_size, hipStream_t stream) {
    static int grid = 0;
    if (grid == 0) {
        if (n_in != 20 || in_sizes[0] != M * D || out_size != M * D || ws_size < WS_END) { fprintf(stderr, "kernel_launch: unexpected shapes (n_in %d, in0 %d, out %d, ws %zu); nothing launched\n", n_in, n_in > 0 ? in_sizes[0] : -1, out_size, ws_size); grid = -1; return; }
        int dev = 0, cus = 0, per_cu = 0;
        if (hipGetDevice(&dev) != hipSuccess || hipDeviceGetAttribute(&cus, hipDeviceAttributeMultiprocessorCount, dev) != hipSuccess) { grid = -1; return; }
        if (hipFuncSetAttribute((const void*)hybrid_fwd, hipFuncAttributeMaxDynamicSharedMemorySize, LDS_BYTES) != hipSuccess) { fprintf(stderr, "kernel_launch: hipFuncSetAttribute failed\n"); grid = -1; return; }
        if (hipOccupancyMaxActiveBlocksPerMultiprocessor(&per_cu, (const void*)hybrid_fwd, NWAVES * 64, LDS_BYTES) != hipSuccess || per_cu < 1)
            fprintf(stderr, "kernel_launch: note: occupancy query reports %d workgroups per CU\n", per_cu);
        (void)hipGetLastError();
        grid = cus;
    }
    if (grid < 0) return;
    if (hipMemsetAsync((char*)d_ws + WS_CTL, 0, CTL_ZERO_BYTES, stream) != hipSuccess) { fprintf(stderr, "kernel_launch: hipMemsetAsync failed\n"); return; }
    Args a{};
    for (int i = 0; i < 20; ++i) a.in[i] = d_in[i];
    a.out = (float*)d_out; a.ws = (unsigned char*)d_ws;
    for (int li = 0; li < N_LAUNCHES; ++li) {
        a.ph_lo = (N_LAUNCHES == 1) ? 0 : li; a.ph_hi = (N_LAUNCHES == 1) ? NPHASE : li + 1;
        hipLaunchKernelGGL(hybrid_fwd, dim3(grid), dim3(NWAVES * 64), LDS_BYTES, stream, a);
        const hipError_t le = hipPeekAtLastError();
        if (le != hipSuccess) { fprintf(stderr, "kernel_launch: launch %d failed: %s\n", li, hipGetErrorName(le)); break; }
    }
}
```

```cpp
#define MK_N_LAUNCHES 1
#include <hip/hip_runtime.h>
#include <hip/hip_bf16.h>
#include <cstdio>
#include <cstdint>
#include <cmath>
namespace pg8 {
#define PG8_LAS __attribute__((address_space(3)))
typedef unsigned short bf16_t;
typedef short bf16x8 __attribute__((ext_vector_type(8)));
typedef float f32x4 __attribute__((ext_vector_type(4)));
typedef unsigned u32x4 __attribute__((ext_vector_type(4)));
constexpr int BM = 256, BK = 64, HALF = 128, HTB = HALF * BK * 2  , STAGE_BYTES = 8 * HTB, NXCD = 8, WGM = 8;

__host__ __device__ __forceinline__ int lds_byte(int r, int c) { const int st = (r >> 4) * 2 + (c >> 5), rr = r & 15, cc = c & 31, ob = rr * 64 + cc * 2; return st * 1024 + (ob ^ (((ob >> 9) & 1) << 5)); }
__host__ __device__ __forceinline__ void stage_rc(int b, int& R, int& C) { const int st = b / 1024, sb = b % 1024, swz = sb ^ (((sb >> 9) & 1) << 5); R = (st >> 1) * 16 + swz / 64; C = (st & 1) * 32 + (swz % 64) / 2; }
__host__ __device__ __forceinline__ int perm32(int rho) { const int n = rho >> 4, i = rho & 15; return 8 * (i >> 2) + 4 * n + (i & 3); }

struct Unit { int pm, pn; };
struct Gemm { const bf16_t* A; const bf16_t* Bt; int M, N, K; };

struct StaticOrder {
    int nM, nN, nwg, G, c;
    __host__ __device__ void init(int M, int N, int G_, int c_) { nM = M / BM; nN = N / BM; nwg = nM * nN; G = G_; c = c_; }
    __host__ __device__ bool next(int i, Unit& u) const {
        const long L = (long)i * G + c; if (L >= nwg) return false;
        int wgid = (int)L; { const int q = nwg / NXCD, r = nwg % NXCD, xcd = wgid % NXCD, off = wgid / NXCD; wgid = (xcd < r ? xcd * (q + 1) : r * (q + 1) + (xcd - r) * q) + off; }
        const int nig = WGM * nN, gid = wgid / nig, fm = gid * WGM, gsz = (nM - fm) < WGM ? (nM - fm) : WGM;
        u.pm = fm + ((wgid % nig) % gsz); u.pn = (wgid % nig) / gsz; return true;
    }
    __device__ __forceinline__ void a_ready(const Unit&) const {}
    __device__ __forceinline__ void done(const Unit&) const {}
};

__device__ __forceinline__ unsigned cvt_pk_bf16(float lo, float hi) { unsigned r; asm volatile("v_cvt_pk_bf16_f32 %0, %1, %2" : "=v"(r) : "v"(lo), "v"(hi)); return r; }
typedef float f32x2 __attribute__((ext_vector_type(2)));
template <class Epi, class Sched, bool ALIGN_EPI = false, bool SP2 = false>
__device__ __forceinline__ void gemm_phase(PG8_LAS unsigned char* lds, const Gemm g, const Sched& S, const Epi& E) {
    const int tid = threadIdx.x, wid = __builtin_amdgcn_readfirstlane(tid >> 6), lane = tid & 63, wr = wid >> 2, wc = wid & 3, fr = lane & 15, fq = lane >> 4;
    const int K = g.K, nt = K / BK;
    unsigned voffA[2], voffB[2];
#pragma unroll
    for (int i = 0; i < 2; ++i) { int R, C; stage_rc(tid * 16 + i * 8192, R, C); const int Rb = Epi::PERM ? ((R & ~31) + perm32(R & 31)) : R;
        voffA[i] = (unsigned)(R * K + C) * 2u; voffB[i] = (unsigned)(Rb * K + C) * 2u; }
    const size_t kstep = (size_t)(BK * 2);
    const size_t hstep = (size_t)HALF * K * 2;
    const size_t tstep = 2 * hstep;
    const unsigned ldsw = (unsigned)wid * 1024u;
    const int aoff = lds_byte(wr * 64 + fr, fq * 8), boff = lds_byte(wc * 32 + fr, fq * 8);
#define PG8_SA(b, h) (((b) * 2 + (h)) * HTB)
#define PG8_SB(b, h) ((4 + (b) * 2 + (h)) * HTB)
#define PG8_STAGE(bufoff, gbase, voff) do { _Pragma("unroll") for (int _i = 0; _i < 2; ++_i) \
        __builtin_amdgcn_global_load_lds((const unsigned*)((const char*)(gbase) + (voff)[_i]), (PG8_LAS unsigned*)(lds + (bufoff) + ldsw + _i * 8192), 16, 0, 0); } while (0)
#define PG8_LDA(dst, b, h) do { _Pragma("unroll") for (int m = 0; m < 4; ++m) _Pragma("unroll") for (int k = 0; k < 2; ++k) dst[m][k] = *(const PG8_LAS bf16x8*)(lds + PG8_SA(b, h) + aoff + m * 2048 + k * 1024); } while (0)
#define PG8_LDB(dst, b, h) do { _Pragma("unroll") for (int n = 0; n < 2; ++n) _Pragma("unroll") for (int k = 0; k < 2; ++k) dst[n][k] = *(const PG8_LAS bf16x8*)(lds + PG8_SB(b, h) + boff + n * 2048 + k * 1024); } while (0)
#define PG8_MMA(ai, bj, At, Bt) do { __builtin_amdgcn_s_setprio(1); _Pragma("unroll") for (int m = 0; m < 4; ++m) _Pragma("unroll") for (int n = 0; n < 2; ++n) _Pragma("unroll") for (int k = 0; k < 2; ++k) \
        acc[ai][bj][m][n] = __builtin_amdgcn_mfma_f32_16x16x32_bf16(Bt[n][k], At[m][k], acc[ai][bj][m][n], 0, 0, 0); __builtin_amdgcn_s_setprio(0); } while (0)
#define PG8_WAIT_V(n) asm volatile("s_waitcnt vmcnt(" #n ")" ::: "memory")
#define PG8_WAIT_L(n) asm volatile("s_waitcnt lgkmcnt(" #n ")" ::: "memory")
#define PG8_BAR __builtin_amdgcn_s_barrier()
#define PG8_SCHED __builtin_amdgcn_sched_barrier(0)
    Unit cur, nxt; int ui = 0;
    if (!S.next(0, cur)) return;
    f32x4 acc[2][2][4][2];
#pragma unroll
    for (int a = 0; a < 2; ++a)
#pragma unroll
        for (int b = 0; b < 2; ++b)
#pragma unroll
            for (int m = 0; m < 4; ++m)
#pragma unroll
                for (int n = 0; n < 2; ++n) acc[a][b][m][n] = (f32x4){0.f, 0.f, 0.f, 0.f};
    bf16x8 At[4][2], B0[2][2], B1[2][2];
    const char* cA = (const char*)g.A + (size_t)cur.pm * tstep; const char* cB = (const char*)g.Bt + (size_t)cur.pn * tstep;
    S.a_ready(cur);
    if constexpr (SP2) {
        PG8_STAGE(PG8_SB(0, 0), cB, voffB); PG8_STAGE(PG8_SB(0, 1), cB + hstep, voffB); PG8_STAGE(PG8_SA(0, 0), cA, voffA); PG8_STAGE(PG8_SA(0, 1), cA + hstep, voffA);
        if (wr == 1) PG8_BAR;
        PG8_WAIT_V(2); PG8_BAR;
        PG8_STAGE(PG8_SB(1, 0), cB + kstep, voffB); PG8_STAGE(PG8_SA(1, 0), cA + kstep, voffA); PG8_STAGE(PG8_SB(1, 1), cB + hstep + kstep, voffB);
        PG8_WAIT_V(6); PG8_BAR;
    } else {
        PG8_STAGE(PG8_SB(0, 0), cB, voffB); PG8_STAGE(PG8_SA(0, 0), cA, voffA); PG8_STAGE(PG8_SB(0, 1), cB + hstep, voffB); PG8_STAGE(PG8_SA(0, 1), cA + hstep, voffA);
        if (wr == 1) PG8_BAR;
        PG8_WAIT_V(4); PG8_BAR;
        PG8_STAGE(PG8_SB(1, 0), cB + kstep, voffB); PG8_STAGE(PG8_SA(1, 0), cA + kstep, voffA); PG8_STAGE(PG8_SB(1, 1), cB + hstep + kstep, voffB);
        PG8_WAIT_V(6); PG8_BAR;
    }
    for (;;) {
        const bool has_next = S.next(ui + 1, nxt);
        const char* nA = has_next ? (const char*)g.A + (size_t)nxt.pm * tstep : cA; const char* nB = has_next ? (const char*)g.Bt + (size_t)nxt.pn * tstep : cB;
        for (int t = 0; t < nt; t += 2) {
            const bool last = (t == nt - 2);
            const char* a1 = cA + (size_t)(t + 1) * kstep;
            const char* a2 = last ? nA : cA + (size_t)(t + 2) * kstep; const char* b2 = last ? nB : cB + (size_t)(t + 2) * kstep;
            const char* a3 = a2 + kstep; const char* b3 = b2 + kstep;
            if (last && has_next) S.a_ready(nxt);
            if constexpr (SP2) {
            PG8_LDB(B0, 0, 0); PG8_LDB(B1, 0, 1); PG8_SCHED; PG8_LDA(At, 0, 0); PG8_STAGE(PG8_SA(1, 1), a1 + hstep, voffA);
            PG8_WAIT_V(8); PG8_WAIT_L(0); PG8_BAR; PG8_MMA(0, 0, At, B0); PG8_MMA(0, 1, At, B1); PG8_BAR; PG8_SCHED;
            PG8_LDA(At, 0, 1); PG8_STAGE(PG8_SB(0, 0), b2, voffB); PG8_STAGE(PG8_SB(0, 1), b2 + hstep, voffB); PG8_STAGE(PG8_SA(0, 0), a2, voffA);
            PG8_WAIT_V(8); PG8_WAIT_L(0); PG8_BAR; PG8_MMA(1, 0, At, B0); PG8_MMA(1, 1, At, B1); PG8_BAR; PG8_SCHED;
            PG8_LDB(B0, 1, 0); PG8_LDB(B1, 1, 1); PG8_SCHED; PG8_LDA(At, 1, 0); PG8_STAGE(PG8_SA(0, 1), a2 + hstep, voffA);
            PG8_WAIT_V(8); PG8_WAIT_L(0); PG8_BAR; PG8_MMA(0, 0, At, B0); PG8_MMA(0, 1, At, B1); PG8_BAR; PG8_SCHED;
            PG8_LDA(At, 1, 1); PG8_STAGE(PG8_SB(1, 0), b3, voffB); PG8_STAGE(PG8_SB(1, 1), b3 + hstep, voffB); PG8_STAGE(PG8_SA(1, 0), a3, voffA);
            PG8_WAIT_V(8); PG8_WAIT_L(0); PG8_BAR; PG8_MMA(1, 0, At, B0); PG8_MMA(1, 1, At, B1); PG8_BAR; PG8_SCHED;
            } else {
            PG8_LDB(B0, 0, 0); PG8_SCHED; PG8_LDA(At, 0, 0); PG8_STAGE(PG8_SA(1, 1), a1 + hstep, voffA);
            PG8_WAIT_L(8); PG8_BAR; PG8_WAIT_L(0); PG8_MMA(0, 0, At, B0); PG8_BAR; PG8_SCHED;
            PG8_LDB(B1, 0, 1); PG8_STAGE(PG8_SB(0, 0), b2, voffB);
            PG8_BAR; PG8_WAIT_L(0); PG8_MMA(0, 1, At, B1); PG8_BAR;
            PG8_LDA(At, 0, 1); PG8_STAGE(PG8_SA(0, 0), a2, voffA);
            PG8_BAR; PG8_WAIT_L(0); PG8_MMA(1, 0, At, B0); PG8_BAR; PG8_SCHED;
            PG8_STAGE(PG8_SB(0, 1), b2 + hstep, voffB);
            PG8_WAIT_V(6); PG8_BAR; PG8_MMA(1, 1, At, B1); PG8_BAR;
            PG8_LDB(B0, 1, 0); PG8_SCHED; PG8_LDA(At, 1, 0); PG8_STAGE(PG8_SA(0, 1), a2 + hstep, voffA);
            PG8_WAIT_L(8); PG8_BAR; PG8_WAIT_L(0); PG8_MMA(0, 0, At, B0); PG8_BAR; PG8_SCHED;
            PG8_LDB(B1, 1, 1); PG8_STAGE(PG8_SB(1, 0), b3, voffB);
            PG8_BAR; PG8_WAIT_L(0); PG8_MMA(0, 1, At, B1); PG8_BAR;
            PG8_LDA(At, 1, 1); PG8_STAGE(PG8_SA(1, 0), a3, voffA);
            PG8_BAR; PG8_WAIT_L(0); PG8_MMA(1, 0, At, B0); PG8_BAR; PG8_SCHED;
            PG8_STAGE(PG8_SB(1, 1), b3 + hstep, voffB);
            PG8_WAIT_V(6); PG8_BAR; PG8_MMA(1, 1, At, B1); PG8_BAR;
            }
        }
        if constexpr (ALIGN_EPI) { if (wr == 0) PG8_BAR; }
        bool keep_acc = false;
        if constexpr (Epi::CHAIN) { keep_acc = E.chain(acc, cur, wr, wc, fr, fq); S.done(cur); }
        else if constexpr (!Epi::AFTER_DRAIN) { E(acc, cur, wr, wc, fr, fq); S.done(cur); }
        if (!has_next) break;
        if (!keep_acc)
#pragma unroll
        for (int a = 0; a < 2; ++a)
#pragma unroll
            for (int b = 0; b < 2; ++b)
#pragma unroll
                for (int m = 0; m < 4; ++m)
#pragma unroll
                    for (int n = 0; n < 2; ++n) acc[a][b][m][n] = (f32x4){0.f, 0.f, 0.f, 0.f};
        cur = nxt; cA = nA; cB = nB; ++ui;
        if constexpr (ALIGN_EPI) { if (wr == 1) PG8_BAR; }
    }
    PG8_WAIT_V(0);
    if constexpr (!ALIGN_EPI) { if (wr == 0) PG8_BAR; }
    PG8_BAR;
    if constexpr (Epi::AFTER_DRAIN) { E.fused(acc, cur, wr, wc, fr, fq, lds, wid, lane); S.done(cur); }
#undef PG8_SA
#undef PG8_SB
#undef PG8_STAGE
#undef PG8_LDA
#undef PG8_LDB
#undef PG8_MMA
#undef PG8_WAIT_V
#undef PG8_WAIT_L
#undef PG8_BAR
#undef PG8_SCHED
}
template <class Epi, class Sched, class RowMap, bool ALIGN_EPI = false, bool SP2 = true>
__device__ __forceinline__ void gemm_phase_g(PG8_LAS unsigned char* lds, const Gemm g, const Sched& S, const Epi& E, const RowMap& RM) {
    static_assert(SP2, "gather variant: SP2 path only");
    const int tid = threadIdx.x, wid = __builtin_amdgcn_readfirstlane(tid >> 6), lane = tid & 63, wr = wid >> 2, wc = wid & 3, fr = lane & 15, fq = lane >> 4;
    const int K = g.K, nt = K / BK;
    unsigned voffA[2], voffB[2]; int rAg[2]; unsigned cAg[2]; unsigned vC[2][2], vN[2][2];
#pragma unroll
    for (int i = 0; i < 2; ++i) { int R, C; stage_rc(tid * 16 + i * 8192, R, C); const int Rb = Epi::PERM ? ((R & ~31) + perm32(R & 31)) : R;
        voffA[i] = (unsigned)(R * K + C) * 2u; voffB[i] = (unsigned)(Rb * K + C) * 2u; rAg[i] = R; cAg[i] = (unsigned)C * 2u; }
    const size_t kstep = (size_t)(BK * 2);
    const size_t hstep = (size_t)HALF * K * 2;
    const size_t tstep = 2 * hstep;
    const unsigned ldsw = (unsigned)wid * 1024u;
    const int aoff = lds_byte(wr * 64 + fr, fq * 8), boff = lds_byte(wc * 32 + fr, fq * 8);
#define PG8_SA(b, h) (((b) * 2 + (h)) * HTB)
#define PG8_SB(b, h) ((4 + (b) * 2 + (h)) * HTB)
#define PG8_STAGE(bufoff, gbase, voff) do { _Pragma("unroll") for (int _i = 0; _i < 2; ++_i) \
        __builtin_amdgcn_global_load_lds((const unsigned*)((const char*)(gbase) + (voff)[_i]), (PG8_LAS unsigned*)(lds + (bufoff) + ldsw + _i * 8192), 16, 0, 0); } while (0)
#define PG8_LDA(dst, b, h) do { _Pragma("unroll") for (int m = 0; m < 4; ++m) _Pragma("unroll") for (int k = 0; k < 2; ++k) dst[m][k] = *(const PG8_LAS bf16x8*)(lds + PG8_SA(b, h) + aoff + m * 2048 + k * 1024); } while (0)
#define PG8_LDB(dst, b, h) do { _Pragma("unroll") for (int n = 0; n < 2; ++n) _Pragma("unroll") for (int k = 0; k < 2; ++k) dst[n][k] = *(const PG8_LAS bf16x8*)(lds + PG8_SB(b, h) + boff + n * 2048 + k * 1024); } while (0)
#define PG8_MMA(ai, bj, At, Bt) do { __builtin_amdgcn_s_setprio(1); _Pragma("unroll") for (int m = 0; m < 4; ++m) _Pragma("unroll") for (int n = 0; n < 2; ++n) _Pragma("unroll") for (int k = 0; k < 2; ++k) \
        acc[ai][bj][m][n] = __builtin_amdgcn_mfma_f32_16x16x32_bf16(Bt[n][k], At[m][k], acc[ai][bj][m][n], 0, 0, 0); __builtin_amdgcn_s_setprio(0); } while (0)
#define PG8_WAIT_V(n) asm volatile("s_waitcnt vmcnt(" #n ")" ::: "memory")
#define PG8_WAIT_L(n) asm volatile("s_waitcnt lgkmcnt(" #n ")" ::: "memory")
#define PG8_BAR __builtin_amdgcn_s_barrier()
#define PG8_SCHED __builtin_amdgcn_sched_barrier(0)
    Unit cur, nxt; int ui = 0;
    if (!S.next(0, cur)) return;
#define PG8_FILL(v, uu) do { _Pragma("unroll") for (int h_ = 0; h_ < 2; ++h_) _Pragma("unroll") for (int i_ = 0; i_ < 2; ++i_) v[h_][i_] = RM.rowoff(uu, h_ * HALF + rAg[i_]) + cAg[i_]; } while (0)
    PG8_FILL(vC, cur);
    const char* gA = (const char*)g.A;
    f32x4 acc[2][2][4][2];
#pragma unroll
    for (int a = 0; a < 2; ++a)
#pragma unroll
        for (int b = 0; b < 2; ++b)
#pragma unroll
            for (int m = 0; m < 4; ++m)
#pragma unroll
                for (int n = 0; n < 2; ++n) acc[a][b][m][n] = (f32x4){0.f, 0.f, 0.f, 0.f};
    bf16x8 At[4][2], B0[2][2], B1[2][2];
    const char* cA = (const char*)g.A + (size_t)cur.pm * tstep; const char* cB = (const char*)g.Bt + (size_t)cur.pn * tstep;
    S.a_ready(cur);
    if constexpr (SP2) {
        PG8_STAGE(PG8_SB(0, 0), cB, voffB); PG8_STAGE(PG8_SB(0, 1), cB + hstep, voffB); PG8_STAGE(PG8_SA(0, 0), gA, vC[0]); PG8_STAGE(PG8_SA(0, 1), gA, vC[1]);
        if (wr == 1) PG8_BAR;
        PG8_WAIT_V(2); PG8_BAR;
        PG8_STAGE(PG8_SB(1, 0), cB + kstep, voffB); PG8_STAGE(PG8_SA(1, 0), gA + kstep, vC[0]); PG8_STAGE(PG8_SB(1, 1), cB + hstep + kstep, voffB);
        PG8_WAIT_V(6); PG8_BAR;
    } else {
        PG8_STAGE(PG8_SB(0, 0), cB, voffB); PG8_STAGE(PG8_SA(0, 0), cA, voffA); PG8_STAGE(PG8_SB(0, 1), cB + hstep, voffB); PG8_STAGE(PG8_SA(0, 1), cA + hstep, voffA);
        if (wr == 1) PG8_BAR;
        PG8_WAIT_V(4); PG8_BAR;
        PG8_STAGE(PG8_SB(1, 0), cB + kstep, voffB); PG8_STAGE(PG8_SA(1, 0), cA + kstep, voffA); PG8_STAGE(PG8_SB(1, 1), cB + hstep + kstep, voffB);
        PG8_WAIT_V(6); PG8_BAR;
    }
    for (;;) {
        const bool has_next = S.next(ui + 1, nxt);
        if (has_next) PG8_FILL(vN, nxt); else { vN[0][0] = vC[0][0]; vN[0][1] = vC[0][1]; vN[1][0] = vC[1][0]; vN[1][1] = vC[1][1]; }
        const char* nA = has_next ? (const char*)g.A + (size_t)nxt.pm * tstep : cA; const char* nB = has_next ? (const char*)g.Bt + (size_t)nxt.pn * tstep : cB;
        for (int t = 0; t < nt; t += 2) {
            const bool last = (t == nt - 2);
            const char* a1 = cA + (size_t)(t + 1) * kstep;
            const char* a2 = last ? nA : cA + (size_t)(t + 2) * kstep; const char* b2 = last ? nB : cB + (size_t)(t + 2) * kstep;
            const char* a3 = a2 + kstep; const char* b3 = b2 + kstep;
            const char* ga2 = last ? gA : gA + (size_t)(t + 2) * kstep;
            unsigned vs0[2] = {last ? vN[0][0] : vC[0][0], last ? vN[0][1] : vC[0][1]}, vs1[2] = {last ? vN[1][0] : vC[1][0], last ? vN[1][1] : vC[1][1]};
            if (last && has_next) S.a_ready(nxt);
            if constexpr (SP2) {
            PG8_LDB(B0, 0, 0); PG8_LDB(B1, 0, 1); PG8_SCHED; PG8_LDA(At, 0, 0); PG8_STAGE(PG8_SA(1, 1), gA + (size_t)(t + 1) * kstep, vC[1]);
            PG8_WAIT_V(8); PG8_WAIT_L(0); PG8_BAR; PG8_MMA(0, 0, At, B0); PG8_MMA(0, 1, At, B1); PG8_BAR; PG8_SCHED;
            PG8_LDA(At, 0, 1); PG8_STAGE(PG8_SB(0, 0), b2, voffB); PG8_STAGE(PG8_SB(0, 1), b2 + hstep, voffB); PG8_STAGE(PG8_SA(0, 0), ga2, vs0);
            PG8_WAIT_V(8); PG8_WAIT_L(0); PG8_BAR; PG8_MMA(1, 0, At, B0); PG8_MMA(1, 1, At, B1); PG8_BAR; PG8_SCHED;
            PG8_LDB(B0, 1, 0); PG8_LDB(B1, 1, 1); PG8_SCHED; PG8_LDA(At, 1, 0); PG8_STAGE(PG8_SA(0, 1), ga2, vs1);
            PG8_WAIT_V(8); PG8_WAIT_L(0); PG8_BAR; PG8_MMA(0, 0, At, B0); PG8_MMA(0, 1, At, B1); PG8_BAR; PG8_SCHED;
            PG8_LDA(At, 1, 1); PG8_STAGE(PG8_SB(1, 0), b3, voffB); PG8_STAGE(PG8_SB(1, 1), b3 + hstep, voffB); PG8_STAGE(PG8_SA(1, 0), ga2 + kstep, vs0);
            PG8_WAIT_V(8); PG8_WAIT_L(0); PG8_BAR; PG8_MMA(1, 0, At, B0); PG8_MMA(1, 1, At, B1); PG8_BAR; PG8_SCHED;
            } else {
            PG8_LDB(B0, 0, 0); PG8_SCHED; PG8_LDA(At, 0, 0); PG8_STAGE(PG8_SA(1, 1), a1 + hstep, voffA);
            PG8_WAIT_L(8); PG8_BAR; PG8_WAIT_L(0); PG8_MMA(0, 0, At, B0); PG8_BAR; PG8_SCHED;
            PG8_LDB(B1, 0, 1); PG8_STAGE(PG8_SB(0, 0), b2, voffB);
            PG8_BAR; PG8_WAIT_L(0); PG8_MMA(0, 1, At, B1); PG8_BAR;
            PG8_LDA(At, 0, 1); PG8_STAGE(PG8_SA(0, 0), a2, voffA);
            PG8_BAR; PG8_WAIT_L(0); PG8_MMA(1, 0, At, B0); PG8_BAR; PG8_SCHED;
            PG8_STAGE(PG8_SB(0, 1), b2 + hstep, voffB);
            PG8_WAIT_V(6); PG8_BAR; PG8_MMA(1, 1, At, B1); PG8_BAR;
            PG8_LDB(B0, 1, 0); PG8_SCHED; PG8_LDA(At, 1, 0); PG8_STAGE(PG8_SA(0, 1), a2 + hstep, voffA);
            PG8_WAIT_L(8); PG8_BAR; PG8_WAIT_L(0); PG8_MMA(0, 0, At, B0); PG8_BAR; PG8_SCHED;
            PG8_LDB(B1, 1, 1); PG8_STAGE(PG8_SB(1, 0), b3, voffB);
            PG8_BAR; PG8_WAIT_L(0); PG8_MMA(0, 1, At, B1); PG8_BAR;
            PG8_LDA(At, 1, 1); PG8_STAGE(PG8_SA(1, 0), a3, voffA);
            PG8_BAR; PG8_WAIT_L(0); PG8_MMA(1, 0, At, B0); PG8_BAR; PG8_SCHED;
            PG8_STAGE(PG8_SB(1, 1), b3 + hstep, voffB);
            PG8_WAIT_V(6); PG8_BAR; PG8_MMA(1, 1, At, B1); PG8_BAR;
            }
        }
        if constexpr (ALIGN_EPI) { if (wr == 0) PG8_BAR; }
        if constexpr (!Epi::AFTER_DRAIN) { E(acc, cur, wr, wc, fr, fq); S.done(cur); }
        if (!has_next) break;
#pragma unroll
        for (int a = 0; a < 2; ++a)
#pragma unroll
            for (int b = 0; b < 2; ++b)
#pragma unroll
                for (int m = 0; m < 4; ++m)
#pragma unroll
                    for (int n = 0; n < 2; ++n) acc[a][b][m][n] = (f32x4){0.f, 0.f, 0.f, 0.f};
        cur = nxt; cA = nA; cB = nB; ++ui; vC[0][0] = vN[0][0]; vC[0][1] = vN[0][1]; vC[1][0] = vN[1][0]; vC[1][1] = vN[1][1];
        if constexpr (ALIGN_EPI) { if (wr == 1) PG8_BAR; }
    }
    PG8_WAIT_V(0);
    if constexpr (!ALIGN_EPI) { if (wr == 0) PG8_BAR; }
    PG8_BAR;
    if constexpr (Epi::AFTER_DRAIN) { E.fused(acc, cur, wr, wc, fr, fq, lds, wid, lane); S.done(cur); }
#undef PG8_FILL
#undef PG8_SA
#undef PG8_SB
#undef PG8_STAGE
#undef PG8_LDA
#undef PG8_LDB
#undef PG8_MMA
#undef PG8_WAIT_V
#undef PG8_WAIT_L
#undef PG8_BAR
#undef PG8_SCHED
}
}
constexpr int NWAVES = 8;
constexpr int BATCH = 4, SEQ = 4096, D = 1024, M = BATCH * SEQ;
constexpr int NPROJ = 4864;
constexpr float RMS_EPS = 1e-6f;
constexpr float LOG2E = 1.4426950408889634f;
constexpr float QSCALE = 0.125f * LOG2E;
constexpr int PMAX = 40960, NTMAX = 160;
constexpr int NPHASE = 11;
#ifndef MK_N_LAUNCHES
#define MK_N_LAUNCHES 1
#endif
constexpr int N_LAUNCHES = MK_N_LAUNCHES;

constexpr size_t MiB = 1u << 20;
constexpr size_t WS_CTL = 0, CTL_ZERO_BYTES = 1 * MiB;
constexpr size_t WS_MOD = 1 * MiB;
constexpr size_t WS_WRT = 1 * MiB + 256 * 1024;
constexpr int ECAP = 16384;
constexpr size_t WS_TOKSLOT = 212 * MiB;
constexpr size_t WS_WROW = 214 * MiB;
constexpr size_t WS_COS = 2 * MiB, WS_SIN = 2 * MiB + 512 * 1024;
constexpr size_t WS_WI = 3 * MiB, WS_LOGF = 3 * MiB + 512 * 1024;
constexpr size_t WS_ROUTE = 4 * MiB;
constexpr size_t WS_WIN = 5 * MiB;
constexpr size_t WS_WOA = 15 * MiB, WS_WOB = 16 * MiB, WS_WO = 17 * MiB;
constexpr size_t WS_WGU = 19 * MiB, WS_WDN = 83 * MiB;
constexpr size_t WS_H = 115 * MiB;
constexpr size_t WS_OA = 115 * MiB, WS_OB = 131 * MiB, WS_H2 = 115 * MiB;
constexpr size_t WS_QA = 147 * MiB, WS_QI = 163 * MiB, WS_QB = 179 * MiB, WS_KB = 195 * MiB, WS_VB = 211 * MiB;
constexpr size_t WS_KA = 227 * MiB, WS_VA = 229 * MiB, WS_KI = 231 * MiB;
constexpr size_t WS_XS = 147 * MiB;
constexpr size_t WS_YC = 147 * MiB;
constexpr size_t WS_GA = 233 * MiB, WS_GB = 265 * MiB;
constexpr size_t WS_HID = 233 * MiB;
constexpr size_t WS_END = 297 * MiB;
constexpr int CW_BAR = 4096, CW_CNT = 8192, CW_SSQ = 16384, CW_KN2 = 131072;
constexpr int RING_OFF = 0, RING_BYTES = 131072;
constexpr int SEL_OFF = 131072;
constexpr int LX_OFF = 139264;
constexpr int HIST_OFF = 143360;
constexpr int LDS_BYTES = 151552;

#define GAS __attribute__((address_space(1)))
#define LAS __attribute__((address_space(3)))
typedef unsigned short bf16;
typedef unsigned v4u __attribute__((ext_vector_type(4)));
typedef float f32x4 __attribute__((ext_vector_type(4)));
typedef short bf16x8 __attribute__((ext_vector_type(8)));
typedef GAS unsigned gu32;
typedef GAS unsigned long long gu64;
#define RLX_AGENT __ATOMIC_RELAXED, __HIP_MEMORY_SCOPE_AGENT
#define LDS_WAIT() asm volatile("s_waitcnt lgkmcnt(0)" ::: "memory")
#define VM_WAIT() asm volatile("s_waitcnt vmcnt(0)" ::: "memory")
__device__ __forceinline__ unsigned long long rt() { return __builtin_amdgcn_s_memrealtime(); }
__device__ __forceinline__ unsigned f2bf(float f) { unsigned u = __builtin_bit_cast(unsigned, f); return (u + 0x7fffu + ((u >> 16) & 1u)) >> 16; }
__device__ __forceinline__ unsigned pk2(float lo, float hi) { return f2bf(lo) | (f2bf(hi) << 16); }

#define XB_TMO      128
#define XB_XCNT(j)  (256  + 64 * (j))
#define XB_XSUB(j)  (1280 + 64 * (j))
#define XB_XGEN(j)  (2304 + 64 * (j))
#define XB_TOP      3328
#define XB_TOPGEN   3392
#define XCD_BAR_WORDS 3456
#define XB_SPIN_CAP (1u << 18)

__device__ __forceinline__ unsigned xb_ld(unsigned* p)              { return __hip_atomic_load(p, __ATOMIC_RELAXED, __HIP_MEMORY_SCOPE_AGENT); }
__device__ __forceinline__ unsigned xb_add(unsigned* p, unsigned v) { return __hip_atomic_fetch_add(p, v, __ATOMIC_RELAXED, __HIP_MEMORY_SCOPE_AGENT); }
__device__ __forceinline__ unsigned xb_xcc_id() { return (unsigned)__builtin_amdgcn_s_getreg((3 << 11) | 20) & 0xFu; }
#define XB_SPIN(cond, bar) do { unsigned _sp = 0; while (cond) { __builtin_amdgcn_s_sleep(1); \
    if ((++_sp & 255u) == 0u) { if (xb_ld(&(bar)[XB_TMO])) break; if (_sp > XB_SPIN_CAP) { atomicAdd(&(bar)[XB_TMO], 1u); break; } } } } while (0)

struct XcdBarrier {
    unsigned* bar; unsigned x;
    volatile LAS unsigned* st;
};

__device__ __forceinline__ XcdBarrier xcd_barrier_post(unsigned* bar, volatile LAS unsigned* st) {
    XcdBarrier b; b.bar = bar; b.x = xb_xcc_id(); b.st = st;
    if (threadIdx.x == 0) (void)xb_add(&bar[XB_XCNT(b.x)], 1u);
    return b;
}
__device__ __forceinline__ void xcd_barrier_complete(unsigned* bar, unsigned x, unsigned& nloc, unsigned& nx) {
    const unsigned G = gridDim.x * gridDim.y * gridDim.z;
    unsigned sum, cnt, mine, sp = 0u;
    for (;;) {
        sum = 0u; cnt = 0u; mine = 0u;
#pragma unroll
        for (unsigned j = 0; j < 16; ++j) { const unsigned c = xb_ld(&bar[XB_XCNT(j)]); sum += c; cnt += (c > 0u) ? 1u : 0u; mine = (j == x) ? c : mine; }
        if (sum == G) break;
        __builtin_amdgcn_s_sleep(1);
        if ((++sp & 255u) == 0u) { if (xb_ld(&bar[XB_TMO])) break; if (sp > XB_SPIN_CAP) { atomicAdd(&bar[XB_TMO], 1u); break; } }
    }
    nloc = mine > 0u ? mine : 1u; nx = cnt > 0u ? cnt : 1u;
}

__device__ __forceinline__ void xcd_barrier(const XcdBarrier& b) {
    asm volatile("s_waitcnt vmcnt(0)" ::: "memory");
    __syncthreads();
    if (threadIdx.x == 0) {
        unsigned* bar = b.bar;
        __builtin_amdgcn_s_waitcnt(0);
        unsigned nloc = b.st[0], nx = b.st[1];
        if (nloc == 0u) { xcd_barrier_complete(bar, b.x, nloc, nx); b.st[0] = nloc; b.st[1] = nx; }
        const unsigned old = xb_add(&bar[XB_XSUB(b.x)], 1u);
        const unsigned gen = old / nloc;
        if (old + 1u == (gen + 1u) * nloc) {
            __builtin_amdgcn_fence(__ATOMIC_RELEASE, "agent");
            asm volatile("s_waitcnt vmcnt(0)" ::: "memory");
            const unsigned og = xb_add(&bar[XB_TOP], 1u);
            const unsigned tg = og / nx;
            if (og + 1u == (tg + 1u) * nx) xb_add(&bar[XB_TOPGEN], 1u);
            else XB_SPIN(xb_ld(&bar[XB_TOPGEN]) == tg, bar);
            __builtin_amdgcn_fence(__ATOMIC_ACQUIRE, "agent");
            xb_add(&bar[XB_XGEN(b.x)], 1u);
            asm volatile("s_waitcnt vmcnt(0)" ::: "memory");
        } else {
            XB_SPIN(xb_ld(&bar[XB_XGEN(b.x)]) == gen, bar);
            __builtin_amdgcn_fence(__ATOMIC_ACQUIRE, "agent");
            asm volatile("s_waitcnt vmcnt(0)" ::: "memory");
        }
    }
    __syncthreads();
}
typedef float f32x2_t __attribute__((ext_vector_type(2))); typedef __bf16 bf16x2_t __attribute__((ext_vector_type(2)));
typedef float f32x16 __attribute__((ext_vector_type(16)));
typedef short s16x4 __attribute__((ext_vector_type(4)));
__device__ __forceinline__ unsigned cvtpk(float lo, float hi) { f32x2_t v = {lo, hi}; bf16x2_t b = __builtin_convertvector(v, bf16x2_t); return __builtin_bit_cast(unsigned, b); }
__device__ __forceinline__ float bflo(unsigned w) { return __uint_as_float(w << 16); }
__device__ __forceinline__ float bfhi(unsigned w) { return __uint_as_float(w & 0xffff0000u); }
__device__ __forceinline__ float sigmoidf_(float v) { return 1.f / (1.f + __expf(-v)); }
#define MFMA32(a, b, c) __builtin_amdgcn_mfma_f32_32x32x16_bf16((a), (b), (c), 0, 0, 0)
#define MFMA16(a, b, c) __builtin_amdgcn_mfma_f32_16x16x32_bf16((a), (b), (c), 0, 0, 0)

struct Frame {
    unsigned char* lds;
    LAS unsigned char* ldsl;
    volatile LAS unsigned* LX;
    gu32* ctl;
    unsigned char* ws;
    int tid, lane, wave, vcu, G;
    const float *x, *c, *w_mod, *b_mod, *g_mix, *w_in, *b_forget, *w_out_a, *w_out_b, *w_out, *g_ffn, *w_group, *b_group, *w_router, *b_router, *w_e_gate, *w_e_up, *w_e_down, *g_final;
    const int* positions;
    float* out;
};
__device__ __forceinline__ float wave_sum(float v) {
#pragma unroll
    for (int o = 1; o < 64; o <<= 1) v += __shfl_xor(v, o);
    return v;
}

struct CmIn { __device__ __forceinline__ int operator()(int n) const { if (n < 1216) return n; if (n < 2752) return n + 8; if (n < 4800) return n + 16; if (n < 4808) return n - 4800 + 1216; if (n < 4816) return n - 4808 + 2760; return -1; } };
struct CmId { int base; __device__ __forceinline__ int operator()(int n) const { return n - base; } };
template <class CM>
__device__ __forceinline__ void transpose_item(const float* W, int ldw, bf16* WT, int K, int k0, int n0, const CM& cm, LAS float* scr, int lane) {
    const int sc = cm(n0 + (lane & 31));
#pragma unroll
    for (int i = 0; i < 32; ++i) { const int kk = 2 * i + (lane >> 5); scr[kk * 33 + (lane & 31)] = sc >= 0 ? W[(size_t)(k0 + kk) * ldw + sc] : 0.f; }
    LDS_WAIT(); asm volatile("" ::: "memory");
    const int c = lane & 7;
#pragma unroll
    for (int j = 0; j < 4; ++j) { const int n = (lane >> 3) + 8 * j; const LAS float* s = scr + (8 * c) * 33 + n;
        v4u o; o.x = pk2(s[0 * 33], s[1 * 33]); o.y = pk2(s[2 * 33], s[3 * 33]); o.z = pk2(s[4 * 33], s[5 * 33]); o.w = pk2(s[6 * 33], s[7 * 33]);
        *(GAS v4u*)(WT + (size_t)(n0 + n) * K + k0 + 8 * c) = o; }
    LDS_WAIT(); asm volatile("" ::: "memory");
}
__device__ __forceinline__ void p0_prologue(Frame& F) {
    __syncthreads();
    {
        LAS float* ca = (LAS float*)(F.ldsl + RING_OFF);
        LAS float* red = (LAS float*)(F.ldsl + RING_OFF + 16384);
        for (int i = F.tid; i < 4096; i += NWAVES * 64) { const float v = F.c[i]; ca[i] = v / (1.f + expf(-v)); }
        __syncthreads();
        float* MOD = (float*)(F.ws + WS_MOD);
        for (int cb = F.vcu; cb < 256; cb += F.G) {
            const int col0 = cb * 24;
            if (F.tid < 384) { const int j = F.tid % 24, ks = F.tid / 24; float a0 = 0.f, a1 = 0.f, a2 = 0.f, a3 = 0.f;
#pragma unroll 8
                for (int i = 0; i < 64; ++i) { const int k = ks + 16 * i; const float w = F.w_mod[(size_t)k * 6144 + col0 + j];
                    a0 += ca[k] * w; a1 += ca[1024 + k] * w; a2 += ca[2048 + k] * w; a3 += ca[3072 + k] * w; }
                LAS float* r = red + (ks * 24 + j) * 4; r[0] = a0; r[1] = a1; r[2] = a2; r[3] = a3; }
            __syncthreads();
            if (F.tid < 96) { const int j = F.tid % 24, bb = F.tid / 24; float s = 0.f;
#pragma unroll
                for (int ks = 0; ks < 16; ++ks) s += red[(ks * 24 + j) * 4 + bb];
                MOD[bb * 6144 + col0 + j] = s + F.b_mod[col0 + j]; }
            __syncthreads();
        }
    }
    LAS float* scr = (LAS float*)(F.ldsl + RING_OFF + F.wave * 16384);
    const int gw = F.vcu * NWAVES + F.wave, NGW = F.G * NWAVES;
    constexpr int I_IN = 16 * 152, I_OA = 8 * 32, I_O = 16 * 32, I_GU = 32 * 16 * 32, I_DN = 32 * 8 * 32;
    constexpr int NITEMS = I_IN + 2 * I_OA + I_O + I_GU + I_DN;
    bf16* WinT = (bf16*)(F.ws + WS_WIN); bf16* WoaT = (bf16*)(F.ws + WS_WOA); bf16* WobT = (bf16*)(F.ws + WS_WOB); bf16* WoT = (bf16*)(F.ws + WS_WO);
    bf16* WguT = (bf16*)(F.ws + WS_WGU); bf16* WdnT = (bf16*)(F.ws + WS_WDN);
    for (int it = gw; it < NITEMS; it += NGW) {
        int r = it;
        if (r < I_IN) { const int kb = r / 152, nb = r % 152; transpose_item(F.w_in, 4816, WinT, 1024, 64 * kb, 32 * nb, CmIn{}, scr, F.lane); continue; } r -= I_IN;
        if (r < I_OA) { const int kb = r / 32, nb = r % 32; transpose_item(F.w_out_a + 32 * nb, 1024, WoaT, 512, 64 * kb, 32 * nb, CmId{32 * nb}, scr, F.lane); continue; } r -= I_OA;
        if (r < I_OA) { const int kb = r / 32, nb = r % 32; transpose_item(F.w_out_b + 32 * nb, 1024, WobT, 512, 64 * kb, 32 * nb, CmId{32 * nb}, scr, F.lane); continue; } r -= I_OA;
        if (r < I_O) { const int kb = r / 32, nb = r % 32; transpose_item(F.w_out + 32 * nb, 1024, WoT, 1024, 64 * kb, 32 * nb, CmId{32 * nb}, scr, F.lane); continue; } r -= I_O;
        if (r < I_GU) { const int e = r / 512, q = r % 512, kb = q / 32, nb = q % 32;
            const int np = 32 * nb, ct = np >> 8, bj = (np >> 7) & 1, j0 = np & 127;
            const float* src = (bj ? F.w_e_up : F.w_e_gate) + (size_t)e * 1024 * 512 + ct * 128 + j0;
            transpose_item(src, 512, WguT, 1024, 64 * kb, e * 1024 + np, CmId{e * 1024 + np}, scr, F.lane); continue; } r -= I_GU;
        { const int e = r / 256, q = r % 256, kb = q / 32, nb = q % 32;
            const float* src = F.w_e_down + (size_t)e * 512 * 1024 + 32 * nb;
            transpose_item(src, 1024, WdnT, 512, 64 * kb, e * 1024 + 32 * nb, CmId{e * 1024 + 32 * nb}, scr, F.lane); }
    }
    { bf16* WrT = (bf16*)(F.ws + WS_WRT);
      for (int i = (F.vcu * NWAVES * 64 + F.tid); i < 64 * 1024; i += F.G * NWAVES * 64) { const int n = i >> 10, k = i & 1023;
          float v = 0.f; if (n < 32) v = F.w_router[k * 32 + n]; else if (n < 36) v = F.w_group[k * 4 + (n - 32)];
          WrT[i] = (bf16)f2bf(v); } }
}

__device__ __forceinline__ void p1_hnorm(Frame& F) {
    const int gw = F.vcu * NWAVES + F.wave, NGW = F.G * NWAVES;
    const float* MOD = (const float*)(F.ws + WS_MOD); bf16* H = (bf16*)(F.ws + WS_H);
    float* COS = (float*)(F.ws + WS_COS); float* SIN = (float*)(F.ws + WS_SIN);
    for (int m = gw; m < M; m += NGW) {
        const int b = m >> 12;
        const GAS f32x4* xr = (const GAS f32x4*)(F.x + (size_t)m * D) + F.lane;
        f32x4 v[4]; float s = 0.f;
#pragma unroll
        for (int j = 0; j < 4; ++j) { v[j] = xr[64 * j]; s += (v[j].x * v[j].x + v[j].y * v[j].y) + (v[j].z * v[j].z + v[j].w * v[j].w); }
        const float rstd = 1.f / sqrtf(wave_sum(s) * (1.f / D) + RMS_EPS);
        GAS unsigned long long* o8 = (GAS unsigned long long*)(H + (size_t)m * D) + F.lane;
#pragma unroll
        for (int j = 0; j < 4; ++j) { const int col = 4 * F.lane + 256 * j;
            const f32x4 g = *(const f32x4*)(F.g_mix + col), sc = *(const f32x4*)(MOD + b * 6144 + 1024 + col), sh = *(const f32x4*)(MOD + b * 6144 + col);
            const f32x4 h = v[j] * rstd * g * (sc + 1.0f) + sh;
            o8[64 * j] = (unsigned long long)cvtpk(h.x, h.y) | ((unsigned long long)cvtpk(h.z, h.w) << 32); }
        if (F.lane < 8) { const float invf = exp2f(-(float)F.lane * 2.3664460711655218f); const float ang = (float)F.positions[m] * invf;
            COS[m * 8 + F.lane] = cosf(ang); SIN[m * 8 + F.lane] = sinf(ang); }
    }
}

struct EpiProj {
    static constexpr bool PERM = true, AFTER_DRAIN = false, CHAIN = false;
    unsigned char* ws; const float* bfg;
    template <int BJ>
    __device__ __forceinline__ void part(const pg8::f32x4 (&acc)[2][2][4][2], const pg8::Unit& u, int wr, int wc, int fr, int fq) const {
        const float* COS = (const float*)(ws + WS_COS); const float* SIN = (const float*)(ws + WS_SIN);
        const int cg = __builtin_amdgcn_readfirstlane(u.pn * 256 + BJ * 128 + wc * 32);
        size_t boff = 0; int ld = 0, cofs = 0, kind = 4; float scale = 1.f;
        if (cg < 512)       { boff = WS_QA; ld = 512; cofs = 0;    kind = 1; scale = QSCALE; }
        else if (cg < 576)  { boff = WS_KA; ld = 64;  cofs = 512;  kind = 1; }
        else if (cg < 640)  { boff = WS_VA; ld = 64;  cofs = 576;  kind = 0; }
        else if (cg < 1152) { boff = WS_QI; ld = 512; cofs = 640;  kind = 1; scale = 0.125f; }
        else if (cg < 1216) { boff = WS_KI; ld = 64;  cofs = 1152; kind = 1; }
        else if (cg < 1728) { boff = WS_QB; ld = 512; cofs = 1216; kind = 0; scale = QSCALE; }
        else if (cg < 2240) { boff = WS_KB; ld = 512; cofs = 1728; kind = 0; }
        else if (cg < 2752) { boff = WS_VB; ld = 512; cofs = 2240; kind = 0; }
        else if (cg < 3776) { boff = WS_GA; ld = 1024; cofs = 2752; kind = 2; }
        else if (cg < 4800) { boff = WS_GB; ld = 1024; cofs = 3776; kind = 2; }
        else if (cg == 4800) { kind = 3; }
        if (kind == 4) return;
        if (kind == 3) {
#pragma unroll
            for (int ai = 0; ai < 2; ++ai)
#pragma unroll
                for (int m = 0; m < 4; ++m) {
                    const int row = u.pm * 256 + ai * 128 + wr * 64 + m * 16 + fr;
                    const pg8::f32x4 v0 = acc[ai][BJ][m][0], v1 = acc[ai][BJ][m][1];
                    if (fq == 0) { float* wi = (float*)(ws + WS_WI) + (size_t)row * 8; const float s = 0.35355339059327373f; *(pg8::f32x4*)wi = v0 * s; *(pg8::f32x4*)(wi + 4) = v1 * s; }
                    else if (fq == 1) { float* lf = (float*)(ws + WS_LOGF) + (size_t)(row >> 12) * 8 * SEQ + (row & (SEQ - 1));
#pragma unroll
                        for (int i = 0; i < 8; ++i) { const float z = (i < 4 ? v0[i & 3] : v1[i & 3]) + bfg[i];
                            const float ls = z >= 0.f ? -log1pf(expf(-z)) : z - log1pf(expf(z)); lf[(size_t)i * SEQ] = ls; } }
                }
            return;
        }
        const bool rope = (kind == 1) && ((cg & 63) == 0);
        const bool isKB = (cg >= 1728) && (cg < 2240);
        bf16* base = (bf16*)(ws + boff);
        const int c0 = cg + 8 * fq - cofs;
#pragma unroll
        for (int ai = 0; ai < 2; ++ai)
#pragma unroll
            for (int m = 0; m < 4; ++m) {
                const int row = u.pm * 256 + ai * 128 + wr * 64 + m * 16 + fr;
                pg8::f32x4 v0 = acc[ai][BJ][m][0], v1 = acc[ai][BJ][m][1];
                if (rope) {
                    pg8::f32x4 o0, o1;
#pragma unroll
                    for (int i = 0; i < 4; ++i) { o0[i] = __shfl_xor(v0[i], 16); o1[i] = __shfl_xor(v1[i], 16); }
                    const pg8::f32x4 c0v = *(const pg8::f32x4*)(COS + (size_t)row * 8), c1v = *(const pg8::f32x4*)(COS + (size_t)row * 8 + 4);
                    const pg8::f32x4 s0v = *(const pg8::f32x4*)(SIN + (size_t)row * 8), s1v = *(const pg8::f32x4*)(SIN + (size_t)row * 8 + 4);
                    if (fq < 2) { const float sg = fq == 0 ? -1.f : 1.f; v0 = v0 * c0v + o0 * s0v * sg; v1 = v1 * c1v + o1 * s1v * sg; }
                }
                if (kind == 2) {
#pragma unroll
                    for (int i = 0; i < 4; ++i) { v0[i] = sigmoidf_(v0[i]); v1[i] = sigmoidf_(v1[i]); }
                }
                v0 = v0 * scale; v1 = v1 * scale;
                pg8::u32x4 w; w.x = cvtpk(v0[0], v0[1]); w.y = cvtpk(v0[2], v0[3]); w.z = cvtpk(v1[0], v1[1]); w.w = cvtpk(v1[2], v1[3]);
                *(pg8::u32x4*)(base + (size_t)row * ld + c0) = w;
                if (isKB) {
                    float ss = (v0[0] * v0[0] + v0[1] * v0[1]) + (v0[2] * v0[2] + v0[3] * v0[3]) + (v1[0] * v1[0] + v1[1] * v1[1]) + (v1[2] * v1[2] + v1[3] * v1[3]);
                    ss += __shfl_xor(ss, 16); ss += __shfl_xor(ss, 32);
                    if (fq == 0) atomicAdd((float*)(ws + WS_CTL) + CW_KN2 + ((size_t)(row >> 12) * 8 + ((cg - 1728) >> 6)) * SEQ + (row & (SEQ - 1)), ss);
                }
            }
    }
    __device__ __forceinline__ void operator()(const pg8::f32x4 (&acc)[2][2][4][2], const pg8::Unit& u, int wr, int wc, int fr, int fq) const {
        part<0>(acc, u, wr, wc, fr, fq); part<1>(acc, u, wr, wc, fr, fq);
    }
};
struct EpiMerge {
    static constexpr bool PERM = true, AFTER_DRAIN = false, CHAIN = true;
    unsigned char* ws; size_t dst_off;
    __device__ __forceinline__ bool chain(pg8::f32x4 (&acc)[2][2][4][2], const pg8::Unit& u, int wr, int wc, int fr, int fq) const {
        bf16* GA = (bf16*)(ws + WS_GA); const bf16* GB = (const bf16*)(ws + WS_GB);
        const int half = u.pn >> 2, pm = u.pm & 63, pn = u.pn & 3;
#pragma unroll
        for (int ai = 0; ai < 2; ++ai)
#pragma unroll
            for (int m = 0; m < 4; ++m) {
                const int row = pm * 256 + ai * 128 + wr * 64 + m * 16 + fr;
#pragma unroll
                for (int bj = 0; bj < 2; ++bj) {
                    const size_t off = (size_t)row * 1024 + pn * 256 + bj * 128 + wc * 32 + 8 * fq;
                    const pg8::u32x4 g = *(const pg8::u32x4*)(GB + off);
                    if (half == 0) {
                        const pg8::u32x4 a = *(const pg8::u32x4*)(GA + off);
                        pg8::f32x4 r0, r1;
                        r0[0] = bflo(a.x) * __builtin_amdgcn_rcpf(bflo(g.x)); r0[1] = bfhi(a.x) * __builtin_amdgcn_rcpf(bfhi(g.x)); r0[2] = bflo(a.y) * __builtin_amdgcn_rcpf(bflo(g.y)); r0[3] = bfhi(a.y) * __builtin_amdgcn_rcpf(bfhi(g.y));
                        r1[0] = bflo(a.z) * __builtin_amdgcn_rcpf(bflo(g.z)); r1[1] = bfhi(a.z) * __builtin_amdgcn_rcpf(bfhi(g.z)); r1[2] = bflo(a.w) * __builtin_amdgcn_rcpf(bflo(g.w)); r1[3] = bfhi(a.w) * __builtin_amdgcn_rcpf(bfhi(g.w));
                        acc[ai][bj][m][0] = acc[ai][bj][m][0] * r0; acc[ai][bj][m][1] = acc[ai][bj][m][1] * r1;
                    } else {
                        const pg8::f32x4 v0 = acc[ai][bj][m][0], v1 = acc[ai][bj][m][1];
                        pg8::u32x4 w; w.x = cvtpk(bflo(g.x) * v0[0], bfhi(g.x) * v0[1]); w.y = cvtpk(bflo(g.y) * v0[2], bfhi(g.y) * v0[3]);
                        w.z = cvtpk(bflo(g.z) * v1[0], bfhi(g.z) * v1[1]); w.w = cvtpk(bflo(g.w) * v1[2], bfhi(g.w) * v1[3]);
                        *(pg8::u32x4*)((bf16*)(ws + dst_off) + off) = w;
                    }
                }
            }
        return half == 0;
    }
    __device__ __forceinline__ void operator()(const pg8::f32x4 (&)[2][2][4][2], const pg8::Unit&, int, int, int, int) const {}
};
struct MergeOrder {
    pg8::StaticOrder S;
    __device__ __forceinline__ bool next(int i, pg8::Unit& u) const { if (!S.next(i >> 1, u)) return false; const int h = i & 1; u.pm += 64 * h; u.pn += 4 * h; return true; }
    __device__ __forceinline__ void a_ready(const pg8::Unit&) const {}
    __device__ __forceinline__ void done(const pg8::Unit&) const {}
};
struct EpiOut {
    static constexpr bool PERM = true, AFTER_DRAIN = false, CHAIN = false;
    unsigned char* ws; const float* x; float* out; bool stats;
    __device__ __forceinline__ void operator()(const pg8::f32x4 (&acc)[2][2][4][2], const pg8::Unit& u, int wr, int wc, int fr, int fq) const {
        const float* MOD = (const float*)(ws + WS_MOD); float* SSQ = (float*)(ws + WS_CTL) + CW_SSQ;
        const int b = u.pm >> 4;
        const int colb = u.pn * 256 + wc * 32 + 8 * fq;
        pg8::f32x4 gt[2][2];
#pragma unroll
        for (int bj = 0; bj < 2; ++bj) { gt[bj][0] = *(const pg8::f32x4*)(MOD + b * 6144 + 2048 + colb + bj * 128); gt[bj][1] = *(const pg8::f32x4*)(MOD + b * 6144 + 2048 + colb + bj * 128 + 4); }
#pragma unroll
        for (int ai = 0; ai < 2; ++ai)
#pragma unroll
            for (int m = 0; m < 4; ++m) {
                const int row = u.pm * 256 + ai * 128 + wr * 64 + m * 16 + fr; float ss = 0.f;
#pragma unroll
                for (int bj = 0; bj < 2; ++bj) {
                    const size_t off = (size_t)row * 1024 + colb + bj * 128;
                    const pg8::f32x4 x0 = *(const pg8::f32x4*)(x + off), x1 = *(const pg8::f32x4*)(x + off + 4);
                    const pg8::f32x4 y0 = x0 + gt[bj][0] * acc[ai][bj][m][0], y1 = x1 + gt[bj][1] * acc[ai][bj][m][1];
                    *(pg8::f32x4*)(out + off) = y0; *(pg8::f32x4*)(out + off + 4) = y1;
                    ss += (y0[0] * y0[0] + y0[1] * y0[1]) + (y0[2] * y0[2] + y0[3] * y0[3]) + (y1[0] * y1[0] + y1[1] * y1[1]) + (y1[2] * y1[2] + y1[3] * y1[3]);
                }
                ss += __shfl_xor(ss, 16); ss += __shfl_xor(ss, 32);
                if (fq == 0 && stats) atomicAdd(SSQ + row, ss);
            }
    }
};
struct EpiGU {
    static constexpr bool PERM = true, AFTER_DRAIN = false, CHAIN = false;
    unsigned char* ws;
    __device__ __forceinline__ void operator()(const pg8::f32x4 (&acc)[2][2][4][2], const pg8::Unit& u, int wr, int wc, int fr, int fq) const {
        bf16* HID = (bf16*)(ws + WS_HID);
        const int col = (u.pn & 3) * 128 + wc * 32 + 8 * fq;
#pragma unroll
        for (int ai = 0; ai < 2; ++ai)
#pragma unroll
            for (int m = 0; m < 4; ++m) {
                const int row = u.pm * 256 + ai * 128 + wr * 64 + m * 16 + fr;
                float r[8];
#pragma unroll
                for (int i = 0; i < 8; ++i) { const float g = i < 4 ? acc[ai][0][m][0][i] : acc[ai][0][m][1][i - 4]; const float up = i < 4 ? acc[ai][1][m][0][i] : acc[ai][1][m][1][i - 4];
                    r[i] = g * sigmoidf_(g) * up; }
                pg8::u32x4 w; w.x = cvtpk(r[0], r[1]); w.y = cvtpk(r[2], r[3]); w.z = cvtpk(r[4], r[5]); w.w = cvtpk(r[6], r[7]);
                *(pg8::u32x4*)(HID + (size_t)row * 512 + col) = w;
            }
    }
};
struct EpiDown {
    static constexpr bool PERM = true, AFTER_DRAIN = false, CHAIN = false;
    unsigned char* ws; const volatile LAS unsigned* LX;
    __device__ __forceinline__ void operator()(const pg8::f32x4 (&acc)[2][2][4][2], const pg8::Unit& u, int wr, int wc, int fr, int fq) const {
        bf16* YC = (bf16*)(ws + WS_YC); const int* TOKSLOT = (const int*)(ws + WS_TOKSLOT); const float* WROW = (const float*)(ws + WS_WROW);
        const int colb = (u.pn & 3) * 256 + wc * 32 + 8 * fq;
        const int e = u.pn >> 2; const int lbase = (u.pm - (int)(LX[96 + e] >> 8)) * 256, cnt = (int)LX[320 + e];
#pragma unroll
        for (int ai = 0; ai < 2; ++ai)
#pragma unroll
            for (int m = 0; m < 4; ++m) {
                const int local = lbase + ai * 128 + wr * 64 + m * 16 + fr;
                if (local < cnt) {
                    const int ts = TOKSLOT[e * ECAP + local]; const float gw = WROW[e * ECAP + local];
#pragma unroll
                    for (int bj = 0; bj < 2; ++bj) { const pg8::f32x4 v0 = acc[ai][bj][m][0] * gw, v1 = acc[ai][bj][m][1] * gw;
                        pg8::u32x4 w; w.x = cvtpk(v0[0], v0[1]); w.y = cvtpk(v0[2], v0[3]); w.z = cvtpk(v1[0], v1[1]); w.w = cvtpk(v1[2], v1[3]);
                        *(pg8::u32x4*)(YC + (size_t)ts * 1024 + colb + bj * 128) = w; }
                }
            }
    }
};
struct MoeRowMap {
    const int* TOKSLOT; const volatile LAS unsigned* LX;
    __device__ __forceinline__ unsigned rowoff(const pg8::Unit& u, int r) const {
        const int e = u.pn >> 2; const int local = (u.pm - (int)(LX[96 + e] >> 8)) * 256 + r;
        const int tok = local < (int)LX[320 + e] ? (TOKSLOT[e * ECAP + local] >> 1) : 0;
        return (unsigned)tok * (unsigned)(D * 2);
    }
};
struct MoeOrder {
    int G, c, nunits; const volatile LAS unsigned* tile_e;
    __device__ __forceinline__ bool next(int i, pg8::Unit& u) const { const int L = i * G + c; if (L >= nunits) return false; const int rt = L >> 2; u.pm = rt; u.pn = (int)tile_e[rt] * 4 + (L & 3); return true; }
    __device__ __forceinline__ void a_ready(const pg8::Unit&) const {}
    __device__ __forceinline__ void done(const pg8::Unit&) const {}
};
__device__ __forceinline__ void moe_table(Frame& F) {
    const gu32* CNT = F.ctl + CW_CNT;
    if (F.tid == 0) { unsigned p = 0;
        for (int e = 0; e < 32; ++e) { F.LX[96 + e] = p; const unsigned c = __hip_atomic_load(CNT + e, RLX_AGENT); F.LX[320 + e] = c; const unsigned nt = (c + 255u) >> 8;
            for (unsigned t = 0; t < nt; ++t) if ((p >> 8) + t < (unsigned)NTMAX) F.LX[160 + (p >> 8) + t] = (unsigned)e;
            p += nt << 8; }
        F.LX[128] = p; F.LX[132] = (p >> 8) < (unsigned)NTMAX ? (p >> 8) : (unsigned)NTMAX; }
    __syncthreads();
}
#ifndef DUP_MASK
#define DUP_MASK 0
#endif
typedef short v4i16_t __attribute__((ext_vector_type(4)));
__device__ __forceinline__ s16x4 trread(LAS const unsigned char* p) { return __builtin_bit_cast(s16x4, __builtin_amdgcn_ds_read_tr16_b64_v4i16((LAS v4i16_t*)p)); }
constexpr int FX_CK = 0, FX_K = 16384, FX_V = 32768, FX_VROW = 144, FX_VBUF = 64 * FX_VROW;
__device__ __forceinline__ float xhalf(float v, int hi) { const auto rr = __builtin_amdgcn_permlane32_swap(__float_as_uint(v), __float_as_uint(v), false, false); return __uint_as_float(hi ? rr[0] : rr[1]); }
__device__ __forceinline__ void fox_tile(LAS unsigned char* L, LAS float* CK, int cur, int t, int r32, int hi, int lane, int q, int qminw,
                                         const pg8::bf16x8 (&qf)[4], float& m_run, float& l_run, f32x16& o0, f32x16& o1) {
    LAS const unsigned char* Kb = L + FX_K + cur * 8192; LAS const unsigned char* Vb = L + FX_V + cur * FX_VBUF;
    f32x16 p0, p1;
#pragma unroll
    for (int rq = 0; rq < 4; ++rq) { const f32x4 c0 = *(LAS const f32x4*)(CK + 64 * t + 8 * rq + 4 * hi), c1 = *(LAS const f32x4*)(CK + 64 * t + 32 + 8 * rq + 4 * hi);
#pragma unroll
        for (int i = 0; i < 4; ++i) { p0[4 * rq + i] = c0[i]; p1[4 * rq + i] = c1[i]; } }
#pragma unroll
    for (int d0 = 0; d0 < 4; ++d0) {
        const int co = ((2 * d0 + hi) ^ (r32 & 7)) * 16;
        const pg8::bf16x8 a0 = *(LAS const pg8::bf16x8*)(Kb + r32 * 128 + co);
        const pg8::bf16x8 a1 = *(LAS const pg8::bf16x8*)(Kb + (r32 + 32) * 128 + co);
        p0 = MFMA32(a0, qf[d0], p0); p1 = MFMA32(a1, qf[d0], p1);
    }
    if (64 * t + 63 > qminw) {
#pragma unroll
        for (int r = 0; r < 16; ++r) { const int key = 64 * t + (r & 3) + 8 * (r >> 2) + 4 * hi; if (key > q) p0[r] = -1e30f; if (key + 32 > q) p1[r] = -1e30f; } }
    float mx = p0[0];
#pragma unroll
    for (int r = 1; r < 16; ++r) mx = fmaxf(mx, p0[r]);
#pragma unroll
    for (int r = 0; r < 16; ++r) mx = fmaxf(mx, p1[r]);
    mx = fmaxf(mx, xhalf(mx, hi));
    const float mnew = fmaxf(m_run, mx), alpha = __builtin_amdgcn_exp2f(m_run - mnew); m_run = mnew;
    float rs = 0.f;
#pragma unroll
    for (int r = 0; r < 16; ++r) { p0[r] = __builtin_amdgcn_exp2f(p0[r] - mnew); p1[r] = __builtin_amdgcn_exp2f(p1[r] - mnew); rs += p0[r] + p1[r]; }
    rs += xhalf(rs, hi);
    l_run = l_run * alpha + rs;
#pragma unroll
    for (int r = 0; r < 16; ++r) { o0[r] *= alpha; o1[r] *= alpha; }
    pg8::bf16x8 pb[4];
#pragma unroll
    for (int s = 0; s < 2; ++s) { v4u w;
        w.x = cvtpk(p0[8 * s], p0[8 * s + 1]); w.y = cvtpk(p0[8 * s + 2], p0[8 * s + 3]); w.z = cvtpk(p0[8 * s + 4], p0[8 * s + 5]); w.w = cvtpk(p0[8 * s + 6], p0[8 * s + 7]); pb[s] = __builtin_bit_cast(pg8::bf16x8, w);
        w.x = cvtpk(p1[8 * s], p1[8 * s + 1]); w.y = cvtpk(p1[8 * s + 2], p1[8 * s + 3]); w.z = cvtpk(p1[8 * s + 4], p1[8 * s + 5]); w.w = cvtpk(p1[8 * s + 6], p1[8 * s + 7]); pb[2 + s] = __builtin_bit_cast(pg8::bf16x8, w); }
    LAS const unsigned char* vb = Vb + (4 * hi + ((lane & 15) >> 2)) * FX_VROW + (16 * ((lane >> 4) & 1) + 4 * (lane & 3)) * 2;
#pragma unroll
    for (int s = 0; s < 4; ++s) {
        const s16x4 l0 = trread(vb + (16 * s) * FX_VROW), h0 = trread(vb + (16 * s + 8) * FX_VROW);
        const s16x4 l1 = trread(vb + (16 * s) * FX_VROW + 64), h1 = trread(vb + (16 * s + 8) * FX_VROW + 64);
        const pg8::bf16x8 a0 = {l0[0], l0[1], l0[2], l0[3], h0[0], h0[1], h0[2], h0[3]};
        const pg8::bf16x8 a1 = {l1[0], l1[1], l1[2], l1[3], h1[0], h1[1], h1[2], h1[3]};
        o0 = MFMA32(a0, pb[s], o0); o1 = MFMA32(a1, pb[s], o1);
    }
}
constexpr int FX_PM = 51200;
constexpr float FX_SKIP = 64.f;
__device__ __forceinline__ void fox_unit(Frame& F, int b, int h, int qb) {
    const int tid = F.tid, lane = F.lane, wave = F.wave, r32 = lane & 31, hi = lane >> 5;
    LAS unsigned char* L = F.ldsl + RING_OFF;
    LAS float* CK = (LAS float*)(L + FX_CK); LAS float* PM = (LAS float*)(L + FX_PM);
    const int nkeys = (qb + 1) * 256, NT = nkeys / 64;
    const bf16* QBp = (const bf16*)(F.ws + WS_QB); const bf16* KBp = (const bf16*)(F.ws + WS_KB); const bf16* VBp = (const bf16*)(F.ws + WS_VB);
    __syncthreads();
    {
        const float* lf = (const float*)(F.ws + WS_LOGF) + (size_t)(b * 8 + h) * SEQ;
        const float* kn = (const float*)(F.ws + WS_CTL) + CW_KN2 + (size_t)(b * 8 + h) * SEQ;
        float v[8]; const int k0 = tid * 8; float pm = 0.f;
        if (k0 < nkeys) { const f32x4 a = *(const f32x4*)(lf + k0), c = *(const f32x4*)(lf + k0 + 4); v[0] = a.x; v[1] = a.y; v[2] = a.z; v[3] = a.w; v[4] = c.x; v[5] = c.y; v[6] = c.z; v[7] = c.w;
            const f32x4 n0 = *(const f32x4*)(kn + k0), n1 = *(const f32x4*)(kn + k0 + 4); pm = fmaxf(fmaxf(fmaxf(n0.x, n0.y), fmaxf(n0.z, n0.w)), fmaxf(fmaxf(n1.x, n1.y), fmaxf(n1.z, n1.w))); }
        else {
#pragma unroll
            for (int i = 0; i < 8; ++i) v[i] = 0.f; }
#pragma unroll
        for (int i = 1; i < 8; ++i) v[i] += v[i - 1];
        const float tot = v[7]; float sc = tot;
#pragma unroll
        for (int o = 1; o < 64; o <<= 1) { const float t = __shfl_up(sc, o); if (lane >= o) sc += t; const float u = __shfl_up(pm, o); if (lane >= o) pm = fmaxf(pm, u); }
        if (lane == 63) { F.LX[8 + wave] = __float_as_uint(sc); F.LX[24 + wave] = __float_as_uint(pm); }
        __syncthreads();
        float woff = 0.f, cref = 0.f, pmo = 0.f;
#pragma unroll
        for (int w = 0; w < 8; ++w) { const float t = __uint_as_float(F.LX[8 + w]); cref += t; if (w < wave) { woff += t; pmo = fmaxf(pmo, __uint_as_float(F.LX[24 + w])); } }
        const float base = woff + sc - tot;
        if (k0 < nkeys) {
#pragma unroll
            for (int i = 0; i < 8; ++i) CK[k0 + i] = (cref - (base + v[i])) * LOG2E; }
        PM[tid] = fmaxf(pm, pmo);
    }
    const size_t qrow = (size_t)b * SEQ + qb * 256 + wave * 32 + r32;
    pg8::bf16x8 qf[4]; float qn = 0.f;
#pragma unroll
    for (int d0 = 0; d0 < 4; ++d0) { qf[d0] = *(const pg8::bf16x8*)(QBp + qrow * 512 + h * 64 + d0 * 16 + hi * 8);
#pragma unroll
        for (int j = 0; j < 8; ++j) { const float e = __uint_as_float((unsigned)(unsigned short)qf[d0][j] << 16); qn += e * e; } }
    qn += xhalf(qn, hi); qn = sqrtf(qn) * 1.02f;
    float m_run = -1e30f, l_run = 0.f; f32x16 o0 = {}, o1 = {};
    const int kr = tid >> 3, ch = tid & 7;
    const bf16* Kg = KBp + ((size_t)b * SEQ + kr) * 512 + h * 64 + ch * 8;
    const bf16* Vg = VBp + ((size_t)b * SEQ + kr) * 512 + h * 64 + ch * 8;
    const int kwo = FX_K + kr * 128 + ((ch ^ (kr & 7)) * 16), vwo = FX_V + kr * FX_VROW + ch * 16;
#define FOX_TILE_OFF(i) ((size_t)(NT - 1 - (i)) * 64 * 512)
    v4u kr0 = *(const v4u*)(Kg + FOX_TILE_OFF(0)), vr0 = *(const v4u*)(Vg + FOX_TILE_OFF(0)), kr1 = kr0, vr1 = vr0, kr2 = kr0, vr2 = vr0;
    if (1 < NT) { kr1 = *(const v4u*)(Kg + FOX_TILE_OFF(1)); vr1 = *(const v4u*)(Vg + FOX_TILE_OFF(1)); }
    if (2 < NT) { kr2 = *(const v4u*)(Kg + FOX_TILE_OFF(2)); vr2 = *(const v4u*)(Vg + FOX_TILE_OFF(2)); }
    *(LAS v4u*)(L + kwo) = kr0; *(LAS v4u*)(L + vwo) = vr0;
    __syncthreads();
    const int qminw = qb * 256 + wave * 32, qmaxw = qminw + 31, q = qminw + r32;
    bool stop = false;
#define FOX_STEP(i, KRF, VRF, KRN, VRN) do { \
        const int cur = (i) & 1, t_ = NT - 1 - (i); \
        if ((i) + 3 < NT) { KRF = *(const v4u*)(Kg + FOX_TILE_OFF((i) + 3)); VRF = *(const v4u*)(Vg + FOX_TILE_OFF((i) + 3)); } \
        bool done_ = false; \
        if (64 * t_ <= qmaxw) { fox_tile(L, CK, cur, t_, r32, hi, lane, q, qminw, qf, m_run, l_run, o0, o1); \
            if (t_ > 0) { const float bnd_ = qn * sqrtf(PM[8 * t_ - 1]) + CK[64 * t_ - 1]; done_ = __all(bnd_ < m_run - FX_SKIP); } } \
        if (lane == 0) F.LX[40 + cur * 8 + wave] = done_ ? 1u : 0u; \
        if ((i) + 1 < NT) { const int nb = cur ^ 1; *(LAS v4u*)(L + kwo + nb * 8192) = KRN; *(LAS v4u*)(L + vwo + nb * FX_VBUF) = VRN; } \
        __syncthreads(); \
        { unsigned all_ = 1u; _Pragma("unroll") for (int w_ = 0; w_ < 8; ++w_) all_ &= F.LX[40 + cur * 8 + w_]; stop = all_ != 0u; } } while (0)
    for (int i = 0; i < NT && !stop; i += 3) {
        FOX_STEP(i, kr0, vr0, kr1, vr1);
        if (!stop && i + 1 < NT) FOX_STEP(i + 1, kr1, vr1, kr2, vr2);
        if (!stop && i + 2 < NT) FOX_STEP(i + 2, kr2, vr2, kr0, vr0);
    }
#undef FOX_STEP
#undef FOX_TILE_OFF
    const float inv = 1.f / l_run;
    bf16* Op = (bf16*)(F.ws + WS_OB) + qrow * 512 + h * 64;
#pragma unroll
    for (int rq = 0; rq < 4; ++rq) {
        const unsigned long long w0 = (unsigned long long)cvtpk(o0[4 * rq] * inv, o0[4 * rq + 1] * inv) | ((unsigned long long)cvtpk(o0[4 * rq + 2] * inv, o0[4 * rq + 3] * inv) << 32);
        const unsigned long long w1 = (unsigned long long)cvtpk(o1[4 * rq] * inv, o1[4 * rq + 1] * inv) | ((unsigned long long)cvtpk(o1[4 * rq + 2] * inv, o1[4 * rq + 3] * inv) << 32);
        *(unsigned long long*)(Op + 8 * rq + 4 * hi) = w0; *(unsigned long long*)(Op + 32 + 8 * rq + 4 * hi) = w1;
    }
}
__device__ __forceinline__ void hist_pick(LAS unsigned* hist, int lane, unsigned target, unsigned& bsel_o, unsigned& cge_o, unsigned& cb_o) {
    const v4u hv = *(LAS const v4u*)(hist + 4 * lane);
    *(LAS v4u*)(hist + 4 * lane) = (v4u){0u, 0u, 0u, 0u};
    const unsigned sl = hv.x + hv.y + hv.z + hv.w;
    unsigned suf = sl;
#pragma unroll
    for (int o = 1; o < 64; o <<= 1) { const unsigned t = __shfl_down(suf, o); if (lane + o < 64) suf += t; }
    const unsigned above = suf - sl;
    const bool here = (suf >= target) && (above < target);
    unsigned bsel = 0u, cge = 0u, cb = 0u;
    if (here) {
        if (above + hv.w >= target) { bsel = 4 * lane + 3; cge = above + hv.w; cb = hv.w; }
        else if (above + hv.w + hv.z >= target) { bsel = 4 * lane + 2; cge = above + hv.w + hv.z; cb = hv.z; }
        else if (above + hv.w + hv.z + hv.y >= target) { bsel = 4 * lane + 1; cge = above + hv.w + hv.z + hv.y; cb = hv.y; }
        else { bsel = 4 * lane; cge = suf; cb = hv.x; } }
    const unsigned long long mh = __ballot(here);
    const int src = mh ? (int)__builtin_ctzll(mh) : 0;
    bsel_o = (unsigned)__shfl((int)bsel, src); cge_o = (unsigned)__shfl((int)cge, src); cb_o = (unsigned)__shfl((int)cb, src);
}
template <int NJ>
__device__ __forceinline__ void dsa_select(LAS const unsigned* sr, LAS unsigned* hist, LAS int* SEL, int nj, int lane) {
    unsigned key[NJ];
#pragma unroll
    for (int j = 0; j < NJ; ++j) { unsigned u = 0u; if (j < NJ - 16 || j < nj) u = sr[64 * j + lane]; key[j] = u; }
    unsigned T = 0u; int nge = 0;
    {
        unsigned b1, cge1, c1;
        hist_pick(hist, lane, 256u, b1, cge1, c1);
        T = b1 << 24; nge = (int)cge1;
        unsigned above = cge1 - c1;
#pragma unroll
        for (int sh = 16; sh >= 8; sh -= 8) {
            if (nge != 256) {
                const unsigned pre = T >> (sh + 8);
#pragma unroll
                for (int j = 0; j < NJ; ++j) if ((key[j] >> (sh + 8)) == pre) __hip_atomic_fetch_add(hist + ((key[j] >> sh) & 255u), 1u, __ATOMIC_RELAXED, __HIP_MEMORY_SCOPE_WORKGROUP);
                asm volatile("s_waitcnt lgkmcnt(0)" ::: "memory");
                unsigned b2, cge2, c2;
                hist_pick(hist, lane, 256u - above, b2, cge2, c2);
                T |= b2 << sh; nge = (int)(above + cge2); above += cge2 - c2;
            }
        }
    }
    for (int bit = 7; bit >= 0 && nge != 256; --bit) {
        const unsigned cand = T | (1u << bit); unsigned cl = 0u;
#pragma unroll
        for (int j = 0; j < NJ; ++j) cl += (key[j] >= cand) ? 1u : 0u;
        int cnt = 0;
#pragma unroll
        for (int bb = 0; bb < 7; ++bb) cnt += __popcll(__ballot(((cl >> bb) & 1u) != 0u)) << bb;
        if (cnt >= 256) { T = cand; nge = cnt; }
    }
    if (nge == 256) {
        unsigned cl = 0u;
#pragma unroll
        for (int j = 0; j < NJ; ++j) cl += (key[j] >= T) ? 1u : 0u;
        int p = 0;
#pragma unroll
        for (int bb = 0; bb < 7; ++bb) { const unsigned long long mk = __ballot(((cl >> bb) & 1u) != 0u);
            p += (int)__builtin_amdgcn_mbcnt_hi((unsigned)(mk >> 32), __builtin_amdgcn_mbcnt_lo((unsigned)mk, 0u)) << bb; }
#pragma unroll
        for (int j = 0; j < NJ; ++j) if (key[j] >= T) { SEL[p & 255] = 64 * j + lane; ++p; }
    } else {
        int ngt = 0;
#pragma unroll
        for (int j = 0; j < NJ; ++j) ngt += __popcll(__ballot(key[j] > T));
        const int need_eq = 256 - ngt; int pos = 0, eq_seen = 0;
#pragma unroll
        for (int j = 0; j < NJ; ++j) {
            const bool gt = key[j] > T, eq = key[j] == T;
            const unsigned long long meq = __ballot(eq);
            const int eq_rank = eq_seen + (int)__builtin_amdgcn_mbcnt_hi((unsigned)(meq >> 32), __builtin_amdgcn_mbcnt_lo((unsigned)meq, 0u));
            const bool take = gt || (eq && eq_rank < need_eq);
            const unsigned long long mt = __ballot(take);
            const int pr = (int)__builtin_amdgcn_mbcnt_hi((unsigned)(mt >> 32), __builtin_amdgcn_mbcnt_lo((unsigned)mt, 0u));
            if (take && pos + pr < 256) SEL[pos + pr] = 64 * j + lane;
            pos += __popcll(mt); eq_seen += __popcll(meq);
        }
    }
}
typedef _Float16 h16x8 __attribute__((ext_vector_type(8))); typedef _Float16 h16x2 __attribute__((ext_vector_type(2)));
__device__ __forceinline__ h16x2 relu_pk(float a, float b) { const h16x2 p = __builtin_bit_cast(h16x2, __builtin_amdgcn_cvt_pkrtz(a, b)); const h16x2 z = {0, 0}; return __builtin_elementwise_max(p, z); }
template <bool FULL>
__device__ __forceinline__ void dsa_attend(Frame& F, LAS unsigned char* L, LAS int* SEL, int b, size_t qrow, int nsel) {
    const int lane = F.lane, wave = F.wave;
    const bf16* QA = (const bf16*)(F.ws + WS_QA); const bf16* KA = (const bf16*)(F.ws + WS_KA); const bf16* VA = (const bf16*)(F.ws + WS_VA);
    const int n = lane & 15, kg = lane >> 4;
    pg8::bf16x8 qf[2];
#pragma unroll
    for (int s = 0; s < 2; ++s) { qf[s] = (pg8::bf16x8){0, 0, 0, 0, 0, 0, 0, 0}; if (n < 8) qf[s] = *(const pg8::bf16x8*)(QA + qrow * 512 + n * 64 + 32 * s + 8 * kg); }
    const int ntile = FULL ? 16 : (nsel >> 4);
    const bf16* vgb = VA + (size_t)b * SEQ * 64 + 8 * (lane & 7);
    LAS unsigned char* VS = L + wave * 16384;
    const int nsc = FULL ? 8 : (nsel >> 5);
#define DSA_DMAV(sc, slot) do { _Pragma("unroll") for (int i_ = 0; i_ < 4; ++i_) { const int idx_ = SEL[32 * (sc) + 8 * i_ + (lane >> 3)]; \
        __builtin_amdgcn_global_load_lds((const unsigned*)(vgb + (size_t)idx_ * 64), (LAS unsigned*)(VS + (slot) * 4096 + i_ * 1024), 16, 0, 0); } } while (0)
#define DSA_PV(slot, sc) do { _Pragma("unroll") for (int dt_ = 0; dt_ < 4; ++dt_) { \
        const s16x4 lo_ = trread(vb + (slot) * 4096 + dt_ * 32), hh_ = trread(vb + (slot) * 4096 + 16 * 128 + dt_ * 32); \
        const pg8::bf16x8 a_ = {lo_[0], lo_[1], lo_[2], lo_[3], hh_[0], hh_[1], hh_[2], hh_[3]}; \
        o[dt_] = MFMA16(a_, pb[(sc)], o[dt_]); } } while (0)
    DSA_DMAV(0, 0); DSA_DMAV(1, 1);
    if (FULL || nsc > 2) { DSA_DMAV(2, 2); DSA_DMAV(3, 3); }
    f32x4 x[16];
#pragma unroll
    for (int t = 0; t < 16; ++t) {
        x[t] = (f32x4){-1e30f, -1e30f, -1e30f, -1e30f};
        if (FULL || t < ntile) { const int idx = SEL[16 * t + n]; const bf16* kp = KA + ((size_t)b * SEQ + idx) * 64 + 8 * kg;
            const pg8::bf16x8 a0 = *(const pg8::bf16x8*)kp, a1 = *(const pg8::bf16x8*)(kp + 32);
            f32x4 z = {0.f, 0.f, 0.f, 0.f}; z = MFMA16(a0, qf[0], z); z = MFMA16(a1, qf[1], z); x[t] = z; }
    }
    float mx = -1e30f;
#pragma unroll
    for (int t = 0; t < 16; ++t) mx = fmaxf(fmaxf(mx, fmaxf(x[t][0], x[t][1])), fmaxf(x[t][2], x[t][3]));
    mx = fmaxf(mx, __shfl_xor(mx, 16)); mx = fmaxf(mx, __shfl_xor(mx, 32));
    float ls = 0.f;
#pragma unroll
    for (int t = 0; t < 16; ++t) {
#pragma unroll
        for (int i = 0; i < 4; ++i) { x[t][i] = __builtin_amdgcn_exp2f(x[t][i] - mx); ls += x[t][i]; } }
    ls += __shfl_xor(ls, 16); ls += __shfl_xor(ls, 32);
    pg8::bf16x8 pb[8];
#pragma unroll
    for (int s = 0; s < 8; ++s) { v4u w; w.x = cvtpk(x[2 * s][0], x[2 * s][1]); w.y = cvtpk(x[2 * s][2], x[2 * s][3]); w.z = cvtpk(x[2 * s + 1][0], x[2 * s + 1][1]); w.w = cvtpk(x[2 * s + 1][2], x[2 * s + 1][3]); pb[s] = __builtin_bit_cast(pg8::bf16x8, w); }
    f32x4 o[4];
#pragma unroll
    for (int dt = 0; dt < 4; ++dt) o[dt] = (f32x4){0.f, 0.f, 0.f, 0.f};
    LAS const unsigned char* vb = VS + (4 * kg + (n >> 2)) * 128 + (4 * (n & 3)) * 2;
    asm volatile("s_waitcnt vmcnt(0)" ::: "memory");
    DSA_PV(0, 0); asm volatile("s_waitcnt lgkmcnt(0)" ::: "memory"); if (FULL || nsc > 4) DSA_DMAV(4, 0);
    DSA_PV(1, 1); asm volatile("s_waitcnt lgkmcnt(0)" ::: "memory"); if (FULL || nsc > 4) DSA_DMAV(5, 1);
    if (FULL || nsc > 2) {
        DSA_PV(2, 2); asm volatile("s_waitcnt lgkmcnt(0)" ::: "memory"); if (FULL || nsc > 6) DSA_DMAV(6, 2);
        DSA_PV(3, 3); asm volatile("s_waitcnt lgkmcnt(0)" ::: "memory"); if (FULL || nsc > 6) DSA_DMAV(7, 3);
    }
    if (FULL || nsc > 4) {
        asm volatile("s_waitcnt vmcnt(0)" ::: "memory");
        DSA_PV(0, 4); DSA_PV(1, 5);
        if (FULL || nsc > 6) { DSA_PV(2, 6); DSA_PV(3, 7); }
    }
    asm volatile("s_waitcnt lgkmcnt(0)" ::: "memory");
#undef DSA_DMAV
#undef DSA_PV
    if (n < 8) { const float inv = 1.f / ls; bf16* Op = (bf16*)(F.ws + WS_OA) + qrow * 512 + n * 64 + 4 * kg;
#pragma unroll
        for (int dt = 0; dt < 4; ++dt) *(unsigned long long*)(Op + 16 * dt) = (unsigned long long)cvtpk(o[dt][0] * inv, o[dt][1] * inv) | ((unsigned long long)cvtpk(o[dt][2] * inv, o[dt][3] * inv) << 32); }
}
__device__ __forceinline__ void dsa_attend_stream(Frame& F, LAS unsigned char* L, LAS int* SEL, int b, size_t qrow) {
    const int lane = F.lane, wave = F.wave;
    const bf16* QA = (const bf16*)(F.ws + WS_QA); const bf16* KA = (const bf16*)(F.ws + WS_KA); const bf16* VA = (const bf16*)(F.ws + WS_VA);
    const int n = lane & 15, kg = lane >> 4;
    pg8::bf16x8 qf[2];
#pragma unroll
    for (int s = 0; s < 2; ++s) { qf[s] = (pg8::bf16x8){0, 0, 0, 0, 0, 0, 0, 0}; if (n < 8) qf[s] = *(const pg8::bf16x8*)(QA + qrow * 512 + n * 64 + 32 * s + 8 * kg); }
    asm volatile("s_waitcnt vmcnt(0)" : "+v"(qf[0]), "+v"(qf[1]) :: "memory");
    LAS unsigned char* VS = L + wave * 16384;
    const bf16* kgb = KA + (size_t)b * SEQ * 64 + 8 * ((lane & 7) ^ ((lane >> 3) & 7));
    const bf16* vgb = VA + (size_t)b * SEQ * 64 + 8 * (lane & 7);
#define DSA_DMA(gb, sc, slot) do { _Pragma("unroll") for (int i_ = 0; i_ < 4; ++i_) { const int idx_ = SEL[32 * (sc) + 8 * i_ + (lane >> 3)]; \
        __builtin_amdgcn_global_load_lds((const unsigned*)((gb) + (size_t)idx_ * 64), (LAS unsigned*)(VS + (slot) * 4096 + i_ * 1024), 16, 0, 0); } } while (0)
#define DSA_WAITV(nn) asm volatile("s_waitcnt vmcnt(" #nn ")" ::: "memory")
#define DSA_WAITL() asm volatile("s_waitcnt lgkmcnt(0)" ::: "memory")
    const int kro = n * 128;
#define DSA_QK(slot, sc) do { _Pragma("unroll") for (int tt_ = 0; tt_ < 2; ++tt_) { \
        const pg8::bf16x8 a0_ = *(LAS const pg8::bf16x8*)(VS + (slot) * 4096 + tt_ * 2048 + kro + ((kg ^ (n & 7)) << 4)); \
        const pg8::bf16x8 a1_ = *(LAS const pg8::bf16x8*)(VS + (slot) * 4096 + tt_ * 2048 + kro + (((4 + kg) ^ (n & 7)) << 4)); \
        f32x4 z_ = {0.f, 0.f, 0.f, 0.f}; z_ = MFMA16(a0_, qf[0], z_); z_ = MFMA16(a1_, qf[1], z_); x[2 * (sc) + tt_] = z_; } } while (0)
#define DSA_PV(slot, sc) do { _Pragma("unroll") for (int dt_ = 0; dt_ < 4; ++dt_) { \
        const s16x4 lo_ = trread(vb + (slot) * 4096 + dt_ * 32), hh_ = trread(vb + (slot) * 4096 + 16 * 128 + dt_ * 32); \
        const pg8::bf16x8 a_ = {lo_[0], lo_[1], lo_[2], lo_[3], hh_[0], hh_[1], hh_[2], hh_[3]}; \
        o[dt_] = MFMA16(a_, pb[(sc)], o[dt_]); } } while (0)
    f32x4 x[16];
    DSA_DMA(kgb, 0, 0); DSA_DMA(kgb, 1, 1); DSA_DMA(kgb, 2, 2); DSA_DMA(kgb, 3, 3);
    DSA_WAITV(12); DSA_QK(0, 0); DSA_WAITL(); DSA_DMA(kgb, 4, 0);
    DSA_WAITV(12); DSA_QK(1, 1); DSA_WAITL(); DSA_DMA(kgb, 5, 1);
    DSA_WAITV(12); DSA_QK(2, 2); DSA_WAITL(); DSA_DMA(kgb, 6, 2);
    DSA_WAITV(12); DSA_QK(3, 3); DSA_WAITL(); DSA_DMA(kgb, 7, 3);
    DSA_WAITV(12); DSA_QK(0, 4); DSA_WAITL(); DSA_DMA(vgb, 0, 0);
    DSA_WAITV(12); DSA_QK(1, 5); DSA_WAITL(); DSA_DMA(vgb, 1, 1);
    DSA_WAITV(12); DSA_QK(2, 6); DSA_WAITL(); DSA_DMA(vgb, 2, 2);
    DSA_WAITV(12); DSA_QK(3, 7); DSA_WAITL(); DSA_DMA(vgb, 3, 3);
    float mx = -1e30f;
#pragma unroll
    for (int t = 0; t < 16; ++t) mx = fmaxf(fmaxf(mx, fmaxf(x[t][0], x[t][1])), fmaxf(x[t][2], x[t][3]));
    mx = fmaxf(mx, __shfl_xor(mx, 16)); mx = fmaxf(mx, __shfl_xor(mx, 32));
    float ls = 0.f;
#pragma unroll
    for (int t = 0; t < 16; ++t) {
#pragma unroll
        for (int i = 0; i < 4; ++i) { x[t][i] = __builtin_amdgcn_exp2f(x[t][i] - mx); ls += x[t][i]; } }
    ls += __shfl_xor(ls, 16); ls += __shfl_xor(ls, 32);
    pg8::bf16x8 pb[8];
#pragma unroll
    for (int s = 0; s < 8; ++s) { v4u w; w.x = cvtpk(x[2 * s][0], x[2 * s][1]); w.y = cvtpk(x[2 * s][2], x[2 * s][3]); w.z = cvtpk(x[2 * s + 1][0], x[2 * s + 1][1]); w.w = cvtpk(x[2 * s + 1][2], x[2 * s + 1][3]); pb[s] = __builtin_bit_cast(pg8::bf16x8, w); }
    f32x4 o[4];
#pragma unroll
    for (int dt = 0; dt < 4; ++dt) o[dt] = (f32x4){0.f, 0.f, 0.f, 0.f};
    LAS const unsigned char* vb = VS + (4 * kg + (n >> 2)) * 128 + (4 * (n & 3)) * 2;
    DSA_WAITV(12); DSA_PV(0, 0); DSA_WAITL(); DSA_DMA(vgb, 4, 0);
    DSA_WAITV(12); DSA_PV(1, 1); DSA_WAITL(); DSA_DMA(vgb, 5, 1);
    DSA_WAITV(12); DSA_PV(2, 2); DSA_WAITL(); DSA_DMA(vgb, 6, 2);
    DSA_WAITV(12); DSA_PV(3, 3); DSA_WAITL(); DSA_DMA(vgb, 7, 3);
    DSA_WAITV(12); DSA_PV(0, 4);
    DSA_WAITV(8);  DSA_PV(1, 5);
    DSA_WAITV(4);  DSA_PV(2, 6);
    DSA_WAITV(0);  DSA_PV(3, 7);
    DSA_WAITL();
#undef DSA_DMA
#undef DSA_WAITV
#undef DSA_WAITL
#undef DSA_QK
#undef DSA_PV
    if (n < 8) { const float inv = 1.f / ls; bf16* Op = (bf16*)(F.ws + WS_OA) + qrow * 512 + n * 64 + 4 * kg;
#pragma unroll
        for (int dt = 0; dt < 4; ++dt) *(unsigned long long*)(Op + 16 * dt) = (unsigned long long)cvtpk(o[dt][0] * inv, o[dt][1] * inv) | ((unsigned long long)cvtpk(o[dt][2] * inv, o[dt][3] * inv) << 32); }
}
constexpr int DS_VROW = 144, DS_VBUF = 64 * DS_VROW;
__device__ __forceinline__ void dsa_unit(Frame& F, int b, int c, int g) {
    const int lane = F.lane, wave = F.wave;
    LAS unsigned char* L = F.ldsl + RING_OFF;
    LAS float* SC = (LAS float*)L;
    LAS int* SEL = (LAS int*)(F.ldsl + SEL_OFF) + wave * 256;
    const int q0 = c * 64 + g * 8, Kn = (c + 1) * 64;
    const bf16* QI = (const bf16*)(F.ws + WS_QI); const bf16* KI = (const bf16*)(F.ws + WS_KI); const float* WI = (const float*)(F.ws + WS_WI);
    const bf16* QA = (const bf16*)(F.ws + WS_QA); const bf16* KA = (const bf16*)(F.ws + WS_KA); const bf16* VA = (const bf16*)(F.ws + WS_VA);
    __syncthreads();
    for (int repa_ = 0; repa_ <= ((DUP_MASK >> 12) & 1); ++repa_) {
        const int m = lane & 31, hi = lane >> 5;
        const int q4 = 2 * ((m >> 2) & 1) + (m >> 4), head = (m & 3) + 4 * ((m >> 3) & 1);
        pg8::bf16x8 af[2][4]; h16x8 w2[4];
#pragma unroll
        for (int mt = 0; mt < 2; ++mt) {
            const size_t arow = (size_t)b * SEQ + q0 + 4 * mt + q4;
#pragma unroll
            for (int s = 0; s < 4; ++s) af[mt][s] = *(const pg8::bf16x8*)(QI + arow * 512 + head * 64 + 16 * s + 8 * hi);
        }
        {
            const size_t wrow = (size_t)b * SEQ + q0 + (m & 7);
            const f32x4 wa = *(const f32x4*)(WI + wrow * 8), wb = *(const f32x4*)(WI + wrow * 8 + 4);
            const h16x8 wv = {(_Float16)wa.x, (_Float16)wa.y, (_Float16)wa.z, (_Float16)wa.w, (_Float16)wb.x, (_Float16)wb.y, (_Float16)wb.z, (_Float16)wb.w};
            const h16x8 hz = {0, 0, 0, 0, 0, 0, 0, 0};
#pragma unroll
            for (int ks = 0; ks < 4; ++ks) w2[ks] = (m < 8 && m == 4 * (ks >> 1) + 2 * hi + (ks & 1)) ? wv : hz;
        }
        const int nkt = Kn / 32;
        const bf16* kbase = KI + ((size_t)b * SEQ + m) * 64 + 8 * hi;
        LAS unsigned* sp = (LAS unsigned*)SC + (4 * hi) * 4096 + m;
        LAS unsigned* hp = (LAS unsigned*)(F.ldsl + HIST_OFF) + (4 * hi) * 256;
#define DSA_LOADK(dst, kt) do { _Pragma("unroll") for (int s_ = 0; s_ < 4; ++s_) dst[s_] = *(const pg8::bf16x8*)(kbase + (size_t)(kt) * 32 * 64 + 16 * s_); } while (0)
#define DSA_TILE(src, kt) do { f32x16 y_ = {}; \
            _Pragma("unroll") for (int mt_ = 0; mt_ < 2; ++mt_) { f32x16 acc_ = {}; \
                _Pragma("unroll") for (int s_ = 0; s_ < 4; ++s_) acc_ = MFMA32(af[mt_][s_], src[s_], acc_); \
                _Pragma("unroll") for (int sp_ = 0; sp_ < 2; ++sp_) { h16x8 hb_; \
                    _Pragma("unroll") for (int j_ = 0; j_ < 4; ++j_) { const h16x2 pr_ = relu_pk(acc_[8 * sp_ + 2 * j_], acc_[8 * sp_ + 2 * j_ + 1]); hb_[2 * j_] = pr_[0]; hb_[2 * j_ + 1] = pr_[1]; } \
                    y_ = __builtin_amdgcn_mfma_f32_32x32x16_f16(w2[2 * mt_ + sp_], hb_, y_, 0, 0, 0); } } \
            _Pragma("unroll") for (int r_ = 0; r_ < 4; ++r_) { unsigned u_ = __float_as_uint(y_[r_] + 0.f); u_ = (u_ >> 31) ? ~u_ : (u_ | 0x80000000u); \
                sp[r_ * 4096 + 32 * (kt)] = u_; __hip_atomic_fetch_add(hp + r_ * 256 + (u_ >> 24), 1u, __ATOMIC_RELAXED, __HIP_MEMORY_SCOPE_WORKGROUP); } } while (0)
        pg8::bf16x8 bA[4], bB[4];
        if (wave < nkt) DSA_LOADK(bA, wave);
        if (wave + 8 < nkt) DSA_LOADK(bB, wave + 8);
        for (int kt = wave; kt < nkt; kt += 16) {
            DSA_TILE(bA, kt);
            if (kt + 16 < nkt) DSA_LOADK(bA, kt + 16);
            if (kt + 8 < nkt) { DSA_TILE(bB, kt + 8); if (kt + 24 < nkt) DSA_LOADK(bB, kt + 24); }
        }
#undef DSA_LOADK
#undef DSA_TILE
    }
    __syncthreads();
    int nsel;
    for (int repb_ = 0; repb_ <= ((DUP_MASK >> 13) & 1); ++repb_)
    if (Kn <= 256) { nsel = Kn; for (int i = lane; i < Kn; i += 64) SEL[i] = i; *(LAS v4u*)((LAS unsigned*)(F.ldsl + HIST_OFF) + wave * 256 + 4 * lane) = (v4u){0u, 0u, 0u, 0u}; }
    else {
        nsel = 256;
        LAS const unsigned* sr = (LAS const unsigned*)SC + wave * 4096; LAS unsigned* hs = (LAS unsigned*)(F.ldsl + HIST_OFF) + wave * 256;
        const int nj = Kn >> 6;
        if (nj <= 16) dsa_select<16>(sr, hs, SEL, nj, lane);
        else if (nj <= 32) dsa_select<32>(sr, hs, SEL, nj, lane);
        else if (nj <= 48) dsa_select<48>(sr, hs, SEL, nj, lane);
        else dsa_select<64>(sr, hs, SEL, nj, lane);
    }
    asm volatile("s_waitcnt lgkmcnt(0)" ::: "memory");
    for (int repc_ = 0; repc_ <= ((DUP_MASK >> 14) & 1); ++repc_) {
        const size_t qrow = (size_t)b * SEQ + q0 + wave;
        if (nsel == 256) dsa_attend_stream(F, L, SEL, b, qrow); else dsa_attend<false>(F, L, SEL, b, qrow, nsel);
    }
}
__device__ __forceinline__ void p3_fox(Frame& F) {
    for (int v = F.vcu; v < 256; v += F.G) {
        const int bh = v >> 3, s = v & 7;
        fox_unit(F, bh >> 3, bh & 7, 15 - s);
        fox_unit(F, bh >> 3, bh & 7, s);
    }
}
__device__ __forceinline__ void p3_dsa(Frame& F) {
    for (int i = F.tid; i < 2048; i += NWAVES * 64) ((LAS unsigned*)(F.ldsl + HIST_OFF))[i] = 0u;
    __syncthreads();
    for (int v = F.vcu; v < 256; v += F.G) {
        const int b = v >> 6, t = v & 63, g0 = (t < 32) ? 0 : 4;
        for (int i = 0; i < 4; ++i) dsa_unit(F, b, 63 - t, g0 + i);
        for (int i = 0; i < 4; ++i) dsa_unit(F, b, t, g0 + i);
    }
}

__device__ __forceinline__ void p6_router(Frame& F) {
    const float* MOD = (const float*)(F.ws + WS_MOD); const float* X1 = F.out; const float* SSQ = (const float*)(F.ws + WS_CTL) + CW_SSQ;
    bf16* H2 = (bf16*)(F.ws + WS_H2); const bf16* WrT = (const bf16*)(F.ws + WS_WRT);
    int* TOKSLOT = (int*)(F.ws + WS_TOKSLOT); float* WROW = (float*)(F.ws + WS_WROW);
    const int lane = F.lane, r = lane & 15, kg = lane >> 4;
    const int it4 = F.wave & 3, kh = F.wave >> 2;
    LAS float* GS = (LAS float*)(F.ldsl + RING_OFF);
    LAS float* SH = GS + 1024;
    LAS float* LG = SH + 1024 + it4 * (16 * 52);
    LAS float* LG2 = SH + 1024 + 4 * (16 * 52) + it4 * (16 * 52);
    for (int base = F.vcu * 4; base < M / 16; base += F.G * 4) {
        __syncthreads();
        const int bb = (base * 16) >> 12;
        for (int i = F.tid; i < 1024; i += NWAVES * 64) { GS[i] = F.g_ffn[i] * (MOD[bb * 6144 + 4096 + i] + 1.0f); SH[i] = MOD[bb * 6144 + 3072 + i]; }
        if (F.tid < 32) F.LX[32 + F.tid] = 0u;
        __syncthreads();
        const int item = base + it4; const bool act = item < M / 16;
        int e1 = 0, e2 = 0, lr1 = 0, lr2 = 0; float w1 = 0.f, w2 = 0.f;
        if (act) {
            const int row = item * 16 + r;
            const float rstd = 1.f / sqrtf(SSQ[row] * (1.f / D) + RMS_EPS);
            f32x4 acc[3];
#pragma unroll
            for (int nt = 0; nt < 3; ++nt) acc[nt] = (f32x4){0.f, 0.f, 0.f, 0.f};
#pragma unroll 4
            for (int s = 0; s < 16; ++s) {
                const int k = 32 * (16 * kh + s) + 8 * kg;
                const f32x4 xa = *(const f32x4*)(X1 + (size_t)row * D + k), xb = *(const f32x4*)(X1 + (size_t)row * D + k + 4);
                const f32x4 ga = *(LAS const f32x4*)(GS + k), gb = *(LAS const f32x4*)(GS + k + 4);
                const f32x4 ha = *(LAS const f32x4*)(SH + k), hb = *(LAS const f32x4*)(SH + k + 4);
                const f32x4 ya = xa * rstd * ga + ha, yb = xb * rstd * gb + hb;
                v4u w; w.x = cvtpk(ya.x, ya.y); w.y = cvtpk(ya.z, ya.w); w.z = cvtpk(yb.x, yb.y); w.w = cvtpk(yb.z, yb.w);
                *(v4u*)(H2 + (size_t)row * D + k) = w;
                const pg8::bf16x8 a = __builtin_bit_cast(pg8::bf16x8, w);
#pragma unroll
                for (int nt = 0; nt < 3; ++nt) { const pg8::bf16x8 bw = *(const pg8::bf16x8*)(WrT + (size_t)(16 * nt + r) * D + k); acc[nt] = MFMA16(a, bw, acc[nt]); }
            }
            LAS float* dst = kh ? LG2 : LG;
#pragma unroll
            for (int nt = 0; nt < 3; ++nt)
#pragma unroll
                for (int i = 0; i < 4; ++i) dst[(4 * kg + i) * 52 + 16 * nt + r] = acc[nt][i];
        }
        __syncthreads();
        if (act && kh == 0 && lane < 16) {
            LAS const float* lg = LG + lane * 52; LAS const float* lg2 = LG2 + lane * 52;
            float gl[4]; int grp = 0;
#pragma unroll
            for (int i = 0; i < 4; ++i) gl[i] = lg[32 + i] + lg2[32 + i] + F.b_group[i];
#pragma unroll
            for (int i = 1; i < 4; ++i) if (gl[i] > gl[grp]) grp = i;
            const float gmax = (grp == 0) ? gl[0] : (grp == 1) ? gl[1] : (grp == 2) ? gl[2] : gl[3];
            float den = 0.f;
#pragma unroll
            for (int i = 0; i < 4; ++i) den += expf(gl[i] - gmax);
            const float pg = 1.f / den;
            float ev[8];
#pragma unroll
            for (int i = 0; i < 8; ++i) ev[i] = lg[grp * 8 + i] + lg2[grp * 8 + i] + F.b_router[grp * 8 + i];
            int i1 = 0; float v1 = ev[0];
#pragma unroll
            for (int i = 1; i < 8; ++i) if (ev[i] > v1) { v1 = ev[i]; i1 = i; }
            int i2 = -1; float v2 = -3.0e38f;
#pragma unroll
            for (int i = 0; i < 8; ++i) if (i != i1 && ev[i] > v2) { v2 = ev[i]; i2 = i; }
            const float t = expf(v2 - v1);
            w1 = pg / (1.f + t); w2 = pg * t / (1.f + t);
            e1 = grp * 8 + i1; e2 = grp * 8 + i2;
            lr1 = (int)atomicAdd((unsigned*)&F.LX[32 + e1], 1u); lr2 = (int)atomicAdd((unsigned*)&F.LX[32 + e2], 1u);
        }
        __syncthreads();
        if (F.tid < 32) { const unsigned c = F.LX[32 + F.tid]; F.LX[64 + F.tid] = c ? atomicAdd((unsigned*)(F.ctl + CW_CNT + F.tid), c) : 0u; }
        __syncthreads();
        if (act && kh == 0 && lane < 16) { const int row = item * 16 + lane;
            const int p1 = e1 * ECAP + (int)F.LX[64 + e1] + lr1, p2 = e2 * ECAP + (int)F.LX[64 + e2] + lr2;
            TOKSLOT[p1] = 2 * row; WROW[p1] = w1; TOKSLOT[p2] = 2 * row + 1; WROW[p2] = w2; }
    }
}
__device__ __forceinline__ void p10_final(Frame& F, float* dst) {
    const int gw = F.vcu * NWAVES + F.wave, NGW = F.G * NWAVES;
    const float* MOD = (const float*)(F.ws + WS_MOD); const bf16* YC = (const bf16*)(F.ws + WS_YC);
    for (int m = gw; m < M; m += NGW) {
        const int b = m >> 12;
        GAS f32x4* xr = (GAS f32x4*)(F.out + (size_t)m * D) + F.lane;
        const GAS unsigned long long* y0 = (const GAS unsigned long long*)(YC + (size_t)(2 * m) * D) + F.lane;
        const GAS unsigned long long* y1 = (const GAS unsigned long long*)(YC + (size_t)(2 * m + 1) * D) + F.lane;
        f32x4 v[4]; float s = 0.f;
#pragma unroll
        for (int j = 0; j < 4; ++j) { const int col = 4 * F.lane + 256 * j;
            const f32x4 x1 = xr[64 * j]; const unsigned long long a = y0[64 * j], c = y1[64 * j];
            const f32x4 gt = *(const f32x4*)(MOD + b * 6144 + 5120 + col);
            f32x4 y; y.x = bflo((unsigned)a) + bflo((unsigned)c); y.y = bfhi((unsigned)a) + bfhi((unsigned)c); y.z = bflo((unsigned)(a >> 32)) + bflo((unsigned)(c >> 32)); y.w = bfhi((unsigned)(a >> 32)) + bfhi((unsigned)(c >> 32));
            v[j] = x1 + gt * y; s += (v[j].x * v[j].x + v[j].y * v[j].y) + (v[j].z * v[j].z + v[j].w * v[j].w); }
        const float rstd = 1.f / sqrtf(wave_sum(s) * (1.f / D) + RMS_EPS);
        GAS f32x4* orow = (GAS f32x4*)(dst + (size_t)m * D) + F.lane;
#pragma unroll
        for (int j = 0; j < 4; ++j) { const int col = 4 * F.lane + 256 * j; const f32x4 g = *(const f32x4*)(F.g_final + col); orow[64 * j] = v[j] * rstd * g; }
    }
}

struct Args { const void* in[20]; float* out; unsigned char* ws; int ph_lo, ph_hi; };
__global__ void __launch_bounds__(NWAVES * 64, 2) hybrid_fwd(Args args) {
    extern __shared__ __attribute__((aligned(16))) unsigned char lds[];
    Frame F;
    F.lds = lds; F.ldsl = (LAS unsigned char*)lds; F.LX = (volatile LAS unsigned*)(F.ldsl + LX_OFF);
    F.tid = threadIdx.x; F.lane = F.tid & 63; F.wave = __builtin_amdgcn_readfirstlane(F.tid >> 6);
    F.G = gridDim.x; { const int bx = blockIdx.x; F.vcu = (F.G % 8 == 0) ? (bx % 8) * (F.G / 8) + bx / 8 : bx; }
    F.ws = args.ws; F.ctl = (gu32*)(args.ws + WS_CTL); F.out = args.out;
    F.x = (const float*)args.in[0]; F.c = (const float*)args.in[1]; F.positions = (const int*)args.in[2]; F.w_mod = (const float*)args.in[3]; F.b_mod = (const float*)args.in[4];
    F.g_mix = (const float*)args.in[5]; F.w_in = (const float*)args.in[6]; F.b_forget = (const float*)args.in[7]; F.w_out_a = (const float*)args.in[8]; F.w_out_b = (const float*)args.in[9];
    F.w_out = (const float*)args.in[10]; F.g_ffn = (const float*)args.in[11]; F.w_group = (const float*)args.in[12]; F.b_group = (const float*)args.in[13]; F.w_router = (const float*)args.in[14];
    F.b_router = (const float*)args.in[15]; F.w_e_gate = (const float*)args.in[16]; F.w_e_up = (const float*)args.in[17]; F.w_e_down = (const float*)args.in[18]; F.g_final = (const float*)args.in[19];
    for (int u = F.tid; u < (LDS_BYTES - LX_OFF) / 4; u += NWAVES * 64) F.LX[u] = 0u;
    __syncthreads();
    XcdBarrier bar; bar.bar = (unsigned*)(F.ctl + CW_BAR); bar.x = 0; bar.st = nullptr;
    if (N_LAUNCHES == 1) bar = xcd_barrier_post((unsigned*)(F.ctl + CW_BAR), F.LX);
    const int lo = args.ph_lo, hi = args.ph_hi;
#ifndef PH_MASK
#define PH_MASK 0xFFFF
#endif
#define IN(k) (((PH_MASK >> (k)) & 1) && lo <= (k) && (k) < hi)
#define REP(k) for (int rep_ = 0; rep_ <= ((DUP_MASK >> (k)) & 1); ++rep_)
#define SEAM(k) do { if (IN(k) && IN((k) + 1)) { xcd_barrier(bar); if ((DUP_MASK >> 15) & 1) xcd_barrier(bar); } } while (0)
    LAS unsigned char* ring = F.ldsl + RING_OFF;
    if (IN(0)) { REP(0) p0_prologue(F); } SEAM(0);
    if (IN(1)) { REP(1) p1_hnorm(F); } SEAM(1);
    if (IN(2)) {
        pg8::Gemm g{(const pg8::bf16_t*)(F.ws + WS_H), (const pg8::bf16_t*)(F.ws + WS_WIN), M, NPROJ, D}; pg8::StaticOrder S; S.init(M, NPROJ, F.G, (int)blockIdx.x);
        EpiProj E{F.ws, F.b_forget};
        pg8::gemm_phase<EpiProj, pg8::StaticOrder, true, true>(ring, g, S, E);
#if (DUP_MASK >> 2) & 1
        asm volatile("s_waitcnt vmcnt(0)" ::: "memory"); __syncthreads();
        pg8::gemm_phase<EpiProj, pg8::StaticOrder, true, true>(ring, g, S, E);
#endif
    } SEAM(2);
    if (IN(3)) { REP(3) p3_fox(F); REP(11) p3_dsa(F); } SEAM(3);
    if (IN(4)) {
        static_assert(WS_OB == WS_OA + (size_t)M * 512 * 2 && WS_WOB == WS_WOA + (size_t)1024 * 512 * 2, "stacked operands of the merge GEMM");
        pg8::Gemm g{(const pg8::bf16_t*)(F.ws + WS_OA), (const pg8::bf16_t*)(F.ws + WS_WOA), 2 * M, 2 * D, 512}; MergeOrder S; S.S.init(M, D, F.G, (int)blockIdx.x);
#if (DUP_MASK >> 4) & 1
        { EpiMerge E0{F.ws, WS_QA}; pg8::gemm_phase<EpiMerge, MergeOrder, true, true>(ring, g, S, E0); asm volatile("s_waitcnt vmcnt(0)" ::: "memory"); __syncthreads(); }
#endif
        EpiMerge E{F.ws, WS_GA}; pg8::gemm_phase<EpiMerge, MergeOrder, true, true>(ring, g, S, E);
    } SEAM(4);
    if (IN(5)) {
        pg8::Gemm g{(const pg8::bf16_t*)(F.ws + WS_GA), (const pg8::bf16_t*)(F.ws + WS_WO), M, D, D}; pg8::StaticOrder S; S.init(M, D, F.G, (int)blockIdx.x);
#if (DUP_MASK >> 5) & 1
        { EpiOut E0{F.ws, F.x, (float*)(F.ws + WS_QA), false}; pg8::gemm_phase<EpiOut, pg8::StaticOrder, true, true>(ring, g, S, E0); asm volatile("s_waitcnt vmcnt(0)" ::: "memory"); __syncthreads(); }
#endif
        EpiOut E{F.ws, F.x, F.out, true}; pg8::gemm_phase<EpiOut, pg8::StaticOrder, true, true>(ring, g, S, E);
    } SEAM(5);
    if (IN(6)) { p6_router(F); } SEAM(6);
    if (IN(8)) {
        moe_table(F);
        pg8::Gemm g{(const pg8::bf16_t*)(F.ws + WS_H2), (const pg8::bf16_t*)(F.ws + WS_WGU), PMAX, 32 * 1024, D};
        MoeOrder S{F.G, F.vcu, (int)F.LX[132] * 4, F.LX + 160};
        MoeRowMap RM{(const int*)(F.ws + WS_TOKSLOT), F.LX};
        EpiGU E{F.ws}; REP(8) pg8::gemm_phase_g<EpiGU, MoeOrder, MoeRowMap, true, true>(ring, g, S, E, RM);
    } SEAM(8);
    if (IN(9)) {
        moe_table(F);
        pg8::Gemm g{(const pg8::bf16_t*)(F.ws + WS_HID), (const pg8::bf16_t*)(F.ws + WS_WDN), PMAX, 32 * 1024, 512};
        MoeOrder S{F.G, F.vcu, (int)F.LX[132] * 4, F.LX + 160};
        EpiDown E{F.ws, F.LX}; REP(9) pg8::gemm_phase<EpiDown, MoeOrder, true, true>(ring, g, S, E);
    } SEAM(9);
    if (IN(10)) {
#if (DUP_MASK >> 10) & 1
        p10_final(F, (float*)(F.ws + WS_GA));
#endif
        p10_final(F, F.out); }
#undef IN
#undef SEAM
}

extern "C" void kernel_launch(void* const* d_in, const int* in_sizes, int n_in, void* d_out, int out_size, void* d_ws, size_t ws_size, hipStream_t stream) {
    static int grid = 0;
    if (grid == 0) {
        if (n_in != 20 || in_sizes[0] != M * D || out_size != M * D || ws_size < WS_END) { fprintf(stderr, "kernel_launch: unexpected shapes (n_in %d, in0 %d, out %d, ws %zu); nothing launched\n", n_in, n_in > 0 ? in_sizes[0] : -1, out_size, ws_size); grid = -1; return; }
        int dev = 0, cus = 0, per_cu = 0;
        if (hipGetDevice(&dev) != hipSuccess || hipDeviceGetAttribute(&cus, hipDeviceAttributeMultiprocessorCount, dev) != hipSuccess) { grid = -1; return; }
        if (hipFuncSetAttribute((const void*)hybrid_fwd, hipFuncAttributeMaxDynamicSharedMemorySize, LDS_BYTES) != hipSuccess) { fprintf(stderr, "kernel_launch: hipFuncSetAttribute failed\n"); grid = -1; return; }
        if (hipOccupancyMaxActiveBlocksPerMultiprocessor(&per_cu, (const void*)hybrid_fwd, NWAVES * 64, LDS_BYTES) != hipSuccess || per_cu < 1)
            fprintf(stderr, "kernel_launch: note: occupancy query reports %d workgroups per CU\n", per_cu);
        (void)hipGetLastError();
        grid = cus;
    }
    if (grid < 0) return;
    if (hipMemsetAsync((char*)d_ws + WS_CTL, 0, CTL_ZERO_BYTES, stream) != hipSuccess) { fprintf(stderr, "kernel_launch: hipMemsetAsync failed\n"); return; }
    Args a{};
    for (int i = 0; i < 20; ++i) a.in[i] = d_in[i];
    a.out = (float*)d_out; a.ws = (unsigned char*)d_ws;
    for (int li = 0; li < N_LAUNCHES; ++li) {
        a.ph_lo = (N_LAUNCHES == 1) ? 0 : li; a.ph_hi = (N_LAUNCHES == 1) ? NPHASE : li + 1;
        hipLaunchKernelGGL(hybrid_fwd, dim3(grid), dim3(NWAVES * 64), LDS_BYTES, stream, a);
        const hipError_t le = hipPeekAtLastError();
        if (le != hipSuccess) { fprintf(stderr, "kernel_launch: launch %d failed: %s\n", li, hipGetErrorName(le)); break; }
    }
}
```

```cpp
#define MK_N_LAUNCHES 1
#include <hip/hip_runtime.h>
#include <hip/hip_bf16.h>
#include <cstdio>
#include <cstdint>
#include <cmath>
namespace pg8 {
#define PG8_LAS __attribute__((address_space(3)))
typedef unsigned short bf16_t;
typedef short bf16x8 __attribute__((ext_vector_type(8)));
typedef float f32x4 __attribute__((ext_vector_type(4)));
typedef unsigned u32x4 __attribute__((ext_vector_type(4)));
constexpr int BM = 256, BK = 64, HALF = 128, HTB = HALF * BK * 2  , STAGE_BYTES = 8 * HTB, NXCD = 8, WGM = 8;

__host__ __device__ __forceinline__ int lds_byte(int r, int c) { const int st = (r >> 4) * 2 + (c >> 5), rr = r & 15, cc = c & 31, ob = rr * 64 + cc * 2; return st * 1024 + (ob ^ (((ob >> 9) & 1) << 5)); }
__host__ __device__ __forceinline__ void stage_rc(int b, int& R, int& C) { const int st = b / 1024, sb = b % 1024, swz = sb ^ (((sb >> 9) & 1) << 5); R = (st >> 1) * 16 + swz / 64; C = (st & 1) * 32 + (swz % 64) / 2; }
__host__ __device__ __forceinline__ int perm32(int rho) { const int n = rho >> 4, i = rho & 15; return 8 * (i >> 2) + 4 * n + (i & 3); }

struct Unit { int pm, pn; };
struct Gemm { const bf16_t* A; const bf16_t* Bt; int M, N, K; };

struct StaticOrder {
    int nM, nN, nwg, G, c;
    __host__ __device__ void init(int M, int N, int G_, int c_) { nM = M / BM; nN = N / BM; nwg = nM * nN; G = G_; c = c_; }
    __host__ __device__ bool next(int i, Unit& u) const {
        const long L = (long)i * G + c; if (L >= nwg) return false;
        int wgid = (int)L; { const int q = nwg / NXCD, r = nwg % NXCD, xcd = wgid % NXCD, off = wgid / NXCD; wgid = (xcd < r ? xcd * (q + 1) : r * (q + 1) + (xcd - r) * q) + off; }
        const int nig = WGM * nN, gid = wgid / nig, fm = gid * WGM, gsz = (nM - fm) < WGM ? (nM - fm) : WGM;
        u.pm = fm + ((wgid % nig) % gsz); u.pn = (wgid % nig) / gsz; return true;
    }
    __device__ __forceinline__ void a_ready(const Unit&) const {}
    __device__ __forceinline__ void done(const Unit&) const {}
};

__device__ __forceinline__ unsigned cvt_pk_bf16(float lo, float hi) { unsigned r; asm volatile("v_cvt_pk_bf16_f32 %0, %1, %2" : "=v"(r) : "v"(lo), "v"(hi)); return r; }
typedef float f32x2 __attribute__((ext_vector_type(2)));
template <class Epi, class Sched, bool ALIGN_EPI = false, bool SP2 = false>
__device__ __forceinline__ void gemm_phase(PG8_LAS unsigned char* lds, const Gemm g, const Sched& S, const Epi& E) {
    const int tid = threadIdx.x, wid = __builtin_amdgcn_readfirstlane(tid >> 6), lane = tid & 63, wr = wid >> 2, wc = wid & 3, fr = lane & 15, fq = lane >> 4;
    const int K = g.K, nt = K / BK;
    unsigned voffA[2], voffB[2];
#pragma unroll
    for (int i = 0; i < 2; ++i) { int R, C; stage_rc(tid * 16 + i * 8192, R, C); const int Rb = Epi::PERM ? ((R & ~31) + perm32(R & 31)) : R;
        voffA[i] = (unsigned)(R * K + C) * 2u; voffB[i] = (unsigned)(Rb * K + C) * 2u; }
    const size_t kstep = (size_t)(BK * 2);
    const size_t hstep = (size_t)HALF * K * 2;
    const size_t tstep = 2 * hstep;
    const unsigned ldsw = (unsigned)wid * 1024u;
    const int aoff = lds_byte(wr * 64 + fr, fq * 8), boff = lds_byte(wc * 32 + fr, fq * 8);
#define PG8_SA(b, h) (((b) * 2 + (h)) * HTB)
#define PG8_SB(b, h) ((4 + (b) * 2 + (h)) * HTB)
#define PG8_STAGE(bufoff, gbase, voff) do { _Pragma("unroll") for (int _i = 0; _i < 2; ++_i) \
        __builtin_amdgcn_global_load_lds((const unsigned*)((const char*)(gbase) + (voff)[_i]), (PG8_LAS unsigned*)(lds + (bufoff) + ldsw + _i * 8192), 16, 0, 0); } while (0)
#define PG8_LDA(dst, b, h) do { _Pragma("unroll") for (int m = 0; m < 4; ++m) _Pragma("unroll") for (int k = 0; k < 2; ++k) dst[m][k] = *(const PG8_LAS bf16x8*)(lds + PG8_SA(b, h) + aoff + m * 2048 + k * 1024); } while (0)
#define PG8_LDB(dst, b, h) do { _Pragma("unroll") for (int n = 0; n < 2; ++n) _Pragma("unroll") for (int k = 0; k < 2; ++k) dst[n][k] = *(const PG8_LAS bf16x8*)(lds + PG8_SB(b, h) + boff + n * 2048 + k * 1024); } while (0)
#define PG8_MMA(ai, bj, At, Bt) do { __builtin_amdgcn_s_setprio(1); _Pragma("unroll") for (int m = 0; m < 4; ++m) _Pragma("unroll") for (int n = 0; n < 2; ++n) _Pragma("unroll") for (int k = 0; k < 2; ++k) \
        acc[ai][bj][m][n] = __builtin_amdgcn_mfma_f32_16x16x32_bf16(Bt[n][k], At[m][k], acc[ai][bj][m][n], 0, 0, 0); __builtin_amdgcn_s_setprio(0); } while (0)
#define PG8_WAIT_V(n) asm volatile("s_waitcnt vmcnt(" #n ")" ::: "memory")
#define PG8_WAIT_L(n) asm volatile("s_waitcnt lgkmcnt(" #n ")" ::: "memory")
#define PG8_BAR __builtin_amdgcn_s_barrier()
#define PG8_SCHED __builtin_amdgcn_sched_barrier(0)
    Unit cur, nxt; int ui = 0;
    if (!S.next(0, cur)) return;
    f32x4 acc[2][2][4][2];
#pragma unroll
    for (int a = 0; a < 2; ++a)
#pragma unroll
        for (int b = 0; b < 2; ++b)
#pragma unroll
            for (int m = 0; m < 4; ++m)
#pragma unroll
                for (int n = 0; n < 2; ++n) acc[a][b][m][n] = (f32x4){0.f, 0.f, 0.f, 0.f};
    bf16x8 At[4][2], B0[2][2], B1[2][2];
    const char* cA = (const char*)g.A + (size_t)cur.pm * tstep; const char* cB = (const char*)g.Bt + (size_t)cur.pn * tstep;
    S.a_ready(cur);
    if constexpr (SP2) {
        PG8_STAGE(PG8_SB(0, 0), cB, voffB); PG8_STAGE(PG8_SB(0, 1), cB + hstep, voffB); PG8_STAGE(PG8_SA(0, 0), cA, voffA); PG8_STAGE(PG8_SA(0, 1), cA + hstep, voffA);
        if (wr == 1) PG8_BAR;
        PG8_WAIT_V(2); PG8_BAR;
        PG8_STAGE(PG8_SB(1, 0), cB + kstep, voffB); PG8_STAGE(PG8_SA(1, 0), cA + kstep, voffA); PG8_STAGE(PG8_SB(1, 1), cB + hstep + kstep, voffB);
        PG8_WAIT_V(6); PG8_BAR;
    } else {
        PG8_STAGE(PG8_SB(0, 0), cB, voffB); PG8_STAGE(PG8_SA(0, 0), cA, voffA); PG8_STAGE(PG8_SB(0, 1), cB + hstep, voffB); PG8_STAGE(PG8_SA(0, 1), cA + hstep, voffA);
        if (wr == 1) PG8_BAR;
        PG8_WAIT_V(4); PG8_BAR;
        PG8_STAGE(PG8_SB(1, 0), cB + kstep, voffB); PG8_STAGE(PG8_SA(1, 0), cA + kstep, voffA); PG8_STAGE(PG8_SB(1, 1), cB + hstep + kstep, voffB);
        PG8_WAIT_V(6); PG8_BAR;
    }
    for (;;) {
        const bool has_next = S.next(ui + 1, nxt);
        const char* nA = has_next ? (const char*)g.A + (size_t)nxt.pm * tstep : cA; const char* nB = has_next ? (const char*)g.Bt + (size_t)nxt.pn * tstep : cB;
        for (int t = 0; t < nt; t += 2) {
            const bool last = (t == nt - 2);
            const char* a1 = cA + (size_t)(t + 1) * kstep;
            const char* a2 = last ? nA : cA + (size_t)(t + 2) * kstep; const char* b2 = last ? nB : cB + (size_t)(t + 2) * kstep;
            const char* a3 = a2 + kstep; const char* b3 = b2 + kstep;
            if (last && has_next) S.a_ready(nxt);
            if constexpr (SP2) {
            PG8_LDB(B0, 0, 0); PG8_LDB(B1, 0, 1); PG8_SCHED; PG8_LDA(At, 0, 0); PG8_STAGE(PG8_SA(1, 1), a1 + hstep, voffA);
            PG8_WAIT_V(8); PG8_WAIT_L(0); PG8_BAR; PG8_MMA(0, 0, At, B0); PG8_MMA(0, 1, At, B1); PG8_BAR; PG8_SCHED;
            PG8_LDA(At, 0, 1); PG8_STAGE(PG8_SB(0, 0), b2, voffB); PG8_STAGE(PG8_SB(0, 1), b2 + hstep, voffB); PG8_STAGE(PG8_SA(0, 0), a2, voffA);
            PG8_WAIT_V(8); PG8_WAIT_L(0); PG8_BAR; PG8_MMA(1, 0, At, B0); PG8_MMA(1, 1, At, B1); PG8_BAR; PG8_SCHED;
            PG8_LDB(B0, 1, 0); PG8_LDB(B1, 1, 1); PG8_SCHED; PG8_LDA(At, 1, 0); PG8_STAGE(PG8_SA(0, 1), a2 + hstep, voffA);
            PG8_WAIT_V(8); PG8_WAIT_L(0); PG8_BAR; PG8_MMA(0, 0, At, B0); PG8_MMA(0, 1, At, B1); PG8_BAR; PG8_SCHED;
            PG8_LDA(At, 1, 1); PG8_STAGE(PG8_SB(1, 0), b3, voffB); PG8_STAGE(PG8_SB(1, 1), b3 + hstep, voffB); PG8_STAGE(PG8_SA(1, 0), a3, voffA);
            PG8_WAIT_V(8); PG8_WAIT_L(0); PG8_BAR; PG8_MMA(1, 0, At, B0); PG8_MMA(1, 1, At, B1); PG8_BAR; PG8_SCHED;
            } else {
            PG8_LDB(B0, 0, 0); PG8_SCHED; PG8_LDA(At, 0, 0); PG8_STAGE(PG8_SA(1, 1), a1 + hstep, voffA);
            PG8_WAIT_L(8); PG8_BAR; PG8_WAIT_L(0); PG8_MMA(0, 0, At, B0); PG8_BAR; PG8_SCHED;
            PG8_LDB(B1, 0, 1); PG8_STAGE(PG8_SB(0, 0), b2, voffB);
            PG8_BAR; PG8_WAIT_L(0); PG8_MMA(0, 1, At, B1); PG8_BAR;
            PG8_LDA(At, 0, 1); PG8_STAGE(PG8_SA(0, 0), a2, voffA);
            PG8_BAR; PG8_WAIT_L(0); PG8_MMA(1, 0, At, B0); PG8_BAR; PG8_SCHED;
            PG8_STAGE(PG8_SB(0, 1), b2 + hstep, voffB);
            PG8_WAIT_V(6); PG8_BAR; PG8_MMA(1, 1, At, B1); PG8_BAR;
            PG8_LDB(B0, 1, 0); PG8_SCHED; PG8_LDA(At, 1, 0); PG8_STAGE(PG8_SA(0, 1), a2 + hstep, voffA);
            PG8_WAIT_L(8); PG8_BAR; PG8_WAIT_L(0); PG8_MMA(0, 0, At, B0); PG8_BAR; PG8_SCHED;
            PG8_LDB(B1, 1, 1); PG8_STAGE(PG8_SB(1, 0), b3, voffB);
            PG8_BAR; PG8_WAIT_L(0); PG8_MMA(0, 1, At, B1); PG8_BAR;
            PG8_LDA(At, 1, 1); PG8_STAGE(PG8_SA(1, 0), a3, voffA);
            PG8_BAR; PG8_WAIT_L(0); PG8_MMA(1, 0, At, B0); PG8_BAR; PG8_SCHED;
            PG8_STAGE(PG8_SB(1, 1), b3 + hstep, voffB);
            PG8_WAIT_V(6); PG8_BAR; PG8_MMA(1, 1, At, B1); PG8_BAR;
            }
        }
        if constexpr (ALIGN_EPI) { if (wr == 0) PG8_BAR; }
        bool keep_acc = false;
        if constexpr (Epi::CHAIN) { keep_acc = E.chain(acc, cur, wr, wc, fr, fq); S.done(cur); }
        else if constexpr (!Epi::AFTER_DRAIN) { E(acc, cur, wr, wc, fr, fq); S.done(cur); }
        if (!has_next) break;
        if (!keep_acc)
#pragma unroll
        for (int a = 0; a < 2; ++a)
#pragma unroll
            for (int b = 0; b < 2; ++b)
#pragma unroll
                for (int m = 0; m < 4; ++m)
#pragma unroll
                    for (int n = 0; n < 2; ++n) acc[a][b][m][n] = (f32x4){0.f, 0.f, 0.f, 0.f};
        cur = nxt; cA = nA; cB = nB; ++ui;
        if constexpr (ALIGN_EPI) { if (wr == 1) PG8_BAR; }
    }
    PG8_WAIT_V(0);
    if constexpr (!ALIGN_EPI) { if (wr == 0) PG8_BAR; }
    PG8_BAR;
    if constexpr (Epi::AFTER_DRAIN) { E.fused(acc, cur, wr, wc, fr, fq, lds, wid, lane); S.done(cur); }
#undef PG8_SA
#undef PG8_SB
#undef PG8_STAGE
#undef PG8_LDA
#undef PG8_LDB
#undef PG8_MMA
#undef PG8_WAIT_V
#undef PG8_WAIT_L
#undef PG8_BAR
#undef PG8_SCHED
}
template <class Epi, class Sched, class RowMap, bool ALIGN_EPI = false, bool SP2 = true>
__device__ __forceinline__ void gemm_phase_g(PG8_LAS unsigned char* lds, const Gemm g, const Sched& S, const Epi& E, const RowMap& RM) {
    static_assert(SP2, "gather variant: SP2 path only");
    const int tid = threadIdx.x, wid = __builtin_amdgcn_readfirstlane(tid >> 6), lane = tid & 63, wr = wid >> 2, wc = wid & 3, fr = lane & 15, fq = lane >> 4;
    const int K = g.K, nt = K / BK;
    unsigned voffA[2], voffB[2]; int rAg[2]; unsigned cAg[2]; unsigned vC[2][2], vN[2][2];
#pragma unroll
    for (int i = 0; i < 2; ++i) { int R, C; stage_rc(tid * 16 + i * 8192, R, C); const int Rb = Epi::PERM ? ((R & ~31) + perm32(R & 31)) : R;
        voffA[i] = (unsigned)(R * K + C) * 2u; voffB[i] = (unsigned)(Rb * K + C) * 2u; rAg[i] = R; cAg[i] = (unsigned)C * 2u; }
    const size_t kstep = (size_t)(BK * 2);
    const size_t hstep = (size_t)HALF * K * 2;
    const size_t tstep = 2 * hstep;
    const unsigned ldsw = (unsigned)wid * 1024u;
    const int aoff = lds_byte(wr * 64 + fr, fq * 8), boff = lds_byte(wc * 32 + fr, fq * 8);
#define PG8_SA(b, h) (((b) * 2 + (h)) * HTB)
#define PG8_SB(b, h) ((4 + (b) * 2 + (h)) * HTB)
#define PG8_STAGE(bufoff, gbase, voff) do { _Pragma("unroll") for (int _i = 0; _i < 2; ++_i) \
        __builtin_amdgcn_global_load_lds((const unsigned*)((const char*)(gbase) + (voff)[_i]), (PG8_LAS unsigned*)(lds + (bufoff) + ldsw + _i * 8192), 16, 0, 0); } while (0)
#define PG8_LDA(dst, b, h) do { _Pragma("unroll") for (int m = 0; m < 4; ++m) _Pragma("unroll") for (int k = 0; k < 2; ++k) dst[m][k] = *(const PG8_LAS bf16x8*)(lds + PG8_SA(b, h) + aoff + m * 2048 + k * 1024); } while (0)
#define PG8_LDB(dst, b, h) do { _Pragma("unroll") for (int n = 0; n < 2; ++n) _Pragma("unroll") for (int k = 0; k < 2; ++k) dst[n][k] = *(const PG8_LAS bf16x8*)(lds + PG8_SB(b, h) + boff + n * 2048 + k * 1024); } while (0)
#define PG8_MMA(ai, bj, At, Bt) do { __builtin_amdgcn_s_setprio(1); _Pragma("unroll") for (int m = 0; m < 4; ++m) _Pragma("unroll") for (int n = 0; n < 2; ++n) _Pragma("unroll") for (int k = 0; k < 2; ++k) \
        acc[ai][bj][m][n] = __builtin_amdgcn_mfma_f32_16x16x32_bf16(Bt[n][k], At[m][k], acc[ai][bj][m][n], 0, 0, 0); __builtin_amdgcn_s_setprio(0); } while (0)
#define PG8_WAIT_V(n) asm volatile("s_waitcnt vmcnt(" #n ")" ::: "memory")
#define PG8_WAIT_L(n) asm volatile("s_waitcnt lgkmcnt(" #n ")" ::: "memory")
#define PG8_BAR __builtin_amdgcn_s_barrier()
#define PG8_SCHED __builtin_amdgcn_sched_barrier(0)
    Unit cur, nxt; int ui = 0;
    if (!S.next(0, cur)) return;
#define PG8_FILL(v, uu) do { _Pragma("unroll") for (int h_ = 0; h_ < 2; ++h_) _Pragma("unroll") for (int i_ = 0; i_ < 2; ++i_) v[h_][i_] = RM.rowoff(uu, h_ * HALF + rAg[i_]) + cAg[i_]; } while (0)
    PG8_FILL(vC, cur);
    const char* gA = (const char*)g.A;
    f32x4 acc[2][2][4][2];
#pragma unroll
    for (int a = 0; a < 2; ++a)
#pragma unroll
        for (int b = 0; b < 2; ++b)
#pragma unroll
            for (int m = 0; m < 4; ++m)
#pragma unroll
                for (int n = 0; n < 2; ++n) acc[a][b][m][n] = (f32x4){0.f, 0.f, 0.f, 0.f};
    bf16x8 At[4][2], B0[2][2], B1[2][2];
    const char* cA = (const char*)g.A + (size_t)cur.pm * tstep; const char* cB = (const char*)g.Bt + (size_t)cur.pn * tstep;
    S.a_ready(cur);
    if constexpr (SP2) {
        PG8_STAGE(PG8_SB(0, 0), cB, voffB); PG8_STAGE(PG8_SB(0, 1), cB + hstep, voffB); PG8_STAGE(PG8_SA(0, 0), gA, vC[0]); PG8_STAGE(PG8_SA(0, 1), gA, vC[1]);
        if (wr == 1) PG8_BAR;
        PG8_WAIT_V(2); PG8_BAR;
        PG8_STAGE(PG8_SB(1, 0), cB + kstep, voffB); PG8_STAGE(PG8_SA(1, 0), gA + kstep, vC[0]); PG8_STAGE(PG8_SB(1, 1), cB + hstep + kstep, voffB);
        PG8_WAIT_V(6); PG8_BAR;
    } else {
        PG8_STAGE(PG8_SB(0, 0), cB, voffB); PG8_STAGE(PG8_SA(0, 0), cA, voffA); PG8_STAGE(PG8_SB(0, 1), cB + hstep, voffB); PG8_STAGE(PG8_SA(0, 1), cA + hstep, voffA);
        if (wr == 1) PG8_BAR;
        PG8_WAIT_V(4); PG8_BAR;
        PG8_STAGE(PG8_SB(1, 0), cB + kstep, voffB); PG8_STAGE(PG8_SA(1, 0), cA + kstep, voffA); PG8_STAGE(PG8_SB(1, 1), cB + hstep + kstep, voffB);
        PG8_WAIT_V(6); PG8_BAR;
    }
    for (;;) {
        const bool has_next = S.next(ui + 1, nxt);
        if (has_next) PG8_FILL(vN, nxt); else { vN[0][0] = vC[0][0]; vN[0][1] = vC[0][1]; vN[1][0] = vC[1][0]; vN[1][1] = vC[1][1]; }
        const char* nA = has_next ? (const char*)g.A + (size_t)nxt.pm * tstep : cA; const char* nB = has_next ? (const char*)g.Bt + (size_t)nxt.pn * tstep : cB;
        for (int t = 0; t < nt; t += 2) {
            const bool last = (t == nt - 2);
            const char* a1 = cA + (size_t)(t + 1) * kstep;
            const char* a2 = last ? nA : cA + (size_t)(t + 2) * kstep; const char* b2 = last ? nB : cB + (size_t)(t + 2) * kstep;
            const char* a3 = a2 + kstep; const char* b3 = b2 + kstep;
            const char* ga2 = last ? gA : gA + (size_t)(t + 2) * kstep;
            unsigned vs0[2] = {last ? vN[0][0] : vC[0][0], last ? vN[0][1] : vC[0][1]}, vs1[2] = {last ? vN[1][0] : vC[1][0], last ? vN[1][1] : vC[1][1]};
            if (last && has_next) S.a_ready(nxt);
            if constexpr (SP2) {
            PG8_LDB(B0, 0, 0); PG8_LDB(B1, 0, 1); PG8_SCHED; PG8_LDA(At, 0, 0); PG8_STAGE(PG8_SA(1, 1), gA + (size_t)(t + 1) * kstep, vC[1]);
            PG8_WAIT_V(8); PG8_WAIT_L(0); PG8_BAR; PG8_MMA(0, 0, At, B0); PG8_MMA(0, 1, At, B1); PG8_BAR; PG8_SCHED;
            PG8_LDA(At, 0, 1); PG8_STAGE(PG8_SB(0, 0), b2, voffB); PG8_STAGE(PG8_SB(0, 1), b2 + hstep, voffB); PG8_STAGE(PG8_SA(0, 0), ga2, vs0);
            PG8_WAIT_V(8); PG8_WAIT_L(0); PG8_BAR; PG8_MMA(1, 0, At, B0); PG8_MMA(1, 1, At, B1); PG8_BAR; PG8_SCHED;
            PG8_LDB(B0, 1, 0); PG8_LDB(B1, 1, 1); PG8_SCHED; PG8_LDA(At, 1, 0); PG8_STAGE(PG8_SA(0, 1), ga2, vs1);
            PG8_WAIT_V(8); PG8_WAIT_L(0); PG8_BAR; PG8_MMA(0, 0, At, B0); PG8_MMA(0, 1, At, B1); PG8_BAR; PG8_SCHED;
            PG8_LDA(At, 1, 1); PG8_STAGE(PG8_SB(1, 0), b3, voffB); PG8_STAGE(PG8_SB(1, 1), b3 + hstep, voffB); PG8_STAGE(PG8_SA(1, 0), ga2 + kstep, vs0);
            PG8_WAIT_V(8); PG8_WAIT_L(0); PG8_BAR; PG8_MMA(1, 0, At, B0); PG8_MMA(1, 1, At, B1); PG8_BAR; PG8_SCHED;
            } else {
            PG8_LDB(B0, 0, 0); PG8_SCHED; PG8_LDA(At, 0, 0); PG8_STAGE(PG8_SA(1, 1), a1 + hstep, voffA);
            PG8_WAIT_L(8); PG8_BAR; PG8_WAIT_L(0); PG8_MMA(0, 0, At, B0); PG8_BAR; PG8_SCHED;
            PG8_LDB(B1, 0, 1); PG8_STAGE(PG8_SB(0, 0), b2, voffB);
            PG8_BAR; PG8_WAIT_L(0); PG8_MMA(0, 1, At, B1); PG8_BAR;
            PG8_LDA(At, 0, 1); PG8_STAGE(PG8_SA(0, 0), a2, voffA);
            PG8_BAR; PG8_WAIT_L(0); PG8_MMA(1, 0, At, B0); PG8_BAR; PG8_SCHED;
            PG8_STAGE(PG8_SB(0, 1), b2 + hstep, voffB);
            PG8_WAIT_V(6); PG8_BAR; PG8_MMA(1, 1, At, B1); PG8_BAR;
            PG8_LDB(B0, 1, 0); PG8_SCHED; PG8_LDA(At, 1, 0); PG8_STAGE(PG8_SA(0, 1), a2 + hstep, voffA);
            PG8_WAIT_L(8); PG8_BAR; PG8_WAIT_L(0); PG8_MMA(0, 0, At, B0); PG8_BAR; PG8_SCHED;
            PG8_LDB(B1, 1, 1); PG8_STAGE(PG8_SB(1, 0), b3, voffB);
            PG8_BAR; PG8_WAIT_L(0); PG8_MMA(0, 1, At, B1); PG8_BAR;
            PG8_LDA(At, 1, 1); PG8_STAGE(PG8_SA(1, 0), a3, voffA);
            PG8_BAR; PG8_WAIT_L(0); PG8_MMA(1, 0, At, B0); PG8_BAR; PG8_SCHED;
            PG8_STAGE(PG8_SB(1, 1), b3 + hstep, voffB);
            PG8_WAIT_V(6); PG8_BAR; PG8_MMA(1, 1, At, B1); PG8_BAR;
            }
        }
        if constexpr (ALIGN_EPI) { if (wr == 0) PG8_BAR; }
        if constexpr (!Epi::AFTER_DRAIN) { E(acc, cur, wr, wc, fr, fq); S.done(cur); }
        if (!has_next) break;
#pragma unroll
        for (int a = 0; a < 2; ++a)
#pragma unroll
            for (int b = 0; b < 2; ++b)
#pragma unroll
                for (int m = 0; m < 4; ++m)
#pragma unroll
                    for (int n = 0; n < 2; ++n) acc[a][b][m][n] = (f32x4){0.f, 0.f, 0.f, 0.f};
        cur = nxt; cA = nA; cB = nB; ++ui; vC[0][0] = vN[0][0]; vC[0][1] = vN[0][1]; vC[1][0] = vN[1][0]; vC[1][1] = vN[1][1];
        if constexpr (ALIGN_EPI) { if (wr == 1) PG8_BAR; }
    }
    PG8_WAIT_V(0);
    if constexpr (!ALIGN_EPI) { if (wr == 0) PG8_BAR; }
    PG8_BAR;
    if constexpr (Epi::AFTER_DRAIN) { E.fused(acc, cur, wr, wc, fr, fq, lds, wid, lane); S.done(cur); }
#undef PG8_FILL
#undef PG8_SA
#undef PG8_SB
#undef PG8_STAGE
#undef PG8_LDA
#undef PG8_LDB
#undef PG8_MMA
#undef PG8_WAIT_V
#undef PG8_WAIT_L
#undef PG8_BAR
#undef PG8_SCHED
}
}
constexpr int NWAVES = 8;
constexpr int BATCH = 4, SEQ = 4096, D = 1024, M = BATCH * SEQ;
constexpr int NPROJ = 4864;
constexpr float RMS_EPS = 1e-6f;
constexpr float LOG2E = 1.4426950408889634f;
constexpr float QSCALE = 0.125f * LOG2E;
constexpr int PMAX = 40960, NTMAX = 160;
constexpr int NPHASE = 11;
#ifndef MK_N_LAUNCHES
#define MK_N_LAUNCHES 1
#endif
constexpr int N_LAUNCHES = MK_N_LAUNCHES;

constexpr size_t MiB = 1u << 20;
constexpr size_t WS_CTL = 0, CTL_ZERO_BYTES = 1 * MiB;
constexpr size_t WS_MOD = 1 * MiB;
constexpr size_t WS_WRT = 1 * MiB + 256 * 1024;
constexpr int ECAP = 16384;
constexpr size_t WS_TOKSLOT = 212 * MiB;
constexpr size_t WS_WROW = 214 * MiB;
constexpr size_t WS_COS = 2 * MiB, WS_SIN = 2 * MiB + 512 * 1024;
constexpr size_t WS_WI = 3 * MiB, WS_LOGF = 3 * MiB + 512 * 1024;
constexpr size_t WS_ROUTE = 4 * MiB;
constexpr size_t WS_WIN = 5 * MiB;
constexpr size_t WS_WOA = 15 * MiB, WS_WOB = 16 * MiB, WS_WO = 17 * MiB;
constexpr size_t WS_WGU = 19 * MiB, WS_WDN = 83 * MiB;
constexpr size_t WS_H = 115 * MiB;
constexpr size_t WS_OA = 115 * MiB, WS_OB = 131 * MiB, WS_H2 = 115 * MiB;
constexpr size_t WS_QA = 147 * MiB, WS_QI = 163 * MiB, WS_QB = 179 * MiB, WS_KB = 195 * MiB, WS_VB = 211 * MiB;
constexpr size_t WS_KA = 227 * MiB, WS_VA = 229 * MiB, WS_KI = 231 * MiB;
constexpr size_t WS_XS = 147 * MiB;
constexpr size_t WS_YC = 147 * MiB;
constexpr size_t WS_GA = 233 * MiB, WS_GB = 265 * MiB;
constexpr size_t WS_HID = 233 * MiB;
constexpr size_t WS_END = 297 * MiB;
constexpr int CW_BAR = 4096, CW_CNT = 8192, CW_SSQ = 16384, CW_KN2 = 131072;
constexpr int RING_OFF = 0, RING_BYTES = 131072;
constexpr int SEL_OFF = 131072;
constexpr int LX_OFF = 139264;
constexpr int HIST_OFF = 143360;
constexpr int LDS_BYTES = 151552;

#define GAS __attribute__((address_space(1)))
#define LAS __attribute__((address_space(3)))
typedef unsigned short bf16;
typedef unsigned v4u __attribute__((ext_vector_type(4)));
typedef float f32x4 __attribute__((ext_vector_type(4)));
typedef short bf16x8 __attribute__((ext_vector_type(8)));
typedef GAS unsigned gu32;
typedef GAS unsigned long long gu64;
#define RLX_AGENT __ATOMIC_RELAXED, __HIP_MEMORY_SCOPE_AGENT
#define LDS_WAIT() asm volatile("s_waitcnt lgkmcnt(0)" ::: "memory")
#define VM_WAIT() asm volatile("s_waitcnt vmcnt(0)" ::: "memory")
__device__ __forceinline__ unsigned long long rt() { return __builtin_amdgcn_s_memrealtime(); }
__device__ __forceinline__ unsigned f2bf(float f) { unsigned u = __builtin_bit_cast(unsigned, f); return (u + 0x7fffu + ((u >> 16) & 1u)) >> 16; }
__device__ __forceinline__ unsigned pk2(float lo, float hi) { return f2bf(lo) | (f2bf(hi) << 16); }

#define XB_TMO      128
#define XB_XCNT(j)  (256  + 64 * (j))
#define XB_XSUB(j)  (1280 + 64 * (j))
#define XB_XGEN(j)  (2304 + 64 * (j))
#define XB_TOP      3328
#define XB_TOPGEN   3392
#define XCD_BAR_WORDS 3456
#define XB_SPIN_CAP (1u << 18)

__device__ __forceinline__ unsigned xb_ld(unsigned* p)              { return __hip_atomic_load(p, __ATOMIC_RELAXED, __HIP_MEMORY_SCOPE_AGENT); }
__device__ __forceinline__ unsigned xb_add(unsigned* p, unsigned v) { return __hip_atomic_fetch_add(p, v, __ATOMIC_RELAXED, __HIP_MEMORY_SCOPE_AGENT); }
__device__ __forceinline__ unsigned xb_xcc_id() { return (unsigned)__builtin_amdgcn_s_getreg((3 << 11) | 20) & 0xFu; }
#define XB_SPIN(cond, bar) do { unsigned _sp = 0; while (cond) { __builtin_amdgcn_s_sleep(1); \
    if ((++_sp & 255u) == 0u) { if (xb_ld(&(bar)[XB_TMO])) break; if (_sp > XB_SPIN_CAP) { atomicAdd(&(bar)[XB_TMO], 1u); break; } } } } while (0)

struct XcdBarrier {
    unsigned* bar; unsigned x;
    volatile LAS unsigned* st;
};

__device__ __forceinline__ XcdBarrier xcd_barrier_post(unsigned* bar, volatile LAS unsigned* st) {
    XcdBarrier b; b.bar = bar; b.x = xb_xcc_id(); b.st = st;
    if (threadIdx.x == 0) (void)xb_add(&bar[XB_XCNT(b.x)], 1u);
    return b;
}
__device__ __forceinline__ void xcd_barrier_complete(unsigned* bar, unsigned x, unsigned& nloc, unsigned& nx) {
    const unsigned G = gridDim.x * gridDim.y * gridDim.z;
    unsigned sum, cnt, mine, sp = 0u;
    for (;;) {
        sum = 0u; cnt = 0u; mine = 0u;
#pragma unroll
        for (unsigned j = 0; j < 16; ++j) { const unsigned c = xb_ld(&bar[XB_XCNT(j)]); sum += c; cnt += (c > 0u) ? 1u : 0u; mine = (j == x) ? c : mine; }
        if (sum == G) break;
        __builtin_amdgcn_s_sleep(1);
        if ((++sp & 255u) == 0u) { if (xb_ld(&bar[XB_TMO])) break; if (sp > XB_SPIN_CAP) { atomicAdd(&bar[XB_TMO], 1u); break; } }
    }
    nloc = mine > 0u ? mine : 1u; nx = cnt > 0u ? cnt : 1u;
}

__device__ __forceinline__ void xcd_barrier(const XcdBarrier& b) {
    asm volatile("s_waitcnt vmcnt(0)" ::: "memory");
    __syncthreads();
    if (threadIdx.x == 0) {
        unsigned* bar = b.bar;
        __builtin_amdgcn_s_waitcnt(0);
        unsigned nloc = b.st[0], nx = b.st[1];
        if (nloc == 0u) { xcd_barrier_complete(bar, b.x, nloc, nx); b.st[0] = nloc; b.st[1] = nx; }
        const unsigned old = xb_add(&bar[XB_XSUB(b.x)], 1u);
        const unsigned gen = old / nloc;
        if (old + 1u == (gen + 1u) * nloc) {
            __builtin_amdgcn_fence(__ATOMIC_RELEASE, "agent");
            asm volatile("s_waitcnt vmcnt(0)" ::: "memory");
            const unsigned og = xb_add(&bar[XB_TOP], 1u);
            const unsigned tg = og / nx;
            if (og + 1u == (tg + 1u) * nx) xb_add(&bar[XB_TOPGEN], 1u);
            else XB_SPIN(xb_ld(&bar[XB_TOPGEN]) == tg, bar);
            __builtin_amdgcn_fence(__ATOMIC_ACQUIRE, "agent");
            xb_add(&bar[XB_XGEN(b.x)], 1u);
            asm volatile("s_waitcnt vmcnt(0)" ::: "memory");
        } else {
            XB_SPIN(xb_ld(&bar[XB_XGEN(b.x)]) == gen, bar);
            __builtin_amdgcn_fence(__ATOMIC_ACQUIRE, "agent");
            asm volatile("s_waitcnt vmcnt(0)" ::: "memory");
        }
    }
    __syncthreads();
}
typedef float f32x2_t __attribute__((ext_vector_type(2))); typedef __bf16 bf16x2_t __attribute__((ext_vector_type(2)));
typedef float f32x16 __attribute__((ext_vector_type(16)));
typedef short s16x4 __attribute__((ext_vector_type(4)));
__device__ __forceinline__ unsigned cvtpk(float lo, float hi) { f32x2_t v = {lo, hi}; bf16x2_t b = __builtin_convertvector(v, bf16x2_t); return __builtin_bit_cast(unsigned, b); }
__device__ __forceinline__ float bflo(unsigned w) { return __uint_as_float(w << 16); }
__device__ __forceinline__ float bfhi(unsigned w) { return __uint_as_float(w & 0xffff0000u); }
__device__ __forceinline__ float sigmoidf_(float v) { return 1.f / (1.f + __expf(-v)); }
#define MFMA32(a, b, c) __builtin_amdgcn_mfma_f32_32x32x16_bf16((a), (b), (c), 0, 0, 0)
#define MFMA16(a, b, c) __builtin_amdgcn_mfma_f32_16x16x32_bf16((a), (b), (c), 0, 0, 0)

struct Frame {
    unsigned char* lds;
    LAS unsigned char* ldsl;
    volatile LAS unsigned* LX;
    gu32* ctl;
    unsigned char* ws;
    int tid, lane, wave, vcu, G;
    const float *x, *c, *w_mod, *b_mod, *g_mix, *w_in, *b_forget, *w_out_a, *w_out_b, *w_out, *g_ffn, *w_group, *b_group, *w_router, *b_router, *w_e_gate, *w_e_up, *w_e_down, *g_final;
    const int* positions;
    float* out;
};
__device__ __forceinline__ float wave_sum(float v) {
#pragma unroll
    for (int o = 1; o < 64; o <<= 1) v += __shfl_xor(v, o);
    return v;
}

struct CmIn { __device__ __forceinline__ int operator()(int n) const { if (n < 1216) return n; if (n < 2752) return n + 8; if (n < 4800) return n + 16; if (n < 4808) return n - 4800 + 1216; if (n < 4816) return n - 4808 + 2760; return -1; } };
struct CmId { int base; __device__ __forceinline__ int operator()(int n) const { return n - base; } };
template <class CM>
__device__ __forceinline__ void transpose_item(const float* W, int ldw, bf16* WT, int K, int k0, int n0, const CM& cm, LAS float* scr, int lane) {
    const int sc = cm(n0 + (lane & 31));
#pragma unroll
    for (int i = 0; i < 32; ++i) { const int kk = 2 * i + (lane >> 5); scr[kk * 33 + (lane & 31)] = sc >= 0 ? W[(size_t)(k0 + kk) * ldw + sc] : 0.f; }
    LDS_WAIT(); asm volatile("" ::: "memory");
    const int c = lane & 7;
#pragma unroll
    for (int j = 0; j < 4; ++j) { const int n = (lane >> 3) + 8 * j; const LAS float* s = scr + (8 * c) * 33 + n;
        v4u o; o.x = pk2(s[0 * 33], s[1 * 33]); o.y = pk2(s[2 * 33], s[3 * 33]); o.z = pk2(s[4 * 33], s[5 * 33]); o.w = pk2(s[6 * 33], s[7 * 33]);
        *(GAS v4u*)(WT + (size_t)(n0 + n) * K + k0 + 8 * c) = o; }
    LDS_WAIT(); asm volatile("" ::: "memory");
}
__device__ __forceinline__ void p0_prologue(Frame& F) {
    __syncthreads();
    {
        LAS float* ca = (LAS float*)(F.ldsl + RING_OFF);
        LAS float* red = (LAS float*)(F.ldsl + RING_OFF + 16384);
        for (int i = F.tid; i < 4096; i += NWAVES * 64) { const float v = F.c[i]; ca[i] = v / (1.f + expf(-v)); }
        __syncthreads();
        float* MOD = (float*)(F.ws + WS_MOD);
        for (int cb = F.vcu; cb < 256; cb += F.G) {
            const int col0 = cb * 24;
            if (F.tid < 384) { const int j = F.tid % 24, ks = F.tid / 24; float a0 = 0.f, a1 = 0.f, a2 = 0.f, a3 = 0.f;
#pragma unroll 8
                for (int i = 0; i < 64; ++i) { const int k = ks + 16 * i; const float w = F.w_mod[(size_t)k * 6144 + col0 + j];
                    a0 += ca[k] * w; a1 += ca[1024 + k] * w; a2 += ca[2048 + k] * w; a3 += ca[3072 + k] * w; }
                LAS float* r = red + (ks * 24 + j) * 4; r[0] = a0; r[1] = a1; r[2] = a2; r[3] = a3; }
            __syncthreads();
            if (F.tid < 96) { const int j = F.tid % 24, bb = F.tid / 24; float s = 0.f;
#pragma unroll
                for (int ks = 0; ks < 16; ++ks) s += red[(ks * 24 + j) * 4 + bb];
                MOD[bb * 6144 + col0 + j] = s + F.b_mod[col0 + j]; }
            __syncthreads();
        }
    }
    LAS float* scr = (LAS float*)(F.ldsl + RING_OFF + F.wave * 16384);
    const int gw = F.vcu * NWAVES + F.wave, NGW = F.G * NWAVES;
    constexpr int I_IN = 16 * 152, I_OA = 8 * 32, I_O = 16 * 32;
    constexpr int NITEMS = I_IN + 2 * I_OA + I_O;
    bf16* WinT = (bf16*)(F.ws + WS_WIN); bf16* WoaT = (bf16*)(F.ws + WS_WOA); bf16* WobT = (bf16*)(F.ws + WS_WOB); bf16* WoT = (bf16*)(F.ws + WS_WO);
    for (int it = gw; it < NITEMS; it += NGW) {
        int r = it;
        if (r < I_IN) { const int kb = r / 152, nb = r % 152; transpose_item(F.w_in, 4816, WinT, 1024, 64 * kb, 32 * nb, CmIn{}, scr, F.lane); continue; } r -= I_IN;
        if (r < I_OA) { const int kb = r / 32, nb = r % 32; transpose_item(F.w_out_a + 32 * nb, 1024, WoaT, 512, 64 * kb, 32 * nb, CmId{32 * nb}, scr, F.lane); continue; } r -= I_OA;
        if (r < I_OA) { const int kb = r / 32, nb = r % 32; transpose_item(F.w_out_b + 32 * nb, 1024, WobT, 512, 64 * kb, 32 * nb, CmId{32 * nb}, scr, F.lane); continue; } r -= I_OA;
        { const int kb = r / 32, nb = r % 32; transpose_item(F.w_out + 32 * nb, 1024, WoT, 1024, 64 * kb, 32 * nb, CmId{32 * nb}, scr, F.lane); }
    }
    { bf16* WrT = (bf16*)(F.ws + WS_WRT);
      for (int i = (F.vcu * NWAVES * 64 + F.tid); i < 64 * 1024; i += F.G * NWAVES * 64) { const int n = i >> 10, k = i & 1023;
          float v = 0.f; if (n < 32) v = F.w_router[k * 32 + n]; else if (n < 36) v = F.w_group[k * 4 + (n - 32)];
          WrT[i] = (bf16)f2bf(v); } }
}

__device__ __forceinline__ void conv_experts(Frame& F) {
    __syncthreads();
    LAS float* scr = (LAS float*)(F.ldsl + RING_OFF + F.wave * 16384);
    const int gw = F.vcu * NWAVES + F.wave, NGW = F.G * NWAVES;
    constexpr int I_GU = 32 * 16 * 32, I_DN = 32 * 8 * 32;
    bf16* WguT = (bf16*)(F.ws + WS_WGU); bf16* WdnT = (bf16*)(F.ws + WS_WDN);
    for (int it = gw; it < I_GU + I_DN; it += NGW) {
        int r = it;
        if (r < I_GU) { const int e = r / 512, q = r % 512, kb = q / 32, nb = q % 32;
            const int np = 32 * nb, ct = np >> 8, bj = (np >> 7) & 1, j0 = np & 127;
            const float* src = (bj ? F.w_e_up : F.w_e_gate) + (size_t)e * 1024 * 512 + ct * 128 + j0;
            transpose_item(src, 512, WguT, 1024, 64 * kb, e * 1024 + np, CmId{e * 1024 + np}, scr, F.lane); continue; } r -= I_GU;
        { const int e = r / 256, q = r % 256, kb = q / 32, nb = q % 32;
            const float* src = F.w_e_down + (size_t)e * 512 * 1024 + 32 * nb;
            transpose_item(src, 1024, WdnT, 512, 64 * kb, e * 1024 + 32 * nb, CmId{e * 1024 + 32 * nb}, scr, F.lane); }
    }
    __syncthreads();
}

__device__ __forceinline__ void p1_hnorm(Frame& F) {
    const int gw = F.vcu * NWAVES + F.wave, NGW = F.G * NWAVES;
    const float* MOD = (const float*)(F.ws + WS_MOD); bf16* H = (bf16*)(F.ws + WS_H);
    float* COS = (float*)(F.ws + WS_COS); float* SIN = (float*)(F.ws + WS_SIN);
    for (int m = gw; m < M; m += NGW) {
        const int b = m >> 12;
        const GAS f32x4* xr = (const GAS f32x4*)(F.x + (size_t)m * D) + F.lane;
        f32x4 v[4]; float s = 0.f;
#pragma unroll
        for (int j = 0; j < 4; ++j) { v[j] = xr[64 * j]; s += (v[j].x * v[j].x + v[j].y * v[j].y) + (v[j].z * v[j].z + v[j].w * v[j].w); }
        const float rstd = 1.f / sqrtf(wave_sum(s) * (1.f / D) + RMS_EPS);
        GAS unsigned long long* o8 = (GAS unsigned long long*)(H + (size_t)m * D) + F.lane;
#pragma unroll
        for (int j = 0; j < 4; ++j) { const int col = 4 * F.lane + 256 * j;
            const f32x4 g = *(const f32x4*)(F.g_mix + col), sc = *(const f32x4*)(MOD + b * 6144 + 1024 + col), sh = *(const f32x4*)(MOD + b * 6144 + col);
            const f32x4 h = v[j] * rstd * g * (sc + 1.0f) + sh;
            o8[64 * j] = (unsigned long long)cvtpk(h.x, h.y) | ((unsigned long long)cvtpk(h.z, h.w) << 32); }
        if (F.lane < 8) { const float invf = exp2f(-(float)F.lane * 2.3664460711655218f); const float ang = (float)F.positions[m] * invf;
            COS[m * 8 + F.lane] = cosf(ang); SIN[m * 8 + F.lane] = sinf(ang); }
    }
}

struct EpiProj {
    static constexpr bool PERM = true, AFTER_DRAIN = false, CHAIN = false;
    unsigned char* ws; const float* bfg;
    template <int BJ>
    __device__ __forceinline__ void part(const pg8::f32x4 (&acc)[2][2][4][2], const pg8::Unit& u, int wr, int wc, int fr, int fq) const {
        const float* COS = (const float*)(ws + WS_COS); const float* SIN = (const float*)(ws + WS_SIN);
        const int cg = __builtin_amdgcn_readfirstlane(u.pn * 256 + BJ * 128 + wc * 32);
        size_t boff = 0; int ld = 0, cofs = 0, kind = 4; float scale = 1.f;
        if (cg < 512)       { boff = WS_QA; ld = 512; cofs = 0;    kind = 1; scale = QSCALE; }
        else if (cg < 576)  { boff = WS_KA; ld = 64;  cofs = 512;  kind = 1; }
        else if (cg < 640)  { boff = WS_VA; ld = 64;  cofs = 576;  kind = 0; }
        else if (cg < 1152) { boff = WS_QI; ld = 512; cofs = 640;  kind = 1; scale = 0.125f; }
        else if (cg < 1216) { boff = WS_KI; ld = 64;  cofs = 1152; kind = 1; }
        else if (cg < 1728) { boff = WS_QB; ld = 512; cofs = 1216; kind = 0; scale = QSCALE; }
        else if (cg < 2240) { boff = WS_KB; ld = 512; cofs = 1728; kind = 0; }
        else if (cg < 2752) { boff = WS_VB; ld = 512; cofs = 2240; kind = 0; }
        else if (cg < 3776) { boff = WS_GA; ld = 1024; cofs = 2752; kind = 2; }
        else if (cg < 4800) { boff = WS_GB; ld = 1024; cofs = 3776; kind = 2; }
        else if (cg == 4800) { kind = 3; }
        if (kind == 4) return;
        if (kind == 3) {
#pragma unroll
            for (int ai = 0; ai < 2; ++ai)
#pragma unroll
                for (int m = 0; m < 4; ++m) {
                    const int row = u.pm * 256 + ai * 128 + wr * 64 + m * 16 + fr;
                    const pg8::f32x4 v0 = acc[ai][BJ][m][0], v1 = acc[ai][BJ][m][1];
                    if (fq == 0) { float* wi = (float*)(ws + WS_WI) + (size_t)row * 8; const float s = 0.35355339059327373f; *(pg8::f32x4*)wi = v0 * s; *(pg8::f32x4*)(wi + 4) = v1 * s; }
                    else if (fq == 1) { float* lf = (float*)(ws + WS_LOGF) + (size_t)(row >> 12) * 8 * SEQ + (row & (SEQ - 1));
#pragma unroll
                        for (int i = 0; i < 8; ++i) { const float z = (i < 4 ? v0[i & 3] : v1[i & 3]) + bfg[i];
                            const float ls = z >= 0.f ? -log1pf(expf(-z)) : z - log1pf(expf(z)); lf[(size_t)i * SEQ] = ls; } }
                }
            return;
        }
        const bool rope = (kind == 1) && ((cg & 63) == 0);
        const bool isKB = (cg >= 1728) && (cg < 2240);
        bf16* base = (bf16*)(ws + boff);
        const int c0 = cg + 8 * fq - cofs;
#pragma unroll
        for (int ai = 0; ai < 2; ++ai)
#pragma unroll
            for (int m = 0; m < 4; ++m) {
                const int row = u.pm * 256 + ai * 128 + wr * 64 + m * 16 + fr;
                pg8::f32x4 v0 = acc[ai][BJ][m][0], v1 = acc[ai][BJ][m][1];
                if (rope) {
                    pg8::f32x4 o0, o1;
#pragma unroll
                    for (int i = 0; i < 4; ++i) { o0[i] = __shfl_xor(v0[i], 16); o1[i] = __shfl_xor(v1[i], 16); }
                    const pg8::f32x4 c0v = *(const pg8::f32x4*)(COS + (size_t)row * 8), c1v = *(const pg8::f32x4*)(COS + (size_t)row * 8 + 4);
                    const pg8::f32x4 s0v = *(const pg8::f32x4*)(SIN + (size_t)row * 8), s1v = *(const pg8::f32x4*)(SIN + (size_t)row * 8 + 4);
                    if (fq < 2) { const float sg = fq == 0 ? -1.f : 1.f; v0 = v0 * c0v + o0 * s0v * sg; v1 = v1 * c1v + o1 * s1v * sg; }
                }
                if (kind == 2) {
#pragma unroll
                    for (int i = 0; i < 4; ++i) { v0[i] = sigmoidf_(v0[i]); v1[i] = sigmoidf_(v1[i]); }
                }
                v0 = v0 * scale; v1 = v1 * scale;
                pg8::u32x4 w; w.x = cvtpk(v0[0], v0[1]); w.y = cvtpk(v0[2], v0[3]); w.z = cvtpk(v1[0], v1[1]); w.w = cvtpk(v1[2], v1[3]);
                *(pg8::u32x4*)(base + (size_t)row * ld + c0) = w;
                if (isKB) {
                    float ss = (v0[0] * v0[0] + v0[1] * v0[1]) + (v0[2] * v0[2] + v0[3] * v0[3]) + (v1[0] * v1[0] + v1[1] * v1[1]) + (v1[2] * v1[2] + v1[3] * v1[3]);
                    ss += __shfl_xor(ss, 16); ss += __shfl_xor(ss, 32);
                    if (fq == 0) atomicAdd((float*)(ws + WS_CTL) + CW_KN2 + ((size_t)(row >> 12) * 8 + ((cg - 1728) >> 6)) * SEQ + (row & (SEQ - 1)), ss);
                }
            }
    }
    __device__ __forceinline__ void operator()(const pg8::f32x4 (&acc)[2][2][4][2], const pg8::Unit& u, int wr, int wc, int fr, int fq) const {
        part<0>(acc, u, wr, wc, fr, fq); part<1>(acc, u, wr, wc, fr, fq);
    }
};
struct EpiMerge {
    static constexpr bool PERM = true, AFTER_DRAIN = false, CHAIN = true;
    unsigned char* ws; size_t dst_off;
    __device__ __forceinline__ bool chain(pg8::f32x4 (&acc)[2][2][4][2], const pg8::Unit& u, int wr, int wc, int fr, int fq) const {
        bf16* GA = (bf16*)(ws + WS_GA); const bf16* GB = (const bf16*)(ws + WS_GB);
        const int half = u.pn >> 2, pm = u.pm & 63, pn = u.pn & 3;
#pragma unroll
        for (int ai = 0; ai < 2; ++ai)
#pragma unroll
            for (int m = 0; m < 4; ++m) {
                const int row = pm * 256 + ai * 128 + wr * 64 + m * 16 + fr;
#pragma unroll
                for (int bj = 0; bj < 2; ++bj) {
                    const size_t off = (size_t)row * 1024 + pn * 256 + bj * 128 + wc * 32 + 8 * fq;
                    const pg8::u32x4 g = *(const pg8::u32x4*)(GB + off);
                    if (half == 0) {
                        const pg8::u32x4 a = *(const pg8::u32x4*)(GA + off);
                        pg8::f32x4 r0, r1;
                        r0[0] = bflo(a.x) * __builtin_amdgcn_rcpf(bflo(g.x)); r0[1] = bfhi(a.x) * __builtin_amdgcn_rcpf(bfhi(g.x)); r0[2] = bflo(a.y) * __builtin_amdgcn_rcpf(bflo(g.y)); r0[3] = bfhi(a.y) * __builtin_amdgcn_rcpf(bfhi(g.y));
                        r1[0] = bflo(a.z) * __builtin_amdgcn_rcpf(bflo(g.z)); r1[1] = bfhi(a.z) * __builtin_amdgcn_rcpf(bfhi(g.z)); r1[2] = bflo(a.w) * __builtin_amdgcn_rcpf(bflo(g.w)); r1[3] = bfhi(a.w) * __builtin_amdgcn_rcpf(bfhi(g.w));
                        acc[ai][bj][m][0] = acc[ai][bj][m][0] * r0; acc[ai][bj][m][1] = acc[ai][bj][m][1] * r1;
                    } else {
                        const pg8::f32x4 v0 = acc[ai][bj][m][0], v1 = acc[ai][bj][m][1];
                        pg8::u32x4 w; w.x = cvtpk(bflo(g.x) * v0[0], bfhi(g.x) * v0[1]); w.y = cvtpk(bflo(g.y) * v0[2], bfhi(g.y) * v0[3]);
                        w.z = cvtpk(bflo(g.z) * v1[0], bfhi(g.z) * v1[1]); w.w = cvtpk(bflo(g.w) * v1[2], bfhi(g.w) * v1[3]);
                        *(pg8::u32x4*)((bf16*)(ws + dst_off) + off) = w;
                    }
                }
            }
        return half == 0;
    }
    __device__ __forceinline__ void operator()(const pg8::f32x4 (&)[2][2][4][2], const pg8::Unit&, int, int, int, int) const {}
};
struct MergeOrder {
    pg8::StaticOrder S;
    __device__ __forceinline__ bool next(int i, pg8::Unit& u) const { if (!S.next(i >> 1, u)) return false; const int h = i & 1; u.pm += 64 * h; u.pn += 4 * h; return true; }
    __device__ __forceinline__ void a_ready(const pg8::Unit&) const {}
    __device__ __forceinline__ void done(const pg8::Unit&) const {}
};
struct EpiOut {
    static constexpr bool PERM = true, AFTER_DRAIN = false, CHAIN = false;
    unsigned char* ws; const float* x; float* out; bool stats;
    __device__ __forceinline__ void operator()(const pg8::f32x4 (&acc)[2][2][4][2], const pg8::Unit& u, int wr, int wc, int fr, int fq) const {
        const float* MOD = (const float*)(ws + WS_MOD); float* SSQ = (float*)(ws + WS_CTL) + CW_SSQ;
        const int b = u.pm >> 4;
        const int colb = u.pn * 256 + wc * 32 + 8 * fq;
        pg8::f32x4 gt[2][2];
#pragma unroll
        for (int bj = 0; bj < 2; ++bj) { gt[bj][0] = *(const pg8::f32x4*)(MOD + b * 6144 + 2048 + colb + bj * 128); gt[bj][1] = *(const pg8::f32x4*)(MOD + b * 6144 + 2048 + colb + bj * 128 + 4); }
#pragma unroll
        for (int ai = 0; ai < 2; ++ai)
#pragma unroll
            for (int m = 0; m < 4; ++m) {
                const int row = u.pm * 256 + ai * 128 + wr * 64 + m * 16 + fr; float ss = 0.f;
#pragma unroll
                for (int bj = 0; bj < 2; ++bj) {
                    const size_t off = (size_t)row * 1024 + colb + bj * 128;
                    const pg8::f32x4 x0 = *(const pg8::f32x4*)(x + off), x1 = *(const pg8::f32x4*)(x + off + 4);
                    const pg8::f32x4 y0 = x0 + gt[bj][0] * acc[ai][bj][m][0], y1 = x1 + gt[bj][1] * acc[ai][bj][m][1];
                    *(pg8::f32x4*)(out + off) = y0; *(pg8::f32x4*)(out + off + 4) = y1;
                    ss += (y0[0] * y0[0] + y0[1] * y0[1]) + (y0[2] * y0[2] + y0[3] * y0[3]) + (y1[0] * y1[0] + y1[1] * y1[1]) + (y1[2] * y1[2] + y1[3] * y1[3]);
                }
                ss += __shfl_xor(ss, 16); ss += __shfl_xor(ss, 32);
                if (fq == 0 && stats) atomicAdd(SSQ + row, ss);
            }
    }
};
struct EpiGU {
    static constexpr bool PERM = true, AFTER_DRAIN = false, CHAIN = false;
    unsigned char* ws;
    __device__ __forceinline__ void operator()(const pg8::f32x4 (&acc)[2][2][4][2], const pg8::Unit& u, int wr, int wc, int fr, int fq) const {
        bf16* HID = (bf16*)(ws + WS_HID);
        const int col = (u.pn & 3) * 128 + wc * 32 + 8 * fq;
#pragma unroll
        for (int ai = 0; ai < 2; ++ai)
#pragma unroll
            for (int m = 0; m < 4; ++m) {
                const int row = u.pm * 256 + ai * 128 + wr * 64 + m * 16 + fr;
                float r[8];
#pragma unroll
                for (int i = 0; i < 8; ++i) { const float g = i < 4 ? acc[ai][0][m][0][i] : acc[ai][0][m][1][i - 4]; const float up = i < 4 ? acc[ai][1][m][0][i] : acc[ai][1][m][1][i - 4];
                    r[i] = g * sigmoidf_(g) * up; }
                pg8::u32x4 w; w.x = cvtpk(r[0], r[1]); w.y = cvtpk(r[2], r[3]); w.z = cvtpk(r[4], r[5]); w.w = cvtpk(r[6], r[7]);
                *(pg8::u32x4*)(HID + (size_t)row * 512 + col) = w;
            }
    }
};
struct EpiDown {
    static constexpr bool PERM = true, AFTER_DRAIN = false, CHAIN = false;
    unsigned char* ws; const volatile LAS unsigned* LX;
    __device__ __forceinline__ void operator()(const pg8::f32x4 (&acc)[2][2][4][2], const pg8::Unit& u, int wr, int wc, int fr, int fq) const {
        bf16* YC = (bf16*)(ws + WS_YC); const int* TOKSLOT = (const int*)(ws + WS_TOKSLOT); const float* WROW = (const float*)(ws + WS_WROW);
        const int colb = (u.pn & 3) * 256 + wc * 32 + 8 * fq;
        const int e = u.pn >> 2; const int lbase = (u.pm - (int)(LX[96 + e] >> 8)) * 256, cnt = (int)LX[320 + e];
#pragma unroll
        for (int ai = 0; ai < 2; ++ai)
#pragma unroll
            for (int m = 0; m < 4; ++m) {
                const int local = lbase + ai * 128 + wr * 64 + m * 16 + fr;
                if (local < cnt) {
                    const int ts = TOKSLOT[e * ECAP + local]; const float gw = WROW[e * ECAP + local];
#pragma unroll
                    for (int bj = 0; bj < 2; ++bj) { const pg8::f32x4 v0 = acc[ai][bj][m][0] * gw, v1 = acc[ai][bj][m][1] * gw;
                        pg8::u32x4 w; w.x = cvtpk(v0[0], v0[1]); w.y = cvtpk(v0[2], v0[3]); w.z = cvtpk(v1[0], v1[1]); w.w = cvtpk(v1[2], v1[3]);
                        *(pg8::u32x4*)(YC + (size_t)ts * 1024 + colb + bj * 128) = w; }
                }
            }
    }
};
struct MoeRowMap {
    const int* TOKSLOT; const volatile LAS unsigned* LX;
    __device__ __forceinline__ unsigned rowoff(const pg8::Unit& u, int r) const {
        const int e = u.pn >> 2; const int local = (u.pm - (int)(LX[96 + e] >> 8)) * 256 + r;
        const int tok = local < (int)LX[320 + e] ? (TOKSLOT[e * ECAP + local] >> 1) : 0;
        return (unsigned)tok * (unsigned)(D * 2);
    }
};
struct MoeOrder {
    int G, c, nunits; const volatile LAS unsigned* tile_e;
    __device__ __forceinline__ bool next(int i, pg8::Unit& u) const { const int L = i * G + c; if (L >= nunits) return false; const int rt = L >> 2; u.pm = rt; u.pn = (int)tile_e[rt] * 4 + (L & 3); return true; }
    __device__ __forceinline__ void a_ready(const pg8::Unit&) const {}
    __device__ __forceinline__ void done(const pg8::Unit&) const {}
};
__device__ __forceinline__ void moe_table(Frame& F) {
    const gu32* CNT = F.ctl + CW_CNT;
    if (F.tid == 0) { unsigned p = 0;
        for (int e = 0; e < 32; ++e) { F.LX[96 + e] = p; const unsigned c = __hip_atomic_load(CNT + e, RLX_AGENT); F.LX[320 + e] = c; const unsigned nt = (c + 255u) >> 8;
            for (unsigned t = 0; t < nt; ++t) if ((p >> 8) + t < (unsigned)NTMAX) F.LX[160 + (p >> 8) + t] = (unsigned)e;
            p += nt << 8; }
        F.LX[128] = p; F.LX[132] = (p >> 8) < (unsigned)NTMAX ? (p >> 8) : (unsigned)NTMAX; }
    __syncthreads();
}
#ifndef DUP_MASK
#define DUP_MASK 0
#endif
typedef short v4i16_t __attribute__((ext_vector_type(4)));
__device__ __forceinline__ s16x4 trread(LAS const unsigned char* p) { return __builtin_bit_cast(s16x4, __builtin_amdgcn_ds_read_tr16_b64_v4i16((LAS v4i16_t*)p)); }
constexpr int FX_CK = 0, FX_K = 16384, FX_V = 32768, FX_VROW = 144, FX_VBUF = 64 * FX_VROW;
__device__ __forceinline__ float xhalf(float v, int hi) { const auto rr = __builtin_amdgcn_permlane32_swap(__float_as_uint(v), __float_as_uint(v), false, false); return __uint_as_float(hi ? rr[0] : rr[1]); }
__device__ __forceinline__ void fox_tile(LAS unsigned char* L, LAS float* CK, int cur, int t, int r32, int hi, int lane, int q, int qminw,
                                         const pg8::bf16x8 (&qf)[4], float& m_run, float& l_run, f32x16& o0, f32x16& o1) {
    LAS const unsigned char* Kb = L + FX_K + cur * 8192; LAS const unsigned char* Vb = L + FX_V + cur * FX_VBUF;
    f32x16 p0, p1;
#pragma unroll
    for (int rq = 0; rq < 4; ++rq) { const f32x4 c0 = *(LAS const f32x4*)(CK + 64 * t + 8 * rq + 4 * hi), c1 = *(LAS const f32x4*)(CK + 64 * t + 32 + 8 * rq + 4 * hi);
#pragma unroll
        for (int i = 0; i < 4; ++i) { p0[4 * rq + i] = c0[i]; p1[4 * rq + i] = c1[i]; } }
#pragma unroll
    for (int d0 = 0; d0 < 4; ++d0) {
        const int co = ((2 * d0 + hi) ^ (r32 & 7)) * 16;
        const pg8::bf16x8 a0 = *(LAS const pg8::bf16x8*)(Kb + r32 * 128 + co);
        const pg8::bf16x8 a1 = *(LAS const pg8::bf16x8*)(Kb + (r32 + 32) * 128 + co);
        p0 = MFMA32(a0, qf[d0], p0); p1 = MFMA32(a1, qf[d0], p1);
    }
    if (64 * t + 63 > qminw) {
#pragma unroll
        for (int r = 0; r < 16; ++r) { const int key = 64 * t + (r & 3) + 8 * (r >> 2) + 4 * hi; if (key > q) p0[r] = -1e30f; if (key + 32 > q) p1[r] = -1e30f; } }
    float mx = p0[0];
#pragma unroll
    for (int r = 1; r < 16; ++r) mx = fmaxf(mx, p0[r]);
#pragma unroll
    for (int r = 0; r < 16; ++r) mx = fmaxf(mx, p1[r]);
    mx = fmaxf(mx, xhalf(mx, hi));
    const float mnew = fmaxf(m_run, mx), alpha = __builtin_amdgcn_exp2f(m_run - mnew); m_run = mnew;
    float rs = 0.f;
#pragma unroll
    for (int r = 0; r < 16; ++r) { p0[r] = __builtin_amdgcn_exp2f(p0[r] - mnew); p1[r] = __builtin_amdgcn_exp2f(p1[r] - mnew); rs += p0[r] + p1[r]; }
    rs += xhalf(rs, hi);
    l_run = l_run * alpha + rs;
#pragma unroll
    for (int r = 0; r < 16; ++r) { o0[r] *= alpha; o1[r] *= alpha; }
    pg8::bf16x8 pb[4];
#pragma unroll
    for (int s = 0; s < 2; ++s) { v4u w;
        w.x = cvtpk(p0[8 * s], p0[8 * s + 1]); w.y = cvtpk(p0[8 * s + 2], p0[8 * s + 3]); w.z = cvtpk(p0[8 * s + 4], p0[8 * s + 5]); w.w = cvtpk(p0[8 * s + 6], p0[8 * s + 7]); pb[s] = __builtin_bit_cast(pg8::bf16x8, w);
        w.x = cvtpk(p1[8 * s], p1[8 * s + 1]); w.y = cvtpk(p1[8 * s + 2], p1[8 * s + 3]); w.z = cvtpk(p1[8 * s + 4], p1[8 * s + 5]); w.w = cvtpk(p1[8 * s + 6], p1[8 * s + 7]); pb[2 + s] = __builtin_bit_cast(pg8::bf16x8, w); }
    LAS const unsigned char* vb = Vb + (4 * hi + ((lane & 15) >> 2)) * FX_VROW + (16 * ((lane >> 4) & 1) + 4 * (lane & 3)) * 2;
#pragma unroll
    for (int s = 0; s < 4; ++s) {
        const s16x4 l0 = trread(vb + (16 * s) * FX_VROW), h0 = trread(vb + (16 * s + 8) * FX_VROW);
        const s16x4 l1 = trread(vb + (16 * s) * FX_VROW + 64), h1 = trread(vb + (16 * s + 8) * FX_VROW + 64);
        const pg8::bf16x8 a0 = {l0[0], l0[1], l0[2], l0[3], h0[0], h0[1], h0[2], h0[3]};
        const pg8::bf16x8 a1 = {l1[0], l1[1], l1[2], l1[3], h1[0], h1[1], h1[2], h1[3]};
        o0 = MFMA32(a0, pb[s], o0); o1 = MFMA32(a1, pb[s], o1);
    }
}
constexpr int FX_PM = 51200;
constexpr float FX_SKIP = 64.f;
__device__ __forceinline__ void fox_unit(Frame& F, int b, int h, int qb) {
    const int tid = F.tid, lane = F.lane, wave = F.wave, r32 = lane & 31, hi = lane >> 5;
    LAS unsigned char* L = F.ldsl + RING_OFF;
    LAS float* CK = (LAS float*)(L + FX_CK); LAS float* PM = (LAS float*)(L + FX_PM);
    const int nkeys = (qb + 1) * 256, NT = nkeys / 64;
    const bf16* QBp = (const bf16*)(F.ws + WS_QB); const bf16* KBp = (const bf16*)(F.ws + WS_KB); const bf16* VBp = (const bf16*)(F.ws + WS_VB);
    __syncthreads();
    {
        const float* lf = (const float*)(F.ws + WS_LOGF) + (size_t)(b * 8 + h) * SEQ;
        const float* kn = (const float*)(F.ws + WS_CTL) + CW_KN2 + (size_t)(b * 8 + h) * SEQ;
        float v[8]; const int k0 = tid * 8; float pm = 0.f;
        if (k0 < nkeys) { const f32x4 a = *(const f32x4*)(lf + k0), c = *(const f32x4*)(lf + k0 + 4); v[0] = a.x; v[1] = a.y; v[2] = a.z; v[3] = a.w; v[4] = c.x; v[5] = c.y; v[6] = c.z; v[7] = c.w;
            const f32x4 n0 = *(const f32x4*)(kn + k0), n1 = *(const f32x4*)(kn + k0 + 4); pm = fmaxf(fmaxf(fmaxf(n0.x, n0.y), fmaxf(n0.z, n0.w)), fmaxf(fmaxf(n1.x, n1.y), fmaxf(n1.z, n1.w))); }
        else {
#pragma unroll
            for (int i = 0; i < 8; ++i) v[i] = 0.f; }
#pragma unroll
        for (int i = 1; i < 8; ++i) v[i] += v[i - 1];
        const float tot = v[7]; float sc = tot;
#pragma unroll
        for (int o = 1; o < 64; o <<= 1) { const float t = __shfl_up(sc, o); if (lane >= o) sc += t; const float u = __shfl_up(pm, o); if (lane >= o) pm = fmaxf(pm, u); }
        if (lane == 63) { F.LX[8 + wave] = __float_as_uint(sc); F.LX[24 + wave] = __float_as_uint(pm); }
        __syncthreads();
        float woff = 0.f, cref = 0.f, pmo = 0.f;
#pragma unroll
        for (int w = 0; w < 8; ++w) { const float t = __uint_as_float(F.LX[8 + w]); cref += t; if (w < wave) { woff += t; pmo = fmaxf(pmo, __uint_as_float(F.LX[24 + w])); } }
        const float base = woff + sc - tot;
        if (k0 < nkeys) {
#pragma unroll
            for (int i = 0; i < 8; ++i) CK[k0 + i] = (cref - (base + v[i])) * LOG2E; }
        PM[tid] = fmaxf(pm, pmo);
    }
    const size_t qrow = (size_t)b * SEQ + qb * 256 + wave * 32 + r32;
    pg8::bf16x8 qf[4]; float qn = 0.f;
#pragma unroll
    for (int d0 = 0; d0 < 4; ++d0) { qf[d0] = *(const pg8::bf16x8*)(QBp + qrow * 512 + h * 64 + d0 * 16 + hi * 8);
#pragma unroll
        for (int j = 0; j < 8; ++j) { const float e = __uint_as_float((unsigned)(unsigned short)qf[d0][j] << 16); qn += e * e; } }
    qn += xhalf(qn, hi); qn = sqrtf(qn) * 1.02f;
    float m_run = -1e30f, l_run = 0.f; f32x16 o0 = {}, o1 = {};
    const int kr = tid >> 3, ch = tid & 7;
    const bf16* Kg = KBp + ((size_t)b * SEQ + kr) * 512 + h * 64 + ch * 8;
    const bf16* Vg = VBp + ((size_t)b * SEQ + kr) * 512 + h * 64 + ch * 8;
    const int kwo = FX_K + kr * 128 + ((ch ^ (kr & 7)) * 16), vwo = FX_V + kr * FX_VROW + ch * 16;
#define FOX_TILE_OFF(i) ((size_t)(NT - 1 - (i)) * 64 * 512)
    v4u kr0 = *(const v4u*)(Kg + FOX_TILE_OFF(0)), vr0 = *(const v4u*)(Vg + FOX_TILE_OFF(0)), kr1 = kr0, vr1 = vr0, kr2 = kr0, vr2 = vr0;
    if (1 < NT) { kr1 = *(const v4u*)(Kg + FOX_TILE_OFF(1)); vr1 = *(const v4u*)(Vg + FOX_TILE_OFF(1)); }
    if (2 < NT) { kr2 = *(const v4u*)(Kg + FOX_TILE_OFF(2)); vr2 = *(const v4u*)(Vg + FOX_TILE_OFF(2)); }
    *(LAS v4u*)(L + kwo) = kr0; *(LAS v4u*)(L + vwo) = vr0;
    __syncthreads();
    const int qminw = qb * 256 + wave * 32, qmaxw = qminw + 31, q = qminw + r32;
    bool stop = false;
#define FOX_STEP(i, KRF, VRF, KRN, VRN) do { \
        const int cur = (i) & 1, t_ = NT - 1 - (i); \
        if ((i) + 3 < NT) { KRF = *(const v4u*)(Kg + FOX_TILE_OFF((i) + 3)); VRF = *(const v4u*)(Vg + FOX_TILE_OFF((i) + 3)); } \
        bool done_ = false; \
        if (64 * t_ <= qmaxw) { fox_tile(L, CK, cur, t_, r32, hi, lane, q, qminw, qf, m_run, l_run, o0, o1); \
            if (t_ > 0) { const float bnd_ = qn * sqrtf(PM[8 * t_ - 1]) + CK[64 * t_ - 1]; done_ = __all(bnd_ < m_run - FX_SKIP); } } \
        if (lane == 0) F.LX[40 + cur * 8 + wave] = done_ ? 1u : 0u; \
        if ((i) + 1 < NT) { const int nb = cur ^ 1; *(LAS v4u*)(L + kwo + nb * 8192) = KRN; *(LAS v4u*)(L + vwo + nb * FX_VBUF) = VRN; } \
        __syncthreads(); \
        { unsigned all_ = 1u; _Pragma("unroll") for (int w_ = 0; w_ < 8; ++w_) all_ &= F.LX[40 + cur * 8 + w_]; stop = all_ != 0u; } } while (0)
    for (int i = 0; i < NT && !stop; i += 3) {
        FOX_STEP(i, kr0, vr0, kr1, vr1);
        if (!stop && i + 1 < NT) FOX_STEP(i + 1, kr1, vr1, kr2, vr2);
        if (!stop && i + 2 < NT) FOX_STEP(i + 2, kr2, vr2, kr0, vr0);
    }
#undef FOX_STEP
#undef FOX_TILE_OFF
    const float inv = 1.f / l_run;
    bf16* Op = (bf16*)(F.ws + WS_OB) + qrow * 512 + h * 64;
#pragma unroll
    for (int rq = 0; rq < 4; ++rq) {
        const unsigned long long w0 = (unsigned long long)cvtpk(o0[4 * rq] * inv, o0[4 * rq + 1] * inv) | ((unsigned long long)cvtpk(o0[4 * rq + 2] * inv, o0[4 * rq + 3] * inv) << 32);
        const unsigned long long w1 = (unsigned long long)cvtpk(o1[4 * rq] * inv, o1[4 * rq + 1] * inv) | ((unsigned long long)cvtpk(o1[4 * rq + 2] * inv, o1[4 * rq + 3] * inv) << 32);
        *(unsigned long long*)(Op + 8 * rq + 4 * hi) = w0; *(unsigned long long*)(Op + 32 + 8 * rq + 4 * hi) = w1;
    }
}
__device__ __forceinline__ void hist_pick(LAS unsigned* hist, int lane, unsigned target, unsigned& bsel_o, unsigned& cge_o, unsigned& cb_o) {
    const v4u hv = *(LAS const v4u*)(hist + 4 * lane);
    *(LAS v4u*)(hist + 4 * lane) = (v4u){0u, 0u, 0u, 0u};
    const unsigned sl = hv.x + hv.y + hv.z + hv.w;
    unsigned suf = sl;
#pragma unroll
    for (int o = 1; o < 64; o <<= 1) { const unsigned t = __shfl_down(suf, o); if (lane + o < 64) suf += t; }
    const unsigned above = suf - sl;
    const bool here = (suf >= target) && (above < target);
    unsigned bsel = 0u, cge = 0u, cb = 0u;
    if (here) {
        if (above + hv.w >= target) { bsel = 4 * lane + 3; cge = above + hv.w; cb = hv.w; }
        else if (above + hv.w + hv.z >= target) { bsel = 4 * lane + 2; cge = above + hv.w + hv.z; cb = hv.z; }
        else if (above + hv.w + hv.z + hv.y >= target) { bsel = 4 * lane + 1; cge = above + hv.w + hv.z + hv.y; cb = hv.y; }
        else { bsel = 4 * lane; cge = suf; cb = hv.x; } }
    const unsigned long long mh = __ballot(here);
    const int src = mh ? (int)__builtin_ctzll(mh) : 0;
    bsel_o = (unsigned)__shfl((int)bsel, src); cge_o = (unsigned)__shfl((int)cge, src); cb_o = (unsigned)__shfl((int)cb, src);
}
template <int NJ>
__device__ __forceinline__ void dsa_select(LAS const unsigned* sr, LAS unsigned* hist, LAS int* SEL, int nj, int lane) {
    unsigned key[NJ];
#pragma unroll
    for (int j = 0; j < NJ; ++j) { unsigned u = 0u; if (j < NJ - 16 || j < nj) u = sr[64 * j + lane]; key[j] = u; }
    unsigned T = 0u; int nge = 0;
    {
        unsigned b1, cge1, c1;
        hist_pick(hist, lane, 256u, b1, cge1, c1);
        T = b1 << 24; nge = (int)cge1;
        unsigned above = cge1 - c1;
#pragma unroll
        for (int sh = 16; sh >= 8; sh -= 8) {
            if (nge != 256) {
                const unsigned pre = T >> (sh + 8);
#pragma unroll
                for (int j = 0; j < NJ; ++j) if ((key[j] >> (sh + 8)) == pre) __hip_atomic_fetch_add(hist + ((key[j] >> sh) & 255u), 1u, __ATOMIC_RELAXED, __HIP_MEMORY_SCOPE_WORKGROUP);
                asm volatile("s_waitcnt lgkmcnt(0)" ::: "memory");
                unsigned b2, cge2, c2;
                hist_pick(hist, lane, 256u - above, b2, cge2, c2);
                T |= b2 << sh; nge = (int)(above + cge2); above += cge2 - c2;
            }
        }
    }
    for (int bit = 7; bit >= 0 && nge != 256; --bit) {
        const unsigned cand = T | (1u << bit); unsigned cl = 0u;
#pragma unroll
        for (int j = 0; j < NJ; ++j) cl += (key[j] >= cand) ? 1u : 0u;
        int cnt = 0;
#pragma unroll
        for (int bb = 0; bb < 7; ++bb) cnt += __popcll(__ballot(((cl >> bb) & 1u) != 0u)) << bb;
        if (cnt >= 256) { T = cand; nge = cnt; }
    }
    if (nge == 256) {
        unsigned cl = 0u;
#pragma unroll
        for (int j = 0; j < NJ; ++j) cl += (key[j] >= T) ? 1u : 0u;
        int p = 0;
#pragma unroll
        for (int bb = 0; bb < 7; ++bb) { const unsigned long long mk = __ballot(((cl >> bb) & 1u) != 0u);
            p += (int)__builtin_amdgcn_mbcnt_hi((unsigned)(mk >> 32), __builtin_amdgcn_mbcnt_lo((unsigned)mk, 0u)) << bb; }
#pragma unroll
        for (int j = 0; j < NJ; ++j) if (key[j] >= T) { SEL[p & 255] = 64 * j + lane; ++p; }
    } else {
        int ngt = 0;
#pragma unroll
        for (int j = 0; j < NJ; ++j) ngt += __popcll(__ballot(key[j] > T));
        const int need_eq = 256 - ngt; int pos = 0, eq_seen = 0;
#pragma unroll
        for (int j = 0; j < NJ; ++j) {
            const bool gt = key[j] > T, eq = key[j] == T;
            const unsigned long long meq = __ballot(eq);
            const int eq_rank = eq_seen + (int)__builtin_amdgcn_mbcnt_hi((unsigned)(meq >> 32), __builtin_amdgcn_mbcnt_lo((unsigned)meq, 0u));
            const bool take = gt || (eq && eq_rank < need_eq);
            const unsigned long long mt = __ballot(take);
            const int pr = (int)__builtin_amdgcn_mbcnt_hi((unsigned)(mt >> 32), __builtin_amdgcn_mbcnt_lo((unsigned)mt, 0u));
            if (take && pos + pr < 256) SEL[pos + pr] = 64 * j + lane;
            pos += __popcll(mt); eq_seen += __popcll(meq);
        }
    }
}
typedef _Float16 h16x8 __attribute__((ext_vector_type(8))); typedef _Float16 h16x2 __attribute__((ext_vector_type(2)));
__device__ __forceinline__ h16x2 relu_pk(float a, float b) { const h16x2 p = __builtin_bit_cast(h16x2, __builtin_amdgcn_cvt_pkrtz(a, b)); const h16x2 z = {0, 0}; return __builtin_elementwise_max(p, z); }
template <bool FULL>
__device__ __forceinline__ void dsa_attend(Frame& F, LAS unsigned char* L, LAS int* SEL, int b, size_t qrow, int nsel) {
    const int lane = F.lane, wave = F.wave;
    const bf16* QA = (const bf16*)(F.ws + WS_QA); const bf16* KA = (const bf16*)(F.ws + WS_KA); const bf16* VA = (const bf16*)(F.ws + WS_VA);
    const int n = lane & 15, kg = lane >> 4;
    pg8::bf16x8 qf[2];
#pragma unroll
    for (int s = 0; s < 2; ++s) { qf[s] = (pg8::bf16x8){0, 0, 0, 0, 0, 0, 0, 0}; if (n < 8) qf[s] = *(const pg8::bf16x8*)(QA + qrow * 512 + n * 64 + 32 * s + 8 * kg); }
    const int ntile = FULL ? 16 : (nsel >> 4);
    const bf16* vgb = VA + (size_t)b * SEQ * 64 + 8 * (lane & 7);
    LAS unsigned char* VS = L + wave * 16384;
    const int nsc = FULL ? 8 : (nsel >> 5);
#define DSA_DMAV(sc, slot) do { _Pragma("unroll") for (int i_ = 0; i_ < 4; ++i_) { const int idx_ = SEL[32 * (sc) + 8 * i_ + (lane >> 3)]; \
        __builtin_amdgcn_global_load_lds((const unsigned*)(vgb + (size_t)idx_ * 64), (LAS unsigned*)(VS + (slot) * 4096 + i_ * 1024), 16, 0, 0); } } while (0)
#define DSA_PV(slot, sc) do { _Pragma("unroll") for (int dt_ = 0; dt_ < 4; ++dt_) { \
        const s16x4 lo_ = trread(vb + (slot) * 4096 + dt_ * 32), hh_ = trread(vb + (slot) * 4096 + 16 * 128 + dt_ * 32); \
        const pg8::bf16x8 a_ = {lo_[0], lo_[1], lo_[2], lo_[3], hh_[0], hh_[1], hh_[2], hh_[3]}; \
        o[dt_] = MFMA16(a_, pb[(sc)], o[dt_]); } } while (0)
    DSA_DMAV(0, 0); DSA_DMAV(1, 1);
    if (FULL || nsc > 2) { DSA_DMAV(2, 2); DSA_DMAV(3, 3); }
    f32x4 x[16];
#pragma unroll
    for (int t = 0; t < 16; ++t) {
        x[t] = (f32x4){-1e30f, -1e30f, -1e30f, -1e30f};
        if (FULL || t < ntile) { const int idx = SEL[16 * t + n]; const bf16* kp = KA + ((size_t)b * SEQ + idx) * 64 + 8 * kg;
            const pg8::bf16x8 a0 = *(const pg8::bf16x8*)kp, a1 = *(const pg8::bf16x8*)(kp + 32);
            f32x4 z = {0.f, 0.f, 0.f, 0.f}; z = MFMA16(a0, qf[0], z); z = MFMA16(a1, qf[1], z); x[t] = z; }
    }
    float mx = -1e30f;
#pragma unroll
    for (int t = 0; t < 16; ++t) mx = fmaxf(fmaxf(mx, fmaxf(x[t][0], x[t][1])), fmaxf(x[t][2], x[t][3]));
    mx = fmaxf(mx, __shfl_xor(mx, 16)); mx = fmaxf(mx, __shfl_xor(mx, 32));
    float ls = 0.f;
#pragma unroll
    for (int t = 0; t < 16; ++t) {
#pragma unroll
        for (int i = 0; i < 4; ++i) { x[t][i] = __builtin_amdgcn_exp2f(x[t][i] - mx); ls += x[t][i]; } }
    ls += __shfl_xor(ls, 16); ls += __shfl_xor(ls, 32);
    pg8::bf16x8 pb[8];
#pragma unroll
    for (int s = 0; s < 8; ++s) { v4u w; w.x = cvtpk(x[2 * s][0], x[2 * s][1]); w.y = cvtpk(x[2 * s][2], x[2 * s][3]); w.z = cvtpk(x[2 * s + 1][0], x[2 * s + 1][1]); w.w = cvtpk(x[2 * s + 1][2], x[2 * s + 1][3]); pb[s] = __builtin_bit_cast(pg8::bf16x8, w); }
    f32x4 o[4];
#pragma unroll
    for (int dt = 0; dt < 4; ++dt) o[dt] = (f32x4){0.f, 0.f, 0.f, 0.f};
    LAS const unsigned char* vb = VS + (4 * kg + (n >> 2)) * 128 + (4 * (n & 3)) * 2;
    asm volatile("s_waitcnt vmcnt(0)" ::: "memory");
    DSA_PV(0, 0); asm volatile("s_waitcnt lgkmcnt(0)" ::: "memory"); if (FULL || nsc > 4) DSA_DMAV(4, 0);
    DSA_PV(1, 1); asm volatile("s_waitcnt lgkmcnt(0)" ::: "memory"); if (FULL || nsc > 4) DSA_DMAV(5, 1);
    if (FULL || nsc > 2) {
        DSA_PV(2, 2); asm volatile("s_waitcnt lgkmcnt(0)" ::: "memory"); if (FULL || nsc > 6) DSA_DMAV(6, 2);
        DSA_PV(3, 3); asm volatile("s_waitcnt lgkmcnt(0)" ::: "memory"); if (FULL || nsc > 6) DSA_DMAV(7, 3);
    }
    if (FULL || nsc > 4) {
        asm volatile("s_waitcnt vmcnt(0)" ::: "memory");
        DSA_PV(0, 4); DSA_PV(1, 5);
        if (FULL || nsc > 6) { DSA_PV(2, 6); DSA_PV(3, 7); }
    }
    asm volatile("s_waitcnt lgkmcnt(0)" ::: "memory");
#undef DSA_DMAV
#undef DSA_PV
    if (n < 8) { const float inv = 1.f / ls; bf16* Op = (bf16*)(F.ws + WS_OA) + qrow * 512 + n * 64 + 4 * kg;
#pragma unroll
        for (int dt = 0; dt < 4; ++dt) *(unsigned long long*)(Op + 16 * dt) = (unsigned long long)cvtpk(o[dt][0] * inv, o[dt][1] * inv) | ((unsigned long long)cvtpk(o[dt][2] * inv, o[dt][3] * inv) << 32); }
}
__device__ __forceinline__ void dsa_attend_stream(Frame& F, LAS unsigned char* L, LAS int* SEL, int b, size_t qrow) {
    const int lane = F.lane, wave = F.wave;
    const bf16* QA = (const bf16*)(F.ws + WS_QA); const bf16* KA = (const bf16*)(F.ws + WS_KA); const bf16* VA = (const bf16*)(F.ws + WS_VA);
    const int n = lane & 15, kg = lane >> 4;
    pg8::bf16x8 qf[2];
#pragma unroll
    for (int s = 0; s < 2; ++s) { qf[s] = (pg8::bf16x8){0, 0, 0, 0, 0, 0, 0, 0}; if (n < 8) qf[s] = *(const pg8::bf16x8*)(QA + qrow * 512 + n * 64 + 32 * s + 8 * kg); }
    asm volatile("s_waitcnt vmcnt(0)" : "+v"(qf[0]), "+v"(qf[1]) :: "memory");
    LAS unsigned char* VS = L + wave * 16384;
    const bf16* kgb = KA + (size_t)b * SEQ * 64 + 8 * ((lane & 7) ^ ((lane >> 3) & 7));
    const bf16* vgb = VA + (size_t)b * SEQ * 64 + 8 * (lane & 7);
#define DSA_DMA(gb, sc, slot) do { _Pragma("unroll") for (int i_ = 0; i_ < 4; ++i_) { const int idx_ = SEL[32 * (sc) + 8 * i_ + (lane >> 3)]; \
        __builtin_amdgcn_global_load_lds((const unsigned*)((gb) + (size_t)idx_ * 64), (LAS unsigned*)(VS + (slot) * 4096 + i_ * 1024), 16, 0, 0); } } while (0)
#define DSA_WAITV(nn) asm volatile("s_waitcnt vmcnt(" #nn ")" ::: "memory")
#define DSA_WAITL() asm volatile("s_waitcnt lgkmcnt(0)" ::: "memory")
    const int kro = n * 128;
#define DSA_QK(slot, sc) do { _Pragma("unroll") for (int tt_ = 0; tt_ < 2; ++tt_) { \
        const pg8::bf16x8 a0_ = *(LAS const pg8::bf16x8*)(VS + (slot) * 4096 + tt_ * 2048 + kro + ((kg ^ (n & 7)) << 4)); \
        const pg8::bf16x8 a1_ = *(LAS const pg8::bf16x8*)(VS + (slot) * 4096 + tt_ * 2048 + kro + (((4 + kg) ^ (n & 7)) << 4)); \
        f32x4 z_ = {0.f, 0.f, 0.f, 0.f}; z_ = MFMA16(a0_, qf[0], z_); z_ = MFMA16(a1_, qf[1], z_); x[2 * (sc) + tt_] = z_; } } while (0)
#define DSA_PV(slot, sc) do { _Pragma("unroll") for (int dt_ = 0; dt_ < 4; ++dt_) { \
        const s16x4 lo_ = trread(vb + (slot) * 4096 + dt_ * 32), hh_ = trread(vb + (slot) * 4096 + 16 * 128 + dt_ * 32); \
        const pg8::bf16x8 a_ = {lo_[0], lo_[1], lo_[2], lo_[3], hh_[0], hh_[1], hh_[2], hh_[3]}; \
        o[dt_] = MFMA16(a_, pb[(sc)], o[dt_]); } } while (0)
    f32x4 x[16];
    DSA_DMA(kgb, 0, 0); DSA_DMA(kgb, 1, 1); DSA_DMA(kgb, 2, 2); DSA_DMA(kgb, 3, 3);
    DSA_WAITV(12); DSA_QK(0, 0); DSA_WAITL(); DSA_DMA(kgb, 4, 0);
    DSA_WAITV(12); DSA_QK(1, 1); DSA_WAITL(); DSA_DMA(kgb, 5, 1);
    DSA_WAITV(12); DSA_QK(2, 2); DSA_WAITL(); DSA_DMA(kgb, 6, 2);
    DSA_WAITV(12); DSA_QK(3, 3); DSA_WAITL(); DSA_DMA(kgb, 7, 3);
    DSA_WAITV(12); DSA_QK(0, 4); DSA_WAITL(); DSA_DMA(vgb, 0, 0);
    DSA_WAITV(12); DSA_QK(1, 5); DSA_WAITL(); DSA_DMA(vgb, 1, 1);
    DSA_WAITV(12); DSA_QK(2, 6); DSA_WAITL(); DSA_DMA(vgb, 2, 2);
    DSA_WAITV(12); DSA_QK(3, 7); DSA_WAITL(); DSA_DMA(vgb, 3, 3);
    float mx = -1e30f;
#pragma unroll
    for (int t = 0; t < 16; ++t) mx = fmaxf(fmaxf(mx, fmaxf(x[t][0], x[t][1])), fmaxf(x[t][2], x[t][3]));
    mx = fmaxf(mx, __shfl_xor(mx, 16)); mx = fmaxf(mx, __shfl_xor(mx, 32));
    float ls = 0.f;
#pragma unroll
    for (int t = 0; t < 16; ++t) {
#pragma unroll
        for (int i = 0; i < 4; ++i) { x[t][i] = __builtin_amdgcn_exp2f(x[t][i] - mx); ls += x[t][i]; } }
    ls += __shfl_xor(ls, 16); ls += __shfl_xor(ls, 32);
    pg8::bf16x8 pb[8];
#pragma unroll
    for (int s = 0; s < 8; ++s) { v4u w; w.x = cvtpk(x[2 * s][0], x[2 * s][1]); w.y = cvtpk(x[2 * s][2], x[2 * s][3]); w.z = cvtpk(x[2 * s + 1][0], x[2 * s + 1][1]); w.w = cvtpk(x[2 * s + 1][2], x[2 * s + 1][3]); pb[s] = __builtin_bit_cast(pg8::bf16x8, w); }
    f32x4 o[4];
#pragma unroll
    for (int dt = 0; dt < 4; ++dt) o[dt] = (f32x4){0.f, 0.f, 0.f, 0.f};
    LAS const unsigned char* vb = VS + (4 * kg + (n >> 2)) * 128 + (4 * (n & 3)) * 2;
    DSA_WAITV(12); DSA_PV(0, 0); DSA_WAITL(); DSA_DMA(vgb, 4, 0);
    DSA_WAITV(12); DSA_PV(1, 1); DSA_WAITL(); DSA_DMA(vgb, 5, 1);
    DSA_WAITV(12); DSA_PV(2, 2); DSA_WAITL(); DSA_DMA(vgb, 6, 2);
    DSA_WAITV(12); DSA_PV(3, 3); DSA_WAITL(); DSA_DMA(vgb, 7, 3);
    DSA_WAITV(12); DSA_PV(0, 4);
    DSA_WAITV(8);  DSA_PV(1, 5);
    DSA_WAITV(4);  DSA_PV(2, 6);
    DSA_WAITV(0);  DSA_PV(3, 7);
    DSA_WAITL();
#undef DSA_DMA
#undef DSA_WAITV
#undef DSA_WAITL
#undef DSA_QK
#undef DSA_PV
    if (n < 8) { const float inv = 1.f / ls; bf16* Op = (bf16*)(F.ws + WS_OA) + qrow * 512 + n * 64 + 4 * kg;
#pragma unroll
        for (int dt = 0; dt < 4; ++dt) *(unsigned long long*)(Op + 16 * dt) = (unsigned long long)cvtpk(o[dt][0] * inv, o[dt][1] * inv) | ((unsigned long long)cvtpk(o[dt][2] * inv, o[dt][3] * inv) << 32); }
}
constexpr int DS_VROW = 144, DS_VBUF = 64 * DS_VROW;
__device__ __forceinline__ void dsa_unit(Frame& F, int b, int c, int g) {
    const int lane = F.lane, wave = F.wave;
    LAS unsigned char* L = F.ldsl + RING_OFF;
    LAS float* SC = (LAS float*)L;
    LAS int* SEL = (LAS int*)(F.ldsl + SEL_OFF) + wave * 256;
    const int q0 = c * 64 + g * 8, Kn = (c + 1) * 64;
    const bf16* QI = (const bf16*)(F.ws + WS_QI); const bf16* KI = (const bf16*)(F.ws + WS_KI); const float* WI = (const float*)(F.ws + WS_WI);
    const bf16* QA = (const bf16*)(F.ws + WS_QA); const bf16* KA = (const bf16*)(F.ws + WS_KA); const bf16* VA = (const bf16*)(F.ws + WS_VA);
    __syncthreads();
    for (int repa_ = 0; repa_ <= ((DUP_MASK >> 12) & 1); ++repa_) {
        const int m = lane & 31, hi = lane >> 5;
        const int q4 = 2 * ((m >> 2) & 1) + (m >> 4), head = (m & 3) + 4 * ((m >> 3) & 1);
        pg8::bf16x8 af[2][4]; h16x8 w2[4];
#pragma unroll
        for (int mt = 0; mt < 2; ++mt) {
            const size_t arow = (size_t)b * SEQ + q0 + 4 * mt + q4;
#pragma unroll
            for (int s = 0; s < 4; ++s) af[mt][s] = *(const pg8::bf16x8*)(QI + arow * 512 + head * 64 + 16 * s + 8 * hi);
        }
        {
            const size_t wrow = (size_t)b * SEQ + q0 + (m & 7);
            const f32x4 wa = *(const f32x4*)(WI + wrow * 8), wb = *(const f32x4*)(WI + wrow * 8 + 4);
            const h16x8 wv = {(_Float16)wa.x, (_Float16)wa.y, (_Float16)wa.z, (_Float16)wa.w, (_Float16)wb.x, (_Float16)wb.y, (_Float16)wb.z, (_Float16)wb.w};
            const h16x8 hz = {0, 0, 0, 0, 0, 0, 0, 0};
#pragma unroll
            for (int ks = 0; ks < 4; ++ks) w2[ks] = (m < 8 && m == 4 * (ks >> 1) + 2 * hi + (ks & 1)) ? wv : hz;
        }
        const int nkt = Kn / 32;
        const bf16* kbase = KI + ((size_t)b * SEQ + m) * 64 + 8 * hi;
        LAS unsigned* sp = (LAS unsigned*)SC + (4 * hi) * 4096 + m;
        LAS unsigned* hp = (LAS unsigned*)(F.ldsl + HIST_OFF) + (4 * hi) * 256;
#define DSA_LOADK(dst, kt) do { _Pragma("unroll") for (int s_ = 0; s_ < 4; ++s_) dst[s_] = *(const pg8::bf16x8*)(kbase + (size_t)(kt) * 32 * 64 + 16 * s_); } while (0)
#define DSA_TILE(src, kt) do { f32x16 y_ = {}; \
            _Pragma("unroll") for (int mt_ = 0; mt_ < 2; ++mt_) { f32x16 acc_ = {}; \
                _Pragma("unroll") for (int s_ = 0; s_ < 4; ++s_) acc_ = MFMA32(af[mt_][s_], src[s_], acc_); \
                _Pragma("unroll") for (int sp_ = 0; sp_ < 2; ++sp_) { h16x8 hb_; \
                    _Pragma("unroll") for (int j_ = 0; j_ < 4; ++j_) { const h16x2 pr_ = relu_pk(acc_[8 * sp_ + 2 * j_], acc_[8 * sp_ + 2 * j_ + 1]); hb_[2 * j_] = pr_[0]; hb_[2 * j_ + 1] = pr_[1]; } \
                    y_ = __builtin_amdgcn_mfma_f32_32x32x16_f16(w2[2 * mt_ + sp_], hb_, y_, 0, 0, 0); } } \
            _Pragma("unroll") for (int r_ = 0; r_ < 4; ++r_) { unsigned u_ = __float_as_uint(y_[r_] + 0.f); u_ = (u_ >> 31) ? ~u_ : (u_ | 0x80000000u); \
                sp[r_ * 4096 + 32 * (kt)] = u_; __hip_atomic_fetch_add(hp + r_ * 256 + (u_ >> 24), 1u, __ATOMIC_RELAXED, __HIP_MEMORY_SCOPE_WORKGROUP); } } while (0)
        pg8::bf16x8 bA[4], bB[4];
        if (wave < nkt) DSA_LOADK(bA, wave);
        if (wave + 8 < nkt) DSA_LOADK(bB, wave + 8);
        for (int kt = wave; kt < nkt; kt += 16) {
            DSA_TILE(bA, kt);
            if (kt + 16 < nkt) DSA_LOADK(bA, kt + 16);
            if (kt + 8 < nkt) { DSA_TILE(bB, kt + 8); if (kt + 24 < nkt) DSA_LOADK(bB, kt + 24); }
        }
#undef DSA_LOADK
#undef DSA_TILE
    }
    __syncthreads();
    int nsel;
    for (int repb_ = 0; repb_ <= ((DUP_MASK >> 13) & 1); ++repb_)
    if (Kn <= 256) { nsel = Kn; for (int i = lane; i < Kn; i += 64) SEL[i] = i; *(LAS v4u*)((LAS unsigned*)(F.ldsl + HIST_OFF) + wave * 256 + 4 * lane) = (v4u){0u, 0u, 0u, 0u}; }
    else {
        nsel = 256;
        LAS const unsigned* sr = (LAS const unsigned*)SC + wave * 4096; LAS unsigned* hs = (LAS unsigned*)(F.ldsl + HIST_OFF) + wave * 256;
        const int nj = Kn >> 6;
        if (nj <= 16) dsa_select<16>(sr, hs, SEL, nj, lane);
        else if (nj <= 32) dsa_select<32>(sr, hs, SEL, nj, lane);
        else if (nj <= 48) dsa_select<48>(sr, hs, SEL, nj, lane);
        else dsa_select<64>(sr, hs, SEL, nj, lane);
    }
    asm volatile("s_waitcnt lgkmcnt(0)" ::: "memory");
    for (int repc_ = 0; repc_ <= ((DUP_MASK >> 14) & 1); ++repc_) {
        const size_t qrow = (size_t)b * SEQ + q0 + wave;
        if (nsel == 256) dsa_attend_stream(F, L, SEL, b, qrow); else dsa_attend<false>(F, L, SEL, b, qrow, nsel);
    }
}
__device__ __forceinline__ void p3_fox(Frame& F) {
    for (int v = F.vcu; v < 256; v += F.G) {
        const int bh = v >> 3, s = v & 7;
        fox_unit(F, bh >> 3, bh & 7, 15 - s);
        fox_unit(F, bh >> 3, bh & 7, s);
    }
}
__device__ __forceinline__ void p3_dsa(Frame& F) {
    for (int i = F.tid; i < 2048; i += NWAVES * 64) ((LAS unsigned*)(F.ldsl + HIST_OFF))[i] = 0u;
    __syncthreads();
    for (int v = F.vcu; v < 256; v += F.G) {
        const int b = v >> 6, t = v & 63, g0 = (t < 32) ? 0 : 4;
        for (int i = 0; i < 4; ++i) dsa_unit(F, b, 63 - t, g0 + i);
        for (int i = 0; i < 4; ++i) dsa_unit(F, b, t, g0 + i);
    }
}

__device__ __forceinline__ void p6_router(Frame& F) {
    const float* MOD = (const float*)(F.ws + WS_MOD); const float* X1 = F.out; const float* SSQ = (const float*)(F.ws + WS_CTL) + CW_SSQ;
    bf16* H2 = (bf16*)(F.ws + WS_H2); const bf16* WrT = (const bf16*)(F.ws + WS_WRT);
    int* TOKSLOT = (int*)(F.ws + WS_TOKSLOT); float* WROW = (float*)(F.ws + WS_WROW);
    const int lane = F.lane, r = lane & 15, kg = lane >> 4;
    const int it4 = F.wave & 3, kh = F.wave >> 2;
    LAS float* GS = (LAS float*)(F.ldsl + RING_OFF);
    LAS float* SH = GS + 1024;
    LAS float* LG = SH + 1024 + it4 * (16 * 52);
    LAS float* LG2 = SH + 1024 + 4 * (16 * 52) + it4 * (16 * 52);
    for (int base = F.vcu * 4; base < M / 16; base += F.G * 4) {
        __syncthreads();
        const int bb = (base * 16) >> 12;
        for (int i = F.tid; i < 1024; i += NWAVES * 64) { GS[i] = F.g_ffn[i] * (MOD[bb * 6144 + 4096 + i] + 1.0f); SH[i] = MOD[bb * 6144 + 3072 + i]; }
        if (F.tid < 32) F.LX[32 + F.tid] = 0u;
        __syncthreads();
        const int item = base + it4; const bool act = item < M / 16;
        int e1 = 0, e2 = 0, lr1 = 0, lr2 = 0; float w1 = 0.f, w2 = 0.f;
        if (act) {
            const int row = item * 16 + r;
            const float rstd = 1.f / sqrtf(SSQ[row] * (1.f / D) + RMS_EPS);
            f32x4 acc[3];
#pragma unroll
            for (int nt = 0; nt < 3; ++nt) acc[nt] = (f32x4){0.f, 0.f, 0.f, 0.f};
#pragma unroll 4
            for (int s = 0; s < 16; ++s) {
                const int k = 32 * (16 * kh + s) + 8 * kg;
                const f32x4 xa = *(const f32x4*)(X1 + (size_t)row * D + k), xb = *(const f32x4*)(X1 + (size_t)row * D + k + 4);
                const f32x4 ga = *(LAS const f32x4*)(GS + k), gb = *(LAS const f32x4*)(GS + k + 4);
                const f32x4 ha = *(LAS const f32x4*)(SH + k), hb = *(LAS const f32x4*)(SH + k + 4);
                const f32x4 ya = xa * rstd * ga + ha, yb = xb * rstd * gb + hb;
                v4u w; w.x = cvtpk(ya.x, ya.y); w.y = cvtpk(ya.z, ya.w); w.z = cvtpk(yb.x, yb.y); w.w = cvtpk(yb.z, yb.w);
                *(v4u*)(H2 + (size_t)row * D + k) = w;
                const pg8::bf16x8 a = __builtin_bit_cast(pg8::bf16x8, w);
#pragma unroll
                for (int nt = 0; nt < 3; ++nt) { const pg8::bf16x8 bw = *(const pg8::bf16x8*)(WrT + (size_t)(16 * nt + r) * D + k); acc[nt] = MFMA16(a, bw, acc[nt]); }
            }
            LAS float* dst = kh ? LG2 : LG;
#pragma unroll
            for (int nt = 0; nt < 3; ++nt)
#pragma unroll
                for (int i = 0; i < 4; ++i) dst[(4 * kg + i) * 52 + 16 * nt + r] = acc[nt][i];
        }
        __syncthreads();
        if (act && kh == 0 && lane < 16) {
            LAS const float* lg = LG + lane * 52; LAS const float* lg2 = LG2 + lane * 52;
            float gl[4]; int grp = 0;
#pragma unroll
            for (int i = 0; i < 4; ++i) gl[i] = lg[32 + i] + lg2[32 + i] + F.b_group[i];
#pragma unroll
            for (int i = 1; i < 4; ++i) if (gl[i] > gl[grp]) grp = i;
            const float gmax = (grp == 0) ? gl[0] : (grp == 1) ? gl[1] : (grp == 2) ? gl[2] : gl[3];
            float den = 0.f;
#pragma unroll
            for (int i = 0; i < 4; ++i) den += expf(gl[i] - gmax);
            const float pg = 1.f / den;
            float ev[8];
#pragma unroll
            for (int i = 0; i < 8; ++i) ev[i] = lg[grp * 8 + i] + lg2[grp * 8 + i] + F.b_router[grp * 8 + i];
            int i1 = 0; float v1 = ev[0];
#pragma unroll
            for (int i = 1; i < 8; ++i) if (ev[i] > v1) { v1 = ev[i]; i1 = i; }
            int i2 = -1; float v2 = -3.0e38f;
#pragma unroll
            for (int i = 0; i < 8; ++i) if (i != i1 && ev[i] > v2) { v2 = ev[i]; i2 = i; }
            const float t = expf(v2 - v1);
            w1 = pg / (1.f + t); w2 = pg * t / (1.f + t);
            e1 = grp * 8 + i1; e2 = grp * 8 + i2;
            lr1 = (int)atomicAdd((unsigned*)&F.LX[32 + e1], 1u); lr2 = (int)atomicAdd((unsigned*)&F.LX[32 + e2], 1u);
        }
        __syncthreads();
        if (F.tid < 32) { const unsigned c = F.LX[32 + F.tid]; F.LX[64 + F.tid] = c ? atomicAdd((unsigned*)(F.ctl + CW_CNT + F.tid), c) : 0u; }
        __syncthreads();
        if (act && kh == 0 && lane < 16) { const int row = item * 16 + lane;
            const int p1 = e1 * ECAP + (int)F.LX[64 + e1] + lr1, p2 = e2 * ECAP + (int)F.LX[64 + e2] + lr2;
            TOKSLOT[p1] = 2 * row; WROW[p1] = w1; TOKSLOT[p2] = 2 * row + 1; WROW[p2] = w2; }
    }
}
__device__ __forceinline__ void p10_final(Frame& F, float* dst) {
    const int gw = F.vcu * NWAVES + F.wave, NGW = F.G * NWAVES;
    const float* MOD = (const float*)(F.ws + WS_MOD); const bf16* YC = (const bf16*)(F.ws + WS_YC);
    for (int m = gw; m < M; m += NGW) {
        const int b = m >> 12;
        GAS f32x4* xr = (GAS f32x4*)(F.out + (size_t)m * D) + F.lane;
        const GAS unsigned long long* y0 = (const GAS unsigned long long*)(YC + (size_t)(2 * m) * D) + F.lane;
        const GAS unsigned long long* y1 = (const GAS unsigned long long*)(YC + (size_t)(2 * m + 1) * D) + F.lane;
        f32x4 v[4]; float s = 0.f;
#pragma unroll
        for (int j = 0; j < 4; ++j) { const int col = 4 * F.lane + 256 * j;
            const f32x4 x1 = xr[64 * j]; const unsigned long long a = y0[64 * j], c = y1[64 * j];
            const f32x4 gt = *(const f32x4*)(MOD + b * 6144 + 5120 + col);
            f32x4 y; y.x = bflo((unsigned)a) + bflo((unsigned)c); y.y = bfhi((unsigned)a) + bfhi((unsigned)c); y.z = bflo((unsigned)(a >> 32)) + bflo((unsigned)(c >> 32)); y.w = bfhi((unsigned)(a >> 32)) + bfhi((unsigned)(c >> 32));
            v[j] = x1 + gt * y; s += (v[j].x * v[j].x + v[j].y * v[j].y) + (v[j].z * v[j].z + v[j].w * v[j].w); }
        const float rstd = 1.f / sqrtf(wave_sum(s) * (1.f / D) + RMS_EPS);
        GAS f32x4* orow = (GAS f32x4*)(dst + (size_t)m * D) + F.lane;
#pragma unroll
        for (int j = 0; j < 4; ++j) { const int col = 4 * F.lane + 256 * j; const f32x4 g = *(const f32x4*)(F.g_final + col); orow[64 * j] = v[j] * rstd * g; }
    }
}

struct Args { const void* in[20]; float* out; unsigned char* ws; int ph_lo, ph_hi; };
__global__ void __launch_bounds__(NWAVES * 64, 2) hybrid_fwd(Args args) {
    extern __shared__ __attribute__((aligned(16))) unsigned char lds[];
    Frame F;
    F.lds = lds; F.ldsl = (LAS unsigned char*)lds; F.LX = (volatile LAS unsigned*)(F.ldsl + LX_OFF);
    F.tid = threadIdx.x; F.lane = F.tid & 63; F.wave = __builtin_amdgcn_readfirstlane(F.tid >> 6);
    F.G = gridDim.x; { const int bx = blockIdx.x; F.vcu = (F.G % 8 == 0) ? (bx % 8) * (F.G / 8) + bx / 8 : bx; }
    F.ws = args.ws; F.ctl = (gu32*)(args.ws + WS_CTL); F.out = args.out;
    F.x = (const float*)args.in[0]; F.c = (const float*)args.in[1]; F.positions = (const int*)args.in[2]; F.w_mod = (const float*)args.in[3]; F.b_mod = (const float*)args.in[4];
    F.g_mix = (const float*)args.in[5]; F.w_in = (const float*)args.in[6]; F.b_forget = (const float*)args.in[7]; F.w_out_a = (const float*)args.in[8]; F.w_out_b = (const float*)args.in[9];
    F.w_out = (const float*)args.in[10]; F.g_ffn = (const float*)args.in[11]; F.w_group = (const float*)args.in[12]; F.b_group = (const float*)args.in[13]; F.w_router = (const float*)args.in[14];
    F.b_router = (const float*)args.in[15]; F.w_e_gate = (const float*)args.in[16]; F.w_e_up = (const float*)args.in[17]; F.w_e_down = (const float*)args.in[18]; F.g_final = (const float*)args.in[19];
    for (int u = F.tid; u < (LDS_BYTES - LX_OFF) / 4; u += NWAVES * 64) F.LX[u] = 0u;
    __syncthreads();
    XcdBarrier bar; bar.bar = (unsigned*)(F.ctl + CW_BAR); bar.x = 0; bar.st = nullptr;
    if (N_LAUNCHES == 1) bar = xcd_barrier_post((unsigned*)(F.ctl + CW_BAR), F.LX);
    const int lo = args.ph_lo, hi = args.ph_hi;
#ifndef PH_MASK
#define PH_MASK 0xFFFF
#endif
#define IN(k) (((PH_MASK >> (k)) & 1) && lo <= (k) && (k) < hi)
#define REP(k) for (int rep_ = 0; rep_ <= ((DUP_MASK >> (k)) & 1); ++rep_)
#define SEAM(k) do { if (IN(k) && IN((k) + 1)) { xcd_barrier(bar); if ((DUP_MASK >> 15) & 1) xcd_barrier(bar); } } while (0)
    LAS unsigned char* ring = F.ldsl + RING_OFF;
    if (IN(0)) { REP(0) p0_prologue(F); } SEAM(0);
    if (IN(1)) { REP(1) p1_hnorm(F); } SEAM(1);
    if (IN(2)) {
        pg8::Gemm g{(const pg8::bf16_t*)(F.ws + WS_H), (const pg8::bf16_t*)(F.ws + WS_WIN), M, NPROJ, D}; pg8::StaticOrder S; S.init(M, NPROJ, F.G, (int)blockIdx.x);
        EpiProj E{F.ws, F.b_forget};
        pg8::gemm_phase<EpiProj, pg8::StaticOrder, true, true>(ring, g, S, E);
#if (DUP_MASK >> 2) & 1
        asm volatile("s_waitcnt vmcnt(0)" ::: "memory"); __syncthreads();
        pg8::gemm_phase<EpiProj, pg8::StaticOrder, true, true>(ring, g, S, E);
#endif
    } SEAM(2);
    if (IN(3)) { if ((F.vcu & 1) == 0) { REP(3) p3_fox(F); conv_experts(F); REP(11) p3_dsa(F); } else { REP(11) p3_dsa(F); conv_experts(F); REP(3) p3_fox(F); } } SEAM(3);
    if (IN(4)) {
        static_assert(WS_OB == WS_OA + (size_t)M * 512 * 2 && WS_WOB == WS_WOA + (size_t)1024 * 512 * 2, "stacked operands of the merge GEMM");
        pg8::Gemm g{(const pg8::bf16_t*)(F.ws + WS_OA), (const pg8::bf16_t*)(F.ws + WS_WOA), 2 * M, 2 * D, 512}; MergeOrder S; S.S.init(M, D, F.G, (int)blockIdx.x);
#if (DUP_MASK >> 4) & 1
        { EpiMerge E0{F.ws, WS_QA}; pg8::gemm_phase<EpiMerge, MergeOrder, true, true>(ring, g, S, E0); asm volatile("s_waitcnt vmcnt(0)" ::: "memory"); __syncthreads(); }
#endif
        EpiMerge E{F.ws, WS_GA}; pg8::gemm_phase<EpiMerge, MergeOrder, true, true>(ring, g, S, E);
    } SEAM(4);
    if (IN(5)) {
        pg8::Gemm g{(const pg8::bf16_t*)(F.ws + WS_GA), (const pg8::bf16_t*)(F.ws + WS_WO), M, D, D}; pg8::StaticOrder S; S.init(M, D, F.G, (int)blockIdx.x);
#if (DUP_MASK >> 5) & 1
        { EpiOut E0{F.ws, F.x, (float*)(F.ws + WS_QA), false}; pg8::gemm_phase<EpiOut, pg8::StaticOrder, true, true>(ring, g, S, E0); asm volatile("s_waitcnt vmcnt(0)" ::: "memory"); __syncthreads(); }
#endif
        EpiOut E{F.ws, F.x, F.out, true}; pg8::gemm_phase<EpiOut, pg8::StaticOrder, true, true>(ring, g, S, E);
    } SEAM(5);
    if (IN(6)) { p6_router(F); } SEAM(6);
    if (IN(8)) {
        moe_table(F);
        pg8::Gemm g{(const pg8::bf16_t*)(F.ws + WS_H2), (const pg8::bf16_t*)(F.ws + WS_WGU), PMAX, 32 * 1024, D};
        MoeOrder S{F.G, F.vcu, (int)F.LX[132] * 4, F.LX + 160};
        MoeRowMap RM{(const int*)(F.ws + WS_TOKSLOT), F.LX};
        EpiGU E{F.ws}; REP(8) pg8::gemm_phase_g<EpiGU, MoeOrder, MoeRowMap, true, true>(ring, g, S, E, RM);
    } SEAM(8);
    if (IN(9)) {
        moe_table(F);
        pg8::Gemm g{(const pg8::bf16_t*)(F.ws + WS_HID), (const pg8::bf16_t*)(F.ws + WS_WDN), PMAX, 32 * 1024, 512};
        MoeOrder S{F.G, F.vcu, (int)F.LX[132] * 4, F.LX + 160};
        EpiDown E{F.ws, F.LX}; REP(9) pg8::gemm_phase<EpiDown, MoeOrder, true, true>(ring, g, S, E);
    } SEAM(9);
    if (IN(10)) {
#if (DUP_MASK >> 10) & 1
        p10_final(F, (float*)(F.ws + WS_GA));
#endif
        p10_final(F, F.out); }
#undef IN
#undef SEAM
}

extern "C" void kernel_launch(void* const* d_in, const int* in_sizes, int n_in, void* d_out, int out_size, void* d_ws, size_t ws_size, hipStream_t stream) {
    static int grid = 0;
    if (grid == 0) {
        if (n_in != 20 || in_sizes[0] != M * D || out_size != M * D || ws_size < WS_END) { fprintf(stderr, "kernel_launch: unexpected shapes (n_in %d, in0 %d, out %d, ws %zu); nothing launched\n", n_in, n_in > 0 ? in_sizes[0] : -1, out_size, ws_size); grid = -1; return; }
        int dev = 0, cus = 0, per_cu = 0;
        if (hipGetDevice(&dev) != hipSuccess || hipDeviceGetAttribute(&cus, hipDeviceAttributeMultiprocessorCount, dev) != hipSuccess) { grid = -1; return; }
        if (hipFuncSetAttribute((const void*)hybrid_fwd, hipFuncAttributeMaxDynamicSharedMemorySize, LDS_BYTES) != hipSuccess) { fprintf(stderr, "kernel_launch: hipFuncSetAttribute failed\n"); grid = -1; return; }
        if (hipOccupancyMaxActiveBlocksPerMultiprocessor(&per_cu, (const void*)hybrid_fwd, NWAVES * 64, LDS_BYTES) != hipSuccess || per_cu < 1)
            fprintf(stderr, "kernel_launch: note: occupancy query reports %d workgroups per CU\n", per_cu);
        (void)hipGetLastError();
        grid = cus;
    }
    if (grid < 0) return;
    if (hipMemsetAsync((char*)d_ws + WS_CTL, 0, CTL_ZERO_BYTES, stream) != hipSuccess) { fprintf(stderr, "kernel_launch: hipMemsetAsync failed\n"); return; }
    Args a{};
    for (int i = 0; i < 20; ++i) a.in[i] = d_in[i];
    a.out = (float*)d_out; a.ws = (unsigned char*)d_ws;
    for (int li = 0; li < N_LAUNCHES; ++li) {
        a.ph_lo = (N_LAUNCHES == 1) ? 0 : li; a.ph_hi = (N_LAUNCHES == 1) ? NPHASE : li + 1;
        hipLaunchKernelGGL(hybrid_fwd, dim3(grid), dim3(NWAVES * 64), LDS_BYTES, stream, a);
        const hipError_t le = hipPeekAtLastError();
        if (le != hipSuccess) { fprintf(stderr, "kernel_launch: launch %d failed: %s\n", li, hipGetErrorName(le)); break; }
    }
}
```
